# Optimizing an MI355X kernel written in HIP

```python
import jax, jax.numpy as jnp
from jax import lax
import numpy as np

D_MODEL = 1024
BATCH = 1
SEQ = 16384
DEPTH = 2

D_FF = 2816
NORM_EPS = 1e-6
FFN_RES_WEIGHT = 0.5
GM_WIDTH = 512
GM_GROUPS = 4
GM_CHUNK = 128
RET_HEADS = 4
RET_DK = 64
RET_DV = 128
RET_CHUNK = 128
NSA_HEADS = 8
NSA_KV = 2
NSA_REP = NSA_HEADS // NSA_KV
NSA_DH = 64
CMP_LEN = 32
CMP_STRIDE = 16
CMP_HIDDEN = 128
SLC_BLOCK = 64
N_SELECT = 16
WINDOW = 512
Q_BLOCK = 128
N_NSA_BRANCH = 3
N_MIXERS = 3
MIX_WIDTH = 512
IN_SPLITS = (GM_WIDTH, GM_WIDTH, RET_HEADS * RET_DK, RET_HEADS * RET_DK, RET_HEADS * RET_DV, RET_HEADS * RET_DV, NSA_HEADS * NSA_DH, 6 * NSA_KV * NSA_DH, N_NSA_BRANCH * NSA_HEADS)
D_IN = sum(IN_SPLITS)
BIG = 1e9
NEG = -1e30

kernel_name = 'hybrid_gmlp_retention_nsa_macaron'


def rms_norm(x, g):
    xf = x.astype(jnp.float32)
    y = xf * lax.rsqrt(jnp.mean(xf * xf, axis=-1, keepdims=True) + NORM_EPS)
    return (y * g.astype(jnp.float32)).astype(x.dtype)


def layer_norm(x, g, b):
    xf = x.astype(jnp.float32)
    mu = jnp.mean(xf, axis=-1, keepdims=True)
    xc = xf - mu
    var = jnp.mean(xc * xc, axis=-1, keepdims=True)
    y = xc * lax.rsqrt(var + NORM_EPS) * g.astype(jnp.float32) + b.astype(jnp.float32)
    return y.astype(x.dtype)


def swiglu_ffn(x, w1, w2):
    a, b = jnp.split(x @ w1, 2, axis=-1)
    return (jax.nn.silu(a) * b) @ w2


def masked_softmax(s, mask):
    s = jnp.where(mask, s.astype(jnp.float32), NEG)
    m = jnp.max(s, axis=-1, keepdims=True)
    e = jnp.where(mask, jnp.exp(s - m), 0.0)
    return e / jnp.maximum(jnp.sum(e, axis=-1, keepdims=True), 1e-30)


def alibi_slopes():
    h = jnp.arange(1, NSA_HEADS + 1, dtype=jnp.float32)
    return (2.0 ** (-8.0 * h / NSA_HEADS)).reshape(NSA_KV, NSA_REP)


def gmlp_mixer(u, v, ln_g, ln_b, ws, bs):
    bsz, s, _ = u.shape
    nc = s // GM_CHUNK
    cg = GM_WIDTH // GM_GROUPS
    v = layer_norm(v, ln_g, ln_b).reshape(bsz, nc, GM_CHUNK, GM_GROUPS, cg)
    causal = jnp.tril(jnp.ones((GM_CHUNK, GM_CHUNK), dtype=bool))
    w = jnp.where(causal[None], ws, 0.0)
    sv = jnp.einsum('gts,bnsgc->bntgc', w, v) + jnp.transpose(bs)[None, None, :, :, None]
    return u * sv.reshape(bsz, s, GM_WIDTH)


def retention_mixer(q, k, v, g, gn_g, gn_b):
    f32 = jnp.float32
    bsz, s, _ = q.shape
    nc = s // RET_CHUNK
    q = q.reshape(bsz, nc, RET_CHUNK, RET_HEADS, RET_DK).astype(f32)
    k = (k.reshape(bsz, nc, RET_CHUNK, RET_HEADS, RET_DK) * RET_DK ** -0.5).astype(f32)
    v = v.reshape(bsz, nc, RET_CHUNK, RET_HEADS, RET_DV).astype(f32)
    log_gamma = jnp.log(1.0 - 2.0 ** (-5.0 - jnp.arange(RET_HEADS, dtype=f32)))
    pos = jnp.arange(RET_CHUNK, dtype=f32)
    diff = pos[:, None] - pos[None, :]
    intra_decay = jnp.where(diff >= 0, jnp.exp(log_gamma[:, None, None] * jnp.maximum(diff, 0.0)), 0.0)
    scores = jnp.einsum('bnihd,bnjhd->bnhij', q, k) * intra_decay
    intra = jnp.einsum('bnhij,bnjhe->bnihe', scores, v)
    k_decay = jnp.exp(log_gamma[None, :] * (RET_CHUNK - 1.0 - pos)[:, None])
    kv = jnp.einsum('bnjhd,jh,bnjhe->nbhde', k, k_decay, v)
    chunk_decay = jnp.exp(log_gamma * RET_CHUNK)[None, :, None, None]

    def step(state, kv_c):
        return state * chunk_decay + kv_c, state

    _, prev = lax.scan(step, jnp.zeros((bsz, RET_HEADS, RET_DK, RET_DV), f32), kv)
    q_decay = jnp.exp(log_gamma[None, :] * (pos + 1.0)[:, None])
    cross = jnp.einsum('bnihd,nbhde->bnihe', q, prev) * q_decay[None, None, :, :, None]
    y = layer_norm(intra + cross, gn_g.reshape(RET_HEADS, RET_DV), gn_b.reshape(RET_HEADS, RET_DV))
    return jax.nn.silu(g.astype(f32)) * y.reshape(bsz, s, RET_HEADS * RET_DV)


def nsa_mixer(q, kv, gate_logits, cmp_pos, cmp_w1, cmp_w2):
    f32 = jnp.float32
    bsz, s, _ = q.shape
    n_cmp = s // CMP_STRIDE - 1
    n_slc = s // SLC_BLOCK
    n_sel = min(N_SELECT, n_slc)
    q = q.reshape(bsz, s, NSA_KV, NSA_REP, NSA_DH) * NSA_DH ** -0.5
    k_c, v_c, k_s, v_s, k_w, v_w = [t.reshape(bsz, s, NSA_KV, NSA_DH) for t in jnp.split(kv, 6, axis=-1)]

    def compress(t, pos, w1, w2):
        seg = t.reshape(bsz, s // CMP_STRIDE, CMP_STRIDE, NSA_KV, NSA_DH)
        blocks = jnp.concatenate([seg[:, :-1], seg[:, 1:]], axis=2) + pos[None, None, :, None, :]
        flat = jnp.transpose(blocks, (0, 1, 3, 2, 4)).reshape(bsz, n_cmp, NSA_KV, CMP_LEN * NSA_DH)
        return jax.nn.gelu(flat @ w1) @ w2

    kc = compress(k_c, cmp_pos[0], cmp_w1[0], cmp_w2[0])
    vc = compress(v_c, cmp_pos[1], cmp_w1[1], cmp_w2[1])
    cmp_end = jnp.arange(n_cmp) * CMP_STRIDE + CMP_LEN - 1
    ci = jnp.arange(n_cmp)
    sj = jnp.arange(n_slc)
    overlap = ((ci[:, None] * CMP_STRIDE < (sj[None, :] + 1) * SLC_BLOCK) & (ci[:, None] * CMP_STRIDE + CMP_LEN > sj[None, :] * SLC_BLOCK)).astype(f32)
    ks_blocks = jnp.transpose(k_s.reshape(bsz, n_slc, SLC_BLOCK, NSA_KV, NSA_DH), (0, 3, 1, 2, 4))
    vs_blocks = jnp.transpose(v_s.reshape(bsz, n_slc, SLC_BLOCK, NSA_KV, NSA_DH), (0, 3, 1, 2, 4))
    kw_pad = jnp.pad(k_w, ((0, 0), (WINDOW, 0), (0, 0), (0, 0)))
    vw_pad = jnp.pad(v_w, ((0, 0), (WINDOW, 0), (0, 0), (0, 0)))
    gates = jax.nn.sigmoid(gate_logits.astype(f32)).reshape(bsz, s, NSA_KV, NSA_REP, N_NSA_BRANCH)
    slopes = alibi_slopes()
    bi = jnp.arange(bsz)[:, None, None, None]
    gi = jnp.arange(NSA_KV)[None, :, None, None]

    def block_fn(qb):
        t0 = qb * Q_BLOCK
        qblk = lax.dynamic_slice_in_dim(q, t0, Q_BLOCK, axis=1)
        tpos = t0 + jnp.arange(Q_BLOCK)
        s_c = jnp.einsum('bqgrd,bngd->bgrqn', qblk, kc)
        dist_c = tpos[:, None] - cmp_end[None, :]
        s_c = s_c - slopes[None, :, :, None, None] * dist_c.astype(f32)
        p_c = masked_softmax(s_c, dist_c >= 0)
        o_c = jnp.einsum('bgrqn,bngd->bqgrd', p_c, vc)
        imp = jnp.einsum('bgrqn,nj->bgqj', p_c, overlap)
        cur = tpos // SLC_BLOCK
        jj = sj[None, :]
        forced = (jj == 0) | (jj == cur[:, None]) | (jj == cur[:, None] - 1)
        imp = jnp.where(forced, BIG, imp)
        imp = jnp.where(jj > cur[:, None], -BIG, imp)
        _, sel = lax.top_k(imp, n_sel)
        ks = ks_blocks[bi, gi, sel]
        vs = vs_blocks[bi, gi, sel]
        s_s = jnp.einsum('bqgrd,bgqnkd->bgrqnk', qblk, ks)
        kpos = sel[..., None] * SLC_BLOCK + jnp.arange(SLC_BLOCK)
        dist_s = (tpos[None, None, :, None, None] - kpos)[:, :, None]
        s_s = s_s - slopes[None, :, :, None, None, None] * dist_s.astype(f32)
        m_tot = n_sel * SLC_BLOCK
        p_s = masked_softmax(s_s.reshape(bsz, NSA_KV, NSA_REP, Q_BLOCK, m_tot), (dist_s >= 0).reshape(bsz, NSA_KV, 1, Q_BLOCK, m_tot))
        o_s = jnp.einsum('bgrqm,bgqmd->bqgrd', p_s, vs.reshape(bsz, NSA_KV, Q_BLOCK, m_tot, NSA_DH))
        kw = lax.dynamic_slice_in_dim(kw_pad, t0, Q_BLOCK + WINDOW, axis=1)
        vw = lax.dynamic_slice_in_dim(vw_pad, t0, Q_BLOCK + WINDOW, axis=1)
        wpos = t0 - WINDOW + jnp.arange(Q_BLOCK + WINDOW)
        dist_w = tpos[:, None] - wpos[None, :]
        mask_w = (dist_w >= 0) & (dist_w < WINDOW) & (wpos[None, :] >= 0)
        s_w = jnp.einsum('bqgrd,bkgd->bgrqk', qblk, kw) - slopes[None, :, :, None, None] * dist_w.astype(f32)
        p_w = masked_softmax(s_w, mask_w)
        o_w = jnp.einsum('bgrqk,bkgd->bqgrd', p_w, vw)
        g = lax.dynamic_slice_in_dim(gates, t0, Q_BLOCK, axis=1)
        return g[..., 0:1] * o_c + g[..., 1:2] * o_s + g[..., 2:3] * o_w

    out = lax.map(block_fn, jnp.arange(s // Q_BLOCK))
    return jnp.transpose(out, (1, 0, 2, 3, 4, 5)).reshape(bsz, s, NSA_HEADS * NSA_DH)


def setup_inputs(seed: int = 0) -> dict:
    key = jax.random.key(seed)
    ks = jax.random.split(key, 24)
    L = DEPTH
    f32 = jnp.float32

    def nrm(k, shape, scale):
        return jax.random.normal(k, shape, f32) * scale

    def gain(k, shape):
        return 1.0 + 0.02 * jax.random.normal(k, shape, f32)

    return {
        'x': nrm(ks[0], (BATCH, SEQ, D_MODEL), 1.0),
        'ffn1_norm': gain(ks[1], (L, D_MODEL)),
        'ffn1_w1': nrm(ks[2], (L, D_MODEL, 2 * D_FF), D_MODEL ** -0.5),
        'ffn1_w2': nrm(ks[3], (L, D_FF, D_MODEL), D_FF ** -0.5),
        'mix_norm': gain(ks[4], (L, D_MODEL)),
        'w_in': nrm(ks[5], (L, D_MODEL, D_IN), D_MODEL ** -0.5),
        'gm_ln_g': gain(ks[6], (L, GM_WIDTH)),
        'gm_ln_b': nrm(ks[7], (L, GM_WIDTH), 0.02),
        'gm_ws': nrm(ks[8], (L, GM_GROUPS, GM_CHUNK, GM_CHUNK), GM_CHUNK ** -0.5),
        'gm_bs': gain(ks[9], (L, GM_GROUPS, GM_CHUNK)),
        'ret_gn_g': gain(ks[10], (L, RET_HEADS * RET_DV)),
        'ret_gn_b': nrm(ks[11], (L, RET_HEADS * RET_DV), 0.02),
        'cmp_pos': nrm(ks[12], (L, 2, CMP_LEN, NSA_DH), 0.02),
        'cmp_w1': nrm(ks[13], (L, 2, CMP_LEN * NSA_DH, CMP_HIDDEN), (CMP_LEN * NSA_DH) ** -0.5),
        'cmp_w2': nrm(ks[14], (L, 2, CMP_HIDDEN, NSA_DH), CMP_HIDDEN ** -0.5),
        'w_branch_out': nrm(ks[15], (L, N_MIXERS, MIX_WIDTH, D_MODEL), MIX_WIDTH ** -0.5),
        'w_merge_gate': nrm(ks[16], (L, D_MODEL, N_MIXERS * D_MODEL), D_MODEL ** -0.5),
        'b_merge_gate': nrm(ks[17], (L, N_MIXERS * D_MODEL), 0.02),
        'w_o': nrm(ks[18], (L, D_MODEL, D_MODEL), D_MODEL ** -0.5),
        'ffn2_norm': gain(ks[19], (L, D_MODEL)),
        'ffn2_w1': nrm(ks[20], (L, D_MODEL, 2 * D_FF), D_MODEL ** -0.5),
        'ffn2_w2': nrm(ks[21], (L, D_FF, D_MODEL), D_FF ** -0.5),
        'final_norm': gain(ks[22], (D_MODEL,)),
    }


def reference(x, ffn1_norm, ffn1_w1, ffn1_w2, mix_norm, w_in, gm_ln_g, gm_ln_b, gm_ws, gm_bs, ret_gn_g, ret_gn_b, cmp_pos, cmp_w1, cmp_w2, w_branch_out, w_merge_gate, b_merge_gate, w_o, ffn2_norm, ffn2_w1, ffn2_w2, final_norm):
    splits = np.cumsum(IN_SPLITS)[:-1].tolist()
    for l in range(DEPTH):
        x = x + FFN_RES_WEIGHT * swiglu_ffn(rms_norm(x, ffn1_norm[l]), ffn1_w1[l], ffn1_w2[l])
        h = rms_norm(x, mix_norm[l])
        proj = h @ w_in[l]
        gm_u, gm_v, r_q, r_k, r_v, r_g, n_q, n_kv, n_g = jnp.split(proj, splits, axis=-1)
        y_a = gmlp_mixer(jax.nn.gelu(gm_u), jax.nn.gelu(gm_v), gm_ln_g[l], gm_ln_b[l], gm_ws[l], gm_bs[l])
        y_b = retention_mixer(r_q, r_k, r_v, r_g, ret_gn_g[l], ret_gn_b[l])
        y_c = nsa_mixer(n_q, n_kv, n_g, cmp_pos[l], cmp_w1[l], cmp_w2[l])
        g_a, g_b, g_c = jnp.split(jax.nn.sigmoid(h @ w_merge_gate[l] + b_merge_gate[l]), N_MIXERS, axis=-1)
        mix = g_a * (y_a @ w_branch_out[l, 0]) + g_b * (y_b @ w_branch_out[l, 1]) + g_c * (y_c @ w_branch_out[l, 2])
        x = x + mix @ w_o[l]
        x = x + FFN_RES_WEIGHT * swiglu_ffn(rms_norm(x, ffn2_norm[l]), ffn2_w1[l], ffn2_w2[l])
    return rms_norm(x, final_norm)
```

```cpp
#include <hip/hip_runtime.h>
#include <hip/hip_cooperative_groups.h>
#include <cstdio>
#include <cstdint>
namespace cg = cooperative_groups;

typedef unsigned short u16;
typedef unsigned int u32;
typedef unsigned long long u64;
using bf16x8 = __attribute__((ext_vector_type(8))) short;
using bf16x4 = __attribute__((ext_vector_type(4))) short;
using f32x4 = __attribute__((ext_vector_type(4))) float;

constexpr int S = 16384, FF = 2816, DIN = 3864;
constexpr int PS = 3968;
constexpr int C_U = 0, C_V = 512, C_RQ = 1024, C_RK = 1280, C_RV = 1536, C_RG = 2048, C_NQ = 2560,
              C_KC = 3072, C_VC = 3200, C_KS = 3328, C_VS = 3456, C_KW = 3584, C_VW = 3712, C_NG = 3840, C_MIX = 512;
constexpr float EPS = 1e-6f;
constexpr int SMEM_BYTES = 73728;

struct Params {
  const float* x_in;
  const float *ffn1_norm, *ffn1_w1, *ffn1_w2, *mix_norm, *w_in, *gm_ln_g, *gm_ln_b, *gm_ws, *gm_bs, *ret_gn_g, *ret_gn_b,
      *cmp_pos, *cmp_w1, *cmp_w2, *w_branch, *w_gate, *b_gate, *w_o, *ffn2_norm, *ffn2_w1, *ffn2_w2, *final_norm;
  float* xout;
  u16 *w1t_a, *w2t_a, *wint, *wgt, *wbt, *wot, *w1t_b, *w2t_b, *cw1t, *cw2t;
  u16 *H, *BIG, *vsT, *vwT, *kc, *vcT;
  float* ret;
  u16* gst;
  unsigned* bar;
  float* part; unsigned* ncnt;
};

__device__ __forceinline__ u16 f2bf(float f) { __bf16 b = (__bf16)f; return __builtin_bit_cast(u16, b); }
__device__ __forceinline__ float bf2f(u16 h) { return __uint_as_float(((u32)h) << 16); }
typedef __bf16 bf16x2_t __attribute__((ext_vector_type(2)));
typedef float f32x2_t __attribute__((ext_vector_type(2)));
__device__ __forceinline__ u32 pack2(float a, float b) { f32x2_t v = {a, b}; bf16x2_t r = __builtin_convertvector(v, bf16x2_t); return __builtin_bit_cast(u32, r); }
__device__ __forceinline__ float lo2f(u32 w) { return __uint_as_float(w << 16); }
__device__ __forceinline__ float hi2f(u32 w) { return __uint_as_float(w & 0xffff0000u); }
__device__ __forceinline__ float gelu_t(float x) { float y = 1.5957691216057308f * (x + 0.044715f * x * x * x); return x * __builtin_amdgcn_rcpf(1.0f + __expf(-y)); }
__device__ __forceinline__ float silu_f(float x) { return x * __builtin_amdgcn_rcpf(1.0f + __expf(-x)); }
__device__ __forceinline__ float sigm_f(float x) { return __builtin_amdgcn_rcpf(1.0f + __expf(-x)); }
__device__ __forceinline__ f32x4 mfma16(bf16x8 a, bf16x8 b, f32x4 c) { return __builtin_amdgcn_mfma_f32_16x16x32_bf16(a, b, c, 0, 0, 0); }
__device__ __forceinline__ bf16x8 ld8(const u16* p) { return *(const bf16x8*)p; }
__device__ __forceinline__ bf16x8 ld44(const u16* p0, const u16* p1) {
  bf16x4 a = *(const bf16x4*)p0, b = *(const bf16x4*)p1;
  return __builtin_shufflevector(a, b, 0, 1, 2, 3, 4, 5, 6, 7);
}
__device__ __forceinline__ bf16x8 pk8(float a0, float a1, float a2, float a3, float a4, float a5, float a6, float a7) {
  union { uint4 u; bf16x8 v; } x;
  x.u = make_uint4(pack2(a0, a1), pack2(a2, a3), pack2(a4, a5), pack2(a6, a7));
  return x.v;
}
__device__ __forceinline__ bf16x8 scale8(bf16x8 v, float s) {
  union { uint4 u; bf16x8 v; } x; x.v = v;
  x.u.x = pack2(lo2f(x.u.x) * s, hi2f(x.u.x) * s); x.u.y = pack2(lo2f(x.u.y) * s, hi2f(x.u.y) * s);
  x.u.z = pack2(lo2f(x.u.z) * s, hi2f(x.u.z) * s); x.u.w = pack2(lo2f(x.u.w) * s, hi2f(x.u.w) * s);
  return x.v;
}
__device__ __forceinline__ void wave_lds_sync() { asm volatile("s_waitcnt lgkmcnt(0)" ::: "memory"); }

__device__ __forceinline__ int tid_fresh() { int t = threadIdx.x; asm volatile("" : "+v"(t)); return t; }
__device__ __forceinline__ int wmap(int n, int mode) {
  if (mode == 0) return n;
  int isb = n >= FF; int nn = isb ? n - FF : n;
  return (nn >> 4) * 32 + isb * 16 + (nn & 15);
}
__device__ __forceinline__ void wprep_matrix(const float* __restrict__ src, u16* __restrict__ dst, int K, int N, int mode, u16* smem, int vb, int nvb) {
  float* T = (float*)smem;
  const int tid = tid_fresh() & 255;
  const int tk = K >> 6, tn = (N + 63) >> 6, nt = tk * tn;
  for (int t = vb; t < nt; t += nvb) {
    const int k0 = (t % tk) * 64, n0 = (t / tk) * 64;
#pragma unroll
    for (int i = 0; i < 4; i++) {
      int kk = (tid >> 4) + 16 * i, n = n0 + (tid & 15) * 4;
      float4 v = make_float4(0.f, 0.f, 0.f, 0.f);
      if (n < N) v = *(const float4*)(src + (size_t)(k0 + kk) * N + n);
      float* tp = T + kk * 65 + (tid & 15) * 4;
      tp[0] = v.x; tp[1] = v.y; tp[2] = v.z; tp[3] = v.w;
    }
    __syncthreads();
    {
      int n = tid >> 2, kc = (tid & 3) * 16, nn = n0 + n;
      if (nn < N) {
        u32 w[8];
#pragma unroll
        for (int e = 0; e < 8; e++) w[e] = pack2(T[(kc + 2 * e) * 65 + n], T[(kc + 2 * e + 1) * 65 + n]);
        u16* dp = dst + (size_t)wmap(nn, mode) * K + k0 + kc;
        *(uint4*)dp = make_uint4(w[0], w[1], w[2], w[3]);
        *(uint4*)(dp + 8) = make_uint4(w[4], w[5], w[6], w[7]);
      }
    }
    __syncthreads();
  }
}
__device__ __forceinline__ void wprep_phase(const Params& p, int l, u16* smem, int vb, int nvb) {
  wprep_matrix(p.ffn1_w1 + (size_t)l * 1024 * 5632, p.w1t_a, 1024, 5632, 1, smem, vb, nvb);
  wprep_matrix(p.ffn2_w1 + (size_t)l * 1024 * 5632, p.w1t_b, 1024, 5632, 1, smem, vb, nvb);
  wprep_matrix(p.ffn1_w2 + (size_t)l * FF * 1024, p.w2t_a, FF, 1024, 0, smem, vb, nvb);
  wprep_matrix(p.ffn2_w2 + (size_t)l * FF * 1024, p.w2t_b, FF, 1024, 0, smem, vb, nvb);
  wprep_matrix(p.w_in + (size_t)l * 1024 * DIN, p.wint, 1024, DIN, 0, smem, vb, nvb);
  wprep_matrix(p.w_gate + (size_t)l * 1024 * 3072, p.wgt, 1024, 3072, 0, smem, vb, nvb);
  for (int m = 0; m < 3; m++)
    wprep_matrix(p.w_branch + (size_t)(l * 3 + m) * 512 * 1024, p.wbt + (size_t)m * 1024 * 512, 512, 1024, 0, smem, vb, nvb);
  wprep_matrix(p.w_o + (size_t)l * 1024 * 1024, p.wot, 1024, 1024, 0, smem, vb, nvb);
  for (int w = 0; w < 2; w++) {
    wprep_matrix(p.cmp_w1 + (size_t)(l * 2 + w) * 2048 * 128, p.cw1t + (size_t)w * 128 * 2048, 2048, 128, 0, smem, vb, nvb);
    wprep_matrix(p.cmp_w2 + (size_t)(l * 2 + w) * 128 * 64, p.cw2t + (size_t)w * 64 * 128, 128, 64, 0, smem, vb, nvb);
  }
}

__device__ __forceinline__ void norm_phase(const float* __restrict__ x, const float* __restrict__ g, u16* __restrict__ H) {
  const int tidf = tid_fresh();
  const int lane = tidf & 63;
  const int gw = blockIdx.x * 8 + (tidf >> 6), nw = gridDim.x * 8;
  float4 gg[4];
#pragma unroll
  for (int i = 0; i < 4; i++) gg[i] = ((const float4*)g)[lane + 64 * i];
  for (int row0 = gw * 4; row0 < S; row0 += nw * 4) {
    float4 v[4][4]; float ss[4];
#pragma unroll
    for (int rr = 0; rr < 4; rr++)
#pragma unroll
      for (int i = 0; i < 4; i++) v[rr][i] = ((const float4*)(x + (size_t)(row0 + rr) * 1024))[lane + 64 * i];
#pragma unroll
    for (int rr = 0; rr < 4; rr++) {
      float a = 0.f;
#pragma unroll
      for (int i = 0; i < 4; i++) a += v[rr][i].x * v[rr][i].x + v[rr][i].y * v[rr][i].y + v[rr][i].z * v[rr][i].z + v[rr][i].w * v[rr][i].w;
      ss[rr] = a;
    }
#pragma unroll
    for (int o = 32; o >= 1; o >>= 1)
#pragma unroll
      for (int rr = 0; rr < 4; rr++) ss[rr] += __shfl_xor(ss[rr], o);
#pragma unroll
    for (int rr = 0; rr < 4; rr++) {
      const float r = rsqrtf(ss[rr] * (1.0f / 1024.0f) + EPS);
#pragma unroll
      for (int i = 0; i < 4; i++) {
        uint2 o2 = make_uint2(pack2(v[rr][i].x * r * gg[i].x, v[rr][i].y * r * gg[i].y), pack2(v[rr][i].z * r * gg[i].z, v[rr][i].w * r * gg[i].w));
        *(uint2*)(H + (size_t)(row0 + rr) * 1024 + (lane + 64 * i) * 4) = o2;
      }
    }
  }
}
__device__ __forceinline__ void final_norm_phase(float* __restrict__ x, const float* __restrict__ g) {
  const int tidf = tid_fresh();
  const int lane = tidf & 63;
  const int gw = blockIdx.x * 8 + (tidf >> 6), nw = gridDim.x * 8;
  float4 gg[4];
#pragma unroll
  for (int i = 0; i < 4; i++) gg[i] = ((const float4*)g)[lane + 64 * i];
  for (int row0 = gw * 4; row0 < S; row0 += nw * 4) {
    float4 v[4][4]; float ss[4];
#pragma unroll
    for (int rr = 0; rr < 4; rr++)
#pragma unroll
      for (int i = 0; i < 4; i++) v[rr][i] = ((const float4*)(x + (size_t)(row0 + rr) * 1024))[lane + 64 * i];
#pragma unroll
    for (int rr = 0; rr < 4; rr++) {
      float a = 0.f;
#pragma unroll
      for (int i = 0; i < 4; i++) a += v[rr][i].x * v[rr][i].x + v[rr][i].y * v[rr][i].y + v[rr][i].z * v[rr][i].z + v[rr][i].w * v[rr][i].w;
      ss[rr] = a;
    }
#pragma unroll
    for (int o = 32; o >= 1; o >>= 1)
#pragma unroll
      for (int rr = 0; rr < 4; rr++) ss[rr] += __shfl_xor(ss[rr], o);
#pragma unroll
    for (int rr = 0; rr < 4; rr++) {
      const float r = rsqrtf(ss[rr] * (1.0f / 1024.0f) + EPS);
#pragma unroll
      for (int i = 0; i < 4; i++)
        ((float4*)(x + (size_t)(row0 + rr) * 1024))[lane + 64 * i] = make_float4(v[rr][i].x * r * gg[i].x, v[rr][i].y * r * gg[i].y, v[rr][i].z * r * gg[i].z, v[rr][i].w * r * gg[i].w);
    }
  }
}

#define LAS __attribute__((address_space(3)))
constexpr int G_BK = 64, G_HALF = 128, G_HTB = G_HALF * G_BK * 2, G_NXCD = 8, G_WGM = 8;
__device__ __forceinline__ int lds_byte(int r, int c) { const int st = (r >> 4) * 2 + (c >> 5), rr = r & 15, cc = c & 31, ob = rr * 64 + cc * 2; return st * 1024 + (ob ^ (((ob >> 9) & 1) << 5)); }
__device__ __forceinline__ void stage_rc(int b, int& R, int& C) { const int st = b / 1024, sb = b % 1024, swz = sb ^ (((sb >> 9) & 1) << 5); R = (st >> 1) * 16 + swz / 64; C = (st & 1) * 32 + (swz % 64) / 2; }
__device__ __forceinline__ int perm32(int rho) { const int n = rho >> 4, i = rho & 15; return 8 * (i >> 2) + 4 * n + (i & 3); }
struct Unit { int pm, pn; };
struct Gemm { const u16* A; const u16* Bt; int lda, ldb, M, N, K; };
struct StaticOrder {
  int nM, nN, nwg, G, c;
  __device__ void init(int M, int N, int G_, int c_) { nM = M / 256; nN = N / 256; nwg = nM * nN; G = G_; c = c_; }
  __device__ bool next(int i, Unit& u) const {
    const long L = (long)i * G + c; if (L >= nwg) return false;
    int wgid = (int)L; { const int q = nwg / G_NXCD, r = nwg % G_NXCD, xcd = wgid % G_NXCD, off = wgid / G_NXCD; wgid = (xcd < r ? xcd * (q + 1) : r * (q + 1) + (xcd - r) * q) + off; }
    const int nig = G_WGM * nN, gid = wgid / nig, fm = gid * G_WGM, gsz = (nM - fm) < G_WGM ? (nM - fm) : G_WGM;
    u.pm = fm + ((wgid % nig) % gsz); u.pn = (wgid % nig) / gsz; return true;
  }
};
typedef f32x4 AccT[2][2][4][2];
struct EpiSwiglu {
  static constexpr bool PERM = false;
  u16* ACT;
  __device__ __forceinline__ void operator()(const AccT& acc, const Unit& u, int wr, int wc, int fr, int fq) const {
    const int row0 = u.pm * 256 + wr * 64 + fr, col0 = u.pn * 128 + wc * 16 + 4 * fq;
#pragma unroll
    for (int ai = 0; ai < 2; ++ai)
#pragma unroll
      for (int m = 0; m < 4; ++m) {
        u16* rowp = ACT + (size_t)(row0 + ai * 128 + m * 16) * FF + col0;
#pragma unroll
        for (int bj = 0; bj < 2; ++bj) {
          const f32x4 a = acc[ai][bj][m][0], b = acc[ai][bj][m][1];
          { typedef unsigned u32x2n __attribute__((ext_vector_type(2))); const u32x2n val = {pack2(silu_f(a[0]) * b[0], silu_f(a[1]) * b[1]), pack2(silu_f(a[2]) * b[2], silu_f(a[3]) * b[3])};
            __builtin_nontemporal_store(val, (u32x2n*)(rowp + bj * 64)); }
        }
      }
  }
};
struct EpiResid {
  static constexpr bool PERM = false;
  const float* xsrc; float* xdst; float scale;
  __device__ __forceinline__ void operator()(const AccT& acc, const Unit& u, int wr, int wc, int fr, int fq) const {
    const int row0 = u.pm * 256 + wr * 64 + fr, col0 = u.pn * 256 + wc * 32 + 4 * fq;
#pragma unroll
    for (int ai = 0; ai < 2; ++ai) {
      f32x4 xv[4][2][2];
#pragma unroll
      for (int m = 0; m < 4; ++m)
#pragma unroll
        for (int bj = 0; bj < 2; ++bj)
#pragma unroll
          for (int n = 0; n < 2; ++n)
            xv[m][bj][n] = *(const f32x4*)(xsrc + (size_t)(row0 + ai * 128 + m * 16) * 1024 + col0 + bj * 128 + n * 16);
#pragma unroll
      for (int m = 0; m < 4; ++m)
#pragma unroll
        for (int bj = 0; bj < 2; ++bj)
#pragma unroll
          for (int n = 0; n < 2; ++n)
            *(f32x4*)(xdst + (size_t)(row0 + ai * 128 + m * 16) * 1024 + col0 + bj * 128 + n * 16) = xv[m][bj][n] + scale * acc[ai][bj][m][n];
    }
  }
};
struct EpiProj {
  static constexpr bool PERM = true;
  u16* proj;
  __device__ __forceinline__ void operator()(const AccT& acc, const Unit& u, int wr, int wc, int fr, int fq) const {
    const int row0 = u.pm * 256 + wr * 64 + fr, col0 = u.pn * 256 + wc * 32 + 8 * fq;
#pragma unroll
    for (int ai = 0; ai < 2; ++ai)
#pragma unroll
      for (int m = 0; m < 4; ++m) {
        u16* rowp = proj + (size_t)(row0 + ai * 128 + m * 16) * PS;
#pragma unroll
        for (int bj = 0; bj < 2; ++bj) {
          const int col = col0 + bj * 128;
          const f32x4 a = acc[ai][bj][m][0], b = acc[ai][bj][m][1];
          if (col < DIN) *(uint4*)(rowp + col) = make_uint4(pack2(a[0], a[1]), pack2(a[2], a[3]), pack2(b[0], b[1]), pack2(b[2], b[3]));
        }
      }
  }
};
struct EpiGate {
  static constexpr bool PERM = true;
  u16* gst; const float* bias; int tid;
  __device__ __forceinline__ void operator()(const AccT& acc, const Unit& u, int wr, int wc, int fr, int fq) const {
    u16* st = gst + (size_t)(u.pm * 4 + u.pn) * 65536 + tid * 8;
    const int col0 = u.pn * 256 + wc * 32 + 8 * fq;
#pragma unroll
    for (int bj = 0; bj < 2; ++bj) {
      const f32x4 b0 = *(const f32x4*)(bias + col0 + bj * 128), b1 = *(const f32x4*)(bias + col0 + bj * 128 + 4);
#pragma unroll
      for (int ai = 0; ai < 2; ++ai)
#pragma unroll
        for (int m = 0; m < 4; ++m) {
          const f32x4 a = acc[ai][bj][m][0] + b0, b = acc[ai][bj][m][1] + b1;
          *(uint4*)(st + ((ai * 2 + bj) * 4 + m) * 4096) = make_uint4(pack2(sigm_f(a[0]), sigm_f(a[1])), pack2(sigm_f(a[2]), sigm_f(a[3])),
                                                                     pack2(sigm_f(b[0]), sigm_f(b[1])), pack2(sigm_f(b[2]), sigm_f(b[3])));
        }
    }
  }
};
struct EpiBranch {
  static constexpr bool PERM = true;
  const u16* gst; u16* mix; int first; int tid;
  __device__ __forceinline__ void operator()(const AccT& acc, const Unit& u, int wr, int wc, int fr, int fq) const {
    const u16* st = gst + (size_t)(u.pm * 4 + u.pn) * 65536 + tid * 8;
    const int row0 = u.pm * 256 + wr * 64 + fr, col0 = u.pn * 256 + wc * 32 + 8 * fq;
#pragma unroll
    for (int ai = 0; ai < 2; ++ai) {
      uint4 gw[4][2], ov[4][2];
#pragma unroll
      for (int m = 0; m < 4; ++m)
#pragma unroll
        for (int bj = 0; bj < 2; ++bj) {
          gw[m][bj] = *(const uint4*)(st + ((ai * 2 + bj) * 4 + m) * 4096);
          ov[m][bj] = first ? make_uint4(0u, 0u, 0u, 0u) : *(const uint4*)(mix + (size_t)(row0 + ai * 128 + m * 16) * PS + col0 + bj * 128);
        }
#pragma unroll
      for (int m = 0; m < 4; ++m)
#pragma unroll
        for (int bj = 0; bj < 2; ++bj) {
          const uint4 g = gw[m][bj], o = ov[m][bj];
          const f32x4 a = acc[ai][bj][m][0], b = acc[ai][bj][m][1];
          const float v0 = lo2f(g.x) * a[0] + lo2f(o.x), v1 = hi2f(g.x) * a[1] + hi2f(o.x), v2 = lo2f(g.y) * a[2] + lo2f(o.y), v3 = hi2f(g.y) * a[3] + hi2f(o.y);
          const float v4 = lo2f(g.z) * b[0] + lo2f(o.z), v5 = hi2f(g.z) * b[1] + hi2f(o.z), v6 = lo2f(g.w) * b[2] + lo2f(o.w), v7 = hi2f(g.w) * b[3] + hi2f(o.w);
          *(uint4*)(mix + (size_t)(row0 + ai * 128 + m * 16) * PS + col0 + bj * 128) = make_uint4(pack2(v0, v1), pack2(v2, v3), pack2(v4, v5), pack2(v6, v7));
        }
    }
  }
};

template <class Epi, bool AFTER_DRAIN = false>
__device__ __forceinline__ void gemm_phase(LAS unsigned char* lds, const Gemm g, const Epi& E) {
  const int tid = tid_fresh(), wid = __builtin_amdgcn_readfirstlane(tid >> 6), lane = tid & 63, wr = wid >> 2, wc = wid & 3, fr = lane & 15, fq = lane >> 4;
  const int K = g.K, nt = K / G_BK;
  StaticOrder S; S.init(g.M, g.N, (int)gridDim.x, (int)blockIdx.x);
  unsigned voffA[2], voffB[2];
#pragma unroll
  for (int i = 0; i < 2; ++i) { int R, C; stage_rc(tid * 16 + i * 8192, R, C); const int Rb = Epi::PERM ? ((R & ~31) + perm32(R & 31)) : R;
    voffA[i] = (unsigned)(R * g.lda + C) * 2u; voffB[i] = (unsigned)(Rb * g.ldb + C) * 2u; }
  const size_t kstep = (size_t)(G_BK * 2);
  const size_t hstepA = (size_t)G_HALF * g.lda * 2, hstepB = (size_t)G_HALF * g.ldb * 2;
  const size_t tstepA = 2 * hstepA, tstepB = 2 * hstepB;
  const unsigned ldsw = (unsigned)wid * 1024u;
  const int aoff = lds_byte(wr * 64 + fr, fq * 8), boff = lds_byte(wc * 32 + fr, fq * 8);
#define PG8_SA(b, h) (((b) * 2 + (h)) * G_HTB)
#define PG8_SB(b, h) ((4 + (b) * 2 + (h)) * G_HTB)
#define PG8_STAGE(bufoff, gbase, voff) do { _Pragma("unroll") for (int _i = 0; _i < 2; ++_i) \
    __builtin_amdgcn_global_load_lds((const unsigned*)((const char*)(gbase) + (voff)[_i]), (LAS unsigned*)(lds + (bufoff) + ldsw + _i * 8192), 16, 0, 0); } while (0)
#define PG8_LDA(dst, b, h) do { _Pragma("unroll") for (int m = 0; m < 4; ++m) _Pragma("unroll") for (int k = 0; k < 2; ++k) dst[m][k] = *(const LAS bf16x8*)(lds + PG8_SA(b, h) + aoff + m * 2048 + k * 1024); } while (0)
#define PG8_LDB(dst, b, h) do { _Pragma("unroll") for (int n = 0; n < 2; ++n) _Pragma("unroll") for (int k = 0; k < 2; ++k) dst[n][k] = *(const LAS bf16x8*)(lds + PG8_SB(b, h) + boff + n * 2048 + k * 1024); } while (0)
#define PG8_MMA(ai, bj, At, Bt) do { __builtin_amdgcn_s_setprio(1); _Pragma("unroll") for (int m = 0; m < 4; ++m) _Pragma("unroll") for (int n = 0; n < 2; ++n) _Pragma("unroll") for (int k = 0; k < 2; ++k) \
    acc[ai][bj][m][n] = __builtin_amdgcn_mfma_f32_16x16x32_bf16(Bt[n][k], At[m][k], acc[ai][bj][m][n], 0, 0, 0); __builtin_amdgcn_s_setprio(0); } while (0)
#define PG8_WAIT_V(n) asm volatile("s_waitcnt vmcnt(" #n ")" ::: "memory")
#define PG8_WAIT_L(n) asm volatile("s_waitcnt lgkmcnt(" #n ")" ::: "memory")
#define PG8_BAR __builtin_amdgcn_s_barrier()
#define PG8_SCHED __builtin_amdgcn_sched_barrier(0)
  Unit cur, nxt; int ui = 0;
  if (!S.next(0, cur)) return;
  AccT acc;
#pragma unroll
  for (int a = 0; a < 2; ++a)
#pragma unroll
    for (int b = 0; b < 2; ++b)
#pragma unroll
      for (int m = 0; m < 4; ++m)
#pragma unroll
        for (int n = 0; n < 2; ++n) acc[a][b][m][n] = (f32x4){0.f, 0.f, 0.f, 0.f};
  bf16x8 At[4][2], B0[2][2], B1[2][2];
  const char* cA = (const char*)g.A + (size_t)cur.pm * tstepA; const char* cB = (const char*)g.Bt + (size_t)cur.pn * tstepB;
  PG8_STAGE(PG8_SB(0, 0), cB, voffB); PG8_STAGE(PG8_SA(0, 0), cA, voffA); PG8_STAGE(PG8_SB(0, 1), cB + hstepB, voffB); PG8_STAGE(PG8_SA(0, 1), cA + hstepA, voffA);
  if (wr == 1) PG8_BAR;
  PG8_WAIT_V(4); PG8_BAR;
  PG8_STAGE(PG8_SB(1, 0), cB + kstep, voffB); PG8_STAGE(PG8_SA(1, 0), cA + kstep, voffA); PG8_STAGE(PG8_SB(1, 1), cB + hstepB + kstep, voffB);
  PG8_WAIT_V(6); PG8_BAR;
  for (;;) {
    const bool has_next = S.next(ui + 1, nxt);
    const char* nA = has_next ? (const char*)g.A + (size_t)nxt.pm * tstepA : cA; const char* nB = has_next ? (const char*)g.Bt + (size_t)nxt.pn * tstepB : cB;
    for (int t = 0; t < nt; t += 2) {
      const bool last = (t == nt - 2);
      const char* a1 = cA + (size_t)(t + 1) * kstep;
      const char* a2 = last ? nA : cA + (size_t)(t + 2) * kstep; const char* b2 = last ? nB : cB + (size_t)(t + 2) * kstep;
      const char* a3 = a2 + kstep; const char* b3 = b2 + kstep;
      PG8_LDB(B0, 0, 0); PG8_SCHED; PG8_LDA(At, 0, 0); PG8_STAGE(PG8_SA(1, 1), a1 + hstepA, voffA);
      PG8_WAIT_L(8); PG8_BAR; PG8_WAIT_L(0); PG8_MMA(0, 0, At, B0); PG8_BAR; PG8_SCHED;
      PG8_LDB(B1, 0, 1); PG8_STAGE(PG8_SB(0, 0), b2, voffB);
      PG8_BAR; PG8_WAIT_L(0); PG8_MMA(0, 1, At, B1); PG8_BAR;
      PG8_LDA(At, 0, 1); PG8_STAGE(PG8_SA(0, 0), a2, voffA);
      PG8_BAR; PG8_WAIT_L(0); PG8_MMA(1, 0, At, B0); PG8_BAR; PG8_SCHED;
      PG8_STAGE(PG8_SB(0, 1), b2 + hstepB, voffB);
      PG8_WAIT_V(6); PG8_BAR; PG8_MMA(1, 1, At, B1); PG8_BAR;
      PG8_LDB(B0, 1, 0); PG8_SCHED; PG8_LDA(At, 1, 0); PG8_STAGE(PG8_SA(0, 1), a2 + hstepA, voffA);
      PG8_WAIT_L(8); PG8_BAR; PG8_WAIT_L(0); PG8_MMA(0, 0, At, B0); PG8_BAR; PG8_SCHED;
      PG8_LDB(B1, 1, 1); PG8_STAGE(PG8_SB(1, 0), b3, voffB);
      PG8_BAR; PG8_WAIT_L(0); PG8_MMA(0, 1, At, B1); PG8_BAR;
      PG8_LDA(At, 1, 1); PG8_STAGE(PG8_SA(1, 0), a3, voffA);
      PG8_BAR; PG8_WAIT_L(0); PG8_MMA(1, 0, At, B0); PG8_BAR; PG8_SCHED;
      PG8_STAGE(PG8_SB(1, 1), b3 + hstepB, voffB);
      PG8_WAIT_V(6); PG8_BAR; PG8_MMA(1, 1, At, B1); PG8_BAR;
    }
    if constexpr (!AFTER_DRAIN) E(acc, cur, wr, wc, fr, fq);
    if (!has_next) break;
#pragma unroll
    for (int a = 0; a < 2; ++a)
#pragma unroll
      for (int b = 0; b < 2; ++b)
#pragma unroll
        for (int m = 0; m < 4; ++m)
#pragma unroll
          for (int n = 0; n < 2; ++n) acc[a][b][m][n] = (f32x4){0.f, 0.f, 0.f, 0.f};
    cur = nxt; cA = nA; cB = nB; ++ui;
  }
  PG8_WAIT_V(0);
  if (wr == 0) PG8_BAR;
  PG8_BAR;
  if constexpr (AFTER_DRAIN) E.fused(acc, cur, wr, wc, fr, fq, lds);
#undef PG8_SA
#undef PG8_SB
#undef PG8_STAGE
#undef PG8_LDA
#undef PG8_LDB
#undef PG8_MMA
#undef PG8_WAIT_V
#undef PG8_WAIT_L
#undef PG8_BAR
#undef PG8_SCHED
}

struct ChainStep { const char* A; const char* B; unsigned lda2, ldb2; int nt; };
__device__ __forceinline__ ChainStep merge_step(const Params& p, int q, const Unit& u) {
  const int s6 = q % 6, br = s6 >> 1;
  ChainStep c;
  if ((s6 & 1) == 0) {
    c.A = (const char*)(p.H + (size_t)u.pm * 256 * 1024); c.lda2 = 2048u;
    c.B = (const char*)(p.wgt + (size_t)(br * 1024 + u.pn * 256) * 1024); c.ldb2 = 2048u; c.nt = 16;
  } else {
    const int ycol = br == 0 ? C_U : (br == 1 ? C_RG : C_NQ);
    c.A = (const char*)(p.BIG + ycol + (size_t)u.pm * 256 * PS); c.lda2 = (unsigned)PS * 2u;
    c.B = (const char*)(p.wbt + (size_t)(br * 1024 + u.pn * 256) * 512); c.ldb2 = 1024u; c.nt = 8;
  }
  return c;
}
__device__ __forceinline__ void gemm_merge_chain(LAS unsigned char* lds, const Params& p, int l) {
  const int tid = tid_fresh(), wid = __builtin_amdgcn_readfirstlane(tid >> 6), lane = tid & 63, wr = wid >> 2, wc = wid & 3, fr = lane & 15, fq = lane >> 4;
  StaticOrder S; S.init(16384, 1024, (int)gridDim.x, (int)blockIdx.x);
  unsigned rA[2], c2[2];
#pragma unroll
  for (int i = 0; i < 2; ++i) { int R, C; stage_rc(tid * 16 + i * 8192, R, C); rA[i] = (unsigned)R; c2[i] = (unsigned)C * 2u; }
  const size_t kstep = (size_t)(G_BK * 2);
  const unsigned ldsw = (unsigned)wid * 1024u;
  const int aoff = lds_byte(wr * 64 + fr, fq * 8), boff = lds_byte(wc * 32 + fr, fq * 8);
#define PG8_SA(b, h) (((b) * 2 + (h)) * G_HTB)
#define PG8_SB(b, h) ((4 + (b) * 2 + (h)) * G_HTB)
#define CH_ROW_rA(i) (rA[i])
#define CH_ROW_rB(i) ((rA[i] & ~31u) + (unsigned)perm32((int)(rA[i] & 31u)))
#define CH_STAGE(bufoff, gbase, rr, ld2) do { _Pragma("unroll") for (int _i = 0; _i < 2; ++_i) \
    __builtin_amdgcn_global_load_lds((const unsigned*)((const char*)(gbase) + (CH_ROW_##rr(_i) * (ld2) + c2[_i])), (LAS unsigned*)(lds + (bufoff) + ldsw + _i * 8192), 16, 0, 0); } while (0)
#define PG8_LDA(dst, b, h) do { _Pragma("unroll") for (int m = 0; m < 4; ++m) _Pragma("unroll") for (int k = 0; k < 2; ++k) dst[m][k] = *(const LAS bf16x8*)(lds + PG8_SA(b, h) + aoff + m * 2048 + k * 1024); } while (0)
#define PG8_LDB(dst, b, h) do { _Pragma("unroll") for (int n = 0; n < 2; ++n) _Pragma("unroll") for (int k = 0; k < 2; ++k) dst[n][k] = *(const LAS bf16x8*)(lds + PG8_SB(b, h) + boff + n * 2048 + k * 1024); } while (0)
#define PG8_MMA(ai, bj, At, Bt) do { __builtin_amdgcn_s_setprio(1); _Pragma("unroll") for (int m = 0; m < 4; ++m) _Pragma("unroll") for (int n = 0; n < 2; ++n) _Pragma("unroll") for (int k = 0; k < 2; ++k) \
    acc[ai][bj][m][n] = __builtin_amdgcn_mfma_f32_16x16x32_bf16(Bt[n][k], At[m][k], acc[ai][bj][m][n], 0, 0, 0); __builtin_amdgcn_s_setprio(0); } while (0)
#define PG8_WAIT_V(n) asm volatile("s_waitcnt vmcnt(" #n ")" ::: "memory")
#define PG8_WAIT_L(n) asm volatile("s_waitcnt lgkmcnt(" #n ")" ::: "memory")
#define PG8_BAR __builtin_amdgcn_s_barrier()
#define PG8_SCHED __builtin_amdgcn_sched_barrier(0)
  Unit cu, nu; int q = 0;
  if (!S.next(0, cu)) return;
  ChainStep cs = merge_step(p, 0, cu), ns;
  AccT acc;
#pragma unroll
  for (int a = 0; a < 2; ++a)
#pragma unroll
    for (int b = 0; b < 2; ++b)
#pragma unroll
      for (int m = 0; m < 4; ++m)
#pragma unroll
        for (int n = 0; n < 2; ++n) acc[a][b][m][n] = (f32x4){0.f, 0.f, 0.f, 0.f};
  bf16x8 At[4][2], B0[2][2], B1[2][2];
  {
    const size_t hA = (size_t)G_HALF * cs.lda2, hB = (size_t)G_HALF * cs.ldb2;
    CH_STAGE(PG8_SB(0, 0), cs.B, rB, cs.ldb2); CH_STAGE(PG8_SA(0, 0), cs.A, rA, cs.lda2); CH_STAGE(PG8_SB(0, 1), cs.B + hB, rB, cs.ldb2); CH_STAGE(PG8_SA(0, 1), cs.A + hA, rA, cs.lda2);
    if (wr == 1) PG8_BAR;
    PG8_WAIT_V(4); PG8_BAR;
    CH_STAGE(PG8_SB(1, 0), cs.B + kstep, rB, cs.ldb2); CH_STAGE(PG8_SA(1, 0), cs.A + kstep, rA, cs.lda2); CH_STAGE(PG8_SB(1, 1), cs.B + hB + kstep, rB, cs.ldb2);
    PG8_WAIT_V(6); PG8_BAR;
  }
  for (;;) {
    bool has_next;
    if ((q + 1) % 6 != 0) { nu = cu; has_next = true; } else has_next = S.next((q + 1) / 6, nu);
    ns = has_next ? merge_step(p, q + 1, nu) : cs;
    const size_t hA = (size_t)G_HALF * cs.lda2, hB = (size_t)G_HALF * cs.ldb2;
    const size_t nhA = (size_t)G_HALF * ns.lda2, nhB = (size_t)G_HALF * ns.ldb2;
    const int nt = cs.nt;
    for (int t = 0; t < nt; t += 2) {
      const bool last = (t == nt - 2);
      const char* a1 = cs.A + (size_t)(t + 1) * kstep;
      const char* a2 = last ? ns.A : cs.A + (size_t)(t + 2) * kstep; const char* b2 = last ? ns.B : cs.B + (size_t)(t + 2) * kstep;
      const char* a3 = a2 + kstep; const char* b3 = b2 + kstep;
      const unsigned la2 = last ? ns.lda2 : cs.lda2, lb2 = last ? ns.ldb2 : cs.ldb2;
      const size_t hA2 = last ? nhA : hA, hB2 = last ? nhB : hB;
      PG8_LDB(B0, 0, 0); PG8_SCHED; PG8_LDA(At, 0, 0); CH_STAGE(PG8_SA(1, 1), a1 + hA, rA, cs.lda2);
      PG8_WAIT_L(8); PG8_BAR; PG8_WAIT_L(0); PG8_MMA(0, 0, At, B0); PG8_BAR; PG8_SCHED;
      PG8_LDB(B1, 0, 1); CH_STAGE(PG8_SB(0, 0), b2, rB, lb2);
      PG8_BAR; PG8_WAIT_L(0); PG8_MMA(0, 1, At, B1); PG8_BAR;
      PG8_LDA(At, 0, 1); CH_STAGE(PG8_SA(0, 0), a2, rA, la2);
      PG8_BAR; PG8_WAIT_L(0); PG8_MMA(1, 0, At, B0); PG8_BAR; PG8_SCHED;
      CH_STAGE(PG8_SB(0, 1), b2 + hB2, rB, lb2);
      PG8_WAIT_V(6); PG8_BAR; PG8_MMA(1, 1, At, B1); PG8_BAR;
      PG8_LDB(B0, 1, 0); PG8_SCHED; PG8_LDA(At, 1, 0); CH_STAGE(PG8_SA(0, 1), a2 + hA2, rA, la2);
      PG8_WAIT_L(8); PG8_BAR; PG8_WAIT_L(0); PG8_MMA(0, 0, At, B0); PG8_BAR; PG8_SCHED;
      PG8_LDB(B1, 1, 1); CH_STAGE(PG8_SB(1, 0), b3, rB, lb2);
      PG8_BAR; PG8_WAIT_L(0); PG8_MMA(0, 1, At, B1); PG8_BAR;
      PG8_LDA(At, 1, 1); CH_STAGE(PG8_SA(1, 0), a3, rA, la2);
      PG8_BAR; PG8_WAIT_L(0); PG8_MMA(1, 0, At, B0); PG8_BAR; PG8_SCHED;
      CH_STAGE(PG8_SB(1, 1), b3 + hB2, rB, lb2);
      PG8_WAIT_V(6); PG8_BAR; PG8_MMA(1, 1, At, B1); PG8_BAR;
    }
    {
      const int s6 = q % 6, br = s6 >> 1;
      if ((s6 & 1) == 0) { EpiGate e{p.gst, p.b_gate + (size_t)l * 3072 + br * 1024, tid}; e(acc, cu, wr, wc, fr, fq); }
      else { EpiBranch e{p.gst, p.BIG + C_MIX, br == 0, tid}; e(acc, cu, wr, wc, fr, fq); }
    }
    if (!has_next) break;
#pragma unroll
    for (int a = 0; a < 2; ++a)
#pragma unroll
      for (int b = 0; b < 2; ++b)
#pragma unroll
        for (int m = 0; m < 4; ++m)
#pragma unroll
          for (int n = 0; n < 2; ++n) acc[a][b][m][n] = (f32x4){0.f, 0.f, 0.f, 0.f};
    cu = nu; cs = ns; ++q;
  }
  PG8_WAIT_V(0);
  if (wr == 0) PG8_BAR;
  PG8_BAR;
#undef PG8_SA
#undef PG8_SB
#undef CH_STAGE
#undef CH_ROW_rA
#undef CH_ROW_rB
#undef PG8_LDA
#undef PG8_LDB
#undef PG8_MMA
#undef PG8_WAIT_V
#undef PG8_WAIT_L
#undef PG8_BAR
#undef PG8_SCHED
}

__device__ __forceinline__ void gmlp_tile(const Params& p, int l, int tile, u16* smem) {
  const int c = tile >> 2, g = tile & 3, t0 = c * 128;
  u16* Ws = smem; u16* vT = smem + 128 * 136;
  const int tid = tid_fresh() & 255, lane = tid & 63, wave = tid >> 6, wm = wave >> 1, wn = wave & 1, lr = lane & 15, lq = lane >> 4;
  const int tok = tid >> 1, half = tid & 1;
  u16* prow = p.BIG + (size_t)(t0 + tok) * PS;
  float s = 0.f, ss = 0.f;
#pragma unroll 8
  for (int i = 0; i < 32; i++) {
    uint4 raw = *(const uint4*)(prow + C_V + half * 256 + i * 8);
    u32 w[4] = {raw.x, raw.y, raw.z, raw.w};
#pragma unroll
    for (int e = 0; e < 4; e++) { float a = gelu_t(lo2f(w[e])), b = gelu_t(hi2f(w[e])); s += a + b; ss += a * a + b * b; }
  }
  s += __shfl_xor(s, 1); ss += __shfl_xor(ss, 1);
  const float mean = s * (1.0f / 512.0f);
  const float rstd = rsqrtf(fmaxf(ss * (1.0f / 512.0f) - mean * mean, 0.f) + EPS);
  const float* lg = p.gm_ln_g + l * 512 + g * 128; const float* lb = p.gm_ln_b + l * 512 + g * 128;
#pragma unroll
  for (int i = 0; i < 8; i++) {
    uint4 raw = *(const uint4*)(prow + C_V + g * 128 + half * 64 + i * 8);
    u32 w[4] = {raw.x, raw.y, raw.z, raw.w};
#pragma unroll
    for (int e = 0; e < 4; e++) {
      int cc = half * 64 + i * 8 + 2 * e;
      vT[cc * 136 + tok] = f2bf((gelu_t(lo2f(w[e])) - mean) * rstd * lg[cc] + lb[cc]);
      vT[(cc + 1) * 136 + tok] = f2bf((gelu_t(hi2f(w[e])) - mean) * rstd * lg[cc + 1] + lb[cc + 1]);
    }
  }
  const float* wrow = p.gm_ws + ((size_t)(l * 4 + g) * 128 + tok) * 128 + half * 64;
#pragma unroll
  for (int i = 0; i < 16; i++) {
    float4 w = ((const float4*)wrow)[i];
    int s0 = half * 64 + i * 4;
    uint2 o = make_uint2(pack2(s0 <= tok ? w.x : 0.f, s0 + 1 <= tok ? w.y : 0.f), pack2(s0 + 2 <= tok ? w.z : 0.f, s0 + 3 <= tok ? w.w : 0.f));
    *(uint2*)(Ws + tok * 136 + s0) = o;
  }
  __syncthreads();
  f32x4 acc[4][4];
#pragma unroll
  for (int m = 0; m < 4; m++)
#pragma unroll
    for (int n = 0; n < 4; n++) acc[m][n] = (f32x4){0.f, 0.f, 0.f, 0.f};
#pragma unroll
  for (int kk = 0; kk < 4; kk++) {
    bf16x8 a[4], b[4];
#pragma unroll
    for (int m = 0; m < 4; m++) a[m] = ld8(Ws + (wm * 64 + m * 16 + lr) * 136 + kk * 32 + lq * 8);
#pragma unroll
    for (int n = 0; n < 4; n++) b[n] = ld8(vT + (wn * 64 + n * 16 + lr) * 136 + kk * 32 + lq * 8);
#pragma unroll
    for (int m = 0; m < 4; m++)
#pragma unroll
      for (int n = 0; n < 4; n++) acc[m][n] = mfma16(b[n], a[m], acc[m][n]);
  }
  const float* bsp = p.gm_bs + (size_t)(l * 4 + g) * 128;
  uint2 uv[4][4];
#pragma unroll
  for (int m = 0; m < 4; m++)
#pragma unroll
    for (int n = 0; n < 4; n++)
      uv[m][n] = *(const uint2*)(p.BIG + (size_t)(t0 + wm * 64 + m * 16 + lr) * PS + C_U + g * 128 + wn * 64 + n * 16 + lq * 4);
#pragma unroll
  for (int m = 0; m < 4; m++) {
    const float bias = bsp[wm * 64 + m * 16 + lr];
#pragma unroll
    for (int n = 0; n < 4; n++) {
      const uint2 u = uv[m][n];
      *(uint2*)(p.BIG + (size_t)(t0 + wm * 64 + m * 16 + lr) * PS + C_U + g * 128 + wn * 64 + n * 16 + lq * 4) =
          make_uint2(pack2(gelu_t(lo2f(u.x)) * (acc[m][n][0] + bias), gelu_t(hi2f(u.x)) * (acc[m][n][1] + bias)),
                     pack2(gelu_t(lo2f(u.y)) * (acc[m][n][2] + bias), gelu_t(hi2f(u.y)) * (acc[m][n][3] + bias)));
    }
  }
  __syncthreads();
}

__device__ __forceinline__ void ret_kv_tile(const Params& p, int tile, u16* smem) {
  const int c = tile >> 2, h = tile & 3, t0 = c * 128;
  u16* vT = smem; u16* kT = smem + 128 * 136;
  const int tid = tid_fresh() & 255, lane = tid & 63, wave = tid >> 6, lr = lane & 15, lq = lane >> 4;
  const int tok = tid >> 1, half = tid & 1;
  const float lg = logf(1.0f - exp2f(-5.0f - (float)h));
  const u16* prow = p.BIG + (size_t)(t0 + tok) * PS;
#pragma unroll
  for (int i = 0; i < 8; i++) {
    uint4 raw = *(const uint4*)(prow + C_RV + h * 128 + half * 64 + i * 8);
    u32 w[4] = {raw.x, raw.y, raw.z, raw.w};
#pragma unroll
    for (int e = 0; e < 4; e++) {
      int cc = half * 64 + i * 8 + 2 * e;
      vT[cc * 136 + tok] = (u16)(w[e] & 0xffff);
      vT[(cc + 1) * 136 + tok] = (u16)(w[e] >> 16);
    }
  }
  const float sc = 0.125f * expf(lg * (float)(127 - tok));
#pragma unroll
  for (int i = 0; i < 4; i++) {
    uint4 raw = *(const uint4*)(prow + C_RK + h * 64 + half * 32 + i * 8);
    u32 w[4] = {raw.x, raw.y, raw.z, raw.w};
#pragma unroll
    for (int e = 0; e < 4; e++) {
      int cc = half * 32 + i * 8 + 2 * e;
      kT[cc * 136 + tok] = f2bf(lo2f(w[e]) * sc);
      kT[(cc + 1) * 136 + tok] = f2bf(hi2f(w[e]) * sc);
    }
  }
  __syncthreads();
  f32x4 acc[2][4];
#pragma unroll
  for (int m = 0; m < 2; m++)
#pragma unroll
    for (int n = 0; n < 4; n++) acc[m][n] = (f32x4){0.f, 0.f, 0.f, 0.f};
#pragma unroll
  for (int kk = 0; kk < 4; kk++) {
    bf16x8 a[2], b[4];
#pragma unroll
    for (int m = 0; m < 2; m++) a[m] = ld8(vT + (wave * 32 + m * 16 + lr) * 136 + kk * 32 + lq * 8);
#pragma unroll
    for (int n = 0; n < 4; n++) b[n] = ld8(kT + (n * 16 + lr) * 136 + kk * 32 + lq * 8);
#pragma unroll
    for (int m = 0; m < 2; m++)
#pragma unroll
      for (int n = 0; n < 4; n++) acc[m][n] = mfma16(a[m], b[n], acc[m][n]);
  }
  float* rp = p.ret + (size_t)(c * 4 + h) * 8192;
#pragma unroll
  for (int m = 0; m < 2; m++)
#pragma unroll
    for (int n = 0; n < 4; n++)
#pragma unroll
      for (int j = 0; j < 4; j++) rp[(wave * 32 + m * 16 + lq * 4 + j) * 64 + n * 16 + lr] = acc[m][n][j];
  __syncthreads();
}
__device__ __forceinline__ void ret_scan_wg(const Params& p, unsigned char* sm) {
  const int tid = tid_fresh(), seg = tid >> 7, el = tid & 127;
  float* endv = (float*)sm;
  for (int e0 = blockIdx.x * 128; e0 < 32768; e0 += gridDim.x * 128) {
    const int h = e0 >> 13;
    const float cd = expf(logf(1.0f - exp2f(-5.0f - (float)h)) * 128.0f);
    const float cd2 = cd * cd, cd4 = cd2 * cd2, cd8 = cd4 * cd4, cd16 = cd8 * cd8, cd32 = cd16 * cd16;
    float* base = p.ret + (size_t)(seg * 32) * 32768 + e0 + el;
    float v[32];
#pragma unroll
    for (int i = 0; i < 32; i++) v[i] = base[(size_t)i * 32768];
    float st = 0.f;
#pragma unroll
    for (int i = 0; i < 32; i++) st = st * cd + v[i];
    endv[seg * 128 + el] = st;
    __syncthreads();
    float carry = 0.f;
    for (int s2 = 0; s2 < seg; s2++) carry = carry * cd32 + endv[s2 * 128 + el];
    __syncthreads();
    st = carry;
#pragma unroll
    for (int i = 0; i < 32; i++) { base[(size_t)i * 32768] = st; st = st * cd + v[i]; }
  }
}
__device__ __forceinline__ void ret_out_tile(const Params& p, int l, int tile, u16* smem) {
  const int c = tile >> 2, h = tile & 3, t0 = c * 128;
  u16* vT = smem;
  u16* kS = smem + 128 * 136;
  u16* pT = kS + 128 * 72;
  const int tid = tid_fresh() & 255, lane = tid & 63, wave = tid >> 6, lr = lane & 15, lq = lane >> 4;
  const int tok = tid >> 1, half = tid & 1;
  const float lg = logf(1.0f - exp2f(-5.0f - (float)h));
  {
    const u16* prow = p.BIG + (size_t)(t0 + tok) * PS;
#pragma unroll
    for (int i = 0; i < 8; i++) {
      uint4 raw = *(const uint4*)(prow + C_RV + h * 128 + half * 64 + i * 8);
      u32 w[4] = {raw.x, raw.y, raw.z, raw.w};
#pragma unroll
      for (int e = 0; e < 4; e++) {
        int cc = half * 64 + i * 8 + 2 * e;
        vT[cc * 136 + tok] = (u16)(w[e] & 0xffff);
        vT[(cc + 1) * 136 + tok] = (u16)(w[e] >> 16);
      }
    }
#pragma unroll
    for (int i = 0; i < 4; i++)
      *(uint4*)(kS + tok * 72 + half * 32 + i * 8) = *(const uint4*)(prow + C_RK + h * 64 + half * 32 + i * 8);
    const float* rp = p.ret + (size_t)(c * 4 + h) * 8192 + tok * 64 + half * 32;
#pragma unroll
    for (int i = 0; i < 4; i++) {
      float4 a = ((const float4*)rp)[2 * i], b = ((const float4*)rp)[2 * i + 1];
      *(uint4*)(pT + tok * 72 + half * 32 + i * 8) = make_uint4(pack2(a.x, a.y), pack2(a.z, a.w), pack2(b.x, b.y), pack2(b.z, b.w));
    }
  }
  __syncthreads();
#pragma unroll 1
  for (int it = 0; it < 2; it++) {
    const int i = wave * 32 + it * 16 + lr;
    const u16* qp = p.BIG + (size_t)(t0 + i) * PS + C_RQ + h * 64 + lq * 8;
    const bf16x8 q_lo = ld8(qp), q_hi = ld8(qp + 32);
    f32x4 Y[8];
#pragma unroll
    for (int e = 0; e < 8; e++) Y[e] = (f32x4){0.f, 0.f, 0.f, 0.f};
    const int nch = ((wave * 32 + it * 16 + 15) >> 5) + 1;
    for (int jc = 0; jc < nch; jc++) {
      f32x4 s0 = (f32x4){0.f, 0.f, 0.f, 0.f}, s1 = s0;
      const u16* kp = kS + (jc * 32 + lr) * 72 + lq * 8;
      s0 = mfma16(ld8(kp), q_lo, s0); s0 = mfma16(ld8(kp + 32), q_hi, s0);
      s1 = mfma16(ld8(kp + 16 * 72), q_lo, s1); s1 = mfma16(ld8(kp + 16 * 72 + 32), q_hi, s1);
      float pv[8];
#pragma unroll
      for (int j = 0; j < 4; j++) {
        int d0 = i - (jc * 32 + lq * 4 + j), d1 = d0 - 16;
        pv[j] = d0 >= 0 ? s0[j] * 0.125f * __expf(lg * (float)d0) : 0.f;
        pv[4 + j] = d1 >= 0 ? s1[j] * 0.125f * __expf(lg * (float)d1) : 0.f;
      }
      const bf16x8 pb = pk8(pv[0], pv[1], pv[2], pv[3], pv[4], pv[5], pv[6], pv[7]);
#pragma unroll
      for (int e = 0; e < 8; e++) {
        const u16* vp = vT + (e * 16 + lr) * 136 + jc * 32 + lq * 4;
        Y[e] = mfma16(ld44(vp, vp + 16), pb, Y[e]);
      }
    }
    {
      const float qd = __expf(lg * (float)(i + 1));
      const bf16x8 ql = scale8(q_lo, qd), qh = scale8(q_hi, qd);
#pragma unroll
      for (int e = 0; e < 8; e++) {
        const u16* pp = pT + (e * 16 + lr) * 72 + lq * 8;
        Y[e] = mfma16(ld8(pp), ql, Y[e]);
        Y[e] = mfma16(ld8(pp + 32), qh, Y[e]);
      }
    }
    float s = 0.f, ss = 0.f;
#pragma unroll
    for (int e = 0; e < 8; e++)
#pragma unroll
      for (int j = 0; j < 4; j++) { s += Y[e][j]; ss += Y[e][j] * Y[e][j]; }
    s += __shfl_xor(s, 16); ss += __shfl_xor(ss, 16);
    s += __shfl_xor(s, 32); ss += __shfl_xor(ss, 32);
    const float mean = s * (1.0f / 128.0f);
    const float rstd = rsqrtf(fmaxf(ss * (1.0f / 128.0f) - mean * mean, 0.f) + EPS);
    u16* gp = p.BIG + (size_t)(t0 + i) * PS + C_RG + h * 128;
    const float* gg = p.ret_gn_g + l * 512 + h * 128; const float* gb = p.ret_gn_b + l * 512 + h * 128;
    uint2 grawv[8];
#pragma unroll
    for (int e = 0; e < 8; e++) grawv[e] = *(const uint2*)(gp + e * 16 + lq * 4);
#pragma unroll
    for (int e = 0; e < 8; e++) {
      const int e0 = e * 16 + lq * 4;
      const uint2 graw = grawv[e];
      float4 g4 = *(const float4*)(gg + e0), b4 = *(const float4*)(gb + e0);
      float y0 = (Y[e][0] - mean) * rstd * g4.x + b4.x, y1 = (Y[e][1] - mean) * rstd * g4.y + b4.y;
      float y2 = (Y[e][2] - mean) * rstd * g4.z + b4.z, y3 = (Y[e][3] - mean) * rstd * g4.w + b4.w;
      *(uint2*)(gp + e0) = make_uint2(pack2(silu_f(lo2f(graw.x)) * y0, silu_f(hi2f(graw.x)) * y1),
                                      pack2(silu_f(lo2f(graw.y)) * y2, silu_f(hi2f(graw.y)) * y3));
    }
  }
  __syncthreads();
}

__device__ __forceinline__ void cmp_tile(const Params& p, int l, int tile, u16* smem) {
  const int which = tile >> 6, g = (tile >> 5) & 1, ci0 = (tile & 31) * 32;
  const int tid = tid_fresh() & 255, lane = tid & 63, wave = tid >> 6, lr = lane & 15, lq = lane >> 4;
  float* part = (float*)smem;
  u16* hid = smem + 32768;
  const int colbase = (which ? C_VC : C_KC) + g * 64;
  const float* pos = p.cmp_pos + (size_t)(l * 2 + which) * 32 * 64;
  const u16* w1t = p.cw1t + (size_t)which * 128 * 2048;
  f32x4 acc[2][8];
#pragma unroll
  for (int m = 0; m < 2; m++)
#pragma unroll
    for (int n = 0; n < 8; n++) acc[m][n] = (f32x4){0.f, 0.f, 0.f, 0.f};
  int cir0 = ci0 + lr, cir1 = ci0 + 16 + lr;
  if (cir0 > 1022) cir0 = 1022;
  if (cir1 > 1022) cir1 = 1022;
#pragma unroll 4
  for (int ks = 0; ks < 16; ks++) {
    const int kk = wave * 512 + ks * 32 + lq * 8, toff = kk >> 6, dim = kk & 63;
    const float4 p0 = *(const float4*)(pos + toff * 64 + dim), p1 = *(const float4*)(pos + toff * 64 + dim + 4);
    bf16x8 a[2], b[8];
#pragma unroll
    for (int m = 0; m < 2; m++) {
      const int cr = m == 0 ? cir0 : cir1;
      uint4 raw = *(const uint4*)(p.BIG + (size_t)(cr * 16 + toff) * PS + colbase + dim);
      a[m] = pk8(lo2f(raw.x) + p0.x, hi2f(raw.x) + p0.y, lo2f(raw.y) + p0.z, hi2f(raw.y) + p0.w,
                 lo2f(raw.z) + p1.x, hi2f(raw.z) + p1.y, lo2f(raw.w) + p1.z, hi2f(raw.w) + p1.w);
    }
#pragma unroll
    for (int n = 0; n < 8; n++) b[n] = ld8(w1t + (size_t)(n * 16 + lr) * 2048 + kk);
#pragma unroll
    for (int m = 0; m < 2; m++)
#pragma unroll
      for (int n = 0; n < 8; n++) acc[m][n] = mfma16(a[m], b[n], acc[m][n]);
  }
#pragma unroll
  for (int m = 0; m < 2; m++)
#pragma unroll
    for (int n = 0; n < 8; n++)
#pragma unroll
      for (int j = 0; j < 4; j++) part[wave * 4096 + (m * 16 + lq * 4 + j) * 128 + n * 16 + lr] = acc[m][n][j];
  __syncthreads();
  for (int e = tid; e < 4096; e += 256) {
    const float v = part[e] + part[4096 + e] + part[8192 + e] + part[12288 + e];
    hid[e] = f2bf(gelu_t(v));
  }
  __syncthreads();
  f32x4 o[2] = {(f32x4){0.f, 0.f, 0.f, 0.f}, (f32x4){0.f, 0.f, 0.f, 0.f}};
  const u16* w2t = p.cw2t + (size_t)which * 64 * 128;
#pragma unroll
  for (int kk = 0; kk < 4; kk++) {
    bf16x8 bb = ld8(w2t + (wave * 16 + lr) * 128 + kk * 32 + lq * 8);
#pragma unroll
    for (int m = 0; m < 2; m++) o[m] = mfma16(ld8(hid + (m * 16 + lr) * 128 + kk * 32 + lq * 8), bb, o[m]);
  }
#pragma unroll
  for (int m = 0; m < 2; m++)
#pragma unroll
    for (int j = 0; j < 4; j++) {
      int ci = ci0 + m * 16 + lq * 4 + j, d = wave * 16 + lr;
      u16 v = ci < 1023 ? f2bf(o[m][j]) : (u16)0;
      if (which == 0) p.kc[(size_t)(g * 1024 + ci) * 64 + d] = v;
      else p.vcT[(size_t)(g * 64 + d) * 1024 + ci] = v;
    }
  __syncthreads();
}
__device__ __forceinline__ void vt_tile(const Params& p, int tile, u16* smem) {
  const int sw = tile >> 9, g = (tile >> 8) & 1, t0 = (tile & 255) * 64;
  const int tid = tid_fresh() & 255;
  u16* T = smem;
  const int col = (sw ? C_VW : C_VS) + g * 64;
  {
    const int tok = tid >> 2, dq = (tid & 3) * 16;
    const u16* src = p.BIG + (size_t)(t0 + tok) * PS + col + dq;
    uint4 r0 = *(const uint4*)src, r1 = *(const uint4*)(src + 8);
    u32 w[8] = {r0.x, r0.y, r0.z, r0.w, r1.x, r1.y, r1.z, r1.w};
#pragma unroll
    for (int e = 0; e < 8; e++) { T[(dq + 2 * e) * 72 + tok] = (u16)(w[e] & 0xffff); T[(dq + 2 * e + 1) * 72 + tok] = (u16)(w[e] >> 16); }
  }
  __syncthreads();
  {
    const int d = tid >> 2, tq = (tid & 3) * 16;
    u16* dst = (sw ? p.vwT : p.vsT) + (size_t)(g * 64 + d) * S + t0 + tq;
    *(uint4*)dst = *(const uint4*)(T + d * 72 + tq);
    *(uint4*)(dst + 8) = *(const uint4*)(T + d * 72 + tq + 8);
  }
  __syncthreads();
}

constexpr int NT_ST = 72;
constexpr int NT_EL = 64 * NT_ST;
__device__ __forceinline__ float quad_sum(float x) {
  x += __uint_as_float((u32)__builtin_amdgcn_mov_dpp((int)__float_as_uint(x), 0xB1, 0xF, 0xF, true));
  x += __uint_as_float((u32)__builtin_amdgcn_mov_dpp((int)__float_as_uint(x), 0x4E, 0xF, 0xF, true));
  return x;
}
__device__ __forceinline__ void qk64(const u16* kt, int lr, int lq, bf16x8 q_lo, bf16x8 q_hi, f32x4 (&s)[2][2]) {
#pragma unroll
  for (int c = 0; c < 2; c++)
#pragma unroll
    for (int t = 0; t < 2; t++) {
      const u16* kp = kt + (c * 32 + t * 16 + lr) * NT_ST + lq * 8;
      f32x4 a = s[c][t];
      a = mfma16(ld8(kp), q_lo, a); a = mfma16(ld8(kp + 32), q_hi, a);
      s[c][t] = a;
    }
}
__device__ __forceinline__ float ex2(float x) { return __builtin_amdgcn_exp2f(x); }
template <bool FAST>
__device__ __forceinline__ void attend_tile(const u16* kt, const u16* vt, int lr, int lq, bf16x8 q_lo, bf16x8 q_hi, float slope2, int dbase,
                                            bool rowsel, int win, float& m, float& lsum, f32x4 (&O)[4]) {
  f32x4 s[2][2];
  float sv[16];
  float mx = -1e30f;
  if (FAST) {
    const float binit = rowsel ? -slope2 * (float)(dbase - lq * 4) : -1e30f;
#pragma unroll
    for (int c = 0; c < 2; c++)
#pragma unroll
      for (int t = 0; t < 2; t++)
#pragma unroll
        for (int j = 0; j < 4; j++) s[c][t][j] = __builtin_fmaf(slope2, (float)(c * 32 + t * 16 + j), binit);
    qk64(kt, lr, lq, q_lo, q_hi, s);
#pragma unroll
    for (int c = 0; c < 2; c++)
#pragma unroll
      for (int t = 0; t < 2; t++)
#pragma unroll
        for (int j = 0; j < 4; j++) { sv[(c * 2 + t) * 4 + j] = s[c][t][j]; mx = fmaxf(mx, s[c][t][j]); }
  } else {
#pragma unroll
    for (int c = 0; c < 2; c++)
#pragma unroll
      for (int t = 0; t < 2; t++) s[c][t] = (f32x4){0.f, 0.f, 0.f, 0.f};
    qk64(kt, lr, lq, q_lo, q_hi, s);
#pragma unroll
    for (int c = 0; c < 2; c++)
#pragma unroll
      for (int t = 0; t < 2; t++)
#pragma unroll
        for (int j = 0; j < 4; j++) {
          const int d = dbase - (c * 32 + t * 16 + lq * 4 + j);
          const bool o = rowsel && d >= 0 && d < win;
          const float v = o ? s[c][t][j] - slope2 * (float)d : -1e30f;
          sv[(c * 2 + t) * 4 + j] = v;
          mx = fmaxf(mx, v);
        }
  }
  if (__any(mx > m)) {
    mx = fmaxf(mx, __shfl_xor(mx, 16)); mx = fmaxf(mx, __shfl_xor(mx, 32));
    const float mnew = fmaxf(m, mx);
    const float alpha = ex2(m - mnew);
    m = mnew;
    lsum *= alpha;
#pragma unroll
    for (int dt = 0; dt < 4; dt++)
#pragma unroll
      for (int j = 0; j < 4; j++) O[dt][j] *= alpha;
  }
  const float mn = m;
  float ps = 0.f;
  bf16x8 pb[2];
#pragma unroll
  for (int c = 0; c < 2; c++) {
    float pv[8];
#pragma unroll
    for (int j = 0; j < 8; j++) {
      const float v = sv[c * 8 + j];
      pv[j] = FAST ? ex2(v - mn) : (v > -1e29f ? ex2(v - mn) : 0.f);
      ps += pv[j];
    }
    pb[c] = pk8(pv[0], pv[1], pv[2], pv[3], pv[4], pv[5], pv[6], pv[7]);
  }
  lsum += ps;
#pragma unroll
  for (int dt = 0; dt < 4; dt++)
#pragma unroll
    for (int c = 0; c < 2; c++) {
      const u16* vp = vt + (dt * 16 + lr) * NT_ST + c * 32 + lq * 4;
      O[dt] = mfma16(ld44(vp, vp + 16), pb[c], O[dt]);
    }
}

template <bool HASV, class KS, class VS, class CF>
__device__ __forceinline__ void tile_pipe2(int n, u16* ktb, u16* vtb, int soff, KS ksrc, VS vsrc, CF compute) {
  uint4 kE, vE, kO, vO;
  kE = vE = kO = vO = make_uint4(0u, 0u, 0u, 0u);
  if (n > 0) { kE = *(const uint4*)ksrc(0); if (HASV) vE = *(const uint4*)vsrc(0); }
  if (n > 1) { kO = *(const uint4*)ksrc(1); if (HASV) vO = *(const uint4*)vsrc(1); }
  if (n > 0) { *(uint4*)(ktb + soff) = kE; if (HASV) *(uint4*)(vtb + soff) = vE; }
  __syncthreads();
#pragma unroll 1
  for (int i = 0; i < n; i += 2) {
    if (i + 2 < n) { kE = *(const uint4*)ksrc(i + 2); if (HASV) vE = *(const uint4*)vsrc(i + 2); }
    compute(i, ktb, vtb);
    if (i + 1 < n) { *(uint4*)(ktb + NT_EL + soff) = kO; if (HASV) *(uint4*)(vtb + NT_EL + soff) = vO; }
    __syncthreads();
    if (i + 1 >= n) break;
    if (i + 3 < n) { kO = *(const uint4*)ksrc(i + 3); if (HASV) vO = *(const uint4*)vsrc(i + 3); }
    compute(i + 1, ktb + NT_EL, vtb + NT_EL);
    if (i + 2 < n) { *(uint4*)(ktb + soff) = kE; if (HASV) *(uint4*)(vtb + soff) = vE; }
    __syncthreads();
  }
}

__device__ __forceinline__ void nsa_wg(const Params& p, int g, int T0, unsigned char* sm) {
  const int tid = tid_fresh(), lane = tid & 63, lr = lane & 15, lq = lane >> 4;
  const int wv = __builtin_amdgcn_readfirstlane(tid >> 6);
  const int t0 = T0 + wv * 4;
  const int tok = lr >> 2, r = lr & 3, tpos = t0 + tok;
  const float slope = 1.4426950408889634f * exp2f(-(float)(g * 4 + r + 1));
  u16* proj = p.BIG;
  float* wl = (float*)sm + wv * 2112;
  float* impA = wl; float* impB = wl + 1024; u32* selm = (u32*)(wl + 1024 + 1040);
  u16* ktb = (u16*)(sm + 67584);
  u16* vtb = ktb + 2 * NT_EL;
  u32* wgm = (u32*)(vtb + 2 * NT_EL);
  u32* wgu = wgm + 64;
  int* blist = (int*)(wgu + 8);
  const int srow = tid >> 3, sseg = (tid & 7) * 8;
  const int soff = srow * NT_ST + sseg;
  bf16x8 q_lo, q_hi;
  {
    const u16* qp = proj + (size_t)tpos * PS + C_NQ + (g * 4 + r) * 64 + lq * 8;
    q_lo = scale8(ld8(qp), 0.125f * 1.4426950408889634f); q_hi = scale8(ld8(qp + 32), 0.125f * 1.4426950408889634f);
  }
  float g0, g1, g2;
  {
    const u16* gp = proj + (size_t)tpos * PS + C_NG + (g * 4 + r) * 3;
    g0 = sigm_f(bf2f(gp[0])); g1 = sigm_f(bf2f(gp[1])); g2 = sigm_f(bf2f(gp[2]));
  }
  f32x4 outacc[4];
#pragma unroll
  for (int dt = 0; dt < 4; dt++) outacc[dt] = (f32x4){0.f, 0.f, 0.f, 0.f};
  const int cur = T0 >> 6;

  for (int i = lane; i < 1024 + 1040; i += 64) wl[i] = 0.f;
  {
    const int ncmp = (T0 + 31 >= 31) ? ((T0 + 31 - 31) >> 4) + 1 : 0;
    const int nst = (ncmp + 63) >> 6;
    const u16* ksrc = p.kc + (size_t)g * 1024 * 64 + (size_t)srow * 64 + sseg;
    const u16* vsrc = p.vcT + (size_t)(g * 64 + srow) * 1024 + sseg;
    float m = -1e30f, lsum = 0.f;
    tile_pipe2<false>(nst, ktb, vtb, soff,
      [&](int i) { return ksrc + (size_t)(nst - 1 - i) * 4096; }, [&](int i) { return ksrc; },
      [&](int i, const u16* kt, const u16* vt) {
        const int st = nst - 1 - i;
        f32x4 s[2][2];
        float sv[16]; float mx = -1e30f;
        const bool fast = t0 - 31 - 16 * (st * 64 + 63) >= 0;
        if (fast) {
          const float binit = -slope * (float)(tpos - 31 - 16 * (st * 64 + lq * 4)), slope16 = slope * 16.0f;
#pragma unroll
          for (int c = 0; c < 2; c++)
#pragma unroll
            for (int t = 0; t < 2; t++)
#pragma unroll
              for (int j = 0; j < 4; j++) s[c][t][j] = __builtin_fmaf(slope16, (float)(c * 32 + t * 16 + j), binit);
          qk64(kt, lr, lq, q_lo, q_hi, s);
#pragma unroll
          for (int c = 0; c < 2; c++)
#pragma unroll
            for (int t = 0; t < 2; t++)
#pragma unroll
              for (int j = 0; j < 4; j++) { sv[(c * 2 + t) * 4 + j] = s[c][t][j]; mx = fmaxf(mx, s[c][t][j]); }
        } else {
#pragma unroll
          for (int c = 0; c < 2; c++)
#pragma unroll
            for (int t = 0; t < 2; t++) s[c][t] = (f32x4){0.f, 0.f, 0.f, 0.f};
          qk64(kt, lr, lq, q_lo, q_hi, s);
#pragma unroll
          for (int c = 0; c < 2; c++)
#pragma unroll
            for (int t = 0; t < 2; t++)
#pragma unroll
              for (int j = 0; j < 4; j++) {
                const int ci = st * 64 + c * 32 + t * 16 + lq * 4 + j;
                const int d = tpos - (ci * 16 + 31);
                const float v = d >= 0 ? s[c][t][j] - slope * (float)d : -1e30f;
                sv[(c * 2 + t) * 4 + j] = v; mx = fmaxf(mx, v);
              }
        }
        if (__any(mx > m)) {
          mx = fmaxf(mx, __shfl_xor(mx, 16)); mx = fmaxf(mx, __shfl_xor(mx, 32));
          const float mnew = fmaxf(m, mx);
          lsum *= ex2(m - mnew);
          m = mnew;
        }
        const float mn = m;
        float ps = 0.f;
        if (fast) {
#pragma unroll
          for (int j = 0; j < 16; j++) ps += ex2(sv[j] - mn);
        } else {
#pragma unroll
          for (int j = 0; j < 16; j++) ps += sv[j] > -1e29f ? ex2(sv[j] - mn) : 0.f;
        }
        lsum += ps;
      });
    lsum += __shfl_xor(lsum, 16); lsum += __shfl_xor(lsum, 32);
    const float invL = lsum > 0.f ? 1.0f / lsum : 0.f;
    f32x4 O[4];
#pragma unroll
    for (int dt = 0; dt < 4; dt++) O[dt] = (f32x4){0.f, 0.f, 0.f, 0.f};
    tile_pipe2<true>(nst, ktb, vtb, soff,
      [&](int st) { return ksrc + (size_t)st * 4096; }, [&](int st) { return vsrc + st * 64; },
      [&](int st, const u16* kt, const u16* vt) {
        f32x4 s[2][2];
        const bool fast = t0 - 31 - 16 * (st * 64 + 63) >= 0;
        if (fast) {
          const float binit = -slope * (float)(tpos - 31 - 16 * (st * 64 + lq * 4)) - m, slope16 = slope * 16.0f;
#pragma unroll
          for (int c = 0; c < 2; c++)
#pragma unroll
            for (int t = 0; t < 2; t++)
#pragma unroll
              for (int j = 0; j < 4; j++) s[c][t][j] = __builtin_fmaf(slope16, (float)(c * 32 + t * 16 + j), binit);
        } else {
#pragma unroll
          for (int c = 0; c < 2; c++)
#pragma unroll
            for (int t = 0; t < 2; t++) s[c][t] = (f32x4){0.f, 0.f, 0.f, 0.f};
        }
        qk64(kt, lr, lq, q_lo, q_hi, s);
        bf16x8 pb[2];
#pragma unroll
        for (int c = 0; c < 2; c++) {
          float p0[4], p1[4];
          if (fast) {
#pragma unroll
            for (int j = 0; j < 4; j++) { p0[j] = ex2(s[c][0][j]) * invL; p1[j] = ex2(s[c][1][j]) * invL; }
          } else {
#pragma unroll
            for (int j = 0; j < 4; j++) {
              const int ci = st * 64 + c * 32 + lq * 4 + j;
              const int d0 = tpos - (ci * 16 + 31), d1 = d0 - 256;
              p0[j] = d0 >= 0 ? ex2(s[c][0][j] - slope * (float)d0 - m) * invL : 0.f;
              p1[j] = d1 >= 0 ? ex2(s[c][1][j] - slope * (float)d1 - m) * invL : 0.f;
            }
          }
          float a0 = p0[0] + p0[1] + p0[2] + p0[3], b0 = p0[3], a1 = p1[0] + p1[1] + p1[2] + p1[3], b1 = p1[3];
          a0 = quad_sum(a0); b0 = quad_sum(b0); a1 = quad_sum(a1); b1 = quad_sum(b1);
          if (r == 0) {
            const int J0 = st * 16 + c * 8 + lq;
            impA[tok * 256 + J0] = a0; impB[tok * 260 + J0 + 1] = b0;
            impA[tok * 256 + J0 + 4] = a1; impB[tok * 260 + J0 + 5] = b1;
          }
          pb[c] = pk8(p0[0], p0[1], p0[2], p0[3], p1[0], p1[1], p1[2], p1[3]);
        }
#pragma unroll
        for (int dt = 0; dt < 4; dt++)
#pragma unroll
          for (int c = 0; c < 2; c++) {
            const u16* vp = vt + (dt * 16 + lr) * NT_ST + c * 32 + lq * 4;
            O[dt] = mfma16(ld44(vp, vp + 16), pb[c], O[dt]);
          }
      });
#pragma unroll
    for (int dt = 0; dt < 4; dt++)
#pragma unroll
      for (int j = 0; j < 4; j++) outacc[dt][j] += g0 * O[dt][j];
  }
  wave_lds_sync();

  if (cur < 16) {
    if (lane < 32) selm[lane] = ((lane & 7) == 0) ? ((2u << cur) - 1u) : 0u;
  } else {
    u32 kk[4][4];
#pragma unroll
    for (int tk = 0; tk < 4; tk++) {
      const float* ia = impA + tk * 256; const float* ib = impB + tk * 260;
#pragma unroll
      for (int i = 0; i < 4; i++) {
        const int j = lane + 64 * i;
        kk[tk][i] = (j >= 1 && j <= cur - 2) ? __float_as_uint(ia[j] + ib[j]) + 1u : 0u;
      }
    }
    u32 T[4] = {0u, 0u, 0u, 0u};
#pragma unroll 1
    for (int bit = 30; bit >= 0; bit--) {
#pragma unroll
      for (int tk = 0; tk < 4; tk++) {
        const u32 t = T[tk] | (1u << bit);
        const int cnt = __popcll(__ballot(kk[tk][0] >= t)) + __popcll(__ballot(kk[tk][1] >= t)) + __popcll(__ballot(kk[tk][2] >= t)) + __popcll(__ballot(kk[tk][3] >= t));
        if (cnt >= 13) T[tk] = t;
      }
    }
#pragma unroll
    for (int tk = 0; tk < 4; tk++) {
      const u32 k0 = kk[tk][0], k1 = kk[tk][1], k2 = kk[tk][2], k3 = kk[tk][3], Tt = T[tk];
      int need = 13 - (__popcll(__ballot(k0 > Tt)) + __popcll(__ballot(k1 > Tt)) + __popcll(__ballot(k2 > Tt)) + __popcll(__ballot(k3 > Tt)));
      u64 sel0, sel1, sel2, sel3;
      {
        u64 e = __ballot(k0 == Tt); int below = __builtin_amdgcn_mbcnt_hi((u32)(e >> 32), __builtin_amdgcn_mbcnt_lo((u32)e, 0u));
        sel0 = __ballot(k0 > Tt || (k0 == Tt && below < need)); need -= min(need, (int)__popcll(e));
        e = __ballot(k1 == Tt); below = __builtin_amdgcn_mbcnt_hi((u32)(e >> 32), __builtin_amdgcn_mbcnt_lo((u32)e, 0u));
        sel1 = __ballot(k1 > Tt || (k1 == Tt && below < need)); need -= min(need, (int)__popcll(e));
        e = __ballot(k2 == Tt); below = __builtin_amdgcn_mbcnt_hi((u32)(e >> 32), __builtin_amdgcn_mbcnt_lo((u32)e, 0u));
        sel2 = __ballot(k2 > Tt || (k2 == Tt && below < need)); need -= min(need, (int)__popcll(e));
        e = __ballot(k3 == Tt); below = __builtin_amdgcn_mbcnt_hi((u32)(e >> 32), __builtin_amdgcn_mbcnt_lo((u32)e, 0u));
        sel3 = __ballot(k3 > Tt || (k3 == Tt && below < need));
      }
      u32 myword = 0;
      if (lane == 0) myword = (u32)sel0; else if (lane == 1) myword = (u32)(sel0 >> 32);
      else if (lane == 2) myword = (u32)sel1; else if (lane == 3) myword = (u32)(sel1 >> 32);
      else if (lane == 4) myword = (u32)sel2; else if (lane == 5) myword = (u32)(sel2 >> 32);
      else if (lane == 6) myword = (u32)sel3; else if (lane == 7) myword = (u32)(sel3 >> 32);
      if (lane == 0) myword |= 1u;
      if (lane == ((cur - 1) >> 5)) myword |= 1u << ((cur - 1) & 31);
      if (lane == (cur >> 5)) myword |= 1u << (cur & 31);
      if (lane < 8) selm[tk * 8 + lane] = myword;
    }
  }
  wave_lds_sync();
  if (lane < 8) wgm[wv * 8 + lane] = selm[lane] | selm[8 + lane] | selm[16 + lane] | selm[24 + lane];
  __syncthreads();
  if (tid < 8) {
    u32 u = 0;
#pragma unroll
    for (int w = 0; w < 8; w++) u |= wgm[w * 8 + tid];
    const int lim = cur - tid * 32;
    if (lim < 0) u = 0; else if (lim < 31) u &= (2u << lim) - 1u;
    wgu[tid] = u;
  }
  __syncthreads();
  if (tid < 256) {
    const int w = tid >> 5, b = tid & 31;
    int idx = 0;
#pragma unroll
    for (int ww = 0; ww < 8; ww++) { const u32 x = wgu[ww]; idx += ww < w ? __builtin_popcount(x) : 0; }
    const u32 x = wgu[w];
    idx += __builtin_popcount(x & ((1u << b) - 1u));
    if ((x >> b) & 1u) blist[idx] = tid;
  }
  if (tid == 0) {
    int n = 0;
#pragma unroll
    for (int ww = 0; ww < 8; ww++) n += __builtin_popcount(wgu[ww]);
    blist[256] = n;
  }
  __syncthreads();

  {
    const int nblk = blist[256];
    const u16* ksrc = proj + C_KS + g * 64 + (size_t)srow * PS + sseg;
    const u16* vsrc = p.vsT + (size_t)(g * 64 + srow) * S + sseg;
    float m = -1e30f, lsum = 0.f;
    f32x4 O[4];
#pragma unroll
    for (int dt = 0; dt < 4; dt++) O[dt] = (f32x4){0.f, 0.f, 0.f, 0.f};
    tile_pipe2<true>(nblk, ktb, vtb, soff,
      [&](int i) { return ksrc + (size_t)blist[nblk - 1 - i] * 64 * PS; }, [&](int i) { return vsrc + blist[nblk - 1 - i] * 64; },
      [&](int i, const u16* kt, const u16* vt) {
        const int jb = blist[nblk - 1 - i];
        const u32 wany = wgm[wv * 8 + (jb >> 5)];
        if ((wany >> (jb & 31)) & 1u) {
          const bool rowsel = (selm[tok * 8 + (jb >> 5)] >> (jb & 31)) & 1u;
          if (jb < cur) attend_tile<true>(kt, vt, lr, lq, q_lo, q_hi, slope, tpos - jb * 64, rowsel, 1 << 30, m, lsum, O);
          else attend_tile<false>(kt, vt, lr, lq, q_lo, q_hi, slope, tpos - jb * 64, rowsel, 1 << 30, m, lsum, O);
        }
      });
    lsum += __shfl_xor(lsum, 16); lsum += __shfl_xor(lsum, 32);
    const float sc = g1 / fmaxf(lsum, 1e-30f);
#pragma unroll
    for (int dt = 0; dt < 4; dt++)
#pragma unroll
      for (int j = 0; j < 4; j++) outacc[dt][j] += sc * O[dt][j];
  }
  {
    int ks = T0 - 511; if (ks < 0) ks = 0; ks &= ~63;
    const int nst = ((T0 + 31 - ks) >> 6) + 1;
    const u16* ksrc = proj + C_KW + g * 64 + (size_t)(ks + srow) * PS + sseg;
    const u16* vsrc = p.vwT + (size_t)(g * 64 + srow) * S + ks + sseg;
    float m = -1e30f, lsum = 0.f;
    f32x4 O[4];
#pragma unroll
    for (int dt = 0; dt < 4; dt++) O[dt] = (f32x4){0.f, 0.f, 0.f, 0.f};
    tile_pipe2<true>(nst, ktb, vtb, soff,
      [&](int st) { return ksrc + (size_t)(nst - 1 - st) * 64 * PS; }, [&](int st) { return vsrc + (nst - 1 - st) * 64; },
      [&](int st, const u16* kt, const u16* vt) {
        const int kp0 = ks + (nst - 1 - st) * 64;
        if (t0 - (kp0 + 63) >= 0 && t0 + 3 - kp0 < 512) attend_tile<true>(kt, vt, lr, lq, q_lo, q_hi, slope, tpos - kp0, true, 512, m, lsum, O);
        else attend_tile<false>(kt, vt, lr, lq, q_lo, q_hi, slope, tpos - kp0, true, 512, m, lsum, O);
      });
    lsum += __shfl_xor(lsum, 16); lsum += __shfl_xor(lsum, 32);
    const float sc = g2 / fmaxf(lsum, 1e-30f);
#pragma unroll
    for (int dt = 0; dt < 4; dt++)
#pragma unroll
      for (int j = 0; j < 4; j++) outacc[dt][j] += sc * O[dt][j];
  }
  {
    u16* op = proj + (size_t)tpos * PS + C_NQ + (g * 4 + r) * 64 + lq * 4;
#pragma unroll
    for (int dt = 0; dt < 4; dt++)
      *(uint2*)(op + dt * 16) = make_uint2(pack2(outacc[dt][0], outacc[dt][1]), pack2(outacc[dt][2], outacc[dt][3]));
  }
  __syncthreads();
}

#define XB_TMO      128
#define XB_XCNT(j)  (256  + 64 * (j))
#define XB_XSUB(j)  (1280 + 64 * (j))
#define XB_XGEN(j)  (2304 + 64 * (j))
#define XB_TOP      3328
#define XB_TOPGEN   3392
#define XCD_BAR_WORDS 3456
#define XB_SPIN_CAP (1u << 18)
__device__ __forceinline__ unsigned xb_ld(unsigned* p)              { return __hip_atomic_load(p, __ATOMIC_RELAXED, __HIP_MEMORY_SCOPE_AGENT); }
__device__ __forceinline__ unsigned xb_add(unsigned* p, unsigned v) { return __hip_atomic_fetch_add(p, v, __ATOMIC_RELAXED, __HIP_MEMORY_SCOPE_AGENT); }
__device__ __forceinline__ unsigned xb_xcc_id() { return (unsigned)__builtin_amdgcn_s_getreg((3 << 11) | 20) & 0xFu; }
#define XB_SPIN(cond, bar) do { unsigned _sp = 0; while (cond) { __builtin_amdgcn_s_sleep(1); \
    if ((++_sp & 255u) == 0u) { if (xb_ld(&(bar)[XB_TMO])) break; if (_sp > XB_SPIN_CAP) { atomicAdd(&(bar)[XB_TMO], 1u); break; } } } } while (0)
struct XcdBarrier { unsigned* bar; unsigned x; volatile __attribute__((address_space(3))) unsigned* st; };
__device__ __forceinline__ XcdBarrier xcd_barrier_post(unsigned* bar, volatile __attribute__((address_space(3))) unsigned* st) {
  XcdBarrier b; b.bar = bar; b.x = xb_xcc_id(); b.st = st;
  if (threadIdx.x == 0) (void)xb_add(&bar[XB_XCNT(b.x)], 1u);
  return b;
}
__device__ __forceinline__ void xcd_barrier_complete(unsigned* bar, unsigned x, unsigned& nloc, unsigned& nx) {
  const unsigned G = gridDim.x * gridDim.y * gridDim.z;
  unsigned sum, cnt, mine, sp = 0u;
  for (;;) {
    sum = 0u; cnt = 0u; mine = 0u;
#pragma unroll
    for (unsigned j = 0; j < 16; ++j) { const unsigned c = xb_ld(&bar[XB_XCNT(j)]); sum += c; cnt += (c > 0u) ? 1u : 0u; mine = (j == x) ? c : mine; }
    if (sum == G) break;
    __builtin_amdgcn_s_sleep(1);
    if ((++sp & 255u) == 0u) { if (xb_ld(&bar[XB_TMO])) break; if (sp > XB_SPIN_CAP) { atomicAdd(&bar[XB_TMO], 1u); break; } }
  }
  nloc = mine > 0u ? mine : 1u; nx = cnt > 0u ? cnt : 1u;
}
__device__ __forceinline__ void xcd_barrier(const XcdBarrier& b) {
  asm volatile("s_waitcnt vmcnt(0)" ::: "memory");
  __syncthreads();
  if (threadIdx.x == 0) {
    unsigned* bar = b.bar;
    __builtin_amdgcn_s_waitcnt(0);
    unsigned nloc = b.st[0], nx = b.st[1];
    if (nloc == 0u) { xcd_barrier_complete(bar, b.x, nloc, nx); b.st[0] = nloc; b.st[1] = nx; }
    const unsigned old = xb_add(&bar[XB_XSUB(b.x)], 1u);
    const unsigned gen = old / nloc;
    if (old + 1u == (gen + 1u) * nloc) {
      __builtin_amdgcn_fence(__ATOMIC_RELEASE, "agent");
      asm volatile("s_waitcnt vmcnt(0)" ::: "memory");
      const unsigned og = xb_add(&bar[XB_TOP], 1u);
      const unsigned tg = og / nx;
      if (og + 1u == (tg + 1u) * nx) xb_add(&bar[XB_TOPGEN], 1u);
      else XB_SPIN(xb_ld(&bar[XB_TOPGEN]) == tg, bar);
      __builtin_amdgcn_fence(__ATOMIC_ACQUIRE, "agent");
      xb_add(&bar[XB_XGEN(b.x)], 1u);
      asm volatile("s_waitcnt vmcnt(0)" ::: "memory");
    } else {
      XB_SPIN(xb_ld(&bar[XB_XGEN(b.x)]) == gen, bar);
      __builtin_amdgcn_fence(__ATOMIC_ACQUIRE, "agent");
      asm volatile("s_waitcnt vmcnt(0)" ::: "memory");
    }
  }
  __syncthreads();
}

template <bool FINAL>
struct EpiResidNorm {
  static constexpr bool PERM = false;
  const float* xsrc; float* xdst; float scale; const float* gnext; u16* Hout; float* part; unsigned* cnt; unsigned* tmo;
  __device__ __forceinline__ void fused(AccT& acc, const Unit& u, int wr, int wc, int fr, int fq, LAS unsigned char* lds) const {
    volatile LAS float* ps = (volatile LAS float*)(lds + 131072);
    volatile LAS float* rr = (volatile LAS float*)(lds + 131072 + 4096);
    const int tid = tid_fresh();
    const int row0 = u.pm * 256 + wr * 64 + fr, col0 = u.pn * 256 + wc * 32 + 4 * fq;
#pragma unroll
    for (int ai = 0; ai < 2; ++ai) {
      f32x4 xv[4][2][2];
#pragma unroll
      for (int m = 0; m < 4; ++m)
#pragma unroll
        for (int bj = 0; bj < 2; ++bj)
#pragma unroll
          for (int n = 0; n < 2; ++n)
            xv[m][bj][n] = *(const f32x4*)(xsrc + (size_t)(row0 + ai * 128 + m * 16) * 1024 + col0 + bj * 128 + n * 16);
#pragma unroll
      for (int m = 0; m < 4; ++m) {
        float ss = 0.f;
#pragma unroll
        for (int bj = 0; bj < 2; ++bj)
#pragma unroll
          for (int n = 0; n < 2; ++n) {
            const f32x4 v = xv[m][bj][n] + scale * acc[ai][bj][m][n];
            if (!FINAL) *(f32x4*)(xdst + (size_t)(row0 + ai * 128 + m * 16) * 1024 + col0 + bj * 128 + n * 16) = v;
            acc[ai][bj][m][n] = v;
            ss += v[0] * v[0] + v[1] * v[1] + v[2] * v[2] + v[3] * v[3];
          }
        ss += __shfl_xor(ss, 16); ss += __shfl_xor(ss, 32);
        if (fq == 0) ps[wc * 256 + ai * 128 + wr * 64 + m * 16 + fr] = ss;
      }
    }
    __syncthreads();
    if (tid < 256) __hip_atomic_store(part + (size_t)(u.pm * 4 + u.pn) * 256 + tid, ps[tid] + ps[256 + tid] + ps[512 + tid] + ps[768 + tid], __ATOMIC_RELAXED, __HIP_MEMORY_SCOPE_AGENT);
    asm volatile("s_waitcnt vmcnt(0)" ::: "memory");
    __syncthreads();
    if (tid == 0) {
      (void)xb_add(cnt + u.pm, 1u);
      XB_SPIN(xb_ld(cnt + u.pm) < 4u, tmo);
      __builtin_amdgcn_fence(__ATOMIC_ACQUIRE, "agent");
      asm volatile("s_waitcnt vmcnt(0)" ::: "memory");
    }
    __syncthreads();
    if (tid < 256) {
      const float* pp = part + (size_t)(u.pm * 4) * 256 + tid;
      const float t0 = __hip_atomic_load(pp, __ATOMIC_RELAXED, __HIP_MEMORY_SCOPE_AGENT), t1 = __hip_atomic_load(pp + 256, __ATOMIC_RELAXED, __HIP_MEMORY_SCOPE_AGENT);
      const float t2 = __hip_atomic_load(pp + 512, __ATOMIC_RELAXED, __HIP_MEMORY_SCOPE_AGENT), t3 = __hip_atomic_load(pp + 768, __ATOMIC_RELAXED, __HIP_MEMORY_SCOPE_AGENT);
      rr[tid] = rsqrtf(((t0 + t1) + (t2 + t3)) * (1.0f / 1024.0f) + EPS);
    }
    __syncthreads();
    f32x4 gv[2][2];
#pragma unroll
    for (int bj = 0; bj < 2; ++bj)
#pragma unroll
      for (int n = 0; n < 2; ++n) gv[bj][n] = *(const f32x4*)(gnext + col0 + bj * 128 + n * 16);
#pragma unroll
    for (int ai = 0; ai < 2; ++ai)
#pragma unroll
      for (int m = 0; m < 4; ++m) {
        const float r = rr[ai * 128 + wr * 64 + m * 16 + fr];
#pragma unroll
        for (int bj = 0; bj < 2; ++bj)
#pragma unroll
          for (int n = 0; n < 2; ++n) {
            const f32x4 h = acc[ai][bj][m][n] * r * gv[bj][n];
            if (FINAL) *(f32x4*)(xdst + (size_t)(row0 + ai * 128 + m * 16) * 1024 + col0 + bj * 128 + n * 16) = h;
            else *(uint2*)(Hout + (size_t)(row0 + ai * 128 + m * 16) * 1024 + col0 + bj * 128 + n * 16) = make_uint2(pack2(h[0], h[1]), pack2(h[2], h[3]));
          }
      }
    __syncthreads();
  }
};

constexpr int SMEM_TOTAL = 147456;
__global__ void __launch_bounds__(512, 2) mega(Params p) {
  cg::grid_group grid = cg::this_grid();
  __shared__ __attribute__((aligned(16))) unsigned char smem_raw[SMEM_TOTAL + 16];
  LAS unsigned char* glds = (LAS unsigned char*)smem_raw;
  volatile LAS unsigned* xb_words = (volatile LAS unsigned*)(glds + SMEM_TOTAL);
  if (threadIdx.x == 0) { xb_words[0] = 0u; xb_words[1] = 0u; }
  if (blockIdx.x == 0) { for (int i = threadIdx.x; i < XCD_BAR_WORDS; i += 512) p.bar[i] = 0u; if (threadIdx.x < 384) p.ncnt[threadIdx.x] = 0u; }
  __syncthreads();
  XcdBarrier xb; xb.bar = p.bar; xb.x = 0; xb.st = xb_words;
#define VB_SETUP const int _tf = tid_fresh(); const int half = __builtin_amdgcn_readfirstlane(_tf >> 8); const int nb = gridDim.x * 2, bid = blockIdx.x * 2 + half; \
  u16* smem = (u16*)(smem_raw + half * SMEM_BYTES); const int vwave = __builtin_amdgcn_readfirstlane((_tf & 255) >> 6); (void)vwave; (void)nb; (void)bid; (void)smem;
#pragma unroll 1
  for (int l = 0; l < 2; l++) {
    const float* xsrc = l == 0 ? p.x_in : p.xout;
    const bool fusedn = gridDim.x == 256;
    if (l == 0 || !fusedn) norm_phase(xsrc, p.ffn1_norm + l * 1024, p.H);
    { VB_SETUP wprep_phase(p, l, smem, bid, nb); }
    if (l == 0) { grid.sync(); xb = xcd_barrier_post(p.bar, xb_words); } else xcd_barrier(xb);
    { Gemm g{p.H, p.w1t_a, 1024, 1024, S, 5632, 1024}; EpiSwiglu e{p.BIG}; gemm_phase(glds, g, e); }
    xcd_barrier(xb);
    if (fusedn) {
      Gemm g{p.BIG, p.w2t_a, FF, FF, S, 1024, FF};
      EpiResidNorm<false> e{xsrc, p.xout, 0.5f, p.mix_norm + l * 1024, p.H, p.part + (size_t)(l * 2) * 65536, p.ncnt + (l * 2) * 64, p.bar};
      gemm_phase<EpiResidNorm<false>, true>(glds, g, e);
      xcd_barrier(xb);
    } else {
      { Gemm g{p.BIG, p.w2t_a, FF, FF, S, 1024, FF}; EpiResid e{xsrc, p.xout, 0.5f}; gemm_phase(glds, g, e); }
      xcd_barrier(xb);
      norm_phase(p.xout, p.mix_norm + l * 1024, p.H);
      xcd_barrier(xb);
    }
    { Gemm g{p.H, p.wint, 1024, 1024, S, 4096, 1024}; EpiProj e{p.BIG}; gemm_phase(glds, g, e); }
    xcd_barrier(xb);
    { VB_SETUP
    if (nb == 512) {
      if (bid < 128) { cmp_tile(p, l, bid, smem); ret_kv_tile(p, bid, smem); ret_kv_tile(p, 128 + bid, smem); }
      else {
        const int h2 = bid - 128;
        gmlp_tile(p, l, h2, smem);
        if (h2 < 128) gmlp_tile(p, l, 384 + h2, smem); else ret_kv_tile(p, 256 + (h2 - 128), smem);
      }
      vt_tile(p, bid, smem); vt_tile(p, 512 + bid, smem);
    } else {
    for (int t = bid; t < 128 + 512 + 512 + 1024; t += nb) {
      if (t < 128) cmp_tile(p, l, t, smem);
      else if (t < 640) gmlp_tile(p, l, t - 128, smem);
      else if (t < 1152) ret_kv_tile(p, t - 640, smem);
      else vt_tile(p, t - 1152, smem);
    } } }
    xcd_barrier(xb);
    {
      const int tf = tid_fresh();
      const int wv = __builtin_amdgcn_readfirstlane(tf >> 6);
      ret_scan_wg(p, smem_raw);
      const int xcd = blockIdx.x & 7, slot = blockIdx.x >> 3, nslot = gridDim.x >> 3;
      for (int i = slot; i < 128; i += nslot) {
        const int rsel = i >> 6, j = i & 63;
        const int range = rsel == 0 ? 15 - xcd : xcd;
        const int g = (j ^ (j >> 5)) & 1, w = range * 32 + 31 - (j >> 1);
        nsa_wg(p, g, w * 32, smem_raw);
      }
    }
    xcd_barrier(xb);
    { VB_SETUP for (int t = bid; t < 512; t += nb) ret_out_tile(p, l, t, smem); }
    xcd_barrier(xb);
    gemm_merge_chain(glds, p, l);
    xcd_barrier(xb);
    if (fusedn) {
      Gemm g{p.BIG + C_MIX, p.wot, PS, 1024, S, 1024, 1024};
      EpiResidNorm<false> e{p.xout, p.xout, 1.0f, p.ffn2_norm + l * 1024, p.H, p.part + (size_t)(l * 2 + 1) * 65536, p.ncnt + (l * 2 + 1) * 64, p.bar};
      gemm_phase<EpiResidNorm<false>, true>(glds, g, e);
      xcd_barrier(xb);
    } else {
      { Gemm g{p.BIG + C_MIX, p.wot, PS, 1024, S, 1024, 1024}; EpiResid e{p.xout, p.xout, 1.0f}; gemm_phase(glds, g, e); }
      xcd_barrier(xb);
      norm_phase(p.xout, p.ffn2_norm + l * 1024, p.H);
      xcd_barrier(xb);
    }
    { Gemm g{p.H, p.w1t_b, 1024, 1024, S, 5632, 1024}; EpiSwiglu e{p.BIG}; gemm_phase(glds, g, e); }
    xcd_barrier(xb);
    if (fusedn && l == 0) {
      Gemm g{p.BIG, p.w2t_b, FF, FF, S, 1024, FF};
      EpiResidNorm<false> e{p.xout, p.xout, 0.5f, p.ffn1_norm + 1024, p.H, p.part + (size_t)4 * 65536, p.ncnt + 4 * 64, p.bar};
      gemm_phase<EpiResidNorm<false>, true>(glds, g, e);
      xcd_barrier(xb);
    } else if (fusedn) {
      Gemm g{p.BIG, p.w2t_b, FF, FF, S, 1024, FF};
      EpiResidNorm<true> e{p.xout, p.xout, 0.5f, p.final_norm, p.H, p.part + (size_t)5 * 65536, p.ncnt + 5 * 64, p.bar};
      gemm_phase<EpiResidNorm<true>, true>(glds, g, e);
    } else {
      { Gemm g{p.BIG, p.w2t_b, FF, FF, S, 1024, FF}; EpiResid e{p.xout, p.xout, 0.5f}; gemm_phase(glds, g, e); }
      xcd_barrier(xb);
      if (l == 1) final_norm_phase(p.xout, p.final_norm);
    }
  }
}

extern "C" void kernel_launch(void* const* d_in, const int* in_sizes, int n_in, void* d_out, int out_size, void* d_ws,
                              size_t ws_size, hipStream_t stream) {
  static int grid_blocks = 0;
  if (!grid_blocks) {
    int dev = 0, cus = 0, per_cu = 0;
    (void)hipGetDevice(&dev);
    (void)hipDeviceGetAttribute(&cus, hipDeviceAttributeMultiprocessorCount, dev);
    (void)hipOccupancyMaxActiveBlocksPerMultiprocessor(&per_cu, mega, 512, 0);
    if (per_cu > 1) per_cu = 1;
    if (per_cu < 1) per_cu = 1;
    grid_blocks = cus * per_cu;
    grid_blocks &= ~7;
  }
  Params p{};
  p.x_in = (const float*)d_in[0];
  p.ffn1_norm = (const float*)d_in[1]; p.ffn1_w1 = (const float*)d_in[2]; p.ffn1_w2 = (const float*)d_in[3];
  p.mix_norm = (const float*)d_in[4]; p.w_in = (const float*)d_in[5]; p.gm_ln_g = (const float*)d_in[6];
  p.gm_ln_b = (const float*)d_in[7]; p.gm_ws = (const float*)d_in[8]; p.gm_bs = (const float*)d_in[9];
  p.ret_gn_g = (const float*)d_in[10]; p.ret_gn_b = (const float*)d_in[11]; p.cmp_pos = (const float*)d_in[12];
  p.cmp_w1 = (const float*)d_in[13]; p.cmp_w2 = (const float*)d_in[14]; p.w_branch = (const float*)d_in[15];
  p.w_gate = (const float*)d_in[16]; p.b_gate = (const float*)d_in[17]; p.w_o = (const float*)d_in[18];
  p.ffn2_norm = (const float*)d_in[19]; p.ffn2_w1 = (const float*)d_in[20]; p.ffn2_w2 = (const float*)d_in[21];
  p.final_norm = (const float*)d_in[22];
  p.xout = (float*)d_out;
  char* w = (char*)d_ws;
  auto take = [&](size_t bytes) { char* r = w; w += (bytes + 255) & ~(size_t)255; return r; };
  p.w1t_a = (u16*)take((size_t)5632 * 1024 * 2);
  p.w1t_b = (u16*)take((size_t)5632 * 1024 * 2);
  p.w2t_a = (u16*)take((size_t)1024 * FF * 2);
  p.w2t_b = (u16*)take((size_t)1024 * FF * 2);
  p.wint = (u16*)take((size_t)4096 * 1024 * 2);
  p.wgt = (u16*)take((size_t)3072 * 1024 * 2);
  p.wbt = (u16*)take((size_t)3 * 1024 * 512 * 2);
  p.wot = (u16*)take((size_t)1024 * 1024 * 2);
  p.cw1t = (u16*)take((size_t)2 * 128 * 2048 * 2);
  p.cw2t = (u16*)take((size_t)2 * 64 * 128 * 2);
  p.H = (u16*)take((size_t)S * 1024 * 2);
  p.BIG = (u16*)take((size_t)S * PS * 2);
  p.vsT = (u16*)take((size_t)2 * 64 * S * 2);
  p.vwT = (u16*)take((size_t)2 * 64 * S * 2);
  p.kc = (u16*)take((size_t)2 * 1024 * 64 * 2);
  p.vcT = (u16*)take((size_t)2 * 64 * 1024 * 2);
  p.ret = (float*)take((size_t)128 * 4 * 8192 * 4);
  p.gst = (u16*)take((size_t)256 * 65536 * 2);
  p.bar = (unsigned*)take((size_t)XCD_BAR_WORDS * 4);
  p.part = (float*)take((size_t)6 * 64 * 4 * 256 * 4);
  p.ncnt = (unsigned*)take((size_t)6 * 64 * 4);
  if ((size_t)(w - (char*)d_ws) > ws_size) { fprintf(stderr, "workspace too small: need %zu have %zu\n", (size_t)(w - (char*)d_ws), ws_size); return; }
  void* args[] = {&p};
  hipError_t e = hipLaunchCooperativeKernel((void*)mega, dim3(grid_blocks), dim3(512), args, 0, stream);
  if (e != hipSuccess) fprintf(stderr, "coop launch failed: %s (grid %d)\n", hipGetErrorString(e), grid_blocks);
}
```

```cpp
#include <hip/hip_runtime.h>
#include <hip/hip_cooperative_groups.h>
#include <cstdio>
#include <cstdint>
namespace cg = cooperative_groups;

typedef unsigned short u16;
typedef unsigned int u32;
typedef unsigned long long u64;
using bf16x8 = __attribute__((ext_vector_type(8))) short;
using bf16x4 = __attribute__((ext_vector_type(4))) short;
using f32x4 = __attribute__((ext_vector_type(4))) float;

constexpr int S = 16384, FF = 2816, DIN = 3864;
constexpr int PS = 3968;
constexpr int C_U = 0, C_V = 512, C_RQ = 1024, C_RK = 1280, C_RV = 1536, C_RG = 2048, C_NQ = 2560,
              C_KC = 3072, C_VC = 3200, C_KS = 3328, C_VS = 3456, C_KW = 3584, C_VW = 3712, C_NG = 3840, C_MIX = 512;
constexpr float EPS = 1e-6f;
constexpr int SMEM_BYTES = 73728;

struct Params {
  const float* x_in;
  const float *ffn1_norm, *ffn1_w1, *ffn1_w2, *mix_norm, *w_in, *gm_ln_g, *gm_ln_b, *gm_ws, *gm_bs, *ret_gn_g, *ret_gn_b,
      *cmp_pos, *cmp_w1, *cmp_w2, *w_branch, *w_gate, *b_gate, *w_o, *ffn2_norm, *ffn2_w1, *ffn2_w2, *final_norm;
  float* xout;
  u16 *w1t_a, *w2t_a, *wint, *wgt, *wbt, *wot, *w1t_b, *w2t_b, *cw1t, *cw2t;
  u16 *H, *BIG, *vsT, *vwT, *kc, *vcT;
  float* ret;
  u16* gst;
  unsigned* bar;
  float* part; unsigned* ncnt;
};

__device__ __forceinline__ u16 f2bf(float f) { __bf16 b = (__bf16)f; return __builtin_bit_cast(u16, b); }
__device__ __forceinline__ float bf2f(u16 h) { return __uint_as_float(((u32)h) << 16); }
typedef __bf16 bf16x2_t __attribute__((ext_vector_type(2)));
typedef float f32x2_t __attribute__((ext_vector_type(2)));
__device__ __forceinline__ u32 pack2(float a, float b) { f32x2_t v = {a, b}; bf16x2_t r = __builtin_convertvector(v, bf16x2_t); return __builtin_bit_cast(u32, r); }
__device__ __forceinline__ float lo2f(u32 w) { return __uint_as_float(w << 16); }
__device__ __forceinline__ float hi2f(u32 w) { return __uint_as_float(w & 0xffff0000u); }
__device__ __forceinline__ float gelu_t(float x) { float y = 1.5957691216057308f * (x + 0.044715f * x * x * x); return x * __builtin_amdgcn_rcpf(1.0f + __expf(-y)); }
__device__ __forceinline__ float silu_f(float x) { return x * __builtin_amdgcn_rcpf(1.0f + __expf(-x)); }
__device__ __forceinline__ float sigm_f(float x) { return __builtin_amdgcn_rcpf(1.0f + __expf(-x)); }
__device__ __forceinline__ f32x4 mfma16(bf16x8 a, bf16x8 b, f32x4 c) { return __builtin_amdgcn_mfma_f32_16x16x32_bf16(a, b, c, 0, 0, 0); }
__device__ __forceinline__ bf16x8 ld8(const u16* p) { return *(const bf16x8*)p; }
__device__ __forceinline__ bf16x8 ld44(const u16* p0, const u16* p1) {
  bf16x4 a = *(const bf16x4*)p0, b = *(const bf16x4*)p1;
  return __builtin_shufflevector(a, b, 0, 1, 2, 3, 4, 5, 6, 7);
}
__device__ __forceinline__ bf16x8 pk8(float a0, float a1, float a2, float a3, float a4, float a5, float a6, float a7) {
  union { uint4 u; bf16x8 v; } x;
  x.u = make_uint4(pack2(a0, a1), pack2(a2, a3), pack2(a4, a5), pack2(a6, a7));
  return x.v;
}
__device__ __forceinline__ bf16x8 scale8(bf16x8 v, float s) {
  union { uint4 u; bf16x8 v; } x; x.v = v;
  x.u.x = pack2(lo2f(x.u.x) * s, hi2f(x.u.x) * s); x.u.y = pack2(lo2f(x.u.y) * s, hi2f(x.u.y) * s);
  x.u.z = pack2(lo2f(x.u.z) * s, hi2f(x.u.z) * s); x.u.w = pack2(lo2f(x.u.w) * s, hi2f(x.u.w) * s);
  return x.v;
}
__device__ __forceinline__ void wave_lds_sync() { asm volatile("s_waitcnt lgkmcnt(0)" ::: "memory"); }

__device__ __forceinline__ int tid_fresh() { int t = threadIdx.x; asm volatile("" : "+v"(t)); return t; }
__device__ __forceinline__ int wmap(int n, int mode) {
  if (mode == 0) return n;
  int isb = n >= FF; int nn = isb ? n - FF : n;
  return (nn >> 4) * 32 + isb * 16 + (nn & 15);
}
__device__ __forceinline__ void wprep_matrix(const float* __restrict__ src, u16* __restrict__ dst, int K, int N, int mode, u16* smem, int vb, int nvb) {
  float* T = (float*)smem;
  const int tid = tid_fresh() & 255;
  const int tk = K >> 6, tn = (N + 63) >> 6, nt = tk * tn;
  for (int t = vb; t < nt; t += nvb) {
    const int k0 = (t % tk) * 64, n0 = (t / tk) * 64;
#pragma unroll
    for (int i = 0; i < 4; i++) {
      int kk = (tid >> 4) + 16 * i, n = n0 + (tid & 15) * 4;
      float4 v = make_float4(0.f, 0.f, 0.f, 0.f);
      if (n < N) v = *(const float4*)(src + (size_t)(k0 + kk) * N + n);
      float* tp = T + kk * 65 + (tid & 15) * 4;
      tp[0] = v.x; tp[1] = v.y; tp[2] = v.z; tp[3] = v.w;
    }
    __syncthreads();
    {
      int n = tid >> 2, kc = (tid & 3) * 16, nn = n0 + n;
      if (nn < N) {
        u32 w[8];
#pragma unroll
        for (int e = 0; e < 8; e++) w[e] = pack2(T[(kc + 2 * e) * 65 + n], T[(kc + 2 * e + 1) * 65 + n]);
        u16* dp = dst + (size_t)wmap(nn, mode) * K + k0 + kc;
        *(uint4*)dp = make_uint4(w[0], w[1], w[2], w[3]);
        *(uint4*)(dp + 8) = make_uint4(w[4], w[5], w[6], w[7]);
      }
    }
    __syncthreads();
  }
}
__device__ __forceinline__ void wprep_phase(const Params& p, int l, u16* smem, int vb, int nvb) {
  wprep_matrix(p.ffn1_w1 + (size_t)l * 1024 * 5632, p.w1t_a, 1024, 5632, 1, smem, vb, nvb);
  wprep_matrix(p.ffn2_w1 + (size_t)l * 1024 * 5632, p.w1t_b, 1024, 5632, 1, smem, vb, nvb);
  wprep_matrix(p.ffn1_w2 + (size_t)l * FF * 1024, p.w2t_a, FF, 1024, 0, smem, vb, nvb);
  wprep_matrix(p.ffn2_w2 + (size_t)l * FF * 1024, p.w2t_b, FF, 1024, 0, smem, vb, nvb);
  wprep_matrix(p.w_in + (size_t)l * 1024 * DIN, p.wint, 1024, DIN, 0, smem, vb, nvb);
  wprep_matrix(p.w_gate + (size_t)l * 1024 * 3072, p.wgt, 1024, 3072, 0, smem, vb, nvb);
  for (int m = 0; m < 3; m++)
    wprep_matrix(p.w_branch + (size_t)(l * 3 + m) * 512 * 1024, p.wbt + (size_t)m * 1024 * 512, 512, 1024, 0, smem, vb, nvb);
  wprep_matrix(p.w_o + (size_t)l * 1024 * 1024, p.wot, 1024, 1024, 0, smem, vb, nvb);
  for (int w = 0; w < 2; w++) {
    wprep_matrix(p.cmp_w1 + (size_t)(l * 2 + w) * 2048 * 128, p.cw1t + (size_t)w * 128 * 2048, 2048, 128, 0, smem, vb, nvb);
    wprep_matrix(p.cmp_w2 + (size_t)(l * 2 + w) * 128 * 64, p.cw2t + (size_t)w * 64 * 128, 128, 64, 0, smem, vb, nvb);
  }
}

__device__ __forceinline__ void norm_phase(const float* __restrict__ x, const float* __restrict__ g, u16* __restrict__ H) {
  const int tidf = tid_fresh();
  const int lane = tidf & 63;
  const int gw = blockIdx.x * 8 + (tidf >> 6), nw = gridDim.x * 8;
  float4 gg[4];
#pragma unroll
  for (int i = 0; i < 4; i++) gg[i] = ((const float4*)g)[lane + 64 * i];
  for (int row0 = gw * 4; row0 < S; row0 += nw * 4) {
    float4 v[4][4]; float ss[4];
#pragma unroll
    for (int rr = 0; rr < 4; rr++)
#pragma unroll
      for (int i = 0; i < 4; i++) v[rr][i] = ((const float4*)(x + (size_t)(row0 + rr) * 1024))[lane + 64 * i];
#pragma unroll
    for (int rr = 0; rr < 4; rr++) {
      float a = 0.f;
#pragma unroll
      for (int i = 0; i < 4; i++) a += v[rr][i].x * v[rr][i].x + v[rr][i].y * v[rr][i].y + v[rr][i].z * v[rr][i].z + v[rr][i].w * v[rr][i].w;
      ss[rr] = a;
    }
#pragma unroll
    for (int o = 32; o >= 1; o >>= 1)
#pragma unroll
      for (int rr = 0; rr < 4; rr++) ss[rr] += __shfl_xor(ss[rr], o);
#pragma unroll
    for (int rr = 0; rr < 4; rr++) {
      const float r = rsqrtf(ss[rr] * (1.0f / 1024.0f) + EPS);
#pragma unroll
      for (int i = 0; i < 4; i++) {
        uint2 o2 = make_uint2(pack2(v[rr][i].x * r * gg[i].x, v[rr][i].y * r * gg[i].y), pack2(v[rr][i].z * r * gg[i].z, v[rr][i].w * r * gg[i].w));
        *(uint2*)(H + (size_t)(row0 + rr) * 1024 + (lane + 64 * i) * 4) = o2;
      }
    }
  }
}
__device__ __forceinline__ void final_norm_phase(float* __restrict__ x, const float* __restrict__ g) {
  const int tidf = tid_fresh();
  const int lane = tidf & 63;
  const int gw = blockIdx.x * 8 + (tidf >> 6), nw = gridDim.x * 8;
  float4 gg[4];
#pragma unroll
  for (int i = 0; i < 4; i++) gg[i] = ((const float4*)g)[lane + 64 * i];
  for (int row0 = gw * 4; row0 < S; row0 += nw * 4) {
    float4 v[4][4]; float ss[4];
#pragma unroll
    for (int rr = 0; rr < 4; rr++)
#pragma unroll
      for (int i = 0; i < 4; i++) v[rr][i] = ((const float4*)(x + (size_t)(row0 + rr) * 1024))[lane + 64 * i];
#pragma unroll
    for (int rr = 0; rr < 4; rr++) {
      float a = 0.f;
#pragma unroll
      for (int i = 0; i < 4; i++) a += v[rr][i].x * v[rr][i].x + v[rr][i].y * v[rr][i].y + v[rr][i].z * v[rr][i].z + v[rr][i].w * v[rr][i].w;
      ss[rr] = a;
    }
#pragma unroll
    for (int o = 32; o >= 1; o >>= 1)
#pragma unroll
      for (int rr = 0; rr < 4; rr++) ss[rr] += __shfl_xor(ss[rr], o);
#pragma unroll
    for (int rr = 0; rr < 4; rr++) {
      const float r = rsqrtf(ss[rr] * (1.0f / 1024.0f) + EPS);
#pragma unroll
      for (int i = 0; i < 4; i++)
        ((float4*)(x + (size_t)(row0 + rr) * 1024))[lane + 64 * i] = make_float4(v[rr][i].x * r * gg[i].x, v[rr][i].y * r * gg[i].y, v[rr][i].z * r * gg[i].z, v[rr][i].w * r * gg[i].w);
    }
  }
}

#define LAS __attribute__((address_space(3)))
constexpr int G_BK = 64, G_HALF = 128, G_HTB = G_HALF * G_BK * 2, G_NXCD = 8, G_WGM = 8;
__device__ __forceinline__ int lds_byte(int r, int c) { const int st = (r >> 4) * 2 + (c >> 5), rr = r & 15, cc = c & 31, ob = rr * 64 + cc * 2; return st * 1024 + (ob ^ (((ob >> 9) & 1) << 5)); }
__device__ __forceinline__ void stage_rc(int b, int& R, int& C) { const int st = b / 1024, sb = b % 1024, swz = sb ^ (((sb >> 9) & 1) << 5); R = (st >> 1) * 16 + swz / 64; C = (st & 1) * 32 + (swz % 64) / 2; }
__device__ __forceinline__ int perm32(int rho) { const int n = rho >> 4, i = rho & 15; return 8 * (i >> 2) + 4 * n + (i & 3); }
struct Unit { int pm, pn; };
struct Gemm { const u16* A; const u16* Bt; int lda, ldb, M, N, K; };
struct StaticOrder {
  int nM, nN, nwg, G, c;
  __device__ void init(int M, int N, int G_, int c_) { nM = M / 256; nN = N / 256; nwg = nM * nN; G = G_; c = c_; }
  __device__ bool next(int i, Unit& u) const {
    const long L = (long)i * G + c; if (L >= nwg) return false;
    int wgid = (int)L; { const int q = nwg / G_NXCD, r = nwg % G_NXCD, xcd = wgid % G_NXCD, off = wgid / G_NXCD; wgid = (xcd < r ? xcd * (q + 1) : r * (q + 1) + (xcd - r) * q) + off; }
    const int nig = G_WGM * nN, gid = wgid / nig, fm = gid * G_WGM, gsz = (nM - fm) < G_WGM ? (nM - fm) : G_WGM;
    u.pm = fm + ((wgid % nig) % gsz); u.pn = (wgid % nig) / gsz; return true;
  }
};
typedef f32x4 AccT[2][2][4][2];
struct EpiSwiglu {
  static constexpr bool PERM = false;
  u16* ACT;
  __device__ __forceinline__ void operator()(const AccT& acc, const Unit& u, int wr, int wc, int fr, int fq) const {
    const int row0 = u.pm * 256 + wr * 64 + fr, col0 = u.pn * 128 + wc * 16 + 4 * fq;
#pragma unroll
    for (int ai = 0; ai < 2; ++ai)
#pragma unroll
      for (int m = 0; m < 4; ++m) {
        u16* rowp = ACT + (size_t)(row0 + ai * 128 + m * 16) * FF + col0;
#pragma unroll
        for (int bj = 0; bj < 2; ++bj) {
          const f32x4 a = acc[ai][bj][m][0], b = acc[ai][bj][m][1];
          *(uint2*)(rowp + bj * 64) = make_uint2(pack2(silu_f(a[0]) * b[0], silu_f(a[1]) * b[1]), pack2(silu_f(a[2]) * b[2], silu_f(a[3]) * b[3]));
        }
      }
  }
};
struct EpiResid {
  static constexpr bool PERM = false;
  const float* xsrc; float* xdst; float scale;
  __device__ __forceinline__ void operator()(const AccT& acc, const Unit& u, int wr, int wc, int fr, int fq) const {
    const int row0 = u.pm * 256 + wr * 64 + fr, col0 = u.pn * 256 + wc * 32 + 4 * fq;
#pragma unroll
    for (int ai = 0; ai < 2; ++ai) {
      f32x4 xv[4][2][2];
#pragma unroll
      for (int m = 0; m < 4; ++m)
#pragma unroll
        for (int bj = 0; bj < 2; ++bj)
#pragma unroll
          for (int n = 0; n < 2; ++n)
            xv[m][bj][n] = *(const f32x4*)(xsrc + (size_t)(row0 + ai * 128 + m * 16) * 1024 + col0 + bj * 128 + n * 16);
#pragma unroll
      for (int m = 0; m < 4; ++m)
#pragma unroll
        for (int bj = 0; bj < 2; ++bj)
#pragma unroll
          for (int n = 0; n < 2; ++n)
            *(f32x4*)(xdst + (size_t)(row0 + ai * 128 + m * 16) * 1024 + col0 + bj * 128 + n * 16) = xv[m][bj][n] + scale * acc[ai][bj][m][n];
    }
  }
};
struct EpiProj {
  static constexpr bool PERM = true;
  u16* proj;
  __device__ __forceinline__ void operator()(const AccT& acc, const Unit& u, int wr, int wc, int fr, int fq) const {
    const int row0 = u.pm * 256 + wr * 64 + fr, col0 = u.pn * 256 + wc * 32 + 8 * fq;
#pragma unroll
    for (int ai = 0; ai < 2; ++ai)
#pragma unroll
      for (int m = 0; m < 4; ++m) {
        u16* rowp = proj + (size_t)(row0 + ai * 128 + m * 16) * PS;
#pragma unroll
        for (int bj = 0; bj < 2; ++bj) {
          const int col = col0 + bj * 128;
          const f32x4 a = acc[ai][bj][m][0], b = acc[ai][bj][m][1];
          if (col < DIN) *(uint4*)(rowp + col) = make_uint4(pack2(a[0], a[1]), pack2(a[2], a[3]), pack2(b[0], b[1]), pack2(b[2], b[3]));
        }
      }
  }
};
struct EpiGate {
  static constexpr bool PERM = true;
  u16* gst; const float* bias; int tid;
  __device__ __forceinline__ void operator()(const AccT& acc, const Unit& u, int wr, int wc, int fr, int fq) const {
    u16* st = gst + (size_t)(u.pm * 4 + u.pn) * 65536 + tid * 8;
    const int col0 = u.pn * 256 + wc * 32 + 8 * fq;
#pragma unroll
    for (int bj = 0; bj < 2; ++bj) {
      const f32x4 b0 = *(const f32x4*)(bias + col0 + bj * 128), b1 = *(const f32x4*)(bias + col0 + bj * 128 + 4);
#pragma unroll
      for (int ai = 0; ai < 2; ++ai)
#pragma unroll
        for (int m = 0; m < 4; ++m) {
          const f32x4 a = acc[ai][bj][m][0] + b0, b = acc[ai][bj][m][1] + b1;
          *(uint4*)(st + ((ai * 2 + bj) * 4 + m) * 4096) = make_uint4(pack2(sigm_f(a[0]), sigm_f(a[1])), pack2(sigm_f(a[2]), sigm_f(a[3])),
                                                                     pack2(sigm_f(b[0]), sigm_f(b[1])), pack2(sigm_f(b[2]), sigm_f(b[3])));
        }
    }
  }
};
struct EpiBranch {
  static constexpr bool PERM = true;
  const u16* gst; u16* mix; int first; int tid;
  __device__ __forceinline__ void operator()(const AccT& acc, const Unit& u, int wr, int wc, int fr, int fq) const {
    const u16* st = gst + (size_t)(u.pm * 4 + u.pn) * 65536 + tid * 8;
    const int row0 = u.pm * 256 + wr * 64 + fr, col0 = u.pn * 256 + wc * 32 + 8 * fq;
#pragma unroll
    for (int ai = 0; ai < 2; ++ai) {
      uint4 gw[4][2], ov[4][2];
#pragma unroll
      for (int m = 0; m < 4; ++m)
#pragma unroll
        for (int bj = 0; bj < 2; ++bj) {
          gw[m][bj] = *(const uint4*)(st + ((ai * 2 + bj) * 4 + m) * 4096);
          ov[m][bj] = first ? make_uint4(0u, 0u, 0u, 0u) : *(const uint4*)(mix + (size_t)(row0 + ai * 128 + m * 16) * PS + col0 + bj * 128);
        }
#pragma unroll
      for (int m = 0; m < 4; ++m)
#pragma unroll
        for (int bj = 0; bj < 2; ++bj) {
          const uint4 g = gw[m][bj], o = ov[m][bj];
          const f32x4 a = acc[ai][bj][m][0], b = acc[ai][bj][m][1];
          const float v0 = lo2f(g.x) * a[0] + lo2f(o.x), v1 = hi2f(g.x) * a[1] + hi2f(o.x), v2 = lo2f(g.y) * a[2] + lo2f(o.y), v3 = hi2f(g.y) * a[3] + hi2f(o.y);
          const float v4 = lo2f(g.z) * b[0] + lo2f(o.z), v5 = hi2f(g.z) * b[1] + hi2f(o.z), v6 = lo2f(g.w) * b[2] + lo2f(o.w), v7 = hi2f(g.w) * b[3] + hi2f(o.w);
          *(uint4*)(mix + (size_t)(row0 + ai * 128 + m * 16) * PS + col0 + bj * 128) = make_uint4(pack2(v0, v1), pack2(v2, v3), pack2(v4, v5), pack2(v6, v7));
        }
    }
  }
};

template <class Epi, bool AFTER_DRAIN = false>
__device__ __forceinline__ void gemm_phase(LAS unsigned char* lds, const Gemm g, const Epi& E) {
  const int tid = tid_fresh(), wid = __builtin_amdgcn_readfirstlane(tid >> 6), lane = tid & 63, wr = wid >> 2, wc = wid & 3, fr = lane & 15, fq = lane >> 4;
  const int K = g.K, nt = K / G_BK;
  StaticOrder S; S.init(g.M, g.N, (int)gridDim.x, (int)blockIdx.x);
  unsigned voffA[2], voffB[2];
#pragma unroll
  for (int i = 0; i < 2; ++i) { int R, C; stage_rc(tid * 16 + i * 8192, R, C); const int Rb = Epi::PERM ? ((R & ~31) + perm32(R & 31)) : R;
    voffA[i] = (unsigned)(R * g.lda + C) * 2u; voffB[i] = (unsigned)(Rb * g.ldb + C) * 2u; }
  const size_t kstep = (size_t)(G_BK * 2);
  const size_t hstepA = (size_t)G_HALF * g.lda * 2, hstepB = (size_t)G_HALF * g.ldb * 2;
  const size_t tstepA = 2 * hstepA, tstepB = 2 * hstepB;
  const unsigned ldsw = (unsigned)wid * 1024u;
  const int aoff = lds_byte(wr * 64 + fr, fq * 8), boff = lds_byte(wc * 32 + fr, fq * 8);
#define PG8_SA(b, h) (((b) * 2 + (h)) * G_HTB)
#define PG8_SB(b, h) ((4 + (b) * 2 + (h)) * G_HTB)
#define PG8_STAGE(bufoff, gbase, voff) do { _Pragma("unroll") for (int _i = 0; _i < 2; ++_i) \
    __builtin_amdgcn_global_load_lds((const unsigned*)((const char*)(gbase) + (voff)[_i]), (LAS unsigned*)(lds + (bufoff) + ldsw + _i * 8192), 16, 0, 0); } while (0)
#define PG8_LDA(dst, b, h) do { _Pragma("unroll") for (int m = 0; m < 4; ++m) _Pragma("unroll") for (int k = 0; k < 2; ++k) dst[m][k] = *(const LAS bf16x8*)(lds + PG8_SA(b, h) + aoff + m * 2048 + k * 1024); } while (0)
#define PG8_LDB(dst, b, h) do { _Pragma("unroll") for (int n = 0; n < 2; ++n) _Pragma("unroll") for (int k = 0; k < 2; ++k) dst[n][k] = *(const LAS bf16x8*)(lds + PG8_SB(b, h) + boff + n * 2048 + k * 1024); } while (0)
#define PG8_MMA(ai, bj, At, Bt) do { __builtin_amdgcn_s_setprio(1); _Pragma("unroll") for (int m = 0; m < 4; ++m) _Pragma("unroll") for (int n = 0; n < 2; ++n) _Pragma("unroll") for (int k = 0; k < 2; ++k) \
    acc[ai][bj][m][n] = __builtin_amdgcn_mfma_f32_16x16x32_bf16(Bt[n][k], At[m][k], acc[ai][bj][m][n], 0, 0, 0); __builtin_amdgcn_s_setprio(0); } while (0)
#define PG8_WAIT_V(n) asm volatile("s_waitcnt vmcnt(" #n ")" ::: "memory")
#define PG8_WAIT_L(n) asm volatile("s_waitcnt lgkmcnt(" #n ")" ::: "memory")
#define PG8_BAR __builtin_amdgcn_s_barrier()
#define PG8_SCHED __builtin_amdgcn_sched_barrier(0)
  Unit cur, nxt; int ui = 0;
  if (!S.next(0, cur)) return;
  AccT acc;
#pragma unroll
  for (int a = 0; a < 2; ++a)
#pragma unroll
    for (int b = 0; b < 2; ++b)
#pragma unroll
      for (int m = 0; m < 4; ++m)
#pragma unroll
        for (int n = 0; n < 2; ++n) acc[a][b][m][n] = (f32x4){0.f, 0.f, 0.f, 0.f};
  bf16x8 At[4][2], B0[2][2], B1[2][2];
  const char* cA = (const char*)g.A + (size_t)cur.pm * tstepA; const char* cB = (const char*)g.Bt + (size_t)cur.pn * tstepB;
  PG8_STAGE(PG8_SB(0, 0), cB, voffB); PG8_STAGE(PG8_SA(0, 0), cA, voffA); PG8_STAGE(PG8_SB(0, 1), cB + hstepB, voffB); PG8_STAGE(PG8_SA(0, 1), cA + hstepA, voffA);
  if (wr == 1) PG8_BAR;
  PG8_WAIT_V(4); PG8_BAR;
  PG8_STAGE(PG8_SB(1, 0), cB + kstep, voffB); PG8_STAGE(PG8_SA(1, 0), cA + kstep, voffA); PG8_STAGE(PG8_SB(1, 1), cB + hstepB + kstep, voffB);
  PG8_WAIT_V(6); PG8_BAR;
  for (;;) {
    const bool has_next = S.next(ui + 1, nxt);
    const char* nA = has_next ? (const char*)g.A + (size_t)nxt.pm * tstepA : cA; const char* nB = has_next ? (const char*)g.Bt + (size_t)nxt.pn * tstepB : cB;
    for (int t = 0; t < nt; t += 2) {
      const bool last = (t == nt - 2);
      const char* a1 = cA + (size_t)(t + 1) * kstep;
      const char* a2 = last ? nA : cA + (size_t)(t + 2) * kstep; const char* b2 = last ? nB : cB + (size_t)(t + 2) * kstep;
      const char* a3 = a2 + kstep; const char* b3 = b2 + kstep;
      PG8_LDB(B0, 0, 0); PG8_SCHED; PG8_LDA(At, 0, 0); PG8_STAGE(PG8_SA(1, 1), a1 + hstepA, voffA);
      PG8_WAIT_L(8); PG8_BAR; PG8_WAIT_L(0); PG8_MMA(0, 0, At, B0); PG8_BAR; PG8_SCHED;
      PG8_LDB(B1, 0, 1); PG8_STAGE(PG8_SB(0, 0), b2, voffB);
      PG8_BAR; PG8_WAIT_L(0); PG8_MMA(0, 1, At, B1); PG8_BAR;
      PG8_LDA(At, 0, 1); PG8_STAGE(PG8_SA(0, 0), a2, voffA);
      PG8_BAR; PG8_WAIT_L(0); PG8_MMA(1, 0, At, B0); PG8_BAR; PG8_SCHED;
      PG8_STAGE(PG8_SB(0, 1), b2 + hstepB, voffB);
      PG8_WAIT_V(6); PG8_BAR; PG8_MMA(1, 1, At, B1); PG8_BAR;
      PG8_LDB(B0, 1, 0); PG8_SCHED; PG8_LDA(At, 1, 0); PG8_STAGE(PG8_SA(0, 1), a2 + hstepA, voffA);
      PG8_WAIT_L(8); PG8_BAR; PG8_WAIT_L(0); PG8_MMA(0, 0, At, B0); PG8_BAR; PG8_SCHED;
      PG8_LDB(B1, 1, 1); PG8_STAGE(PG8_SB(1, 0), b3, voffB);
      PG8_BAR; PG8_WAIT_L(0); PG8_MMA(0, 1, At, B1); PG8_BAR;
      PG8_LDA(At, 1, 1); PG8_STAGE(PG8_SA(1, 0), a3, voffA);
      PG8_BAR; PG8_WAIT_L(0); PG8_MMA(1, 0, At, B0); PG8_BAR; PG8_SCHED;
      PG8_STAGE(PG8_SB(1, 1), b3 + hstepB, voffB);
      PG8_WAIT_V(6); PG8_BAR; PG8_MMA(1, 1, At, B1); PG8_BAR;
    }
    if constexpr (!AFTER_DRAIN) E(acc, cur, wr, wc, fr, fq);
    if (!has_next) break;
#pragma unroll
    for (int a = 0; a < 2; ++a)
#pragma unroll
      for (int b = 0; b < 2; ++b)
#pragma unroll
        for (int m = 0; m < 4; ++m)
#pragma unroll
          for (int n = 0; n < 2; ++n) acc[a][b][m][n] = (f32x4){0.f, 0.f, 0.f, 0.f};
    cur = nxt; cA = nA; cB = nB; ++ui;
  }
  PG8_WAIT_V(0);
  if (wr == 0) PG8_BAR;
  PG8_BAR;
  if constexpr (AFTER_DRAIN) E.fused(acc, cur, wr, wc, fr, fq, lds);
#undef PG8_SA
#undef PG8_SB
#undef PG8_STAGE
#undef PG8_LDA
#undef PG8_LDB
#undef PG8_MMA
#undef PG8_WAIT_V
#undef PG8_WAIT_L
#undef PG8_BAR
#undef PG8_SCHED
}

struct ChainStep { const char* A; const char* B; unsigned lda2, ldb2; int nt; };
__device__ __forceinline__ ChainStep merge_step(const Params& p, int q, const Unit& u) {
  const int s6 = q % 6, br = s6 >> 1;
  ChainStep c;
  if ((s6 & 1) == 0) {
    c.A = (const char*)(p.H + (size_t)u.pm * 256 * 1024); c.lda2 = 2048u;
    c.B = (const char*)(p.wgt + (size_t)(br * 1024 + u.pn * 256) * 1024); c.ldb2 = 2048u; c.nt = 16;
  } else {
    const int ycol = br == 0 ? C_U : (br == 1 ? C_RG : C_NQ);
    c.A = (const char*)(p.BIG + ycol + (size_t)u.pm * 256 * PS); c.lda2 = (unsigned)PS * 2u;
    c.B = (const char*)(p.wbt + (size_t)(br * 1024 + u.pn * 256) * 512); c.ldb2 = 1024u; c.nt = 8;
  }
  return c;
}
__device__ __forceinline__ void gemm_merge_chain(LAS unsigned char* lds, const Params& p, int l) {
  const int tid = tid_fresh(), wid = __builtin_amdgcn_readfirstlane(tid >> 6), lane = tid & 63, wr = wid >> 2, wc = wid & 3, fr = lane & 15, fq = lane >> 4;
  StaticOrder S; S.init(16384, 1024, (int)gridDim.x, (int)blockIdx.x);
  unsigned rA[2], c2[2];
#pragma unroll
  for (int i = 0; i < 2; ++i) { int R, C; stage_rc(tid * 16 + i * 8192, R, C); rA[i] = (unsigned)R; c2[i] = (unsigned)C * 2u; }
  const size_t kstep = (size_t)(G_BK * 2);
  const unsigned ldsw = (unsigned)wid * 1024u;
  const int aoff = lds_byte(wr * 64 + fr, fq * 8), boff = lds_byte(wc * 32 + fr, fq * 8);
#define PG8_SA(b, h) (((b) * 2 + (h)) * G_HTB)
#define PG8_SB(b, h) ((4 + (b) * 2 + (h)) * G_HTB)
#define CH_ROW_rA(i) (rA[i])
#define CH_ROW_rB(i) ((rA[i] & ~31u) + (unsigned)perm32((int)(rA[i] & 31u)))
#define CH_STAGE(bufoff, gbase, rr, ld2) do { _Pragma("unroll") for (int _i = 0; _i < 2; ++_i) \
    __builtin_amdgcn_global_load_lds((const unsigned*)((const char*)(gbase) + (CH_ROW_##rr(_i) * (ld2) + c2[_i])), (LAS unsigned*)(lds + (bufoff) + ldsw + _i * 8192), 16, 0, 0); } while (0)
#define PG8_LDA(dst, b, h) do { _Pragma("unroll") for (int m = 0; m < 4; ++m) _Pragma("unroll") for (int k = 0; k < 2; ++k) dst[m][k] = *(const LAS bf16x8*)(lds + PG8_SA(b, h) + aoff + m * 2048 + k * 1024); } while (0)
#define PG8_LDB(dst, b, h) do { _Pragma("unroll") for (int n = 0; n < 2; ++n) _Pragma("unroll") for (int k = 0; k < 2; ++k) dst[n][k] = *(const LAS bf16x8*)(lds + PG8_SB(b, h) + boff + n * 2048 + k * 1024); } while (0)
#define PG8_MMA(ai, bj, At, Bt) do { __builtin_amdgcn_s_setprio(1); _Pragma("unroll") for (int m = 0; m < 4; ++m) _Pragma("unroll") for (int n = 0; n < 2; ++n) _Pragma("unroll") for (int k = 0; k < 2; ++k) \
    acc[ai][bj][m][n] = __builtin_amdgcn_mfma_f32_16x16x32_bf16(Bt[n][k], At[m][k], acc[ai][bj][m][n], 0, 0, 0); __builtin_amdgcn_s_setprio(0); } while (0)
#define PG8_WAIT_V(n) asm volatile("s_waitcnt vmcnt(" #n ")" ::: "memory")
#define PG8_WAIT_L(n) asm volatile("s_waitcnt lgkmcnt(" #n ")" ::: "memory")
#define PG8_BAR __builtin_amdgcn_s_barrier()
#define PG8_SCHED __builtin_amdgcn_sched_barrier(0)
  Unit cu, nu; int q = 0;
  if (!S.next(0, cu)) return;
  ChainStep cs = merge_step(p, 0, cu), ns;
  AccT acc;
#pragma unroll
  for (int a = 0; a < 2; ++a)
#pragma unroll
    for (int b = 0; b < 2; ++b)
#pragma unroll
      for (int m = 0; m < 4; ++m)
#pragma unroll
        for (int n = 0; n < 2; ++n) acc[a][b][m][n] = (f32x4){0.f, 0.f, 0.f, 0.f};
  bf16x8 At[4][2], B0[2][2], B1[2][2];
  {
    const size_t hA = (size_t)G_HALF * cs.lda2, hB = (size_t)G_HALF * cs.ldb2;
    CH_STAGE(PG8_SB(0, 0), cs.B, rB, cs.ldb2); CH_STAGE(PG8_SA(0, 0), cs.A, rA, cs.lda2); CH_STAGE(PG8_SB(0, 1), cs.B + hB, rB, cs.ldb2); CH_STAGE(PG8_SA(0, 1), cs.A + hA, rA, cs.lda2);
    if (wr == 1) PG8_BAR;
    PG8_WAIT_V(4); PG8_BAR;
    CH_STAGE(PG8_SB(1, 0), cs.B + kstep, rB, cs.ldb2); CH_STAGE(PG8_SA(1, 0), cs.A + kstep, rA, cs.lda2); CH_STAGE(PG8_SB(1, 1), cs.B + hB + kstep, rB, cs.ldb2);
    PG8_WAIT_V(6); PG8_BAR;
  }
  for (;;) {
    bool has_next;
    if ((q + 1) % 6 != 0) { nu = cu; has_next = true; } else has_next = S.next((q + 1) / 6, nu);
    ns = has_next ? merge_step(p, q + 1, nu) : cs;
    const size_t hA = (size_t)G_HALF * cs.lda2, hB = (size_t)G_HALF * cs.ldb2;
    const size_t nhA = (size_t)G_HALF * ns.lda2, nhB = (size_t)G_HALF * ns.ldb2;
    const int nt = cs.nt;
    for (int t = 0; t < nt; t += 2) {
      const bool last = (t == nt - 2);
      const char* a1 = cs.A + (size_t)(t + 1) * kstep;
      const char* a2 = last ? ns.A : cs.A + (size_t)(t + 2) * kstep; const char* b2 = last ? ns.B : cs.B + (size_t)(t + 2) * kstep;
      const char* a3 = a2 + kstep; const char* b3 = b2 + kstep;
      const unsigned la2 = last ? ns.lda2 : cs.lda2, lb2 = last ? ns.ldb2 : cs.ldb2;
      const size_t hA2 = last ? nhA : hA, hB2 = last ? nhB : hB;
      PG8_LDB(B0, 0, 0); PG8_SCHED; PG8_LDA(At, 0, 0); CH_STAGE(PG8_SA(1, 1), a1 + hA, rA, cs.lda2);
      PG8_WAIT_L(8); PG8_BAR; PG8_WAIT_L(0); PG8_MMA(0, 0, At, B0); PG8_BAR; PG8_SCHED;
      PG8_LDB(B1, 0, 1); CH_STAGE(PG8_SB(0, 0), b2, rB, lb2);
      PG8_BAR; PG8_WAIT_L(0); PG8_MMA(0, 1, At, B1); PG8_BAR;
      PG8_LDA(At, 0, 1); CH_STAGE(PG8_SA(0, 0), a2, rA, la2);
      PG8_BAR; PG8_WAIT_L(0); PG8_MMA(1, 0, At, B0); PG8_BAR; PG8_SCHED;
      CH_STAGE(PG8_SB(0, 1), b2 + hB2, rB, lb2);
      PG8_WAIT_V(6); PG8_BAR; PG8_MMA(1, 1, At, B1); PG8_BAR;
      PG8_LDB(B0, 1, 0); PG8_SCHED; PG8_LDA(At, 1, 0); CH_STAGE(PG8_SA(0, 1), a2 + hA2, rA, la2);
      PG8_WAIT_L(8); PG8_BAR; PG8_WAIT_L(0); PG8_MMA(0, 0, At, B0); PG8_BAR; PG8_SCHED;
      PG8_LDB(B1, 1, 1); CH_STAGE(PG8_SB(1, 0), b3, rB, lb2);
      PG8_BAR; PG8_WAIT_L(0); PG8_MMA(0, 1, At, B1); PG8_BAR;
      PG8_LDA(At, 1, 1); CH_STAGE(PG8_SA(1, 0), a3, rA, la2);
      PG8_BAR; PG8_WAIT_L(0); PG8_MMA(1, 0, At, B0); PG8_BAR; PG8_SCHED;
      CH_STAGE(PG8_SB(1, 1), b3 + hB2, rB, lb2);
      PG8_WAIT_V(6); PG8_BAR; PG8_MMA(1, 1, At, B1); PG8_BAR;
    }
    {
      const int s6 = q % 6, br = s6 >> 1;
      if ((s6 & 1) == 0) { EpiGate e{p.gst, p.b_gate + (size_t)l * 3072 + br * 1024, tid}; e(acc, cu, wr, wc, fr, fq); }
      else { EpiBranch e{p.gst, p.BIG + C_MIX, br == 0, tid}; e(acc, cu, wr, wc, fr, fq); }
    }
    if (!has_next) break;
#pragma unroll
    for (int a = 0; a < 2; ++a)
#pragma unroll
      for (int b = 0; b < 2; ++b)
#pragma unroll
        for (int m = 0; m < 4; ++m)
#pragma unroll
          for (int n = 0; n < 2; ++n) acc[a][b][m][n] = (f32x4){0.f, 0.f, 0.f, 0.f};
    cu = nu; cs = ns; ++q;
  }
  PG8_WAIT_V(0);
  if (wr == 0) PG8_BAR;
  PG8_BAR;
#undef PG8_SA
#undef PG8_SB
#undef CH_STAGE
#undef CH_ROW_rA
#undef CH_ROW_rB
#undef PG8_LDA
#undef PG8_LDB
#undef PG8_MMA
#undef PG8_WAIT_V
#undef PG8_WAIT_L
#undef PG8_BAR
#undef PG8_SCHED
}

__device__ __forceinline__ void gmlp_tile(const Params& p, int l, int tile, u16* smem) {
  const int c = tile >> 2, g = tile & 3, t0 = c * 128;
  u16* Ws = smem; u16* vT = smem + 128 * 136;
  const int tid = tid_fresh() & 255, lane = tid & 63, wave = tid >> 6, wm = wave >> 1, wn = wave & 1, lr = lane & 15, lq = lane >> 4;
  const int tok = tid >> 1, half = tid & 1;
  u16* prow = p.BIG + (size_t)(t0 + tok) * PS;
  float s = 0.f, ss = 0.f;
#pragma unroll 8
  for (int i = 0; i < 32; i++) {
    uint4 raw = *(const uint4*)(prow + C_V + half * 256 + i * 8);
    u32 w[4] = {raw.x, raw.y, raw.z, raw.w};
#pragma unroll
    for (int e = 0; e < 4; e++) { float a = gelu_t(lo2f(w[e])), b = gelu_t(hi2f(w[e])); s += a + b; ss += a * a + b * b; }
  }
  s += __shfl_xor(s, 1); ss += __shfl_xor(ss, 1);
  const float mean = s * (1.0f / 512.0f);
  const float rstd = rsqrtf(fmaxf(ss * (1.0f / 512.0f) - mean * mean, 0.f) + EPS);
  const float* lg = p.gm_ln_g + l * 512 + g * 128; const float* lb = p.gm_ln_b + l * 512 + g * 128;
#pragma unroll
  for (int i = 0; i < 8; i++) {
    uint4 raw = *(const uint4*)(prow + C_V + g * 128 + half * 64 + i * 8);
    u32 w[4] = {raw.x, raw.y, raw.z, raw.w};
#pragma unroll
    for (int e = 0; e < 4; e++) {
      int cc = half * 64 + i * 8 + 2 * e;
      vT[cc * 136 + tok] = f2bf((gelu_t(lo2f(w[e])) - mean) * rstd * lg[cc] + lb[cc]);
      vT[(cc + 1) * 136 + tok] = f2bf((gelu_t(hi2f(w[e])) - mean) * rstd * lg[cc + 1] + lb[cc + 1]);
    }
  }
  const float* wrow = p.gm_ws + ((size_t)(l * 4 + g) * 128 + tok) * 128 + half * 64;
#pragma unroll
  for (int i = 0; i < 16; i++) {
    float4 w = ((const float4*)wrow)[i];
    int s0 = half * 64 + i * 4;
    uint2 o = make_uint2(pack2(s0 <= tok ? w.x : 0.f, s0 + 1 <= tok ? w.y : 0.f), pack2(s0 + 2 <= tok ? w.z : 0.f, s0 + 3 <= tok ? w.w : 0.f));
    *(uint2*)(Ws + tok * 136 + s0) = o;
  }
  __syncthreads();
  f32x4 acc[4][4];
#pragma unroll
  for (int m = 0; m < 4; m++)
#pragma unroll
    for (int n = 0; n < 4; n++) acc[m][n] = (f32x4){0.f, 0.f, 0.f, 0.f};
#pragma unroll
  for (int kk = 0; kk < 4; kk++) {
    bf16x8 a[4], b[4];
#pragma unroll
    for (int m = 0; m < 4; m++) a[m] = ld8(Ws + (wm * 64 + m * 16 + lr) * 136 + kk * 32 + lq * 8);
#pragma unroll
    for (int n = 0; n < 4; n++) b[n] = ld8(vT + (wn * 64 + n * 16 + lr) * 136 + kk * 32 + lq * 8);
#pragma unroll
    for (int m = 0; m < 4; m++)
#pragma unroll
      for (int n = 0; n < 4; n++) acc[m][n] = mfma16(b[n], a[m], acc[m][n]);
  }
  const float* bsp = p.gm_bs + (size_t)(l * 4 + g) * 128;
  uint2 uv[4][4];
#pragma unroll
  for (int m = 0; m < 4; m++)
#pragma unroll
    for (int n = 0; n < 4; n++)
      uv[m][n] = *(const uint2*)(p.BIG + (size_t)(t0 + wm * 64 + m * 16 + lr) * PS + C_U + g * 128 + wn * 64 + n * 16 + lq * 4);
#pragma unroll
  for (int m = 0; m < 4; m++) {
    const float bias = bsp[wm * 64 + m * 16 + lr];
#pragma unroll
    for (int n = 0; n < 4; n++) {
      const uint2 u = uv[m][n];
      *(uint2*)(p.BIG + (size_t)(t0 + wm * 64 + m * 16 + lr) * PS + C_U + g * 128 + wn * 64 + n * 16 + lq * 4) =
          make_uint2(pack2(gelu_t(lo2f(u.x)) * (acc[m][n][0] + bias), gelu_t(hi2f(u.x)) * (acc[m][n][1] + bias)),
                     pack2(gelu_t(lo2f(u.y)) * (acc[m][n][2] + bias), gelu_t(hi2f(u.y)) * (acc[m][n][3] + bias)));
    }
  }
  __syncthreads();
}

__device__ __forceinline__ void ret_kv_tile(const Params& p, int tile, u16* smem) {
  const int c = tile >> 2, h = tile & 3, t0 = c * 128;
  u16* vT = smem; u16* kT = smem + 128 * 136;
  const int tid = tid_fresh() & 255, lane = tid & 63, wave = tid >> 6, lr = lane & 15, lq = lane >> 4;
  const int tok = tid >> 1, half = tid & 1;
  const float lg = logf(1.0f - exp2f(-5.0f - (float)h));
  const u16* prow = p.BIG + (size_t)(t0 + tok) * PS;
#pragma unroll
  for (int i = 0; i < 8; i++) {
    uint4 raw = *(const uint4*)(prow + C_RV + h * 128 + half * 64 + i * 8);
    u32 w[4] = {raw.x, raw.y, raw.z, raw.w};
#pragma unroll
    for (int e = 0; e < 4; e++) {
      int cc = half * 64 + i * 8 + 2 * e;
      vT[cc * 136 + tok] = (u16)(w[e] & 0xffff);
      vT[(cc + 1) * 136 + tok] = (u16)(w[e] >> 16);
    }
  }
  const float sc = 0.125f * expf(lg * (float)(127 - tok));
#pragma unroll
  for (int i = 0; i < 4; i++) {
    uint4 raw = *(const uint4*)(prow + C_RK + h * 64 + half * 32 + i * 8);
    u32 w[4] = {raw.x, raw.y, raw.z, raw.w};
#pragma unroll
    for (int e = 0; e < 4; e++) {
      int cc = half * 32 + i * 8 + 2 * e;
      kT[cc * 136 + tok] = f2bf(lo2f(w[e]) * sc);
      kT[(cc + 1) * 136 + tok] = f2bf(hi2f(w[e]) * sc);
    }
  }
  __syncthreads();
  f32x4 acc[2][4];
#pragma unroll
  for (int m = 0; m < 2; m++)
#pragma unroll
    for (int n = 0; n < 4; n++) acc[m][n] = (f32x4){0.f, 0.f, 0.f, 0.f};
#pragma unroll
  for (int kk = 0; kk < 4; kk++) {
    bf16x8 a[2], b[4];
#pragma unroll
    for (int m = 0; m < 2; m++) a[m] = ld8(vT + (wave * 32 + m * 16 + lr) * 136 + kk * 32 + lq * 8);
#pragma unroll
    for (int n = 0; n < 4; n++) b[n] = ld8(kT + (n * 16 + lr) * 136 + kk * 32 + lq * 8);
#pragma unroll
    for (int m = 0; m < 2; m++)
#pragma unroll
      for (int n = 0; n < 4; n++) acc[m][n] = mfma16(a[m], b[n], acc[m][n]);
  }
  float* rp = p.ret + (size_t)(c * 4 + h) * 8192;
#pragma unroll
  for (int m = 0; m < 2; m++)
#pragma unroll
    for (int n = 0; n < 4; n++)
#pragma unroll
      for (int j = 0; j < 4; j++) rp[(wave * 32 + m * 16 + lq * 4 + j) * 64 + n * 16 + lr] = acc[m][n][j];
  __syncthreads();
}
__device__ __forceinline__ void ret_scan_wg(const Params& p, unsigned char* sm) {
  const int tid = tid_fresh(), seg = tid >> 7, el = tid & 127;
  float* endv = (float*)sm;
  for (int e0 = blockIdx.x * 128; e0 < 32768; e0 += gridDim.x * 128) {
    const int h = e0 >> 13;
    const float cd = expf(logf(1.0f - exp2f(-5.0f - (float)h)) * 128.0f);
    const float cd2 = cd * cd, cd4 = cd2 * cd2, cd8 = cd4 * cd4, cd16 = cd8 * cd8, cd32 = cd16 * cd16;
    float* base = p.ret + (size_t)(seg * 32) * 32768 + e0 + el;
    float v[32];
#pragma unroll
    for (int i = 0; i < 32; i++) v[i] = base[(size_t)i * 32768];
    float st = 0.f;
#pragma unroll
    for (int i = 0; i < 32; i++) st = st * cd + v[i];
    endv[seg * 128 + el] = st;
    __syncthreads();
    float carry = 0.f;
    for (int s2 = 0; s2 < seg; s2++) carry = carry * cd32 + endv[s2 * 128 + el];
    __syncthreads();
    st = carry;
#pragma unroll
    for (int i = 0; i < 32; i++) { base[(size_t)i * 32768] = st; st = st * cd + v[i]; }
  }
}
__device__ __forceinline__ void ret_out_tile(const Params& p, int l, int tile, u16* smem) {
  const int c = tile >> 2, h = tile & 3, t0 = c * 128;
  u16* vT = smem;
  u16* kS = smem + 128 * 136;
  u16* pT = kS + 128 * 72;
  const int tid = tid_fresh() & 255, lane = tid & 63, wave = tid >> 6, lr = lane & 15, lq = lane >> 4;
  const int tok = tid >> 1, half = tid & 1;
  const float lg = logf(1.0f - exp2f(-5.0f - (float)h));
  {
    const u16* prow = p.BIG + (size_t)(t0 + tok) * PS;
#pragma unroll
    for (int i = 0; i < 8; i++) {
      uint4 raw = *(const uint4*)(prow + C_RV + h * 128 + half * 64 + i * 8);
      u32 w[4] = {raw.x, raw.y, raw.z, raw.w};
#pragma unroll
      for (int e = 0; e < 4; e++) {
        int cc = half * 64 + i * 8 + 2 * e;
        vT[cc * 136 + tok] = (u16)(w[e] & 0xffff);
        vT[(cc + 1) * 136 + tok] = (u16)(w[e] >> 16);
      }
    }
#pragma unroll
    for (int i = 0; i < 4; i++)
      *(uint4*)(kS + tok * 72 + half * 32 + i * 8) = *(const uint4*)(prow + C_RK + h * 64 + half * 32 + i * 8);
    const float* rp = p.ret + (size_t)(c * 4 + h) * 8192 + tok * 64 + half * 32;
#pragma unroll
    for (int i = 0; i < 4; i++) {
      float4 a = ((const float4*)rp)[2 * i], b = ((const float4*)rp)[2 * i + 1];
      *(uint4*)(pT + tok * 72 + half * 32 + i * 8) = make_uint4(pack2(a.x, a.y), pack2(a.z, a.w), pack2(b.x, b.y), pack2(b.z, b.w));
    }
  }
  __syncthreads();
#pragma unroll 1
  for (int it = 0; it < 2; it++) {
    const int i = wave * 32 + it * 16 + lr;
    const u16* qp = p.BIG + (size_t)(t0 + i) * PS + C_RQ + h * 64 + lq * 8;
    const bf16x8 q_lo = ld8(qp), q_hi = ld8(qp + 32);
    f32x4 Y[8];
#pragma unroll
    for (int e = 0; e < 8; e++) Y[e] = (f32x4){0.f, 0.f, 0.f, 0.f};
    const int nch = ((wave * 32 + it * 16 + 15) >> 5) + 1;
    for (int jc = 0; jc < nch; jc++) {
      f32x4 s0 = (f32x4){0.f, 0.f, 0.f, 0.f}, s1 = s0;
      const u16* kp = kS + (jc * 32 + lr) * 72 + lq * 8;
      s0 = mfma16(ld8(kp), q_lo, s0); s0 = mfma16(ld8(kp + 32), q_hi, s0);
      s1 = mfma16(ld8(kp + 16 * 72), q_lo, s1); s1 = mfma16(ld8(kp + 16 * 72 + 32), q_hi, s1);
      float pv[8];
#pragma unroll
      for (int j = 0; j < 4; j++) {
        int d0 = i - (jc * 32 + lq * 4 + j), d1 = d0 - 16;
        pv[j] = d0 >= 0 ? s0[j] * 0.125f * __expf(lg * (float)d0) : 0.f;
        pv[4 + j] = d1 >= 0 ? s1[j] * 0.125f * __expf(lg * (float)d1) : 0.f;
      }
      const bf16x8 pb = pk8(pv[0], pv[1], pv[2], pv[3], pv[4], pv[5], pv[6], pv[7]);
#pragma unroll
      for (int e = 0; e < 8; e++) {
        const u16* vp = vT + (e * 16 + lr) * 136 + jc * 32 + lq * 4;
        Y[e] = mfma16(ld44(vp, vp + 16), pb, Y[e]);
      }
    }
    {
      const float qd = __expf(lg * (float)(i + 1));
      const bf16x8 ql = scale8(q_lo, qd), qh = scale8(q_hi, qd);
#pragma unroll
      for (int e = 0; e < 8; e++) {
        const u16* pp = pT + (e * 16 + lr) * 72 + lq * 8;
        Y[e] = mfma16(ld8(pp), ql, Y[e]);
        Y[e] = mfma16(ld8(pp + 32), qh, Y[e]);
      }
    }
    float s = 0.f, ss = 0.f;
#pragma unroll
    for (int e = 0; e < 8; e++)
#pragma unroll
      for (int j = 0; j < 4; j++) { s += Y[e][j]; ss += Y[e][j] * Y[e][j]; }
    s += __shfl_xor(s, 16); ss += __shfl_xor(ss, 16);
    s += __shfl_xor(s, 32); ss += __shfl_xor(ss, 32);
    const float mean = s * (1.0f / 128.0f);
    const float rstd = rsqrtf(fmaxf(ss * (1.0f / 128.0f) - mean * mean, 0.f) + EPS);
    u16* gp = p.BIG + (size_t)(t0 + i) * PS + C_RG + h * 128;
    const float* gg = p.ret_gn_g + l * 512 + h * 128; const float* gb = p.ret_gn_b + l * 512 + h * 128;
    uint2 grawv[8];
#pragma unroll
    for (int e = 0; e < 8; e++) grawv[e] = *(const uint2*)(gp + e * 16 + lq * 4);
#pragma unroll
    for (int e = 0; e < 8; e++) {
      const int e0 = e * 16 + lq * 4;
      const uint2 graw = grawv[e];
      float4 g4 = *(const float4*)(gg + e0), b4 = *(const float4*)(gb + e0);
      float y0 = (Y[e][0] - mean) * rstd * g4.x + b4.x, y1 = (Y[e][1] - mean) * rstd * g4.y + b4.y;
      float y2 = (Y[e][2] - mean) * rstd * g4.z + b4.z, y3 = (Y[e][3] - mean) * rstd * g4.w + b4.w;
      *(uint2*)(gp + e0) = make_uint2(pack2(silu_f(lo2f(graw.x)) * y0, silu_f(hi2f(graw.x)) * y1),
                                      pack2(silu_f(lo2f(graw.y)) * y2, silu_f(hi2f(graw.y)) * y3));
    }
  }
  __syncthreads();
}

__device__ __forceinline__ void cmp_tile(const Params& p, int l, int tile, u16* smem) {
  const int which = tile >> 6, g = (tile >> 5) & 1, ci0 = (tile & 31) * 32;
  const int tid = tid_fresh() & 255, lane = tid & 63, wave = tid >> 6, lr = lane & 15, lq = lane >> 4;
  float* part = (float*)smem;
  u16* hid = smem + 32768;
  const int colbase = (which ? C_VC : C_KC) + g * 64;
  const float* pos = p.cmp_pos + (size_t)(l * 2 + which) * 32 * 64;
  const u16* w1t = p.cw1t + (size_t)which * 128 * 2048;
  f32x4 acc[2][8];
#pragma unroll
  for (int m = 0; m < 2; m++)
#pragma unroll
    for (int n = 0; n < 8; n++) acc[m][n] = (f32x4){0.f, 0.f, 0.f, 0.f};
  int cir0 = ci0 + lr, cir1 = ci0 + 16 + lr;
  if (cir0 > 1022) cir0 = 1022;
  if (cir1 > 1022) cir1 = 1022;
#pragma unroll 4
  for (int ks = 0; ks < 16; ks++) {
    const int kk = wave * 512 + ks * 32 + lq * 8, toff = kk >> 6, dim = kk & 63;
    const float4 p0 = *(const float4*)(pos + toff * 64 + dim), p1 = *(const float4*)(pos + toff * 64 + dim + 4);
    bf16x8 a[2], b[8];
#pragma unroll
    for (int m = 0; m < 2; m++) {
      const int cr = m == 0 ? cir0 : cir1;
      uint4 raw = *(const uint4*)(p.BIG + (size_t)(cr * 16 + toff) * PS + colbase + dim);
      a[m] = pk8(lo2f(raw.x) + p0.x, hi2f(raw.x) + p0.y, lo2f(raw.y) + p0.z, hi2f(raw.y) + p0.w,
                 lo2f(raw.z) + p1.x, hi2f(raw.z) + p1.y, lo2f(raw.w) + p1.z, hi2f(raw.w) + p1.w);
    }
#pragma unroll
    for (int n = 0; n < 8; n++) b[n] = ld8(w1t + (size_t)(n * 16 + lr) * 2048 + kk);
#pragma unroll
    for (int m = 0; m < 2; m++)
#pragma unroll
      for (int n = 0; n < 8; n++) acc[m][n] = mfma16(a[m], b[n], acc[m][n]);
  }
#pragma unroll
  for (int m = 0; m < 2; m++)
#pragma unroll
    for (int n = 0; n < 8; n++)
#pragma unroll
      for (int j = 0; j < 4; j++) part[wave * 4096 + (m * 16 + lq * 4 + j) * 128 + n * 16 + lr] = acc[m][n][j];
  __syncthreads();
  for (int e = tid; e < 4096; e += 256) {
    const float v = part[e] + part[4096 + e] + part[8192 + e] + part[12288 + e];
    hid[e] = f2bf(gelu_t(v));
  }
  __syncthreads();
  f32x4 o[2] = {(f32x4){0.f, 0.f, 0.f, 0.f}, (f32x4){0.f, 0.f, 0.f, 0.f}};
  const u16* w2t = p.cw2t + (size_t)which * 64 * 128;
#pragma unroll
  for (int kk = 0; kk < 4; kk++) {
    bf16x8 bb = ld8(w2t + (wave * 16 + lr) * 128 + kk * 32 + lq * 8);
#pragma unroll
    for (int m = 0; m < 2; m++) o[m] = mfma16(ld8(hid + (m * 16 + lr) * 128 + kk * 32 + lq * 8), bb, o[m]);
  }
#pragma unroll
  for (int m = 0; m < 2; m++)
#pragma unroll
    for (int j = 0; j < 4; j++) {
      int ci = ci0 + m * 16 + lq * 4 + j, d = wave * 16 + lr;
      u16 v = ci < 1023 ? f2bf(o[m][j]) : (u16)0;
      if (which == 0) p.kc[(size_t)(g * 1024 + ci) * 64 + d] = v;
      else p.vcT[(size_t)(g * 64 + d) * 1024 + ci] = v;
    }
  __syncthreads();
}
__device__ __forceinline__ void vt_tile(const Params& p, int tile, u16* smem) {
  const int sw = tile >> 9, g = (tile >> 8) & 1, t0 = (tile & 255) * 64;
  const int tid = tid_fresh() & 255;
  u16* T = smem;
  const int col = (sw ? C_VW : C_VS) + g * 64;
  {
    const int tok = tid >> 2, dq = (tid & 3) * 16;
    const u16* src = p.BIG + (size_t)(t0 + tok) * PS + col + dq;
    uint4 r0 = *(const uint4*)src, r1 = *(const uint4*)(src + 8);
    u32 w[8] = {r0.x, r0.y, r0.z, r0.w, r1.x, r1.y, r1.z, r1.w};
#pragma unroll
    for (int e = 0; e < 8; e++) { T[(dq + 2 * e) * 72 + tok] = (u16)(w[e] & 0xffff); T[(dq + 2 * e + 1) * 72 + tok] = (u16)(w[e] >> 16); }
  }
  __syncthreads();
  {
    const int d = tid >> 2, tq = (tid & 3) * 16;
    u16* dst = (sw ? p.vwT : p.vsT) + (size_t)(g * 64 + d) * S + t0 + tq;
    *(uint4*)dst = *(const uint4*)(T + d * 72 + tq);
    *(uint4*)(dst + 8) = *(const uint4*)(T + d * 72 + tq + 8);
  }
  __syncthreads();
}

constexpr int NT_ST = 72;
constexpr int NT_EL = 64 * NT_ST;
__device__ __forceinline__ float quad_sum(float x) {
  x += __uint_as_float((u32)__builtin_amdgcn_mov_dpp((int)__float_as_uint(x), 0xB1, 0xF, 0xF, true));
  x += __uint_as_float((u32)__builtin_amdgcn_mov_dpp((int)__float_as_uint(x), 0x4E, 0xF, 0xF, true));
  return x;
}
__device__ __forceinline__ void qk64(const u16* kt, int lr, int lq, bf16x8 q_lo, bf16x8 q_hi, f32x4 (&s)[2][2]) {
#pragma unroll
  for (int c = 0; c < 2; c++)
#pragma unroll
    for (int t = 0; t < 2; t++) {
      const u16* kp = kt + (c * 32 + t * 16 + lr) * NT_ST + lq * 8;
      f32x4 a = s[c][t];
      a = mfma16(ld8(kp), q_lo, a); a = mfma16(ld8(kp + 32), q_hi, a);
      s[c][t] = a;
    }
}
__device__ __forceinline__ float ex2(float x) { return __builtin_amdgcn_exp2f(x); }
template <bool FAST>
__device__ __forceinline__ void attend_tile(const u16* kt, const u16* vt, int lr, int lq, bf16x8 q_lo, bf16x8 q_hi, float slope2, int dbase,
                                            bool rowsel, int win, float& m, float& lsum, f32x4 (&O)[4]) {
  f32x4 s[2][2];
  float sv[16];
  float mx = -1e30f;
  if (FAST) {
    const float binit = rowsel ? -slope2 * (float)(dbase - lq * 4) : -1e30f;
#pragma unroll
    for (int c = 0; c < 2; c++)
#pragma unroll
      for (int t = 0; t < 2; t++)
#pragma unroll
        for (int j = 0; j < 4; j++) s[c][t][j] = __builtin_fmaf(slope2, (float)(c * 32 + t * 16 + j), binit);
    qk64(kt, lr, lq, q_lo, q_hi, s);
#pragma unroll
    for (int c = 0; c < 2; c++)
#pragma unroll
      for (int t = 0; t < 2; t++)
#pragma unroll
        for (int j = 0; j < 4; j++) { sv[(c * 2 + t) * 4 + j] = s[c][t][j]; mx = fmaxf(mx, s[c][t][j]); }
  } else {
#pragma unroll
    for (int c = 0; c < 2; c++)
#pragma unroll
      for (int t = 0; t < 2; t++) s[c][t] = (f32x4){0.f, 0.f, 0.f, 0.f};
    qk64(kt, lr, lq, q_lo, q_hi, s);
#pragma unroll
    for (int c = 0; c < 2; c++)
#pragma unroll
      for (int t = 0; t < 2; t++)
#pragma unroll
        for (int j = 0; j < 4; j++) {
          const int d = dbase - (c * 32 + t * 16 + lq * 4 + j);
          const bool o = rowsel && d >= 0 && d < win;
          const float v = o ? s[c][t][j] - slope2 * (float)d : -1e30f;
          sv[(c * 2 + t) * 4 + j] = v;
          mx = fmaxf(mx, v);
        }
  }
  if (__any(mx > m)) {
    mx = fmaxf(mx, __shfl_xor(mx, 16)); mx = fmaxf(mx, __shfl_xor(mx, 32));
    const float mnew = fmaxf(m, mx);
    const float alpha = ex2(m - mnew);
    m = mnew;
    lsum *= alpha;
#pragma unroll
    for (int dt = 0; dt < 4; dt++)
#pragma unroll
      for (int j = 0; j < 4; j++) O[dt][j] *= alpha;
  }
  const float mn = m;
  float ps = 0.f;
  bf16x8 pb[2];
#pragma unroll
  for (int c = 0; c < 2; c++) {
    float pv[8];
#pragma unroll
    for (int j = 0; j < 8; j++) {
      const float v = sv[c * 8 + j];
      pv[j] = FAST ? ex2(v - mn) : (v > -1e29f ? ex2(v - mn) : 0.f);
      ps += pv[j];
    }
    pb[c] = pk8(pv[0], pv[1], pv[2], pv[3], pv[4], pv[5], pv[6], pv[7]);
  }
  lsum += ps;
#pragma unroll
  for (int dt = 0; dt < 4; dt++)
#pragma unroll
    for (int c = 0; c < 2; c++) {
      const u16* vp = vt + (dt * 16 + lr) * NT_ST + c * 32 + lq * 4;
      O[dt] = mfma16(ld44(vp, vp + 16), pb[c], O[dt]);
    }
}

template <bool HASV, class KS, class VS, class CF>
__device__ __forceinline__ void tile_pipe2(int n, u16* ktb, u16* vtb, int soff, KS ksrc, VS vsrc, CF compute) {
  uint4 kE, vE, kO, vO;
  kE = vE = kO = vO = make_uint4(0u, 0u, 0u, 0u);
  if (n > 0) { kE = *(const uint4*)ksrc(0); if (HASV) vE = *(const uint4*)vsrc(0); }
  if (n > 1) { kO = *(const uint4*)ksrc(1); if (HASV) vO = *(const uint4*)vsrc(1); }
  if (n > 0) { *(uint4*)(ktb + soff) = kE; if (HASV) *(uint4*)(vtb + soff) = vE; }
  __syncthreads();
#pragma unroll 1
  for (int i = 0; i < n; i += 2) {
    if (i + 2 < n) { kE = *(const uint4*)ksrc(i + 2); if (HASV) vE = *(const uint4*)vsrc(i + 2); }
    compute(i, ktb, vtb);
    if (i + 1 < n) { *(uint4*)(ktb + NT_EL + soff) = kO; if (HASV) *(uint4*)(vtb + NT_EL + soff) = vO; }
    __syncthreads();
    if (i + 1 >= n) break;
    if (i + 3 < n) { kO = *(const uint4*)ksrc(i + 3); if (HASV) vO = *(const uint4*)vsrc(i + 3); }
    compute(i + 1, ktb + NT_EL, vtb + NT_EL);
    if (i + 2 < n) { *(uint4*)(ktb + soff) = kE; if (HASV) *(uint4*)(vtb + soff) = vE; }
    __syncthreads();
  }
}

__device__ __forceinline__ void nsa_wg(const Params& p, int g, int T0, unsigned char* sm) {
  const int tid = tid_fresh(), lane = tid & 63, lr = lane & 15, lq = lane >> 4;
  const int wv = __builtin_amdgcn_readfirstlane(tid >> 6);
  const int t0 = T0 + wv * 4;
  const int tok = lr >> 2, r = lr & 3, tpos = t0 + tok;
  const float slope = 1.4426950408889634f * exp2f(-(float)(g * 4 + r + 1));
  u16* proj = p.BIG;
  float* wl = (float*)sm + wv * 2112;
  float* impA = wl; float* impB = wl + 1024; u32* selm = (u32*)(wl + 1024 + 1040);
  u16* ktb = (u16*)(sm + 67584);
  u16* vtb = ktb + 2 * NT_EL;
  u32* wgm = (u32*)(vtb + 2 * NT_EL);
  u32* wgu = wgm + 64;
  int* blist = (int*)(wgu + 8);
  const int srow = tid >> 3, sseg = (tid & 7) * 8;
  const int soff = srow * NT_ST + sseg;
  bf16x8 q_lo, q_hi;
  {
    const u16* qp = proj + (size_t)tpos * PS + C_NQ + (g * 4 + r) * 64 + lq * 8;
    q_lo = scale8(ld8(qp), 0.125f * 1.4426950408889634f); q_hi = scale8(ld8(qp + 32), 0.125f * 1.4426950408889634f);
  }
  float g0, g1, g2;
  {
    const u16* gp = proj + (size_t)tpos * PS + C_NG + (g * 4 + r) * 3;
    g0 = sigm_f(bf2f(gp[0])); g1 = sigm_f(bf2f(gp[1])); g2 = sigm_f(bf2f(gp[2]));
  }
  f32x4 outacc[4];
#pragma unroll
  for (int dt = 0; dt < 4; dt++) outacc[dt] = (f32x4){0.f, 0.f, 0.f, 0.f};
  const int cur = T0 >> 6;

  for (int i = lane; i < 1024 + 1040; i += 64) wl[i] = 0.f;
  {
    const int ncmp = (T0 + 31 >= 31) ? ((T0 + 31 - 31) >> 4) + 1 : 0;
    const int nst = (ncmp + 63) >> 6;
    const u16* ksrc = p.kc + (size_t)g * 1024 * 64 + (size_t)srow * 64 + sseg;
    const u16* vsrc = p.vcT + (size_t)(g * 64 + srow) * 1024 + sseg;
    float m = -1e30f, lsum = 0.f;
    tile_pipe2<false>(nst, ktb, vtb, soff,
      [&](int i) { return ksrc + (size_t)(nst - 1 - i) * 4096; }, [&](int i) { return ksrc; },
      [&](int i, const u16* kt, const u16* vt) {
        const int st = nst - 1 - i;
        f32x4 s[2][2];
        float sv[16]; float mx = -1e30f;
        const bool fast = t0 - 31 - 16 * (st * 64 + 63) >= 0;
        if (fast) {
          const float binit = -slope * (float)(tpos - 31 - 16 * (st * 64 + lq * 4)), slope16 = slope * 16.0f;
#pragma unroll
          for (int c = 0; c < 2; c++)
#pragma unroll
            for (int t = 0; t < 2; t++)
#pragma unroll
              for (int j = 0; j < 4; j++) s[c][t][j] = __builtin_fmaf(slope16, (float)(c * 32 + t * 16 + j), binit);
          qk64(kt, lr, lq, q_lo, q_hi, s);
#pragma unroll
          for (int c = 0; c < 2; c++)
#pragma unroll
            for (int t = 0; t < 2; t++)
#pragma unroll
              for (int j = 0; j < 4; j++) { sv[(c * 2 + t) * 4 + j] = s[c][t][j]; mx = fmaxf(mx, s[c][t][j]); }
        } else {
#pragma unroll
          for (int c = 0; c < 2; c++)
#pragma unroll
            for (int t = 0; t < 2; t++) s[c][t] = (f32x4){0.f, 0.f, 0.f, 0.f};
          qk64(kt, lr, lq, q_lo, q_hi, s);
#pragma unroll
          for (int c = 0; c < 2; c++)
#pragma unroll
            for (int t = 0; t < 2; t++)
#pragma unroll
              for (int j = 0; j < 4; j++) {
                const int ci = st * 64 + c * 32 + t * 16 + lq * 4 + j;
                const int d = tpos - (ci * 16 + 31);
                const float v = d >= 0 ? s[c][t][j] - slope * (float)d : -1e30f;
                sv[(c * 2 + t) * 4 + j] = v; mx = fmaxf(mx, v);
              }
        }
        if (__any(mx > m)) {
          mx = fmaxf(mx, __shfl_xor(mx, 16)); mx = fmaxf(mx, __shfl_xor(mx, 32));
          const float mnew = fmaxf(m, mx);
          lsum *= ex2(m - mnew);
          m = mnew;
        }
        const float mn = m;
        float ps = 0.f;
        if (fast) {
#pragma unroll
          for (int j = 0; j < 16; j++) ps += ex2(sv[j] - mn);
        } else {
#pragma unroll
          for (int j = 0; j < 16; j++) ps += sv[j] > -1e29f ? ex2(sv[j] - mn) : 0.f;
        }
        lsum += ps;
      });
    lsum += __shfl_xor(lsum, 16); lsum += __shfl_xor(lsum, 32);
    const float invL = lsum > 0.f ? 1.0f / lsum : 0.f;
    f32x4 O[4];
#pragma unroll
    for (int dt = 0; dt < 4; dt++) O[dt] = (f32x4){0.f, 0.f, 0.f, 0.f};
    tile_pipe2<true>(nst, ktb, vtb, soff,
      [&](int st) { return ksrc + (size_t)st * 4096; }, [&](int st) { return vsrc + st * 64; },
      [&](int st, const u16* kt, const u16* vt) {
        f32x4 s[2][2];
        const bool fast = t0 - 31 - 16 * (st * 64 + 63) >= 0;
        if (fast) {
          const float binit = -slope * (float)(tpos - 31 - 16 * (st * 64 + lq * 4)) - m, slope16 = slope * 16.0f;
#pragma unroll
          for (int c = 0; c < 2; c++)
#pragma unroll
            for (int t = 0; t < 2; t++)
#pragma unroll
              for (int j = 0; j < 4; j++) s[c][t][j] = __builtin_fmaf(slope16, (float)(c * 32 + t * 16 + j), binit);
        } else {
#pragma unroll
          for (int c = 0; c < 2; c++)
#pragma unroll
            for (int t = 0; t < 2; t++) s[c][t] = (f32x4){0.f, 0.f, 0.f, 0.f};
        }
        qk64(kt, lr, lq, q_lo, q_hi, s);
        bf16x8 pb[2];
#pragma unroll
        for (int c = 0; c < 2; c++) {
          float p0[4], p1[4];
          if (fast) {
#pragma unroll
            for (int j = 0; j < 4; j++) { p0[j] = ex2(s[c][0][j]) * invL; p1[j] = ex2(s[c][1][j]) * invL; }
          } else {
#pragma unroll
            for (int j = 0; j < 4; j++) {
              const int ci = st * 64 + c * 32 + lq * 4 + j;
              const int d0 = tpos - (ci * 16 + 31), d1 = d0 - 256;
              p0[j] = d0 >= 0 ? ex2(s[c][0][j] - slope * (float)d0 - m) * invL : 0.f;
              p1[j] = d1 >= 0 ? ex2(s[c][1][j] - slope * (float)d1 - m) * invL : 0.f;
            }
          }
          float a0 = p0[0] + p0[1] + p0[2] + p0[3], b0 = p0[3], a1 = p1[0] + p1[1] + p1[2] + p1[3], b1 = p1[3];
          a0 = quad_sum(a0); b0 = quad_sum(b0); a1 = quad_sum(a1); b1 = quad_sum(b1);
          if (r == 0) {
            const int J0 = st * 16 + c * 8 + lq;
            impA[tok * 256 + J0] = a0; impB[tok * 260 + J0 + 1] = b0;
            impA[tok * 256 + J0 + 4] = a1; impB[tok * 260 + J0 + 5] = b1;
          }
          pb[c] = pk8(p0[0], p0[1], p0[2], p0[3], p1[0], p1[1], p1[2], p1[3]);
        }
#pragma unroll
        for (int dt = 0; dt < 4; dt++)
#pragma unroll
          for (int c = 0; c < 2; c++) {
            const u16* vp = vt + (dt * 16 + lr) * NT_ST + c * 32 + lq * 4;
            O[dt] = mfma16(ld44(vp, vp + 16), pb[c], O[dt]);
          }
      });
#pragma unroll
    for (int dt = 0; dt < 4; dt++)
#pragma unroll
      for (int j = 0; j < 4; j++) outacc[dt][j] += g0 * O[dt][j];
  }
  wave_lds_sync();

  if (cur < 16) {
    if (lane < 32) selm[lane] = ((lane & 7) == 0) ? ((2u << cur) - 1u) : 0u;
  } else {
    u32 kk[4][4];
#pragma unroll
    for (int tk = 0; tk < 4; tk++) {
      const float* ia = impA + tk * 256; const float* ib = impB + tk * 260;
#pragma unroll
      for (int i = 0; i < 4; i++) {
        const int j = lane + 64 * i;
        kk[tk][i] = (j >= 1 && j <= cur - 2) ? __float_as_uint(ia[j] + ib[j]) + 1u : 0u;
      }
    }
    u32 T[4] = {0u, 0u, 0u, 0u};
#pragma unroll 1
    for (int bit = 30; bit >= 0; bit--) {
#pragma unroll
      for (int tk = 0; tk < 4; tk++) {
        const u32 t = T[tk] | (1u << bit);
        const int cnt = __popcll(__ballot(kk[tk][0] >= t)) + __popcll(__ballot(kk[tk][1] >= t)) + __popcll(__ballot(kk[tk][2] >= t)) + __popcll(__ballot(kk[tk][3] >= t));
        if (cnt >= 13) T[tk] = t;
      }
    }
#pragma unroll
    for (int tk = 0; tk < 4; tk++) {
      const u32 k0 = kk[tk][0], k1 = kk[tk][1], k2 = kk[tk][2], k3 = kk[tk][3], Tt = T[tk];
      int need = 13 - (__popcll(__ballot(k0 > Tt)) + __popcll(__ballot(k1 > Tt)) + __popcll(__ballot(k2 > Tt)) + __popcll(__ballot(k3 > Tt)));
      u64 sel0, sel1, sel2, sel3;
      {
        u64 e = __ballot(k0 == Tt); int below = __builtin_amdgcn_mbcnt_hi((u32)(e >> 32), __builtin_amdgcn_mbcnt_lo((u32)e, 0u));
        sel0 = __ballot(k0 > Tt || (k0 == Tt && below < need)); need -= min(need, (int)__popcll(e));
        e = __ballot(k1 == Tt); below = __builtin_amdgcn_mbcnt_hi((u32)(e >> 32), __builtin_amdgcn_mbcnt_lo((u32)e, 0u));
        sel1 = __ballot(k1 > Tt || (k1 == Tt && below < need)); need -= min(need, (int)__popcll(e));
        e = __ballot(k2 == Tt); below = __builtin_amdgcn_mbcnt_hi((u32)(e >> 32), __builtin_amdgcn_mbcnt_lo((u32)e, 0u));
        sel2 = __ballot(k2 > Tt || (k2 == Tt && below < need)); need -= min(need, (int)__popcll(e));
        e = __ballot(k3 == Tt); below = __builtin_amdgcn_mbcnt_hi((u32)(e >> 32), __builtin_amdgcn_mbcnt_lo((u32)e, 0u));
        sel3 = __ballot(k3 > Tt || (k3 == Tt && below < need));
      }
      u32 myword = 0;
      if (lane == 0) myword = (u32)sel0; else if (lane == 1) myword = (u32)(sel0 >> 32);
      else if (lane == 2) myword = (u32)sel1; else if (lane == 3) myword = (u32)(sel1 >> 32);
      else if (lane == 4) myword = (u32)sel2; else if (lane == 5) myword = (u32)(sel2 >> 32);
      else if (lane == 6) myword = (u32)sel3; else if (lane == 7) myword = (u32)(sel3 >> 32);
      if (lane == 0) myword |= 1u;
      if (lane == ((cur - 1) >> 5)) myword |= 1u << ((cur - 1) & 31);
      if (lane == (cur >> 5)) myword |= 1u << (cur & 31);
      if (lane < 8) selm[tk * 8 + lane] = myword;
    }
  }
  wave_lds_sync();
  if (lane < 8) wgm[wv * 8 + lane] = selm[lane] | selm[8 + lane] | selm[16 + lane] | selm[24 + lane];
  __syncthreads();
  if (tid < 8) {
    u32 u = 0;
#pragma unroll
    for (int w = 0; w < 8; w++) u |= wgm[w * 8 + tid];
    const int lim = cur - tid * 32;
    if (lim < 0) u = 0; else if (lim < 31) u &= (2u << lim) - 1u;
    wgu[tid] = u;
  }
  __syncthreads();
  if (tid < 256) {
    const int w = tid >> 5, b = tid & 31;
    int idx = 0;
#pragma unroll
    for (int ww = 0; ww < 8; ww++) { const u32 x = wgu[ww]; idx += ww < w ? __builtin_popcount(x) : 0; }
    const u32 x = wgu[w];
    idx += __builtin_popcount(x & ((1u << b) - 1u));
    if ((x >> b) & 1u) blist[idx] = tid;
  }
  if (tid == 0) {
    int n = 0;
#pragma unroll
    for (int ww = 0; ww < 8; ww++) n += __builtin_popcount(wgu[ww]);
    blist[256] = n;
  }
  __syncthreads();

  {
    const int nblk = blist[256];
    const u16* ksrc = proj + C_KS + g * 64 + (size_t)srow * PS + sseg;
    const u16* vsrc = p.vsT + (size_t)(g * 64 + srow) * S + sseg;
    float m = -1e30f, lsum = 0.f;
    f32x4 O[4];
#pragma unroll
    for (int dt = 0; dt < 4; dt++) O[dt] = (f32x4){0.f, 0.f, 0.f, 0.f};
    tile_pipe2<true>(nblk, ktb, vtb, soff,
      [&](int i) { return ksrc + (size_t)blist[nblk - 1 - i] * 64 * PS; }, [&](int i) { return vsrc + blist[nblk - 1 - i] * 64; },
      [&](int i, const u16* kt, const u16* vt) {
        const int jb = blist[nblk - 1 - i];
        const u32 wany = wgm[wv * 8 + (jb >> 5)];
        if ((wany >> (jb & 31)) & 1u) {
          const bool rowsel = (selm[tok * 8 + (jb >> 5)] >> (jb & 31)) & 1u;
          if (jb < cur) attend_tile<true>(kt, vt, lr, lq, q_lo, q_hi, slope, tpos - jb * 64, rowsel, 1 << 30, m, lsum, O);
          else attend_tile<false>(kt, vt, lr, lq, q_lo, q_hi, slope, tpos - jb * 64, rowsel, 1 << 30, m, lsum, O);
        }
      });
    lsum += __shfl_xor(lsum, 16); lsum += __shfl_xor(lsum, 32);
    const float sc = g1 / fmaxf(lsum, 1e-30f);
#pragma unroll
    for (int dt = 0; dt < 4; dt++)
#pragma unroll
      for (int j = 0; j < 4; j++) outacc[dt][j] += sc * O[dt][j];
  }
  {
    int ks = T0 - 511; if (ks < 0) ks = 0; ks &= ~63;
    const int nst = ((T0 + 31 - ks) >> 6) + 1;
    const u16* ksrc = proj + C_KW + g * 64 + (size_t)(ks + srow) * PS + sseg;
    const u16* vsrc = p.vwT + (size_t)(g * 64 + srow) * S + ks + sseg;
    float m = -1e30f, lsum = 0.f;
    f32x4 O[4];
#pragma unroll
    for (int dt = 0; dt < 4; dt++) O[dt] = (f32x4){0.f, 0.f, 0.f, 0.f};
    tile_pipe2<true>(nst, ktb, vtb, soff,
      [&](int st) { return ksrc + (size_t)(nst - 1 - st) * 64 * PS; }, [&](int st) { return vsrc + (nst - 1 - st) * 64; },
      [&](int st, const u16* kt, const u16* vt) {
        const int kp0 = ks + (nst - 1 - st) * 64;
        if (t0 - (kp0 + 63) >= 0 && t0 + 3 - kp0 < 512) attend_tile<true>(kt, vt, lr, lq, q_lo, q_hi, slope, tpos - kp0, true, 512, m, lsum, O);
        else attend_tile<false>(kt, vt, lr, lq, q_lo, q_hi, slope, tpos - kp0, true, 512, m, lsum, O);
      });
    lsum += __shfl_xor(lsum, 16); lsum += __shfl_xor(lsum, 32);
    const float sc = g2 / fmaxf(lsum, 1e-30f);
#pragma unroll
    for (int dt = 0; dt < 4; dt++)
#pragma unroll
      for (int j = 0; j < 4; j++) outacc[dt][j] += sc * O[dt][j];
  }
  {
    u16* op = proj + (size_t)tpos * PS + C_NQ + (g * 4 + r) * 64 + lq * 4;
#pragma unroll
    for (int dt = 0; dt < 4; dt++)
      *(uint2*)(op + dt * 16) = make_uint2(pack2(outacc[dt][0], outacc[dt][1]), pack2(outacc[dt][2], outacc[dt][3]));
  }
  __syncthreads();
}

#define XB_TMO      128
#define XB_XCNT(j)  (256  + 64 * (j))
#define XB_XSUB(j)  (1280 + 64 * (j))
#define XB_XGEN(j)  (2304 + 64 * (j))
#define XB_TOP      3328
#define XB_TOPGEN   3392
#define XCD_BAR_WORDS 3456
#define XB_SPIN_CAP (1u << 18)
__device__ __forceinline__ unsigned xb_ld(unsigned* p)              { return __hip_atomic_load(p, __ATOMIC_RELAXED, __HIP_MEMORY_SCOPE_AGENT); }
__device__ __forceinline__ unsigned xb_add(unsigned* p, unsigned v) { return __hip_atomic_fetch_add(p, v, __ATOMIC_RELAXED, __HIP_MEMORY_SCOPE_AGENT); }
__device__ __forceinline__ unsigned xb_xcc_id() { return (unsigned)__builtin_amdgcn_s_getreg((3 << 11) | 20) & 0xFu; }
#define XB_SPIN(cond, bar) do { unsigned _sp = 0; while (cond) { __builtin_amdgcn_s_sleep(1); \
    if ((++_sp & 255u) == 0u) { if (xb_ld(&(bar)[XB_TMO])) break; if (_sp > XB_SPIN_CAP) { atomicAdd(&(bar)[XB_TMO], 1u); break; } } } } while (0)
struct XcdBarrier { unsigned* bar; unsigned x; volatile __attribute__((address_space(3))) unsigned* st; };
__device__ __forceinline__ XcdBarrier xcd_barrier_post(unsigned* bar, volatile __attribute__((address_space(3))) unsigned* st) {
  XcdBarrier b; b.bar = bar; b.x = xb_xcc_id(); b.st = st;
  if (threadIdx.x == 0) (void)xb_add(&bar[XB_XCNT(b.x)], 1u);
  return b;
}
__device__ __forceinline__ void xcd_barrier_complete(unsigned* bar, unsigned x, unsigned& nloc, unsigned& nx) {
  const unsigned G = gridDim.x * gridDim.y * gridDim.z;
  unsigned sum, cnt, mine, sp = 0u;
  for (;;) {
    sum = 0u; cnt = 0u; mine = 0u;
#pragma unroll
    for (unsigned j = 0; j < 16; ++j) { const unsigned c = xb_ld(&bar[XB_XCNT(j)]); sum += c; cnt += (c > 0u) ? 1u : 0u; mine = (j == x) ? c : mine; }
    if (sum == G) break;
    __builtin_amdgcn_s_sleep(1);
    if ((++sp & 255u) == 0u) { if (xb_ld(&bar[XB_TMO])) break; if (sp > XB_SPIN_CAP) { atomicAdd(&bar[XB_TMO], 1u); break; } }
  }
  nloc = mine > 0u ? mine : 1u; nx = cnt > 0u ? cnt : 1u;
}
__device__ __forceinline__ void xcd_barrier(const XcdBarrier& b) {
  asm volatile("s_waitcnt vmcnt(0)" ::: "memory");
  __syncthreads();
  if (threadIdx.x == 0) {
    unsigned* bar = b.bar;
    __builtin_amdgcn_s_waitcnt(0);
    unsigned nloc = b.st[0], nx = b.st[1];
    if (nloc == 0u) { xcd_barrier_complete(bar, b.x, nloc, nx); b.st[0] = nloc; b.st[1] = nx; }
    const unsigned old = xb_add(&bar[XB_XSUB(b.x)], 1u);
    const unsigned gen = old / nloc;
    if (old + 1u == (gen + 1u) * nloc) {
      __builtin_amdgcn_fence(__ATOMIC_RELEASE, "agent");
      asm volatile("s_waitcnt vmcnt(0)" ::: "memory");
      const unsigned og = xb_add(&bar[XB_TOP], 1u);
      const unsigned tg = og / nx;
      if (og + 1u == (tg + 1u) * nx) xb_add(&bar[XB_TOPGEN], 1u);
      else XB_SPIN(xb_ld(&bar[XB_TOPGEN]) == tg, bar);
      __builtin_amdgcn_fence(__ATOMIC_ACQUIRE, "agent");
      xb_add(&bar[XB_XGEN(b.x)], 1u);
      asm volatile("s_waitcnt vmcnt(0)" ::: "memory");
    } else {
      XB_SPIN(xb_ld(&bar[XB_XGEN(b.x)]) == gen, bar);
      __builtin_amdgcn_fence(__ATOMIC_ACQUIRE, "agent");
      asm volatile("s_waitcnt vmcnt(0)" ::: "memory");
    }
  }
  __syncthreads();
}

template <bool FINAL>
struct EpiResidNorm {
  static constexpr bool PERM = false;
  const float* xsrc; float* xdst; float scale; const float* gnext; u16* Hout; float* part; unsigned* cnt; unsigned* tmo;
  __device__ __forceinline__ void fused(AccT& acc, const Unit& u, int wr, int wc, int fr, int fq, LAS unsigned char* lds) const {
    volatile LAS float* ps = (volatile LAS float*)(lds + 131072);
    volatile LAS float* rr = (volatile LAS float*)(lds + 131072 + 4096);
    const int tid = tid_fresh();
    const int row0 = u.pm * 256 + wr * 64 + fr, col0 = u.pn * 256 + wc * 32 + 4 * fq;
#pragma unroll
    for (int ai = 0; ai < 2; ++ai) {
      f32x4 xv[4][2][2];
#pragma unroll
      for (int m = 0; m < 4; ++m)
#pragma unroll
        for (int bj = 0; bj < 2; ++bj)
#pragma unroll
          for (int n = 0; n < 2; ++n)
            xv[m][bj][n] = *(const f32x4*)(xsrc + (size_t)(row0 + ai * 128 + m * 16) * 1024 + col0 + bj * 128 + n * 16);
#pragma unroll
      for (int m = 0; m < 4; ++m) {
        float ss = 0.f;
#pragma unroll
        for (int bj = 0; bj < 2; ++bj)
#pragma unroll
          for (int n = 0; n < 2; ++n) {
            const f32x4 v = xv[m][bj][n] + scale * acc[ai][bj][m][n];
            if (!FINAL) *(f32x4*)(xdst + (size_t)(row0 + ai * 128 + m * 16) * 1024 + col0 + bj * 128 + n * 16) = v;
            acc[ai][bj][m][n] = v;
            ss += v[0] * v[0] + v[1] * v[1] + v[2] * v[2] + v[3] * v[3];
          }
        ss += __shfl_xor(ss, 16); ss += __shfl_xor(ss, 32);
        if (fq == 0) ps[wc * 256 + ai * 128 + wr * 64 + m * 16 + fr] = ss;
      }
    }
    __syncthreads();
    if (tid < 256) __hip_atomic_store(part + (size_t)(u.pm * 4 + u.pn) * 256 + tid, ps[tid] + ps[256 + tid] + ps[512 + tid] + ps[768 + tid], __ATOMIC_RELAXED, __HIP_MEMORY_SCOPE_AGENT);
    asm volatile("s_waitcnt vmcnt(0)" ::: "memory");
    __syncthreads();
    if (tid == 0) {
      (void)xb_add(cnt + u.pm, 1u);
      XB_SPIN(xb_ld(cnt + u.pm) < 4u, tmo);
      __builtin_amdgcn_fence(__ATOMIC_ACQUIRE, "agent");
      asm volatile("s_waitcnt vmcnt(0)" ::: "memory");
    }
    __syncthreads();
    if (tid < 256) {
      const float* pp = part + (size_t)(u.pm * 4) * 256 + tid;
      const float t0 = __hip_atomic_load(pp, __ATOMIC_RELAXED, __HIP_MEMORY_SCOPE_AGENT), t1 = __hip_atomic_load(pp + 256, __ATOMIC_RELAXED, __HIP_MEMORY_SCOPE_AGENT);
      const float t2 = __hip_atomic_load(pp + 512, __ATOMIC_RELAXED, __HIP_MEMORY_SCOPE_AGENT), t3 = __hip_atomic_load(pp + 768, __ATOMIC_RELAXED, __HIP_MEMORY_SCOPE_AGENT);
      rr[tid] = rsqrtf(((t0 + t1) + (t2 + t3)) * (1.0f / 1024.0f) + EPS);
    }
    __syncthreads();
    f32x4 gv[2][2];
#pragma unroll
    for (int bj = 0; bj < 2; ++bj)
#pragma unroll
      for (int n = 0; n < 2; ++n) gv[bj][n] = *(const f32x4*)(gnext + col0 + bj * 128 + n * 16);
#pragma unroll
    for (int ai = 0; ai < 2; ++ai)
#pragma unroll
      for (int m = 0; m < 4; ++m) {
        const float r = rr[ai * 128 + wr * 64 + m * 16 + fr];
#pragma unroll
        for (int bj = 0; bj < 2; ++bj)
#pragma unroll
          for (int n = 0; n < 2; ++n) {
            const f32x4 h = acc[ai][bj][m][n] * r * gv[bj][n];
            if (FINAL) *(f32x4*)(xdst + (size_t)(row0 + ai * 128 + m * 16) * 1024 + col0 + bj * 128 + n * 16) = h;
            else *(uint2*)(Hout + (size_t)(row0 + ai * 128 + m * 16) * 1024 + col0 + bj * 128 + n * 16) = make_uint2(pack2(h[0], h[1]), pack2(h[2], h[3]));
          }
      }
    __syncthreads();
  }
};

constexpr int SMEM_TOTAL = 147456;
__global__ void __launch_bounds__(512, 2) mega(Params p) {
  cg::grid_group grid = cg::this_grid();
  __shared__ __attribute__((aligned(16))) unsigned char smem_raw[SMEM_TOTAL + 16];
  LAS unsigned char* glds = (LAS unsigned char*)smem_raw;
  volatile LAS unsigned* xb_words = (volatile LAS unsigned*)(glds + SMEM_TOTAL);
  if (threadIdx.x == 0) { xb_words[0] = 0u; xb_words[1] = 0u; }
  if (blockIdx.x == 0) { for (int i = threadIdx.x; i < XCD_BAR_WORDS; i += 512) p.bar[i] = 0u; if (threadIdx.x < 384) p.ncnt[threadIdx.x] = 0u; }
  __syncthreads();
  XcdBarrier xb; xb.bar = p.bar; xb.x = 0; xb.st = xb_words;
#define VB_SETUP const int _tf = tid_fresh(); const int half = __builtin_amdgcn_readfirstlane(_tf >> 8); const int nb = gridDim.x * 2, bid = blockIdx.x * 2 + half; \
  u16* smem = (u16*)(smem_raw + half * SMEM_BYTES); const int vwave = __builtin_amdgcn_readfirstlane((_tf & 255) >> 6); (void)vwave; (void)nb; (void)bid; (void)smem;
#pragma unroll 1
  for (int l = 0; l < 2; l++) {
    const float* xsrc = l == 0 ? p.x_in : p.xout;
    const bool fusedn = gridDim.x == 256;
    if (l == 0 || !fusedn) norm_phase(xsrc, p.ffn1_norm + l * 1024, p.H);
    { VB_SETUP wprep_phase(p, l, smem, bid, nb); }
    if (l == 0) { grid.sync(); xb = xcd_barrier_post(p.bar, xb_words); } else xcd_barrier(xb);
    { Gemm g{p.H, p.w1t_a, 1024, 1024, S, 5632, 1024}; EpiSwiglu e{p.BIG}; gemm_phase(glds, g, e); }
    xcd_barrier(xb);
    if (fusedn) {
      Gemm g{p.BIG, p.w2t_a, FF, FF, S, 1024, FF};
      EpiResidNorm<false> e{xsrc, p.xout, 0.5f, p.mix_norm + l * 1024, p.H, p.part + (size_t)(l * 2) * 65536, p.ncnt + (l * 2) * 64, p.bar};
      gemm_phase<EpiResidNorm<false>, true>(glds, g, e);
      xcd_barrier(xb);
    } else {
      { Gemm g{p.BIG, p.w2t_a, FF, FF, S, 1024, FF}; EpiResid e{xsrc, p.xout, 0.5f}; gemm_phase(glds, g, e); }
      xcd_barrier(xb);
      norm_phase(p.xout, p.mix_norm + l * 1024, p.H);
      xcd_barrier(xb);
    }
    { Gemm g{p.H, p.wint, 1024, 1024, S, 4096, 1024}; EpiProj e{p.BIG}; gemm_phase(glds, g, e); }
    xcd_barrier(xb);
    { VB_SETUP
    if (nb == 512) {
      if (bid < 128) { cmp_tile(p, l, bid, smem); ret_kv_tile(p, bid, smem); ret_kv_tile(p, 128 + bid, smem); }
      else {
        const int h2 = bid - 128;
        gmlp_tile(p, l, h2, smem);
        if (h2 < 128) { gmlp_tile(p, l, 384 + h2, smem); vt_tile(p, h2, smem); }
        else {
          const int ci = h2 - 128;
          ret_kv_tile(p, 256 + ci, smem);
          vt_tile(p, 128 + ci * 3, smem); vt_tile(p, 129 + ci * 3, smem); vt_tile(p, 130 + ci * 3, smem);
          if (ci < 128) vt_tile(p, 896 + ci, smem);
        }
      }
    } else {
    for (int t = bid; t < 128 + 512 + 512 + 1024; t += nb) {
      if (t < 128) cmp_tile(p, l, t, smem);
      else if (t < 640) gmlp_tile(p, l, t - 128, smem);
      else if (t < 1152) ret_kv_tile(p, t - 640, smem);
      else vt_tile(p, t - 1152, smem);
    } } }
    xcd_barrier(xb);
    {
      const int tf = tid_fresh();
      const int wv = __builtin_amdgcn_readfirstlane(tf >> 6);
      ret_scan_wg(p, smem_raw);
      const int xcd = blockIdx.x & 7, slot = blockIdx.x >> 3, nslot = gridDim.x >> 3;
      for (int i = slot; i < 128; i += nslot) {
        const int rsel = i >> 6, j = i & 63;
        const int range = rsel == 0 ? 15 - xcd : xcd;
        const int g = (j ^ (j >> 5)) & 1, w = range * 32 + 31 - (j >> 1);
        nsa_wg(p, g, w * 32, smem_raw);
      }
    }
    xcd_barrier(xb);
    { VB_SETUP for (int t = bid; t < 512; t += nb) ret_out_tile(p, l, t, smem); }
    xcd_barrier(xb);
    gemm_merge_chain(glds, p, l);
    xcd_barrier(xb);
    if (fusedn) {
      Gemm g{p.BIG + C_MIX, p.wot, PS, 1024, S, 1024, 1024};
      EpiResidNorm<false> e{p.xout, p.xout, 1.0f, p.ffn2_norm + l * 1024, p.H, p.part + (size_t)(l * 2 + 1) * 65536, p.ncnt + (l * 2 + 1) * 64, p.bar};
      gemm_phase<EpiResidNorm<false>, true>(glds, g, e);
      xcd_barrier(xb);
    } else {
      { Gemm g{p.BIG + C_MIX, p.wot, PS, 1024, S, 1024, 1024}; EpiResid e{p.xout, p.xout, 1.0f}; gemm_phase(glds, g, e); }
      xcd_barrier(xb);
      norm_phase(p.xout, p.ffn2_norm + l * 1024, p.H);
      xcd_barrier(xb);
    }
    { Gemm g{p.H, p.w1t_b, 1024, 1024, S, 5632, 1024}; EpiSwiglu e{p.BIG}; gemm_phase(glds, g, e); }
    xcd_barrier(xb);
    if (fusedn && l == 0) {
      Gemm g{p.BIG, p.w2t_b, FF, FF, S, 1024, FF};
      EpiResidNorm<false> e{p.xout, p.xout, 0.5f, p.ffn1_norm + 1024, p.H, p.part + (size_t)4 * 65536, p.ncnt + 4 * 64, p.bar};
      gemm_phase<EpiResidNorm<false>, true>(glds, g, e);
      xcd_barrier(xb);
    } else if (fusedn) {
      Gemm g{p.BIG, p.w2t_b, FF, FF, S, 1024, FF};
      EpiResidNorm<true> e{p.xout, p.xout, 0.5f, p.final_norm, p.H, p.part + (size_t)5 * 65536, p.ncnt + 5 * 64, p.bar};
      gemm_phase<EpiResidNorm<true>, true>(glds, g, e);
    } else {
      { Gemm g{p.BIG, p.w2t_b, FF, FF, S, 1024, FF}; EpiResid e{p.xout, p.xout, 0.5f}; gemm_phase(glds, g, e); }
      xcd_barrier(xb);
      if (l == 1) final_norm_phase(p.xout, p.final_norm);
    }
  }
}

extern "C" void kernel_launch(void* const* d_in, const int* in_sizes, int n_in, void* d_out, int out_size, void* d_ws,
                              size_t ws_size, hipStream_t stream) {
  static int grid_blocks = 0;
  if (!grid_blocks) {
    int dev = 0, cus = 0, per_cu = 0;
    (void)hipGetDevice(&dev);
    (void)hipDeviceGetAttribute(&cus, hipDeviceAttributeMultiprocessorCount, dev);
    (void)hipOccupancyMaxActiveBlocksPerMultiprocessor(&per_cu, mega, 512, 0);
    if (per_cu > 1) per_cu = 1;
    if (per_cu < 1) per_cu = 1;
    grid_blocks = cus * per_cu;
    grid_blocks &= ~7;
  }
  Params p{};
  p.x_in = (const float*)d_in[0];
  p.ffn1_norm = (const float*)d_in[1]; p.ffn1_w1 = (const float*)d_in[2]; p.ffn1_w2 = (const float*)d_in[3];
  p.mix_norm = (const float*)d_in[4]; p.w_in = (const float*)d_in[5]; p.gm_ln_g = (const float*)d_in[6];
  p.gm_ln_b = (const float*)d_in[7]; p.gm_ws = (const float*)d_in[8]; p.gm_bs = (const float*)d_in[9];
  p.ret_gn_g = (const float*)d_in[10]; p.ret_gn_b = (const float*)d_in[11]; p.cmp_pos = (const float*)d_in[12];
  p.cmp_w1 = (const float*)d_in[13]; p.cmp_w2 = (const float*)d_in[14]; p.w_branch = (const float*)d_in[15];
  p.w_gate = (const float*)d_in[16]; p.b_gate = (const float*)d_in[17]; p.w_o = (const float*)d_in[18];
  p.ffn2_norm = (const float*)d_in[19]; p.ffn2_w1 = (const float*)d_in[20]; p.ffn2_w2 = (const float*)d_in[21];
  p.final_norm = (const float*)d_in[22];
  p.xout = (float*)d_out;
  char* w = (char*)d_ws;
  auto take = [&](size_t bytes) { char* r = w; w += (bytes + 255) & ~(size_t)255; return r; };
  p.w1t_a = (u16*)take((size_t)5632 * 1024 * 2);
  p.w1t_b = (u16*)take((size_t)5632 * 1024 * 2);
  p.w2t_a = (u16*)take((size_t)1024 * FF * 2);
  p.w2t_b = (u16*)take((size_t)1024 * FF * 2);
  p.wint = (u16*)take((size_t)4096 * 1024 * 2);
  p.wgt = (u16*)take((size_t)3072 * 1024 * 2);
  p.wbt = (u16*)take((size_t)3 * 1024 * 512 * 2);
  p.wot = (u16*)take((size_t)1024 * 1024 * 2);
  p.cw1t = (u16*)take((size_t)2 * 128 * 2048 * 2);
  p.cw2t = (u16*)take((size_t)2 * 64 * 128 * 2);
  p.H = (u16*)take((size_t)S * 1024 * 2);
  p.BIG = (u16*)take((size_t)S * PS * 2);
  p.vsT = (u16*)take((size_t)2 * 64 * S * 2);
  p.vwT = (u16*)take((size_t)2 * 64 * S * 2);
  p.kc = (u16*)take((size_t)2 * 1024 * 64 * 2);
  p.vcT = (u16*)take((size_t)2 * 64 * 1024 * 2);
  p.ret = (float*)take((size_t)128 * 4 * 8192 * 4);
  p.gst = (u16*)take((size_t)256 * 65536 * 2);
  p.bar = (unsigned*)take((size_t)XCD_BAR_WORDS * 4);
  p.part = (float*)take((size_t)6 * 64 * 4 * 256 * 4);
  p.ncnt = (unsigned*)take((size_t)6 * 64 * 4);
  if ((size_t)(w - (char*)d_ws) > ws_size) { fprintf(stderr, "workspace too small: need %zu have %zu\n", (size_t)(w - (char*)d_ws), ws_size); return; }
  void* args[] = {&p};
  hipError_t e = hipLaunchCooperativeKernel((void*)mega, dim3(grid_blocks), dim3(512), args, 0, stream);
  if (e != hipSuccess) fprintf(stderr, "coop launch failed: %s (grid %d)\n", hipGetErrorString(e), grid_blocks);
}
```

```cpp
#include <hip/hip_runtime.h>
#include <hip/hip_cooperative_groups.h>
#include <cstdio>
#include <cstdint>
namespace cg = cooperative_groups;

typedef unsigned short u16;
typedef unsigned int u32;
typedef unsigned long long u64;
using bf16x8 = __attribute__((ext_vector_type(8))) short;
using bf16x4 = __attribute__((ext_vector_type(4))) short;
using f32x4 = __attribute__((ext_vector_type(4))) float;

constexpr int S = 16384, FF = 2816, DIN = 3864;
constexpr int PS = 3968;
constexpr int C_U = 0, C_V = 512, C_RQ = 1024, C_RK = 1280, C_RV = 1536, C_RG = 2048, C_NQ = 2560,
              C_KC = 3072, C_VC = 3200, C_KS = 3328, C_VS = 3456, C_KW = 3584, C_VW = 3712, C_NG = 3840, C_MIX = 512;
constexpr float EPS = 1e-6f;
constexpr int SMEM_BYTES = 73728;

struct Params {
  const float* x_in;
  const float *ffn1_norm, *ffn1_w1, *ffn1_w2, *mix_norm, *w_in, *gm_ln_g, *gm_ln_b, *gm_ws, *gm_bs, *ret_gn_g, *ret_gn_b,
      *cmp_pos, *cmp_w1, *cmp_w2, *w_branch, *w_gate, *b_gate, *w_o, *ffn2_norm, *ffn2_w1, *ffn2_w2, *final_norm;
  float* xout;
  u16 *w1t_a, *w2t_a, *wint, *wgt, *wbt, *wot, *w1t_b, *w2t_b, *cw1t, *cw2t;
  u16 *H, *BIG, *vsT, *vwT, *kc, *vcT;
  float* ret;
  u16* gst;
  unsigned* bar;
  float* part; unsigned* ncnt;
};

__device__ __forceinline__ u16 f2bf(float f) { __bf16 b = (__bf16)f; return __builtin_bit_cast(u16, b); }
__device__ __forceinline__ float bf2f(u16 h) { return __uint_as_float(((u32)h) << 16); }
typedef __bf16 bf16x2_t __attribute__((ext_vector_type(2)));
typedef float f32x2_t __attribute__((ext_vector_type(2)));
__device__ __forceinline__ u32 pack2(float a, float b) { f32x2_t v = {a, b}; bf16x2_t r = __builtin_convertvector(v, bf16x2_t); return __builtin_bit_cast(u32, r); }
__device__ __forceinline__ float lo2f(u32 w) { return __uint_as_float(w << 16); }
__device__ __forceinline__ float hi2f(u32 w) { return __uint_as_float(w & 0xffff0000u); }
__device__ __forceinline__ float gelu_t(float x) { float y = 1.5957691216057308f * (x + 0.044715f * x * x * x); return x * __builtin_amdgcn_rcpf(1.0f + __expf(-y)); }
__device__ __forceinline__ float silu_f(float x) { return x * __builtin_amdgcn_rcpf(1.0f + __expf(-x)); }
__device__ __forceinline__ float sigm_f(float x) { return __builtin_amdgcn_rcpf(1.0f + __expf(-x)); }
__device__ __forceinline__ f32x4 mfma16(bf16x8 a, bf16x8 b, f32x4 c) { return __builtin_amdgcn_mfma_f32_16x16x32_bf16(a, b, c, 0, 0, 0); }
__device__ __forceinline__ bf16x8 ld8(const u16* p) { return *(const bf16x8*)p; }
__device__ __forceinline__ bf16x8 ld44(const u16* p0, const u16* p1) {
  bf16x4 a = *(const bf16x4*)p0, b = *(const bf16x4*)p1;
  return __builtin_shufflevector(a, b, 0, 1, 2, 3, 4, 5, 6, 7);
}
__device__ __forceinline__ bf16x8 pk8(float a0, float a1, float a2, float a3, float a4, float a5, float a6, float a7) {
  union { uint4 u; bf16x8 v; } x;
  x.u = make_uint4(pack2(a0, a1), pack2(a2, a3), pack2(a4, a5), pack2(a6, a7));
  return x.v;
}
__device__ __forceinline__ bf16x8 scale8(bf16x8 v, float s) {
  union { uint4 u; bf16x8 v; } x; x.v = v;
  x.u.x = pack2(lo2f(x.u.x) * s, hi2f(x.u.x) * s); x.u.y = pack2(lo2f(x.u.y) * s, hi2f(x.u.y) * s);
  x.u.z = pack2(lo2f(x.u.z) * s, hi2f(x.u.z) * s); x.u.w = pack2(lo2f(x.u.w) * s, hi2f(x.u.w) * s);
  return x.v;
}
__device__ __forceinline__ void wave_lds_sync() { asm volatile("s_waitcnt lgkmcnt(0)" ::: "memory"); }

__device__ __forceinline__ int tid_fresh() { int t = threadIdx.x; asm volatile("" : "+v"(t)); return t; }
__device__ __forceinline__ int wmap(int n, int mode) {
  if (mode == 0) return n;
  int isb = n >= FF; int nn = isb ? n - FF : n;
  return (nn >> 4) * 32 + isb * 16 + (nn & 15);
}
__device__ __forceinline__ void wprep_matrix(const float* __restrict__ src, u16* __restrict__ dst, int K, int N, int mode, u16* smem, int vb, int nvb) {
  float* T = (float*)smem;
  const int tid = tid_fresh() & 255;
  const int tk = K >> 6, tn = (N + 63) >> 6, nt = tk * tn;
  for (int t = vb; t < nt; t += nvb) {
    const int k0 = (t % tk) * 64, n0 = (t / tk) * 64;
#pragma unroll
    for (int i = 0; i < 4; i++) {
      int kk = (tid >> 4) + 16 * i, n = n0 + (tid & 15) * 4;
      float4 v = make_float4(0.f, 0.f, 0.f, 0.f);
      if (n < N) v = *(const float4*)(src + (size_t)(k0 + kk) * N + n);
      float* tp = T + kk * 65 + (tid & 15) * 4;
      tp[0] = v.x; tp[1] = v.y; tp[2] = v.z; tp[3] = v.w;
    }
    __syncthreads();
    {
      int n = tid >> 2, kc = (tid & 3) * 16, nn = n0 + n;
      if (nn < N) {
        u32 w[8];
#pragma unroll
        for (int e = 0; e < 8; e++) w[e] = pack2(T[(kc + 2 * e) * 65 + n], T[(kc + 2 * e + 1) * 65 + n]);
        u16* dp = dst + (size_t)wmap(nn, mode) * K + k0 + kc;
        *(uint4*)dp = make_uint4(w[0], w[1], w[2], w[3]);
        *(uint4*)(dp + 8) = make_uint4(w[4], w[5], w[6], w[7]);
      }
    }
    __syncthreads();
  }
}
__device__ __forceinline__ void wprep_phase(const Params& p, int l, u16* smem, int vb, int nvb, bool skip_ffn1) {
  if (!skip_ffn1) wprep_matrix(p.ffn1_w1 + (size_t)l * 1024 * 5632, p.w1t_a, 1024, 5632, 1, smem, vb, nvb);
  wprep_matrix(p.ffn2_w1 + (size_t)l * 1024 * 5632, p.w1t_b, 1024, 5632, 1, smem, vb, nvb);
  if (!skip_ffn1) wprep_matrix(p.ffn1_w2 + (size_t)l * FF * 1024, p.w2t_a, FF, 1024, 0, smem, vb, nvb);
  wprep_matrix(p.ffn2_w2 + (size_t)l * FF * 1024, p.w2t_b, FF, 1024, 0, smem, vb, nvb);
  wprep_matrix(p.w_in + (size_t)l * 1024 * DIN, p.wint, 1024, DIN, 0, smem, vb, nvb);
  wprep_matrix(p.w_gate + (size_t)l * 1024 * 3072, p.wgt, 1024, 3072, 0, smem, vb, nvb);
  for (int m = 0; m < 3; m++)
    wprep_matrix(p.w_branch + (size_t)(l * 3 + m) * 512 * 1024, p.wbt + (size_t)m * 1024 * 512, 512, 1024, 0, smem, vb, nvb);
  wprep_matrix(p.w_o + (size_t)l * 1024 * 1024, p.wot, 1024, 1024, 0, smem, vb, nvb);
  for (int w = 0; w < 2; w++) {
    wprep_matrix(p.cmp_w1 + (size_t)(l * 2 + w) * 2048 * 128, p.cw1t + (size_t)w * 128 * 2048, 2048, 128, 0, smem, vb, nvb);
    wprep_matrix(p.cmp_w2 + (size_t)(l * 2 + w) * 128 * 64, p.cw2t + (size_t)w * 64 * 128, 128, 64, 0, smem, vb, nvb);
  }
}

__device__ __forceinline__ void norm_phase(const float* __restrict__ x, const float* __restrict__ g, u16* __restrict__ H) {
  const int tidf = tid_fresh();
  const int lane = tidf & 63;
  const int gw = blockIdx.x * 8 + (tidf >> 6), nw = gridDim.x * 8;
  float4 gg[4];
#pragma unroll
  for (int i = 0; i < 4; i++) gg[i] = ((const float4*)g)[lane + 64 * i];
  for (int row0 = gw * 4; row0 < S; row0 += nw * 4) {
    float4 v[4][4]; float ss[4];
#pragma unroll
    for (int rr = 0; rr < 4; rr++)
#pragma unroll
      for (int i = 0; i < 4; i++) v[rr][i] = ((const float4*)(x + (size_t)(row0 + rr) * 1024))[lane + 64 * i];
#pragma unroll
    for (int rr = 0; rr < 4; rr++) {
      float a = 0.f;
#pragma unroll
      for (int i = 0; i < 4; i++) a += v[rr][i].x * v[rr][i].x + v[rr][i].y * v[rr][i].y + v[rr][i].z * v[rr][i].z + v[rr][i].w * v[rr][i].w;
      ss[rr] = a;
    }
#pragma unroll
    for (int o = 32; o >= 1; o >>= 1)
#pragma unroll
      for (int rr = 0; rr < 4; rr++) ss[rr] += __shfl_xor(ss[rr], o);
#pragma unroll
    for (int rr = 0; rr < 4; rr++) {
      const float r = rsqrtf(ss[rr] * (1.0f / 1024.0f) + EPS);
#pragma unroll
      for (int i = 0; i < 4; i++) {
        uint2 o2 = make_uint2(pack2(v[rr][i].x * r * gg[i].x, v[rr][i].y * r * gg[i].y), pack2(v[rr][i].z * r * gg[i].z, v[rr][i].w * r * gg[i].w));
        *(uint2*)(H + (size_t)(row0 + rr) * 1024 + (lane + 64 * i) * 4) = o2;
      }
    }
  }
}
__device__ __forceinline__ void final_norm_phase(float* __restrict__ x, const float* __restrict__ g) {
  const int tidf = tid_fresh();
  const int lane = tidf & 63;
  const int gw = blockIdx.x * 8 + (tidf >> 6), nw = gridDim.x * 8;
  float4 gg[4];
#pragma unroll
  for (int i = 0; i < 4; i++) gg[i] = ((const float4*)g)[lane + 64 * i];
  for (int row0 = gw * 4; row0 < S; row0 += nw * 4) {
    float4 v[4][4]; float ss[4];
#pragma unroll
    for (int rr = 0; rr < 4; rr++)
#pragma unroll
      for (int i = 0; i < 4; i++) v[rr][i] = ((const float4*)(x + (size_t)(row0 + rr) * 1024))[lane + 64 * i];
#pragma unroll
    for (int rr = 0; rr < 4; rr++) {
      float a = 0.f;
#pragma unroll
      for (int i = 0; i < 4; i++) a += v[rr][i].x * v[rr][i].x + v[rr][i].y * v[rr][i].y + v[rr][i].z * v[rr][i].z + v[rr][i].w * v[rr][i].w;
      ss[rr] = a;
    }
#pragma unroll
    for (int o = 32; o >= 1; o >>= 1)
#pragma unroll
      for (int rr = 0; rr < 4; rr++) ss[rr] += __shfl_xor(ss[rr], o);
#pragma unroll
    for (int rr = 0; rr < 4; rr++) {
      const float r = rsqrtf(ss[rr] * (1.0f / 1024.0f) + EPS);
#pragma unroll
      for (int i = 0; i < 4; i++)
        ((float4*)(x + (size_t)(row0 + rr) * 1024))[lane + 64 * i] = make_float4(v[rr][i].x * r * gg[i].x, v[rr][i].y * r * gg[i].y, v[rr][i].z * r * gg[i].z, v[rr][i].w * r * gg[i].w);
    }
  }
}

#define LAS __attribute__((address_space(3)))
constexpr int G_BK = 64, G_HALF = 128, G_HTB = G_HALF * G_BK * 2, G_NXCD = 8, G_WGM = 8;
__device__ __forceinline__ int lds_byte(int r, int c) { const int st = (r >> 4) * 2 + (c >> 5), rr = r & 15, cc = c & 31, ob = rr * 64 + cc * 2; return st * 1024 + (ob ^ (((ob >> 9) & 1) << 5)); }
__device__ __forceinline__ void stage_rc(int b, int& R, int& C) { const int st = b / 1024, sb = b % 1024, swz = sb ^ (((sb >> 9) & 1) << 5); R = (st >> 1) * 16 + swz / 64; C = (st & 1) * 32 + (swz % 64) / 2; }
__device__ __forceinline__ int perm32(int rho) { const int n = rho >> 4, i = rho & 15; return 8 * (i >> 2) + 4 * n + (i & 3); }
struct Unit { int pm, pn; };
struct Gemm { const u16* A; const u16* Bt; int lda, ldb, M, N, K; };
struct StaticOrder {
  int nM, nN, nwg, G, c;
  __device__ void init(int M, int N, int G_, int c_) { nM = M / 256; nN = N / 256; nwg = nM * nN; G = G_; c = c_; }
  __device__ bool next(int i, Unit& u) const {
    const long L = (long)i * G + c; if (L >= nwg) return false;
    int wgid = (int)L; { const int q = nwg / G_NXCD, r = nwg % G_NXCD, xcd = wgid % G_NXCD, off = wgid / G_NXCD; wgid = (xcd < r ? xcd * (q + 1) : r * (q + 1) + (xcd - r) * q) + off; }
    const int nig = G_WGM * nN, gid = wgid / nig, fm = gid * G_WGM, gsz = (nM - fm) < G_WGM ? (nM - fm) : G_WGM;
    u.pm = fm + ((wgid % nig) % gsz); u.pn = (wgid % nig) / gsz; return true;
  }
};
typedef f32x4 AccT[2][2][4][2];
struct EpiSwiglu {
  static constexpr bool PERM = false;
  u16* ACT;
  __device__ __forceinline__ void operator()(const AccT& acc, const Unit& u, int wr, int wc, int fr, int fq) const {
    const int row0 = u.pm * 256 + wr * 64 + fr, col0 = u.pn * 128 + wc * 16 + 4 * fq;
#pragma unroll
    for (int ai = 0; ai < 2; ++ai)
#pragma unroll
      for (int m = 0; m < 4; ++m) {
        u16* rowp = ACT + (size_t)(row0 + ai * 128 + m * 16) * FF + col0;
#pragma unroll
        for (int bj = 0; bj < 2; ++bj) {
          const f32x4 a = acc[ai][bj][m][0], b = acc[ai][bj][m][1];
          *(uint2*)(rowp + bj * 64) = make_uint2(pack2(silu_f(a[0]) * b[0], silu_f(a[1]) * b[1]), pack2(silu_f(a[2]) * b[2], silu_f(a[3]) * b[3]));
        }
      }
  }
};
struct EpiResid {
  static constexpr bool PERM = false;
  const float* xsrc; float* xdst; float scale;
  __device__ __forceinline__ void operator()(const AccT& acc, const Unit& u, int wr, int wc, int fr, int fq) const {
    const int row0 = u.pm * 256 + wr * 64 + fr, col0 = u.pn * 256 + wc * 32 + 4 * fq;
#pragma unroll
    for (int ai = 0; ai < 2; ++ai) {
      f32x4 xv[4][2][2];
#pragma unroll
      for (int m = 0; m < 4; ++m)
#pragma unroll
        for (int bj = 0; bj < 2; ++bj)
#pragma unroll
          for (int n = 0; n < 2; ++n)
            xv[m][bj][n] = *(const f32x4*)(xsrc + (size_t)(row0 + ai * 128 + m * 16) * 1024 + col0 + bj * 128 + n * 16);
#pragma unroll
      for (int m = 0; m < 4; ++m)
#pragma unroll
        for (int bj = 0; bj < 2; ++bj)
#pragma unroll
          for (int n = 0; n < 2; ++n)
            *(f32x4*)(xdst + (size_t)(row0 + ai * 128 + m * 16) * 1024 + col0 + bj * 128 + n * 16) = xv[m][bj][n] + scale * acc[ai][bj][m][n];
    }
  }
};
struct EpiProj {
  static constexpr bool PERM = true;
  u16* proj;
  __device__ __forceinline__ void operator()(const AccT& acc, const Unit& u, int wr, int wc, int fr, int fq) const {
    const int row0 = u.pm * 256 + wr * 64 + fr, col0 = u.pn * 256 + wc * 32 + 8 * fq;
#pragma unroll
    for (int ai = 0; ai < 2; ++ai)
#pragma unroll
      for (int m = 0; m < 4; ++m) {
        u16* rowp = proj + (size_t)(row0 + ai * 128 + m * 16) * PS;
#pragma unroll
        for (int bj = 0; bj < 2; ++bj) {
          const int col = col0 + bj * 128;
          const f32x4 a = acc[ai][bj][m][0], b = acc[ai][bj][m][1];
          if (col < DIN) *(uint4*)(rowp + col) = make_uint4(pack2(a[0], a[1]), pack2(a[2], a[3]), pack2(b[0], b[1]), pack2(b[2], b[3]));
        }
      }
  }
};
struct EpiGate {
  static constexpr bool PERM = true;
  u16* gst; const float* bias; int tid;
  __device__ __forceinline__ void operator()(const AccT& acc, const Unit& u, int wr, int wc, int fr, int fq) const {
    u16* st = gst + (size_t)(u.pm * 4 + u.pn) * 65536 + tid * 8;
    const int col0 = u.pn * 256 + wc * 32 + 8 * fq;
#pragma unroll
    for (int bj = 0; bj < 2; ++bj) {
      const f32x4 b0 = *(const f32x4*)(bias + col0 + bj * 128), b1 = *(const f32x4*)(bias + col0 + bj * 128 + 4);
#pragma unroll
      for (int ai = 0; ai < 2; ++ai)
#pragma unroll
        for (int m = 0; m < 4; ++m) {
          const f32x4 a = acc[ai][bj][m][0] + b0, b = acc[ai][bj][m][1] + b1;
          *(uint4*)(st + ((ai * 2 + bj) * 4 + m) * 4096) = make_uint4(pack2(sigm_f(a[0]), sigm_f(a[1])), pack2(sigm_f(a[2]), sigm_f(a[3])),
                                                                     pack2(sigm_f(b[0]), sigm_f(b[1])), pack2(sigm_f(b[2]), sigm_f(b[3])));
        }
    }
  }
};
struct EpiBranch {
  static constexpr bool PERM = true;
  const u16* gst; u16* mix; int first; int tid;
  __device__ __forceinline__ void operator()(const AccT& acc, const Unit& u, int wr, int wc, int fr, int fq) const {
    const u16* st = gst + (size_t)(u.pm * 4 + u.pn) * 65536 + tid * 8;
    const int row0 = u.pm * 256 + wr * 64 + fr, col0 = u.pn * 256 + wc * 32 + 8 * fq;
#pragma unroll
    for (int ai = 0; ai < 2; ++ai) {
      uint4 gw[4][2], ov[4][2];
#pragma unroll
      for (int m = 0; m < 4; ++m)
#pragma unroll
        for (int bj = 0; bj < 2; ++bj) {
          gw[m][bj] = *(const uint4*)(st + ((ai * 2 + bj) * 4 + m) * 4096);
          ov[m][bj] = first ? make_uint4(0u, 0u, 0u, 0u) : *(const uint4*)(mix + (size_t)(row0 + ai * 128 + m * 16) * PS + col0 + bj * 128);
        }
#pragma unroll
      for (int m = 0; m < 4; ++m)
#pragma unroll
        for (int bj = 0; bj < 2; ++bj) {
          const uint4 g = gw[m][bj], o = ov[m][bj];
          const f32x4 a = acc[ai][bj][m][0], b = acc[ai][bj][m][1];
          const float v0 = lo2f(g.x) * a[0] + lo2f(o.x), v1 = hi2f(g.x) * a[1] + hi2f(o.x), v2 = lo2f(g.y) * a[2] + lo2f(o.y), v3 = hi2f(g.y) * a[3] + hi2f(o.y);
          const float v4 = lo2f(g.z) * b[0] + lo2f(o.z), v5 = hi2f(g.z) * b[1] + hi2f(o.z), v6 = lo2f(g.w) * b[2] + lo2f(o.w), v7 = hi2f(g.w) * b[3] + hi2f(o.w);
          *(uint4*)(mix + (size_t)(row0 + ai * 128 + m * 16) * PS + col0 + bj * 128) = make_uint4(pack2(v0, v1), pack2(v2, v3), pack2(v4, v5), pack2(v6, v7));
        }
    }
  }
};

template <class Epi, bool AFTER_DRAIN = false>
__device__ __forceinline__ void gemm_phase(LAS unsigned char* lds, const Gemm g, const Epi& E) {
  const int tid = tid_fresh(), wid = __builtin_amdgcn_readfirstlane(tid >> 6), lane = tid & 63, wr = wid >> 2, wc = wid & 3, fr = lane & 15, fq = lane >> 4;
  const int K = g.K, nt = K / G_BK;
  StaticOrder S; S.init(g.M, g.N, (int)gridDim.x, (int)blockIdx.x);
  unsigned voffA[2], voffB[2];
#pragma unroll
  for (int i = 0; i < 2; ++i) { int R, C; stage_rc(tid * 16 + i * 8192, R, C); const int Rb = Epi::PERM ? ((R & ~31) + perm32(R & 31)) : R;
    voffA[i] = (unsigned)(R * g.lda + C) * 2u; voffB[i] = (unsigned)(Rb * g.ldb + C) * 2u; }
  const size_t kstep = (size_t)(G_BK * 2);
  const size_t hstepA = (size_t)G_HALF * g.lda * 2, hstepB = (size_t)G_HALF * g.ldb * 2;
  const size_t tstepA = 2 * hstepA, tstepB = 2 * hstepB;
  const unsigned ldsw = (unsigned)wid * 1024u;
  const int aoff = lds_byte(wr * 64 + fr, fq * 8), boff = lds_byte(wc * 32 + fr, fq * 8);
#define PG8_SA(b, h) (((b) * 2 + (h)) * G_HTB)
#define PG8_SB(b, h) ((4 + (b) * 2 + (h)) * G_HTB)
#define PG8_STAGE(bufoff, gbase, voff) do { _Pragma("unroll") for (int _i = 0; _i < 2; ++_i) \
    __builtin_amdgcn_global_load_lds((const unsigned*)((const char*)(gbase) + (voff)[_i]), (LAS unsigned*)(lds + (bufoff) + ldsw + _i * 8192), 16, 0, 0); } while (0)
#define PG8_LDA(dst, b, h) do { _Pragma("unroll") for (int m = 0; m < 4; ++m) _Pragma("unroll") for (int k = 0; k < 2; ++k) dst[m][k] = *(const LAS bf16x8*)(lds + PG8_SA(b, h) + aoff + m * 2048 + k * 1024); } while (0)
#define PG8_LDB(dst, b, h) do { _Pragma("unroll") for (int n = 0; n < 2; ++n) _Pragma("unroll") for (int k = 0; k < 2; ++k) dst[n][k] = *(const LAS bf16x8*)(lds + PG8_SB(b, h) + boff + n * 2048 + k * 1024); } while (0)
#define PG8_MMA(ai, bj, At, Bt) do { __builtin_amdgcn_s_setprio(1); _Pragma("unroll") for (int m = 0; m < 4; ++m) _Pragma("unroll") for (int n = 0; n < 2; ++n) _Pragma("unroll") for (int k = 0; k < 2; ++k) \
    acc[ai][bj][m][n] = __builtin_amdgcn_mfma_f32_16x16x32_bf16(Bt[n][k], At[m][k], acc[ai][bj][m][n], 0, 0, 0); __builtin_amdgcn_s_setprio(0); } while (0)
#define PG8_WAIT_V(n) asm volatile("s_waitcnt vmcnt(" #n ")" ::: "memory")
#define PG8_WAIT_L(n) asm volatile("s_waitcnt lgkmcnt(" #n ")" ::: "memory")
#define PG8_BAR __builtin_amdgcn_s_barrier()
#define PG8_SCHED __builtin_amdgcn_sched_barrier(0)
  Unit cur, nxt; int ui = 0;
  if (!S.next(0, cur)) return;
  AccT acc;
#pragma unroll
  for (int a = 0; a < 2; ++a)
#pragma unroll
    for (int b = 0; b < 2; ++b)
#pragma unroll
      for (int m = 0; m < 4; ++m)
#pragma unroll
        for (int n = 0; n < 2; ++n) acc[a][b][m][n] = (f32x4){0.f, 0.f, 0.f, 0.f};
  bf16x8 At[4][2], B0[2][2], B1[2][2];
  const char* cA = (const char*)g.A + (size_t)cur.pm * tstepA; const char* cB = (const char*)g.Bt + (size_t)cur.pn * tstepB;
  PG8_STAGE(PG8_SB(0, 0), cB, voffB); PG8_STAGE(PG8_SA(0, 0), cA, voffA); PG8_STAGE(PG8_SB(0, 1), cB + hstepB, voffB); PG8_STAGE(PG8_SA(0, 1), cA + hstepA, voffA);
  if (wr == 1) PG8_BAR;
  PG8_WAIT_V(4); PG8_BAR;
  PG8_STAGE(PG8_SB(1, 0), cB + kstep, voffB); PG8_STAGE(PG8_SA(1, 0), cA + kstep, voffA); PG8_STAGE(PG8_SB(1, 1), cB + hstepB + kstep, voffB);
  PG8_WAIT_V(6); PG8_BAR;
  for (;;) {
    const bool has_next = S.next(ui + 1, nxt);
    const char* nA = has_next ? (const char*)g.A + (size_t)nxt.pm * tstepA : cA; const char* nB = has_next ? (const char*)g.Bt + (size_t)nxt.pn * tstepB : cB;
    for (int t = 0; t < nt; t += 2) {
      const bool last = (t == nt - 2);
      const char* a1 = cA + (size_t)(t + 1) * kstep;
      const char* a2 = last ? nA : cA + (size_t)(t + 2) * kstep; const char* b2 = last ? nB : cB + (size_t)(t + 2) * kstep;
      const char* a3 = a2 + kstep; const char* b3 = b2 + kstep;
      PG8_LDB(B0, 0, 0); PG8_SCHED; PG8_LDA(At, 0, 0); PG8_STAGE(PG8_SA(1, 1), a1 + hstepA, voffA);
      PG8_WAIT_L(8); PG8_BAR; PG8_WAIT_L(0); PG8_MMA(0, 0, At, B0); PG8_BAR; PG8_SCHED;
      PG8_LDB(B1, 0, 1); PG8_STAGE(PG8_SB(0, 0), b2, voffB);
      PG8_BAR; PG8_WAIT_L(0); PG8_MMA(0, 1, At, B1); PG8_BAR;
      PG8_LDA(At, 0, 1); PG8_STAGE(PG8_SA(0, 0), a2, voffA);
      PG8_BAR; PG8_WAIT_L(0); PG8_MMA(1, 0, At, B0); PG8_BAR; PG8_SCHED;
      PG8_STAGE(PG8_SB(0, 1), b2 + hstepB, voffB);
      PG8_WAIT_V(6); PG8_BAR; PG8_MMA(1, 1, At, B1); PG8_BAR;
      PG8_LDB(B0, 1, 0); PG8_SCHED; PG8_LDA(At, 1, 0); PG8_STAGE(PG8_SA(0, 1), a2 + hstepA, voffA);
      PG8_WAIT_L(8); PG8_BAR; PG8_WAIT_L(0); PG8_MMA(0, 0, At, B0); PG8_BAR; PG8_SCHED;
      PG8_LDB(B1, 1, 1); PG8_STAGE(PG8_SB(1, 0), b3, voffB);
      PG8_BAR; PG8_WAIT_L(0); PG8_MMA(0, 1, At, B1); PG8_BAR;
      PG8_LDA(At, 1, 1); PG8_STAGE(PG8_SA(1, 0), a3, voffA);
      PG8_BAR; PG8_WAIT_L(0); PG8_MMA(1, 0, At, B0); PG8_BAR; PG8_SCHED;
      PG8_STAGE(PG8_SB(1, 1), b3 + hstepB, voffB);
      PG8_WAIT_V(6); PG8_BAR; PG8_MMA(1, 1, At, B1); PG8_BAR;
    }
    if constexpr (!AFTER_DRAIN) E(acc, cur, wr, wc, fr, fq);
    if (!has_next) break;
#pragma unroll
    for (int a = 0; a < 2; ++a)
#pragma unroll
      for (int b = 0; b < 2; ++b)
#pragma unroll
        for (int m = 0; m < 4; ++m)
#pragma unroll
          for (int n = 0; n < 2; ++n) acc[a][b][m][n] = (f32x4){0.f, 0.f, 0.f, 0.f};
    cur = nxt; cA = nA; cB = nB; ++ui;
  }
  PG8_WAIT_V(0);
  if (wr == 0) PG8_BAR;
  PG8_BAR;
  if constexpr (AFTER_DRAIN) E.fused(acc, cur, wr, wc, fr, fq, lds);
#undef PG8_SA
#undef PG8_SB
#undef PG8_STAGE
#undef PG8_LDA
#undef PG8_LDB
#undef PG8_MMA
#undef PG8_WAIT_V
#undef PG8_WAIT_L
#undef PG8_BAR
#undef PG8_SCHED
}

struct ChainStep { const char* A; const char* B; unsigned lda2, ldb2; int nt; };
__device__ __forceinline__ ChainStep merge_step(const Params& p, int q, const Unit& u) {
  const int s6 = q % 6, br = s6 >> 1;
  ChainStep c;
  if ((s6 & 1) == 0) {
    c.A = (const char*)(p.H + (size_t)u.pm * 256 * 1024); c.lda2 = 2048u;
    c.B = (const char*)(p.wgt + (size_t)(br * 1024 + u.pn * 256) * 1024); c.ldb2 = 2048u; c.nt = 16;
  } else {
    const int ycol = br == 0 ? C_U : (br == 1 ? C_RG : C_NQ);
    c.A = (const char*)(p.BIG + ycol + (size_t)u.pm * 256 * PS); c.lda2 = (unsigned)PS * 2u;
    c.B = (const char*)(p.wbt + (size_t)(br * 1024 + u.pn * 256) * 512); c.ldb2 = 1024u; c.nt = 8;
  }
  return c;
}
__device__ __forceinline__ void gemm_merge_chain(LAS unsigned char* lds, const Params& p, int l) {
  const int tid = tid_fresh(), wid = __builtin_amdgcn_readfirstlane(tid >> 6), lane = tid & 63, wr = wid >> 2, wc = wid & 3, fr = lane & 15, fq = lane >> 4;
  StaticOrder S; S.init(16384, 1024, (int)gridDim.x, (int)blockIdx.x);
  unsigned rA[2], c2[2];
#pragma unroll
  for (int i = 0; i < 2; ++i) { int R, C; stage_rc(tid * 16 + i * 8192, R, C); rA[i] = (unsigned)R; c2[i] = (unsigned)C * 2u; }
  const size_t kstep = (size_t)(G_BK * 2);
  const unsigned ldsw = (unsigned)wid * 1024u;
  const int aoff = lds_byte(wr * 64 + fr, fq * 8), boff = lds_byte(wc * 32 + fr, fq * 8);
#define PG8_SA(b, h) (((b) * 2 + (h)) * G_HTB)
#define PG8_SB(b, h) ((4 + (b) * 2 + (h)) * G_HTB)
#define CH_ROW_rA(i) (rA[i])
#define CH_ROW_rB(i) ((rA[i] & ~31u) + (unsigned)perm32((int)(rA[i] & 31u)))
#define CH_STAGE(bufoff, gbase, rr, ld2) do { _Pragma("unroll") for (int _i = 0; _i < 2; ++_i) \
    __builtin_amdgcn_global_load_lds((const unsigned*)((const char*)(gbase) + (CH_ROW_##rr(_i) * (ld2) + c2[_i])), (LAS unsigned*)(lds + (bufoff) + ldsw + _i * 8192), 16, 0, 0); } while (0)
#define PG8_LDA(dst, b, h) do { _Pragma("unroll") for (int m = 0; m < 4; ++m) _Pragma("unroll") for (int k = 0; k < 2; ++k) dst[m][k] = *(const LAS bf16x8*)(lds + PG8_SA(b, h) + aoff + m * 2048 + k * 1024); } while (0)
#define PG8_LDB(dst, b, h) do { _Pragma("unroll") for (int n = 0; n < 2; ++n) _Pragma("unroll") for (int k = 0; k < 2; ++k) dst[n][k] = *(const LAS bf16x8*)(lds + PG8_SB(b, h) + boff + n * 2048 + k * 1024); } while (0)
#define PG8_MMA(ai, bj, At, Bt) do { __builtin_amdgcn_s_setprio(1); _Pragma("unroll") for (int m = 0; m < 4; ++m) _Pragma("unroll") for (int n = 0; n < 2; ++n) _Pragma("unroll") for (int k = 0; k < 2; ++k) \
    acc[ai][bj][m][n] = __builtin_amdgcn_mfma_f32_16x16x32_bf16(Bt[n][k], At[m][k], acc[ai][bj][m][n], 0, 0, 0); __builtin_amdgcn_s_setprio(0); } while (0)
#define PG8_WAIT_V(n) asm volatile("s_waitcnt vmcnt(" #n ")" ::: "memory")
#define PG8_WAIT_L(n) asm volatile("s_waitcnt lgkmcnt(" #n ")" ::: "memory")
#define PG8_BAR __builtin_amdgcn_s_barrier()
#define PG8_SCHED __builtin_amdgcn_sched_barrier(0)
  Unit cu, nu; int q = 0;
  if (!S.next(0, cu)) return;
  ChainStep cs = merge_step(p, 0, cu), ns;
  AccT acc;
#pragma unroll
  for (int a = 0; a < 2; ++a)
#pragma unroll
    for (int b = 0; b < 2; ++b)
#pragma unroll
      for (int m = 0; m < 4; ++m)
#pragma unroll
        for (int n = 0; n < 2; ++n) acc[a][b][m][n] = (f32x4){0.f, 0.f, 0.f, 0.f};
  bf16x8 At[4][2], B0[2][2], B1[2][2];
  {
    const size_t hA = (size_t)G_HALF * cs.lda2, hB = (size_t)G_HALF * cs.ldb2;
    CH_STAGE(PG8_SB(0, 0), cs.B, rB, cs.ldb2); CH_STAGE(PG8_SA(0, 0), cs.A, rA, cs.lda2); CH_STAGE(PG8_SB(0, 1), cs.B + hB, rB, cs.ldb2); CH_STAGE(PG8_SA(0, 1), cs.A + hA, rA, cs.lda2);
    if (wr == 1) PG8_BAR;
    PG8_WAIT_V(4); PG8_BAR;
    CH_STAGE(PG8_SB(1, 0), cs.B + kstep, rB, cs.ldb2); CH_STAGE(PG8_SA(1, 0), cs.A + kstep, rA, cs.lda2); CH_STAGE(PG8_SB(1, 1), cs.B + hB + kstep, rB, cs.ldb2);
    PG8_WAIT_V(6); PG8_BAR;
  }
  for (;;) {
    bool has_next;
    if ((q + 1) % 6 != 0) { nu = cu; has_next = true; } else has_next = S.next((q + 1) / 6, nu);
    ns = has_next ? merge_step(p, q + 1, nu) : cs;
    const size_t hA = (size_t)G_HALF * cs.lda2, hB = (size_t)G_HALF * cs.ldb2;
    const size_t nhA = (size_t)G_HALF * ns.lda2, nhB = (size_t)G_HALF * ns.ldb2;
    const int nt = cs.nt;
    for (int t = 0; t < nt; t += 2) {
      const bool last = (t == nt - 2);
      const char* a1 = cs.A + (size_t)(t + 1) * kstep;
      const char* a2 = last ? ns.A : cs.A + (size_t)(t + 2) * kstep; const char* b2 = last ? ns.B : cs.B + (size_t)(t + 2) * kstep;
      const char* a3 = a2 + kstep; const char* b3 = b2 + kstep;
      const unsigned la2 = last ? ns.lda2 : cs.lda2, lb2 = last ? ns.ldb2 : cs.ldb2;
      const size_t hA2 = last ? nhA : hA, hB2 = last ? nhB : hB;
      PG8_LDB(B0, 0, 0); PG8_SCHED; PG8_LDA(At, 0, 0); CH_STAGE(PG8_SA(1, 1), a1 + hA, rA, cs.lda2);
      PG8_WAIT_L(8); PG8_BAR; PG8_WAIT_L(0); PG8_MMA(0, 0, At, B0); PG8_BAR; PG8_SCHED;
      PG8_LDB(B1, 0, 1); CH_STAGE(PG8_SB(0, 0), b2, rB, lb2);
      PG8_BAR; PG8_WAIT_L(0); PG8_MMA(0, 1, At, B1); PG8_BAR;
      PG8_LDA(At, 0, 1); CH_STAGE(PG8_SA(0, 0), a2, rA, la2);
      PG8_BAR; PG8_WAIT_L(0); PG8_MMA(1, 0, At, B0); PG8_BAR; PG8_SCHED;
      CH_STAGE(PG8_SB(0, 1), b2 + hB2, rB, lb2);
      PG8_WAIT_V(6); PG8_BAR; PG8_MMA(1, 1, At, B1); PG8_BAR;
      PG8_LDB(B0, 1, 0); PG8_SCHED; PG8_LDA(At, 1, 0); CH_STAGE(PG8_SA(0, 1), a2 + hA2, rA, la2);
      PG8_WAIT_L(8); PG8_BAR; PG8_WAIT_L(0); PG8_MMA(0, 0, At, B0); PG8_BAR; PG8_SCHED;
      PG8_LDB(B1, 1, 1); CH_STAGE(PG8_SB(1, 0), b3, rB, lb2);
      PG8_BAR; PG8_WAIT_L(0); PG8_MMA(0, 1, At, B1); PG8_BAR;
      PG8_LDA(At, 1, 1); CH_STAGE(PG8_SA(1, 0), a3, rA, la2);
      PG8_BAR; PG8_WAIT_L(0); PG8_MMA(1, 0, At, B0); PG8_BAR; PG8_SCHED;
      CH_STAGE(PG8_SB(1, 1), b3 + hB2, rB, lb2);
      PG8_WAIT_V(6); PG8_BAR; PG8_MMA(1, 1, At, B1); PG8_BAR;
    }
    {
      const int s6 = q % 6, br = s6 >> 1;
      if ((s6 & 1) == 0) { EpiGate e{p.gst, p.b_gate + (size_t)l * 3072 + br * 1024, tid}; e(acc, cu, wr, wc, fr, fq); }
      else { EpiBranch e{p.gst, p.BIG + C_MIX, br == 0, tid}; e(acc, cu, wr, wc, fr, fq); }
    }
    if (!has_next) break;
#pragma unroll
    for (int a = 0; a < 2; ++a)
#pragma unroll
      for (int b = 0; b < 2; ++b)
#pragma unroll
        for (int m = 0; m < 4; ++m)
#pragma unroll
          for (int n = 0; n < 2; ++n) acc[a][b][m][n] = (f32x4){0.f, 0.f, 0.f, 0.f};
    cu = nu; cs = ns; ++q;
  }
  PG8_WAIT_V(0);
  if (wr == 0) PG8_BAR;
  PG8_BAR;
#undef PG8_SA
#undef PG8_SB
#undef CH_STAGE
#undef CH_ROW_rA
#undef CH_ROW_rB
#undef PG8_LDA
#undef PG8_LDB
#undef PG8_MMA
#undef PG8_WAIT_V
#undef PG8_WAIT_L
#undef PG8_BAR
#undef PG8_SCHED
}

__device__ __forceinline__ void gmlp_tile(const Params& p, int l, int tile, u16* smem) {
  const int c = tile >> 2, g = tile & 3, t0 = c * 128;
  u16* Ws = smem; u16* vT = smem + 128 * 136;
  const int tid = tid_fresh() & 255, lane = tid & 63, wave = tid >> 6, wm = wave >> 1, wn = wave & 1, lr = lane & 15, lq = lane >> 4;
  const int tok = tid >> 1, half = tid & 1;
  u16* prow = p.BIG + (size_t)(t0 + tok) * PS;
  float s = 0.f, ss = 0.f;
#pragma unroll 8
  for (int i = 0; i < 32; i++) {
    uint4 raw = *(const uint4*)(prow + C_V + half * 256 + i * 8);
    u32 w[4] = {raw.x, raw.y, raw.z, raw.w};
#pragma unroll
    for (int e = 0; e < 4; e++) { float a = gelu_t(lo2f(w[e])), b = gelu_t(hi2f(w[e])); s += a + b; ss += a * a + b * b; }
  }
  s += __shfl_xor(s, 1); ss += __shfl_xor(ss, 1);
  const float mean = s * (1.0f / 512.0f);
  const float rstd = rsqrtf(fmaxf(ss * (1.0f / 512.0f) - mean * mean, 0.f) + EPS);
  const float* lg = p.gm_ln_g + l * 512 + g * 128; const float* lb = p.gm_ln_b + l * 512 + g * 128;
#pragma unroll
  for (int i = 0; i < 8; i++) {
    uint4 raw = *(const uint4*)(prow + C_V + g * 128 + half * 64 + i * 8);
    u32 w[4] = {raw.x, raw.y, raw.z, raw.w};
#pragma unroll
    for (int e = 0; e < 4; e++) {
      int cc = half * 64 + i * 8 + 2 * e;
      vT[cc * 136 + tok] = f2bf((gelu_t(lo2f(w[e])) - mean) * rstd * lg[cc] + lb[cc]);
      vT[(cc + 1) * 136 + tok] = f2bf((gelu_t(hi2f(w[e])) - mean) * rstd * lg[cc + 1] + lb[cc + 1]);
    }
  }
  const float* wrow = p.gm_ws + ((size_t)(l * 4 + g) * 128 + tok) * 128 + half * 64;
#pragma unroll
  for (int i = 0; i < 16; i++) {
    float4 w = ((const float4*)wrow)[i];
    int s0 = half * 64 + i * 4;
    uint2 o = make_uint2(pack2(s0 <= tok ? w.x : 0.f, s0 + 1 <= tok ? w.y : 0.f), pack2(s0 + 2 <= tok ? w.z : 0.f, s0 + 3 <= tok ? w.w : 0.f));
    *(uint2*)(Ws + tok * 136 + s0) = o;
  }
  __syncthreads();
  f32x4 acc[4][4];
#pragma unroll
  for (int m = 0; m < 4; m++)
#pragma unroll
    for (int n = 0; n < 4; n++) acc[m][n] = (f32x4){0.f, 0.f, 0.f, 0.f};
#pragma unroll
  for (int kk = 0; kk < 4; kk++) {
    bf16x8 a[4], b[4];
#pragma unroll
    for (int m = 0; m < 4; m++) a[m] = ld8(Ws + (wm * 64 + m * 16 + lr) * 136 + kk * 32 + lq * 8);
#pragma unroll
    for (int n = 0; n < 4; n++) b[n] = ld8(vT + (wn * 64 + n * 16 + lr) * 136 + kk * 32 + lq * 8);
#pragma unroll
    for (int m = 0; m < 4; m++)
#pragma unroll
      for (int n = 0; n < 4; n++) acc[m][n] = mfma16(b[n], a[m], acc[m][n]);
  }
  const float* bsp = p.gm_bs + (size_t)(l * 4 + g) * 128;
  uint2 uv[4][4];
#pragma unroll
  for (int m = 0; m < 4; m++)
#pragma unroll
    for (int n = 0; n < 4; n++)
      uv[m][n] = *(const uint2*)(p.BIG + (size_t)(t0 + wm * 64 + m * 16 + lr) * PS + C_U + g * 128 + wn * 64 + n * 16 + lq * 4);
#pragma unroll
  for (int m = 0; m < 4; m++) {
    const float bias = bsp[wm * 64 + m * 16 + lr];
#pragma unroll
    for (int n = 0; n < 4; n++) {
      const uint2 u = uv[m][n];
      *(uint2*)(p.BIG + (size_t)(t0 + wm * 64 + m * 16 + lr) * PS + C_U + g * 128 + wn * 64 + n * 16 + lq * 4) =
          make_uint2(pack2(gelu_t(lo2f(u.x)) * (acc[m][n][0] + bias), gelu_t(hi2f(u.x)) * (acc[m][n][1] + bias)),
                     pack2(gelu_t(lo2f(u.y)) * (acc[m][n][2] + bias), gelu_t(hi2f(u.y)) * (acc[m][n][3] + bias)));
    }
  }
  __syncthreads();
}

__device__ __forceinline__ void ret_kv_tile(const Params& p, int tile, u16* smem) {
  const int c = tile >> 2, h = tile & 3, t0 = c * 128;
  u16* vT = smem; u16* kT = smem + 128 * 136;
  const int tid = tid_fresh() & 255, lane = tid & 63, wave = tid >> 6, lr = lane & 15, lq = lane >> 4;
  const int tok = tid >> 1, half = tid & 1;
  const float lg = logf(1.0f - exp2f(-5.0f - (float)h));
  const u16* prow = p.BIG + (size_t)(t0 + tok) * PS;
#pragma unroll
  for (int i = 0; i < 8; i++) {
    uint4 raw = *(const uint4*)(prow + C_RV + h * 128 + half * 64 + i * 8);
    u32 w[4] = {raw.x, raw.y, raw.z, raw.w};
#pragma unroll
    for (int e = 0; e < 4; e++) {
      int cc = half * 64 + i * 8 + 2 * e;
      vT[cc * 136 + tok] = (u16)(w[e] & 0xffff);
      vT[(cc + 1) * 136 + tok] = (u16)(w[e] >> 16);
    }
  }
  const float sc = 0.125f * expf(lg * (float)(127 - tok));
#pragma unroll
  for (int i = 0; i < 4; i++) {
    uint4 raw = *(const uint4*)(prow + C_RK + h * 64 + half * 32 + i * 8);
    u32 w[4] = {raw.x, raw.y, raw.z, raw.w};
#pragma unroll
    for (int e = 0; e < 4; e++) {
      int cc = half * 32 + i * 8 + 2 * e;
      kT[cc * 136 + tok] = f2bf(lo2f(w[e]) * sc);
      kT[(cc + 1) * 136 + tok] = f2bf(hi2f(w[e]) * sc);
    }
  }
  __syncthreads();
  f32x4 acc[2][4];
#pragma unroll
  for (int m = 0; m < 2; m++)
#pragma unroll
    for (int n = 0; n < 4; n++) acc[m][n] = (f32x4){0.f, 0.f, 0.f, 0.f};
#pragma unroll
  for (int kk = 0; kk < 4; kk++) {
    bf16x8 a[2], b[4];
#pragma unroll
    for (int m = 0; m < 2; m++) a[m] = ld8(vT + (wave * 32 + m * 16 + lr) * 136 + kk * 32 + lq * 8);
#pragma unroll
    for (int n = 0; n < 4; n++) b[n] = ld8(kT + (n * 16 + lr) * 136 + kk * 32 + lq * 8);
#pragma unroll
    for (int m = 0; m < 2; m++)
#pragma unroll
      for (int n = 0; n < 4; n++) acc[m][n] = mfma16(a[m], b[n], acc[m][n]);
  }
  float* rp = p.ret + (size_t)(c * 4 + h) * 8192;
#pragma unroll
  for (int m = 0; m < 2; m++)
#pragma unroll
    for (int n = 0; n < 4; n++)
#pragma unroll
      for (int j = 0; j < 4; j++) rp[(wave * 32 + m * 16 + lq * 4 + j) * 64 + n * 16 + lr] = acc[m][n][j];
  __syncthreads();
}
__device__ __forceinline__ void ret_scan_wg(const Params& p, unsigned char* sm) {
  const int tid = tid_fresh(), seg = tid >> 7, el = tid & 127;
  float* endv = (float*)sm;
  for (int e0 = blockIdx.x * 128; e0 < 32768; e0 += gridDim.x * 128) {
    const int h = e0 >> 13;
    const float cd = expf(logf(1.0f - exp2f(-5.0f - (float)h)) * 128.0f);
    const float cd2 = cd * cd, cd4 = cd2 * cd2, cd8 = cd4 * cd4, cd16 = cd8 * cd8, cd32 = cd16 * cd16;
    float* base = p.ret + (size_t)(seg * 32) * 32768 + e0 + el;
    float v[32];
#pragma unroll
    for (int i = 0; i < 32; i++) v[i] = base[(size_t)i * 32768];
    float st = 0.f;
#pragma unroll
    for (int i = 0; i < 32; i++) st = st * cd + v[i];
    endv[seg * 128 + el] = st;
    __syncthreads();
    float carry = 0.f;
    for (int s2 = 0; s2 < seg; s2++) carry = carry * cd32 + endv[s2 * 128 + el];
    __syncthreads();
    st = carry;
#pragma unroll
    for (int i = 0; i < 32; i++) { base[(size_t)i * 32768] = st; st = st * cd + v[i]; }
  }
}
__device__ __forceinline__ void ret_out_tile(const Params& p, int l, int tile, u16* smem) {
  const int c = tile >> 2, h = tile & 3, t0 = c * 128;
  u16* vT = smem;
  u16* kS = smem + 128 * 136;
  u16* pT = kS + 128 * 72;
  const int tid = tid_fresh() & 255, lane = tid & 63, wave = tid >> 6, lr = lane & 15, lq = lane >> 4;
  const int tok = tid >> 1, half = tid & 1;
  const float lg = logf(1.0f - exp2f(-5.0f - (float)h));
  {
    const u16* prow = p.BIG + (size_t)(t0 + tok) * PS;
#pragma unroll
    for (int i = 0; i < 8; i++) {
      uint4 raw = *(const uint4*)(prow + C_RV + h * 128 + half * 64 + i * 8);
      u32 w[4] = {raw.x, raw.y, raw.z, raw.w};
#pragma unroll
      for (int e = 0; e < 4; e++) {
        int cc = half * 64 + i * 8 + 2 * e;
        vT[cc * 136 + tok] = (u16)(w[e] & 0xffff);
        vT[(cc + 1) * 136 + tok] = (u16)(w[e] >> 16);
      }
    }
#pragma unroll
    for (int i = 0; i < 4; i++)
      *(uint4*)(kS + tok * 72 + half * 32 + i * 8) = *(const uint4*)(prow + C_RK + h * 64 + half * 32 + i * 8);
    const float* rp = p.ret + (size_t)(c * 4 + h) * 8192 + tok * 64 + half * 32;
#pragma unroll
    for (int i = 0; i < 4; i++) {
      float4 a = ((const float4*)rp)[2 * i], b = ((const float4*)rp)[2 * i + 1];
      *(uint4*)(pT + tok * 72 + half * 32 + i * 8) = make_uint4(pack2(a.x, a.y), pack2(a.z, a.w), pack2(b.x, b.y), pack2(b.z, b.w));
    }
  }
  __syncthreads();
#pragma unroll 1
  for (int it = 0; it < 2; it++) {
    const int i = wave * 32 + it * 16 + lr;
    const u16* qp = p.BIG + (size_t)(t0 + i) * PS + C_RQ + h * 64 + lq * 8;
    const bf16x8 q_lo = ld8(qp), q_hi = ld8(qp + 32);
    f32x4 Y[8];
#pragma unroll
    for (int e = 0; e < 8; e++) Y[e] = (f32x4){0.f, 0.f, 0.f, 0.f};
    const int nch = ((wave * 32 + it * 16 + 15) >> 5) + 1;
    for (int jc = 0; jc < nch; jc++) {
      f32x4 s0 = (f32x4){0.f, 0.f, 0.f, 0.f}, s1 = s0;
      const u16* kp = kS + (jc * 32 + lr) * 72 + lq * 8;
      s0 = mfma16(ld8(kp), q_lo, s0); s0 = mfma16(ld8(kp + 32), q_hi, s0);
      s1 = mfma16(ld8(kp + 16 * 72), q_lo, s1); s1 = mfma16(ld8(kp + 16 * 72 + 32), q_hi, s1);
      float pv[8];
#pragma unroll
      for (int j = 0; j < 4; j++) {
        int d0 = i - (jc * 32 + lq * 4 + j), d1 = d0 - 16;
        pv[j] = d0 >= 0 ? s0[j] * 0.125f * __expf(lg * (float)d0) : 0.f;
        pv[4 + j] = d1 >= 0 ? s1[j] * 0.125f * __expf(lg * (float)d1) : 0.f;
      }
      const bf16x8 pb = pk8(pv[0], pv[1], pv[2], pv[3], pv[4], pv[5], pv[6], pv[7]);
#pragma unroll
      for (int e = 0; e < 8; e++) {
        const u16* vp = vT + (e * 16 + lr) * 136 + jc * 32 + lq * 4;
        Y[e] = mfma16(ld44(vp, vp + 16), pb, Y[e]);
      }
    }
    {
      const float qd = __expf(lg * (float)(i + 1));
      const bf16x8 ql = scale8(q_lo, qd), qh = scale8(q_hi, qd);
#pragma unroll
      for (int e = 0; e < 8; e++) {
        const u16* pp = pT + (e * 16 + lr) * 72 + lq * 8;
        Y[e] = mfma16(ld8(pp), ql, Y[e]);
        Y[e] = mfma16(ld8(pp + 32), qh, Y[e]);
      }
    }
    float s = 0.f, ss = 0.f;
#pragma unroll
    for (int e = 0; e < 8; e++)
#pragma unroll
      for (int j = 0; j < 4; j++) { s += Y[e][j]; ss += Y[e][j] * Y[e][j]; }
    s += __shfl_xor(s, 16); ss += __shfl_xor(ss, 16);
    s += __shfl_xor(s, 32); ss += __shfl_xor(ss, 32);
    const float mean = s * (1.0f / 128.0f);
    const float rstd = rsqrtf(fmaxf(ss * (1.0f / 128.0f) - mean * mean, 0.f) + EPS);
    u16* gp = p.BIG + (size_t)(t0 + i) * PS + C_RG + h * 128;
    const float* gg = p.ret_gn_g + l * 512 + h * 128; const float* gb = p.ret_gn_b + l * 512 + h * 128;
    uint2 grawv[8];
#pragma unroll
    for (int e = 0; e < 8; e++) grawv[e] = *(const uint2*)(gp + e * 16 + lq * 4);
#pragma unroll
    for (int e = 0; e < 8; e++) {
      const int e0 = e * 16 + lq * 4;
      const uint2 graw = grawv[e];
      float4 g4 = *(const float4*)(gg + e0), b4 = *(const float4*)(gb + e0);
      float y0 = (Y[e][0] - mean) * rstd * g4.x + b4.x, y1 = (Y[e][1] - mean) * rstd * g4.y + b4.y;
      float y2 = (Y[e][2] - mean) * rstd * g4.z + b4.z, y3 = (Y[e][3] - mean) * rstd * g4.w + b4.w;
      *(uint2*)(gp + e0) = make_uint2(pack2(silu_f(lo2f(graw.x)) * y0, silu_f(hi2f(graw.x)) * y1),
                                      pack2(silu_f(lo2f(graw.y)) * y2, silu_f(hi2f(graw.y)) * y3));
    }
  }
  __syncthreads();
}

__device__ __forceinline__ void cmp_tile(const Params& p, int l, int tile, u16* smem) {
  const int which = tile >> 6, g = (tile >> 5) & 1, ci0 = (tile & 31) * 32;
  const int tid = tid_fresh() & 255, lane = tid & 63, wave = tid >> 6, lr = lane & 15, lq = lane >> 4;
  float* part = (float*)smem;
  u16* hid = smem + 32768;
  const int colbase = (which ? C_VC : C_KC) + g * 64;
  const float* pos = p.cmp_pos + (size_t)(l * 2 + which) * 32 * 64;
  const u16* w1t = p.cw1t + (size_t)which * 128 * 2048;
  f32x4 acc[2][8];
#pragma unroll
  for (int m = 0; m < 2; m++)
#pragma unroll
    for (int n = 0; n < 8; n++) acc[m][n] = (f32x4){0.f, 0.f, 0.f, 0.f};
  int cir0 = ci0 + lr, cir1 = ci0 + 16 + lr;
  if (cir0 > 1022) cir0 = 1022;
  if (cir1 > 1022) cir1 = 1022;
#pragma unroll 4
  for (int ks = 0; ks < 16; ks++) {
    const int kk = wave * 512 + ks * 32 + lq * 8, toff = kk >> 6, dim = kk & 63;
    const float4 p0 = *(const float4*)(pos + toff * 64 + dim), p1 = *(const float4*)(pos + toff * 64 + dim + 4);
    bf16x8 a[2], b[8];
#pragma unroll
    for (int m = 0; m < 2; m++) {
      const int cr = m == 0 ? cir0 : cir1;
      uint4 raw = *(const uint4*)(p.BIG + (size_t)(cr * 16 + toff) * PS + colbase + dim);
      a[m] = pk8(lo2f(raw.x) + p0.x, hi2f(raw.x) + p0.y, lo2f(raw.y) + p0.z, hi2f(raw.y) + p0.w,
                 lo2f(raw.z) + p1.x, hi2f(raw.z) + p1.y, lo2f(raw.w) + p1.z, hi2f(raw.w) + p1.w);
    }
#pragma unroll
    for (int n = 0; n < 8; n++) b[n] = ld8(w1t + (size_t)(n * 16 + lr) * 2048 + kk);
#pragma unroll
    for (int m = 0; m < 2; m++)
#pragma unroll
      for (int n = 0; n < 8; n++) acc[m][n] = mfma16(a[m], b[n], acc[m][n]);
  }
#pragma unroll
  for (int m = 0; m < 2; m++)
#pragma unroll
    for (int n = 0; n < 8; n++)
#pragma unroll
      for (int j = 0; j < 4; j++) part[wave * 4096 + (m * 16 + lq * 4 + j) * 128 + n * 16 + lr] = acc[m][n][j];
  __syncthreads();
  for (int e = tid; e < 4096; e += 256) {
    const float v = part[e] + part[4096 + e] + part[8192 + e] + part[12288 + e];
    hid[e] = f2bf(gelu_t(v));
  }
  __syncthreads();
  f32x4 o[2] = {(f32x4){0.f, 0.f, 0.f, 0.f}, (f32x4){0.f, 0.f, 0.f, 0.f}};
  const u16* w2t = p.cw2t + (size_t)which * 64 * 128;
#pragma unroll
  for (int kk = 0; kk < 4; kk++) {
    bf16x8 bb = ld8(w2t + (wave * 16 + lr) * 128 + kk * 32 + lq * 8);
#pragma unroll
    for (int m = 0; m < 2; m++) o[m] = mfma16(ld8(hid + (m * 16 + lr) * 128 + kk * 32 + lq * 8), bb, o[m]);
  }
#pragma unroll
  for (int m = 0; m < 2; m++)
#pragma unroll
    for (int j = 0; j < 4; j++) {
      int ci = ci0 + m * 16 + lq * 4 + j, d = wave * 16 + lr;
      u16 v = ci < 1023 ? f2bf(o[m][j]) : (u16)0;
      if (which == 0) p.kc[(size_t)(g * 1024 + ci) * 64 + d] = v;
      else p.vcT[(size_t)(g * 64 + d) * 1024 + ci] = v;
    }
  __syncthreads();
}
__device__ __forceinline__ void vt_tile(const Params& p, int tile, u16* smem) {
  const int sw = tile >> 9, g = (tile >> 8) & 1, t0 = (tile & 255) * 64;
  const int tid = tid_fresh() & 255;
  u16* T = smem;
  const int col = (sw ? C_VW : C_VS) + g * 64;
  {
    const int tok = tid >> 2, dq = (tid & 3) * 16;
    const u16* src = p.BIG + (size_t)(t0 + tok) * PS + col + dq;
    uint4 r0 = *(const uint4*)src, r1 = *(const uint4*)(src + 8);
    u32 w[8] = {r0.x, r0.y, r0.z, r0.w, r1.x, r1.y, r1.z, r1.w};
#pragma unroll
    for (int e = 0; e < 8; e++) { T[(dq + 2 * e) * 72 + tok] = (u16)(w[e] & 0xffff); T[(dq + 2 * e + 1) * 72 + tok] = (u16)(w[e] >> 16); }
  }
  __syncthreads();
  {
    const int d = tid >> 2, tq = (tid & 3) * 16;
    u16* dst = (sw ? p.vwT : p.vsT) + (size_t)(g * 64 + d) * S + t0 + tq;
    *(uint4*)dst = *(const uint4*)(T + d * 72 + tq);
    *(uint4*)(dst + 8) = *(const uint4*)(T + d * 72 + tq + 8);
  }
  __syncthreads();
}

constexpr int NT_ST = 72;
constexpr int NT_EL = 64 * NT_ST;
__device__ __forceinline__ float quad_sum(float x) {
  x += __uint_as_float((u32)__builtin_amdgcn_mov_dpp((int)__float_as_uint(x), 0xB1, 0xF, 0xF, true));
  x += __uint_as_float((u32)__builtin_amdgcn_mov_dpp((int)__float_as_uint(x), 0x4E, 0xF, 0xF, true));
  return x;
}
__device__ __forceinline__ void qk64(const u16* kt, int lr, int lq, bf16x8 q_lo, bf16x8 q_hi, f32x4 (&s)[2][2]) {
#pragma unroll
  for (int c = 0; c < 2; c++)
#pragma unroll
    for (int t = 0; t < 2; t++) {
      const u16* kp = kt + (c * 32 + t * 16 + lr) * NT_ST + lq * 8;
      f32x4 a = s[c][t];
      a = mfma16(ld8(kp), q_lo, a); a = mfma16(ld8(kp + 32), q_hi, a);
      s[c][t] = a;
    }
}
__device__ __forceinline__ float ex2(float x) { return __builtin_amdgcn_exp2f(x); }
template <bool FAST>
__device__ __forceinline__ void attend_tile(const u16* kt, const u16* vt, int lr, int lq, bf16x8 q_lo, bf16x8 q_hi, float slope2, int dbase,
                                            bool rowsel, int win, float& m, float& lsum, f32x4 (&O)[4]) {
  f32x4 s[2][2];
  float sv[16];
  float mx = -1e30f;
  if (FAST) {
    const float binit = rowsel ? -slope2 * (float)(dbase - lq * 4) : -1e30f;
#pragma unroll
    for (int c = 0; c < 2; c++)
#pragma unroll
      for (int t = 0; t < 2; t++)
#pragma unroll
        for (int j = 0; j < 4; j++) s[c][t][j] = __builtin_fmaf(slope2, (float)(c * 32 + t * 16 + j), binit);
    qk64(kt, lr, lq, q_lo, q_hi, s);
#pragma unroll
    for (int c = 0; c < 2; c++)
#pragma unroll
      for (int t = 0; t < 2; t++)
#pragma unroll
        for (int j = 0; j < 4; j++) { sv[(c * 2 + t) * 4 + j] = s[c][t][j]; mx = fmaxf(mx, s[c][t][j]); }
  } else {
#pragma unroll
    for (int c = 0; c < 2; c++)
#pragma unroll
      for (int t = 0; t < 2; t++) s[c][t] = (f32x4){0.f, 0.f, 0.f, 0.f};
    qk64(kt, lr, lq, q_lo, q_hi, s);
#pragma unroll
    for (int c = 0; c < 2; c++)
#pragma unroll
      for (int t = 0; t < 2; t++)
#pragma unroll
        for (int j = 0; j < 4; j++) {
          const int d = dbase - (c * 32 + t * 16 + lq * 4 + j);
          const bool o = rowsel && d >= 0 && d < win;
          const float v = o ? s[c][t][j] - slope2 * (float)d : -1e30f;
          sv[(c * 2 + t) * 4 + j] = v;
          mx = fmaxf(mx, v);
        }
  }
  if (__any(mx > m)) {
    mx = fmaxf(mx, __shfl_xor(mx, 16)); mx = fmaxf(mx, __shfl_xor(mx, 32));
    const float mnew = fmaxf(m, mx);
    const float alpha = ex2(m - mnew);
    m = mnew;
    lsum *= alpha;
#pragma unroll
    for (int dt = 0; dt < 4; dt++)
#pragma unroll
      for (int j = 0; j < 4; j++) O[dt][j] *= alpha;
  }
  const float mn = m;
  float ps = 0.f;
  bf16x8 pb[2];
#pragma unroll
  for (int c = 0; c < 2; c++) {
    float pv[8];
#pragma unroll
    for (int j = 0; j < 8; j++) {
      const float v = sv[c * 8 + j];
      pv[j] = FAST ? ex2(v - mn) : (v > -1e29f ? ex2(v - mn) : 0.f);
      ps += pv[j];
    }
    pb[c] = pk8(pv[0], pv[1], pv[2], pv[3], pv[4], pv[5], pv[6], pv[7]);
  }
  lsum += ps;
#pragma unroll
  for (int dt = 0; dt < 4; dt++)
#pragma unroll
    for (int c = 0; c < 2; c++) {
      const u16* vp = vt + (dt * 16 + lr) * NT_ST + c * 32 + lq * 4;
      O[dt] = mfma16(ld44(vp, vp + 16), pb[c], O[dt]);
    }
}

template <bool HASV, class KS, class VS, class CF>
__device__ __forceinline__ void tile_pipe2(int n, u16* ktb, u16* vtb, int soff, KS ksrc, VS vsrc, CF compute) {
  uint4 kE, vE, kO, vO;
  kE = vE = kO = vO = make_uint4(0u, 0u, 0u, 0u);
  if (n > 0) { kE = *(const uint4*)ksrc(0); if (HASV) vE = *(const uint4*)vsrc(0); }
  if (n > 1) { kO = *(const uint4*)ksrc(1); if (HASV) vO = *(const uint4*)vsrc(1); }
  if (n > 0) { *(uint4*)(ktb + soff) = kE; if (HASV) *(uint4*)(vtb + soff) = vE; }
  __syncthreads();
#pragma unroll 1
  for (int i = 0; i < n; i += 2) {
    if (i + 2 < n) { kE = *(const uint4*)ksrc(i + 2); if (HASV) vE = *(const uint4*)vsrc(i + 2); }
    compute(i, ktb, vtb);
    if (i + 1 < n) { *(uint4*)(ktb + NT_EL + soff) = kO; if (HASV) *(uint4*)(vtb + NT_EL + soff) = vO; }
    __syncthreads();
    if (i + 1 >= n) break;
    if (i + 3 < n) { kO = *(const uint4*)ksrc(i + 3); if (HASV) vO = *(const uint4*)vsrc(i + 3); }
    compute(i + 1, ktb + NT_EL, vtb + NT_EL);
    if (i + 2 < n) { *(uint4*)(ktb + soff) = kE; if (HASV) *(uint4*)(vtb + soff) = vE; }
    __syncthreads();
  }
}

__device__ __forceinline__ void nsa_wg(const Params& p, int g, int T0, unsigned char* sm) {
  const int tid = tid_fresh(), lane = tid & 63, lr = lane & 15, lq = lane >> 4;
  const int wv = __builtin_amdgcn_readfirstlane(tid >> 6);
  const int t0 = T0 + wv * 4;
  const int tok = lr >> 2, r = lr & 3, tpos = t0 + tok;
  const float slope = 1.4426950408889634f * exp2f(-(float)(g * 4 + r + 1));
  u16* proj = p.BIG;
  float* wl = (float*)sm + wv * 2112;
  float* impA = wl; float* impB = wl + 1024; u32* selm = (u32*)(wl + 1024 + 1040);
  u16* ktb = (u16*)(sm + 67584);
  u16* vtb = ktb + 2 * NT_EL;
  u32* wgm = (u32*)(vtb + 2 * NT_EL);
  u32* wgu = wgm + 64;
  int* blist = (int*)(wgu + 8);
  const int srow = tid >> 3, sseg = (tid & 7) * 8;
  const int soff = srow * NT_ST + sseg;
  bf16x8 q_lo, q_hi;
  {
    const u16* qp = proj + (size_t)tpos * PS + C_NQ + (g * 4 + r) * 64 + lq * 8;
    q_lo = scale8(ld8(qp), 0.125f * 1.4426950408889634f); q_hi = scale8(ld8(qp + 32), 0.125f * 1.4426950408889634f);
  }
  float g0, g1, g2;
  {
    const u16* gp = proj + (size_t)tpos * PS + C_NG + (g * 4 + r) * 3;
    g0 = sigm_f(bf2f(gp[0])); g1 = sigm_f(bf2f(gp[1])); g2 = sigm_f(bf2f(gp[2]));
  }
  f32x4 outacc[4];
#pragma unroll
  for (int dt = 0; dt < 4; dt++) outacc[dt] = (f32x4){0.f, 0.f, 0.f, 0.f};
  const int cur = T0 >> 6;

  for (int i = lane; i < 1024 + 1040; i += 64) wl[i] = 0.f;
  {
    const int ncmp = (T0 + 31 >= 31) ? ((T0 + 31 - 31) >> 4) + 1 : 0;
    const int nst = (ncmp + 63) >> 6;
    const u16* ksrc = p.kc + (size_t)g * 1024 * 64 + (size_t)srow * 64 + sseg;
    const u16* vsrc = p.vcT + (size_t)(g * 64 + srow) * 1024 + sseg;
    float m = -1e30f, lsum = 0.f;
    tile_pipe2<false>(nst, ktb, vtb, soff,
      [&](int i) { return ksrc + (size_t)(nst - 1 - i) * 4096; }, [&](int i) { return ksrc; },
      [&](int i, const u16* kt, const u16* vt) {
        const int st = nst - 1 - i;
        f32x4 s[2][2];
        float sv[16]; float mx = -1e30f;
        const bool fast = t0 - 31 - 16 * (st * 64 + 63) >= 0;
        if (fast) {
          const float binit = -slope * (float)(tpos - 31 - 16 * (st * 64 + lq * 4)), slope16 = slope * 16.0f;
#pragma unroll
          for (int c = 0; c < 2; c++)
#pragma unroll
            for (int t = 0; t < 2; t++)
#pragma unroll
              for (int j = 0; j < 4; j++) s[c][t][j] = __builtin_fmaf(slope16, (float)(c * 32 + t * 16 + j), binit);
          qk64(kt, lr, lq, q_lo, q_hi, s);
#pragma unroll
          for (int c = 0; c < 2; c++)
#pragma unroll
            for (int t = 0; t < 2; t++)
#pragma unroll
              for (int j = 0; j < 4; j++) { sv[(c * 2 + t) * 4 + j] = s[c][t][j]; mx = fmaxf(mx, s[c][t][j]); }
        } else {
#pragma unroll
          for (int c = 0; c < 2; c++)
#pragma unroll
            for (int t = 0; t < 2; t++) s[c][t] = (f32x4){0.f, 0.f, 0.f, 0.f};
          qk64(kt, lr, lq, q_lo, q_hi, s);
#pragma unroll
          for (int c = 0; c < 2; c++)
#pragma unroll
            for (int t = 0; t < 2; t++)
#pragma unroll
              for (int j = 0; j < 4; j++) {
                const int ci = st * 64 + c * 32 + t * 16 + lq * 4 + j;
                const int d = tpos - (ci * 16 + 31);
                const float v = d >= 0 ? s[c][t][j] - slope * (float)d : -1e30f;
                sv[(c * 2 + t) * 4 + j] = v; mx = fmaxf(mx, v);
              }
        }
        if (__any(mx > m)) {
          mx = fmaxf(mx, __shfl_xor(mx, 16)); mx = fmaxf(mx, __shfl_xor(mx, 32));
          const float mnew = fmaxf(m, mx);
          lsum *= ex2(m - mnew);
          m = mnew;
        }
        const float mn = m;
        float ps = 0.f;
        if (fast) {
#pragma unroll
          for (int j = 0; j < 16; j++) ps += ex2(sv[j] - mn);
        } else {
#pragma unroll
          for (int j = 0; j < 16; j++) ps += sv[j] > -1e29f ? ex2(sv[j] - mn) : 0.f;
        }
        lsum += ps;
      });
    lsum += __shfl_xor(lsum, 16); lsum += __shfl_xor(lsum, 32);
    const float invL = lsum > 0.f ? 1.0f / lsum : 0.f;
    f32x4 O[4];
#pragma unroll
    for (int dt = 0; dt < 4; dt++) O[dt] = (f32x4){0.f, 0.f, 0.f, 0.f};
    tile_pipe2<true>(nst, ktb, vtb, soff,
      [&](int st) { return ksrc + (size_t)st * 4096; }, [&](int st) { return vsrc + st * 64; },
      [&](int st, const u16* kt, const u16* vt) {
        f32x4 s[2][2];
        const bool fast = t0 - 31 - 16 * (st * 64 + 63) >= 0;
        if (fast) {
          const float binit = -slope * (float)(tpos - 31 - 16 * (st * 64 + lq * 4)) - m, slope16 = slope * 16.0f;
#pragma unroll
          for (int c = 0; c < 2; c++)
#pragma unroll
            for (int t = 0; t < 2; t++)
#pragma unroll
              for (int j = 0; j < 4; j++) s[c][t][j] = __builtin_fmaf(slope16, (float)(c * 32 + t * 16 + j), binit);
        } else {
#pragma unroll
          for (int c = 0; c < 2; c++)
#pragma unroll
            for (int t = 0; t < 2; t++) s[c][t] = (f32x4){0.f, 0.f, 0.f, 0.f};
        }
        qk64(kt, lr, lq, q_lo, q_hi, s);
        bf16x8 pb[2];
#pragma unroll
        for (int c = 0; c < 2; c++) {
          float p0[4], p1[4];
          if (fast) {
#pragma unroll
            for (int j = 0; j < 4; j++) { p0[j] = ex2(s[c][0][j]) * invL; p1[j] = ex2(s[c][1][j]) * invL; }
          } else {
#pragma unroll
            for (int j = 0; j < 4; j++) {
              const int ci = st * 64 + c * 32 + lq * 4 + j;
              const int d0 = tpos - (ci * 16 + 31), d1 = d0 - 256;
              p0[j] = d0 >= 0 ? ex2(s[c][0][j] - slope * (float)d0 - m) * invL : 0.f;
              p1[j] = d1 >= 0 ? ex2(s[c][1][j] - slope * (float)d1 - m) * invL : 0.f;
            }
          }
          float a0 = p0[0] + p0[1] + p0[2] + p0[3], b0 = p0[3], a1 = p1[0] + p1[1] + p1[2] + p1[3], b1 = p1[3];
          a0 = quad_sum(a0); b0 = quad_sum(b0); a1 = quad_sum(a1); b1 = quad_sum(b1);
          if (r == 0) {
            const int J0 = st * 16 + c * 8 + lq;
            impA[tok * 256 + J0] = a0; impB[tok * 260 + J0 + 1] = b0;
            impA[tok * 256 + J0 + 4] = a1; impB[tok * 260 + J0 + 5] = b1;
          }
          pb[c] = pk8(p0[0], p0[1], p0[2], p0[3], p1[0], p1[1], p1[2], p1[3]);
        }
#pragma unroll
        for (int dt = 0; dt < 4; dt++)
#pragma unroll
          for (int c = 0; c < 2; c++) {
            const u16* vp = vt + (dt * 16 + lr) * NT_ST + c * 32 + lq * 4;
            O[dt] = mfma16(ld44(vp, vp + 16), pb[c], O[dt]);
          }
      });
#pragma unroll
    for (int dt = 0; dt < 4; dt++)
#pragma unroll
      for (int j = 0; j < 4; j++) outacc[dt][j] += g0 * O[dt][j];
  }
  wave_lds_sync();

  if (cur < 16) {
    if (lane < 32) selm[lane] = ((lane & 7) == 0) ? ((2u << cur) - 1u) : 0u;
  } else {
    u32 kk[4][4];
#pragma unroll
    for (int tk = 0; tk < 4; tk++) {
      const float* ia = impA + tk * 256; const float* ib = impB + tk * 260;
#pragma unroll
      for (int i = 0; i < 4; i++) {
        const int j = lane + 64 * i;
        kk[tk][i] = (j >= 1 && j <= cur - 2) ? __float_as_uint(ia[j] + ib[j]) + 1u : 0u;
      }
    }
    u32 T[4] = {0u, 0u, 0u, 0u};
#pragma unroll 1
    for (int bit = 30; bit >= 0; bit--) {
#pragma unroll
      for (int tk = 0; tk < 4; tk++) {
        const u32 t = T[tk] | (1u << bit);
        const int cnt = __popcll(__ballot(kk[tk][0] >= t)) + __popcll(__ballot(kk[tk][1] >= t)) + __popcll(__ballot(kk[tk][2] >= t)) + __popcll(__ballot(kk[tk][3] >= t));
        if (cnt >= 13) T[tk] = t;
      }
    }
#pragma unroll
    for (int tk = 0; tk < 4; tk++) {
      const u32 k0 = kk[tk][0], k1 = kk[tk][1], k2 = kk[tk][2], k3 = kk[tk][3], Tt = T[tk];
      int need = 13 - (__popcll(__ballot(k0 > Tt)) + __popcll(__ballot(k1 > Tt)) + __popcll(__ballot(k2 > Tt)) + __popcll(__ballot(k3 > Tt)));
      u64 sel0, sel1, sel2, sel3;
      {
        u64 e = __ballot(k0 == Tt); int below = __builtin_amdgcn_mbcnt_hi((u32)(e >> 32), __builtin_amdgcn_mbcnt_lo((u32)e, 0u));
        sel0 = __ballot(k0 > Tt || (k0 == Tt && below < need)); need -= min(need, (int)__popcll(e));
        e = __ballot(k1 == Tt); below = __builtin_amdgcn_mbcnt_hi((u32)(e >> 32), __builtin_amdgcn_mbcnt_lo((u32)e, 0u));
        sel1 = __ballot(k1 > Tt || (k1 == Tt && below < need)); need -= min(need, (int)__popcll(e));
        e = __ballot(k2 == Tt); below = __builtin_amdgcn_mbcnt_hi((u32)(e >> 32), __builtin_amdgcn_mbcnt_lo((u32)e, 0u));
        sel2 = __ballot(k2 > Tt || (k2 == Tt && below < need)); need -= min(need, (int)__popcll(e));
        e = __ballot(k3 == Tt); below = __builtin_amdgcn_mbcnt_hi((u32)(e >> 32), __builtin_amdgcn_mbcnt_lo((u32)e, 0u));
        sel3 = __ballot(k3 > Tt || (k3 == Tt && below < need));
      }
      u32 myword = 0;
      if (lane == 0) myword = (u32)sel0; else if (lane == 1) myword = (u32)(sel0 >> 32);
      else if (lane == 2) myword = (u32)sel1; else if (lane == 3) myword = (u32)(sel1 >> 32);
      else if (lane == 4) myword = (u32)sel2; else if (lane == 5) myword = (u32)(sel2 >> 32);
      else if (lane == 6) myword = (u32)sel3; else if (lane == 7) myword = (u32)(sel3 >> 32);
      if (lane == 0) myword |= 1u;
      if (lane == ((cur - 1) >> 5)) myword |= 1u << ((cur - 1) & 31);
      if (lane == (cur >> 5)) myword |= 1u << (cur & 31);
      if (lane < 8) selm[tk * 8 + lane] = myword;
    }
  }
  wave_lds_sync();
  if (lane < 8) wgm[wv * 8 + lane] = selm[lane] | selm[8 + lane] | selm[16 + lane] | selm[24 + lane];
  __syncthreads();
  if (tid < 8) {
    u32 u = 0;
#pragma unroll
    for (int w = 0; w < 8; w++) u |= wgm[w * 8 + tid];
    const int lim = cur - tid * 32;
    if (lim < 0) u = 0; else if (lim < 31) u &= (2u << lim) - 1u;
    wgu[tid] = u;
  }
  __syncthreads();
  if (tid < 256) {
    const int w = tid >> 5, b = tid & 31;
    int idx = 0;
#pragma unroll
    for (int ww = 0; ww < 8; ww++) { const u32 x = wgu[ww]; idx += ww < w ? __builtin_popcount(x) : 0; }
    const u32 x = wgu[w];
    idx += __builtin_popcount(x & ((1u << b) - 1u));
    if ((x >> b) & 1u) blist[idx] = tid;
  }
  if (tid == 0) {
    int n = 0;
#pragma unroll
    for (int ww = 0; ww < 8; ww++) n += __builtin_popcount(wgu[ww]);
    blist[256] = n;
  }
  __syncthreads();

  {
    const int nblk = blist[256];
    const u16* ksrc = proj + C_KS + g * 64 + (size_t)srow * PS + sseg;
    const u16* vsrc = p.vsT + (size_t)(g * 64 + srow) * S + sseg;
    float m = -1e30f, lsum = 0.f;
    f32x4 O[4];
#pragma unroll
    for (int dt = 0; dt < 4; dt++) O[dt] = (f32x4){0.f, 0.f, 0.f, 0.f};
    tile_pipe2<true>(nblk, ktb, vtb, soff,
      [&](int i) { return ksrc + (size_t)blist[nblk - 1 - i] * 64 * PS; }, [&](int i) { return vsrc + blist[nblk - 1 - i] * 64; },
      [&](int i, const u16* kt, const u16* vt) {
        const int jb = blist[nblk - 1 - i];
        const u32 wany = wgm[wv * 8 + (jb >> 5)];
        if ((wany >> (jb & 31)) & 1u) {
          const bool rowsel = (selm[tok * 8 + (jb >> 5)] >> (jb & 31)) & 1u;
          if (jb < cur) attend_tile<true>(kt, vt, lr, lq, q_lo, q_hi, slope, tpos - jb * 64, rowsel, 1 << 30, m, lsum, O);
          else attend_tile<false>(kt, vt, lr, lq, q_lo, q_hi, slope, tpos - jb * 64, rowsel, 1 << 30, m, lsum, O);
        }
      });
    lsum += __shfl_xor(lsum, 16); lsum += __shfl_xor(lsum, 32);
    const float sc = g1 / fmaxf(lsum, 1e-30f);
#pragma unroll
    for (int dt = 0; dt < 4; dt++)
#pragma unroll
      for (int j = 0; j < 4; j++) outacc[dt][j] += sc * O[dt][j];
  }
  {
    int ks = T0 - 511; if (ks < 0) ks = 0; ks &= ~63;
    const int nst = ((T0 + 31 - ks) >> 6) + 1;
    const u16* ksrc = proj + C_KW + g * 64 + (size_t)(ks + srow) * PS + sseg;
    const u16* vsrc = p.vwT + (size_t)(g * 64 + srow) * S + ks + sseg;
    float m = -1e30f, lsum = 0.f;
    f32x4 O[4];
#pragma unroll
    for (int dt = 0; dt < 4; dt++) O[dt] = (f32x4){0.f, 0.f, 0.f, 0.f};
    tile_pipe2<true>(nst, ktb, vtb, soff,
      [&](int st) { return ksrc + (size_t)(nst - 1 - st) * 64 * PS; }, [&](int st) { return vsrc + (nst - 1 - st) * 64; },
      [&](int st, const u16* kt, const u16* vt) {
        const int kp0 = ks + (nst - 1 - st) * 64;
        if (t0 - (kp0 + 63) >= 0 && t0 + 3 - kp0 < 512) attend_tile<true>(kt, vt, lr, lq, q_lo, q_hi, slope, tpos - kp0, true, 512, m, lsum, O);
        else attend_tile<false>(kt, vt, lr, lq, q_lo, q_hi, slope, tpos - kp0, true, 512, m, lsum, O);
      });
    lsum += __shfl_xor(lsum, 16); lsum += __shfl_xor(lsum, 32);
    const float sc = g2 / fmaxf(lsum, 1e-30f);
#pragma unroll
    for (int dt = 0; dt < 4; dt++)
#pragma unroll
      for (int j = 0; j < 4; j++) outacc[dt][j] += sc * O[dt][j];
  }
  {
    u16* op = proj + (size_t)tpos * PS + C_NQ + (g * 4 + r) * 64 + lq * 4;
#pragma unroll
    for (int dt = 0; dt < 4; dt++)
      *(uint2*)(op + dt * 16) = make_uint2(pack2(outacc[dt][0], outacc[dt][1]), pack2(outacc[dt][2], outacc[dt][3]));
  }
  __syncthreads();
}

#define XB_TMO      128
#define XB_XCNT(j)  (256  + 64 * (j))
#define XB_XSUB(j)  (1280 + 64 * (j))
#define XB_XGEN(j)  (2304 + 64 * (j))
#define XB_TOP      3328
#define XB_TOPGEN   3392
#define XCD_BAR_WORDS 3456
#define XB_SPIN_CAP (1u << 18)
__device__ __forceinline__ unsigned xb_ld(unsigned* p)              { return __hip_atomic_load(p, __ATOMIC_RELAXED, __HIP_MEMORY_SCOPE_AGENT); }
__device__ __forceinline__ unsigned xb_add(unsigned* p, unsigned v) { return __hip_atomic_fetch_add(p, v, __ATOMIC_RELAXED, __HIP_MEMORY_SCOPE_AGENT); }
__device__ __forceinline__ unsigned xb_xcc_id() { return (unsigned)__builtin_amdgcn_s_getreg((3 << 11) | 20) & 0xFu; }
#define XB_SPIN(cond, bar) do { unsigned _sp = 0; while (cond) { __builtin_amdgcn_s_sleep(1); \
    if ((++_sp & 255u) == 0u) { if (xb_ld(&(bar)[XB_TMO])) break; if (_sp > XB_SPIN_CAP) { atomicAdd(&(bar)[XB_TMO], 1u); break; } } } } while (0)
struct XcdBarrier { unsigned* bar; unsigned x; volatile __attribute__((address_space(3))) unsigned* st; };
__device__ __forceinline__ XcdBarrier xcd_barrier_post(unsigned* bar, volatile __attribute__((address_space(3))) unsigned* st) {
  XcdBarrier b; b.bar = bar; b.x = xb_xcc_id(); b.st = st;
  if (threadIdx.x == 0) (void)xb_add(&bar[XB_XCNT(b.x)], 1u);
  return b;
}
__device__ __forceinline__ void xcd_barrier_complete(unsigned* bar, unsigned x, unsigned& nloc, unsigned& nx) {
  const unsigned G = gridDim.x * gridDim.y * gridDim.z;
  unsigned sum, cnt, mine, sp = 0u;
  for (;;) {
    sum = 0u; cnt = 0u; mine = 0u;
#pragma unroll
    for (unsigned j = 0; j < 16; ++j) { const unsigned c = xb_ld(&bar[XB_XCNT(j)]); sum += c; cnt += (c > 0u) ? 1u : 0u; mine = (j == x) ? c : mine; }
    if (sum == G) break;
    __builtin_amdgcn_s_sleep(1);
    if ((++sp & 255u) == 0u) { if (xb_ld(&bar[XB_TMO])) break; if (sp > XB_SPIN_CAP) { atomicAdd(&bar[XB_TMO], 1u); break; } }
  }
  nloc = mine > 0u ? mine : 1u; nx = cnt > 0u ? cnt : 1u;
}
__device__ __forceinline__ void xcd_barrier(const XcdBarrier& b) {
  asm volatile("s_waitcnt vmcnt(0)" ::: "memory");
  __syncthreads();
  if (threadIdx.x == 0) {
    unsigned* bar = b.bar;
    __builtin_amdgcn_s_waitcnt(0);
    unsigned nloc = b.st[0], nx = b.st[1];
    if (nloc == 0u) { xcd_barrier_complete(bar, b.x, nloc, nx); b.st[0] = nloc; b.st[1] = nx; }
    const unsigned old = xb_add(&bar[XB_XSUB(b.x)], 1u);
    const unsigned gen = old / nloc;
    if (old + 1u == (gen + 1u) * nloc) {
      __builtin_amdgcn_fence(__ATOMIC_RELEASE, "agent");
      asm volatile("s_waitcnt vmcnt(0)" ::: "memory");
      const unsigned og = xb_add(&bar[XB_TOP], 1u);
      const unsigned tg = og / nx;
      if (og + 1u == (tg + 1u) * nx) xb_add(&bar[XB_TOPGEN], 1u);
      else XB_SPIN(xb_ld(&bar[XB_TOPGEN]) == tg, bar);
      __builtin_amdgcn_fence(__ATOMIC_ACQUIRE, "agent");
      xb_add(&bar[XB_XGEN(b.x)], 1u);
      asm volatile("s_waitcnt vmcnt(0)" ::: "memory");
    } else {
      XB_SPIN(xb_ld(&bar[XB_XGEN(b.x)]) == gen, bar);
      __builtin_amdgcn_fence(__ATOMIC_ACQUIRE, "agent");
      asm volatile("s_waitcnt vmcnt(0)" ::: "memory");
    }
  }
  __syncthreads();
}

template <bool FINAL>
struct EpiResidNorm {
  static constexpr bool PERM = false;
  const float* xsrc; float* xdst; float scale; const float* gnext; u16* Hout; float* part; unsigned* cnt; unsigned* tmo;
  __device__ __forceinline__ void fused(AccT& acc, const Unit& u, int wr, int wc, int fr, int fq, LAS unsigned char* lds) const {
    volatile LAS float* ps = (volatile LAS float*)(lds + 131072);
    volatile LAS float* rr = (volatile LAS float*)(lds + 131072 + 4096);
    const int tid = tid_fresh();
    const int row0 = u.pm * 256 + wr * 64 + fr, col0 = u.pn * 256 + wc * 32 + 4 * fq;
#pragma unroll
    for (int ai = 0; ai < 2; ++ai) {
      f32x4 xv[4][2][2];
#pragma unroll
      for (int m = 0; m < 4; ++m)
#pragma unroll
        for (int bj = 0; bj < 2; ++bj)
#pragma unroll
          for (int n = 0; n < 2; ++n)
            xv[m][bj][n] = *(const f32x4*)(xsrc + (size_t)(row0 + ai * 128 + m * 16) * 1024 + col0 + bj * 128 + n * 16);
#pragma unroll
      for (int m = 0; m < 4; ++m) {
        float ss = 0.f;
#pragma unroll
        for (int bj = 0; bj < 2; ++bj)
#pragma unroll
          for (int n = 0; n < 2; ++n) {
            const f32x4 v = xv[m][bj][n] + scale * acc[ai][bj][m][n];
            if (!FINAL) *(f32x4*)(xdst + (size_t)(row0 + ai * 128 + m * 16) * 1024 + col0 + bj * 128 + n * 16) = v;
            acc[ai][bj][m][n] = v;
            ss += v[0] * v[0] + v[1] * v[1] + v[2] * v[2] + v[3] * v[3];
          }
        ss += __shfl_xor(ss, 16); ss += __shfl_xor(ss, 32);
        if (fq == 0) ps[wc * 256 + ai * 128 + wr * 64 + m * 16 + fr] = ss;
      }
    }
    __syncthreads();
    if (tid < 256) __hip_atomic_store(part + (size_t)(u.pm * 4 + u.pn) * 256 + tid, ps[tid] + ps[256 + tid] + ps[512 + tid] + ps[768 + tid], __ATOMIC_RELAXED, __HIP_MEMORY_SCOPE_AGENT);
    asm volatile("s_waitcnt vmcnt(0)" ::: "memory");
    __syncthreads();
    if (tid == 0) {
      (void)xb_add(cnt + u.pm, 1u);
      XB_SPIN(xb_ld(cnt + u.pm) < 4u, tmo);
      __builtin_amdgcn_fence(__ATOMIC_ACQUIRE, "agent");
      asm volatile("s_waitcnt vmcnt(0)" ::: "memory");
    }
    __syncthreads();
    if (tid < 256) {
      const float* pp = part + (size_t)(u.pm * 4) * 256 + tid;
      const float t0 = __hip_atomic_load(pp, __ATOMIC_RELAXED, __HIP_MEMORY_SCOPE_AGENT), t1 = __hip_atomic_load(pp + 256, __ATOMIC_RELAXED, __HIP_MEMORY_SCOPE_AGENT);
      const float t2 = __hip_atomic_load(pp + 512, __ATOMIC_RELAXED, __HIP_MEMORY_SCOPE_AGENT), t3 = __hip_atomic_load(pp + 768, __ATOMIC_RELAXED, __HIP_MEMORY_SCOPE_AGENT);
      rr[tid] = rsqrtf(((t0 + t1) + (t2 + t3)) * (1.0f / 1024.0f) + EPS);
    }
    __syncthreads();
    f32x4 gv[2][2];
#pragma unroll
    for (int bj = 0; bj < 2; ++bj)
#pragma unroll
      for (int n = 0; n < 2; ++n) gv[bj][n] = *(const f32x4*)(gnext + col0 + bj * 128 + n * 16);
#pragma unroll
    for (int ai = 0; ai < 2; ++ai)
#pragma unroll
      for (int m = 0; m < 4; ++m) {
        const float r = rr[ai * 128 + wr * 64 + m * 16 + fr];
#pragma unroll
        for (int bj = 0; bj < 2; ++bj)
#pragma unroll
          for (int n = 0; n < 2; ++n) {
            const f32x4 h = acc[ai][bj][m][n] * r * gv[bj][n];
            if (FINAL) *(f32x4*)(xdst + (size_t)(row0 + ai * 128 + m * 16) * 1024 + col0 + bj * 128 + n * 16) = h;
            else *(uint2*)(Hout + (size_t)(row0 + ai * 128 + m * 16) * 1024 + col0 + bj * 128 + n * 16) = make_uint2(pack2(h[0], h[1]), pack2(h[2], h[3]));
          }
      }
    __syncthreads();
  }
};

constexpr int SMEM_TOTAL = 147456;
__global__ void __launch_bounds__(512, 2) mega(Params p) {
  cg::grid_group grid = cg::this_grid();
  __shared__ __attribute__((aligned(16))) unsigned char smem_raw[SMEM_TOTAL + 16];
  LAS unsigned char* glds = (LAS unsigned char*)smem_raw;
  volatile LAS unsigned* xb_words = (volatile LAS unsigned*)(glds + SMEM_TOTAL);
  if (threadIdx.x == 0) { xb_words[0] = 0u; xb_words[1] = 0u; }
  if (blockIdx.x == 0) { for (int i = threadIdx.x; i < XCD_BAR_WORDS; i += 512) p.bar[i] = 0u; if (threadIdx.x < 384) p.ncnt[threadIdx.x] = 0u; }
  __syncthreads();
  XcdBarrier xb; xb.bar = p.bar; xb.x = 0; xb.st = xb_words;
#define VB_SETUP const int _tf = tid_fresh(); const int half = __builtin_amdgcn_readfirstlane(_tf >> 8); const int nb = gridDim.x * 2, bid = blockIdx.x * 2 + half; \
  u16* smem = (u16*)(smem_raw + half * SMEM_BYTES); const int vwave = __builtin_amdgcn_readfirstlane((_tf & 255) >> 6); (void)vwave; (void)nb; (void)bid; (void)smem;
#pragma unroll 1
  for (int l = 0; l < 2; l++) {
    const float* xsrc = l == 0 ? p.x_in : p.xout;
    const bool fusedn = gridDim.x == 256;
    if (l == 0 || !fusedn) norm_phase(xsrc, p.ffn1_norm + l * 1024, p.H);
    { VB_SETUP wprep_phase(p, l, smem, bid, nb, l == 1 && fusedn); }
    if (l == 0) { grid.sync(); xb = xcd_barrier_post(p.bar, xb_words); } else xcd_barrier(xb);
    { Gemm g{p.H, p.w1t_a, 1024, 1024, S, 5632, 1024}; EpiSwiglu e{p.BIG}; gemm_phase(glds, g, e); }
    xcd_barrier(xb);
    if (fusedn) {
      Gemm g{p.BIG, p.w2t_a, FF, FF, S, 1024, FF};
      EpiResidNorm<false> e{xsrc, p.xout, 0.5f, p.mix_norm + l * 1024, p.H, p.part + (size_t)(l * 2) * 65536, p.ncnt + (l * 2) * 64, p.bar};
      gemm_phase<EpiResidNorm<false>, true>(glds, g, e);
      xcd_barrier(xb);
    } else {
      { Gemm g{p.BIG, p.w2t_a, FF, FF, S, 1024, FF}; EpiResid e{xsrc, p.xout, 0.5f}; gemm_phase(glds, g, e); }
      xcd_barrier(xb);
      norm_phase(p.xout, p.mix_norm + l * 1024, p.H);
      xcd_barrier(xb);
    }
    { Gemm g{p.H, p.wint, 1024, 1024, S, 4096, 1024}; EpiProj e{p.BIG}; gemm_phase(glds, g, e); }
    xcd_barrier(xb);
    { VB_SETUP
    if (nb == 512) {
      if (bid < 128) { cmp_tile(p, l, bid, smem); ret_kv_tile(p, bid, smem); ret_kv_tile(p, 128 + bid, smem); }
      else {
        const int h2 = bid - 128;
        gmlp_tile(p, l, h2, smem);
        if (h2 < 128) { gmlp_tile(p, l, 384 + h2, smem); vt_tile(p, h2, smem); }
        else {
          const int ci = h2 - 128;
          ret_kv_tile(p, 256 + ci, smem);
          vt_tile(p, 128 + ci * 3, smem); vt_tile(p, 129 + ci * 3, smem); vt_tile(p, 130 + ci * 3, smem);
          if (ci < 128) vt_tile(p, 896 + ci, smem);
        }
      }
    } else {
    for (int t = bid; t < 128 + 512 + 512 + 1024; t += nb) {
      if (t < 128) cmp_tile(p, l, t, smem);
      else if (t < 640) gmlp_tile(p, l, t - 128, smem);
      else if (t < 1152) ret_kv_tile(p, t - 640, smem);
      else vt_tile(p, t - 1152, smem);
    } } }
    xcd_barrier(xb);
    {
      const int tf = tid_fresh();
      const int wv = __builtin_amdgcn_readfirstlane(tf >> 6);
      ret_scan_wg(p, smem_raw);
      const int xcd = blockIdx.x & 7, slot = blockIdx.x >> 3, nslot = gridDim.x >> 3;
      for (int i = slot; i < 128; i += nslot) {
        const int rsel = i >> 6, j = i & 63;
        const int range = rsel == 0 ? 15 - xcd : xcd;
        const int g = (j ^ (j >> 5)) & 1, w = range * 32 + 31 - (j >> 1);
        nsa_wg(p, g, w * 32, smem_raw);
      }
    }
    xcd_barrier(xb);
    { VB_SETUP for (int t = bid; t < 512; t += nb) ret_out_tile(p, l, t, smem); }
    xcd_barrier(xb);
    gemm_merge_chain(glds, p, l);
    xcd_barrier(xb);
    if (fusedn) {
      Gemm g{p.BIG + C_MIX, p.wot, PS, 1024, S, 1024, 1024};
      EpiResidNorm<false> e{p.xout, p.xout, 1.0f, p.ffn2_norm + l * 1024, p.H, p.part + (size_t)(l * 2 + 1) * 65536, p.ncnt + (l * 2 + 1) * 64, p.bar};
      gemm_phase<EpiResidNorm<false>, true>(glds, g, e);
      xcd_barrier(xb);
    } else {
      { Gemm g{p.BIG + C_MIX, p.wot, PS, 1024, S, 1024, 1024}; EpiResid e{p.xout, p.xout, 1.0f}; gemm_phase(glds, g, e); }
      xcd_barrier(xb);
      norm_phase(p.xout, p.ffn2_norm + l * 1024, p.H);
      xcd_barrier(xb);
    }
    { Gemm g{p.H, p.w1t_b, 1024, 1024, S, 5632, 1024}; EpiSwiglu e{p.BIG}; gemm_phase(glds, g, e); }
    if (l == 0 && fusedn && blockIdx.x >= 128) {
      VB_SETUP
      wprep_matrix(p.ffn1_w1 + (size_t)1024 * 5632, p.w1t_a, 1024, 5632, 1, smem, bid - 256, 256);
      wprep_matrix(p.ffn1_w2 + (size_t)FF * 1024, p.w2t_a, FF, 1024, 0, smem, bid - 256, 256);
    }
    xcd_barrier(xb);
    if (fusedn && l == 0) {
      Gemm g{p.BIG, p.w2t_b, FF, FF, S, 1024, FF};
      EpiResidNorm<false> e{p.xout, p.xout, 0.5f, p.ffn1_norm + 1024, p.H, p.part + (size_t)4 * 65536, p.ncnt + 4 * 64, p.bar};
      gemm_phase<EpiResidNorm<false>, true>(glds, g, e);
      xcd_barrier(xb);
    } else if (fusedn) {
      Gemm g{p.BIG, p.w2t_b, FF, FF, S, 1024, FF};
      EpiResidNorm<true> e{p.xout, p.xout, 0.5f, p.final_norm, p.H, p.part + (size_t)5 * 65536, p.ncnt + 5 * 64, p.bar};
      gemm_phase<EpiResidNorm<true>, true>(glds, g, e);
    } else {
      { Gemm g{p.BIG, p.w2t_b, FF, FF, S, 1024, FF}; EpiResid e{p.xout, p.xout, 0.5f}; gemm_phase(glds, g, e); }
      xcd_barrier(xb);
      if (l == 1) final_norm_phase(p.xout, p.final_norm);
    }
  }
}

extern "C" void kernel_launch(void* const* d_in, const int* in_sizes, int n_in, void* d_out, int out_size, void* d_ws,
                              size_t ws_size, hipStream_t stream) {
  static int grid_blocks = 0;
  if (!grid_blocks) {
    int dev = 0, cus = 0, per_cu = 0;
    (void)hipGetDevice(&dev);
    (void)hipDeviceGetAttribute(&cus, hipDeviceAttributeMultiprocessorCount, dev);
    (void)hipOccupancyMaxActiveBlocksPerMultiprocessor(&per_cu, mega, 512, 0);
    if (per_cu > 1) per_cu = 1;
    if (per_cu < 1) per_cu = 1;
    grid_blocks = cus * per_cu;
    grid_blocks &= ~7;
  }
  Params p{};
  p.x_in = (const float*)d_in[0];
  p.ffn1_norm = (const float*)d_in[1]; p.ffn1_w1 = (const float*)d_in[2]; p.ffn1_w2 = (const float*)d_in[3];
  p.mix_norm = (const float*)d_in[4]; p.w_in = (const float*)d_in[5]; p.gm_ln_g = (const float*)d_in[6];
  p.gm_ln_b = (const float*)d_in[7]; p.gm_ws = (const float*)d_in[8]; p.gm_bs = (const float*)d_in[9];
  p.ret_gn_g = (const float*)d_in[10]; p.ret_gn_b = (const float*)d_in[11]; p.cmp_pos = (const float*)d_in[12];
  p.cmp_w1 = (const float*)d_in[13]; p.cmp_w2 = (const float*)d_in[14]; p.w_branch = (const float*)d_in[15];
  p.w_gate = (const float*)d_in[16]; p.b_gate = (const float*)d_in[17]; p.w_o = (const float*)d_in[18];
  p.ffn2_norm = (const float*)d_in[19]; p.ffn2_w1 = (const float*)d_in[20]; p.ffn2_w2 = (const float*)d_in[21];
  p.final_norm = (const float*)d_in[22];
  p.xout = (float*)d_out;
  char* w = (char*)d_ws;
  auto take = [&](size_t bytes) { char* r = w; w += (bytes + 255) & ~(size_t)255; return r; };
  p.w1t_a = (u16*)take((size_t)5632 * 1024 * 2);
  p.w1t_b = (u16*)take((size_t)5632 * 1024 * 2);
  p.w2t_a = (u16*)take((size_t)1024 * FF * 2);
  p.w2t_b = (u16*)take((size_t)1024 * FF * 2);
  p.wint = (u16*)take((size_t)4096 * 1024 * 2);
  p.wgt = (u16*)take((size_t)3072 * 1024 * 2);
  p.wbt = (u16*)take((size_t)3 * 1024 * 512 * 2);
  p.wot = (u16*)take((size_t)1024 * 1024 * 2);
  p.cw1t = (u16*)take((size_t)2 * 128 * 2048 * 2);
  p.cw2t = (u16*)take((size_t)2 * 64 * 128 * 2);
  p.H = (u16*)take((size_t)S * 1024 * 2);
  p.BIG = (u16*)take((size_t)S * PS * 2);
  p.vsT = (u16*)take((size_t)2 * 64 * S * 2);
  p.vwT = (u16*)take((size_t)2 * 64 * S * 2);
  p.kc = (u16*)take((size_t)2 * 1024 * 64 * 2);
  p.vcT = (u16*)take((size_t)2 * 64 * 1024 * 2);
  p.ret = (float*)take((size_t)128 * 4 * 8192 * 4);
  p.gst = (u16*)take((size_t)256 * 65536 * 2);
  p.bar = (unsigned*)take((size_t)XCD_BAR_WORDS * 4);
  p.part = (float*)take((size_t)6 * 64 * 4 * 256 * 4);
  p.ncnt = (unsigned*)take((size_t)6 * 64 * 4);
  if ((size_t)(w - (char*)d_ws) > ws_size) { fprintf(stderr, "workspace too small: need %zu have %zu\n", (size_t)(w - (char*)d_ws), ws_size); return; }
  void* args[] = {&p};
  hipError_t e = hipLaunchCooperativeKernel((void*)mega, dim3(grid_blocks), dim3(512), args, 0, stream);
  if (e != hipSuccess) fprintf(stderr, "coop launch failed: %s (grid %d)\n", hipGetErrorString(e), grid_blocks);
}
```

```cpp
#include <hip/hip_runtime.h>
#include <hip/hip_cooperative_groups.h>
#include <cstdio>
#include <cstdint>
namespace cg = cooperative_groups;

typedef unsigned short u16;
typedef unsigned int u32;
typedef unsigned long long u64;
using bf16x8 = __attribute__((ext_vector_type(8))) short;
using bf16x4 = __attribute__((ext_vector_type(4))) short;
using f32x4 = __attribute__((ext_vector_type(4))) float;

constexpr int S = 16384, FF = 2816, DIN = 3864;
constexpr int PS = 3968;
constexpr int C_U = 0, C_V = 512, C_RQ = 1024, C_RK = 1280, C_RV = 1536, C_RG = 2048, C_NQ = 2560,
              C_KC = 3072, C_VC = 3200, C_KS = 3328, C_VS = 3456, C_KW = 3584, C_VW = 3712, C_NG = 3840, C_MIX = 512;
constexpr float EPS = 1e-6f;
constexpr int SMEM_BYTES = 73728;

struct Params {
  const float* x_in;
  const float *ffn1_norm, *ffn1_w1, *ffn1_w2, *mix_norm, *w_in, *gm_ln_g, *gm_ln_b, *gm_ws, *gm_bs, *ret_gn_g, *ret_gn_b,
      *cmp_pos, *cmp_w1, *cmp_w2, *w_branch, *w_gate, *b_gate, *w_o, *ffn2_norm, *ffn2_w1, *ffn2_w2, *final_norm;
  float* xout;
  u16 *w1t_a, *w2t_a, *wint, *wgt, *wbt, *wot, *w1t_b, *w2t_b, *cw1t, *cw2t;
  u16 *H, *BIG, *vsT, *vwT, *kc, *vcT;
  float* ret;
  u16* gst;
  unsigned* bar;
  float* part; unsigned* ncnt;
};

__device__ __forceinline__ u16 f2bf(float f) { __bf16 b = (__bf16)f; return __builtin_bit_cast(u16, b); }
__device__ __forceinline__ float bf2f(u16 h) { return __uint_as_float(((u32)h) << 16); }
typedef __bf16 bf16x2_t __attribute__((ext_vector_type(2)));
typedef float f32x2_t __attribute__((ext_vector_type(2)));
__device__ __forceinline__ u32 pack2(float a, float b) { f32x2_t v = {a, b}; bf16x2_t r = __builtin_convertvector(v, bf16x2_t); return __builtin_bit_cast(u32, r); }
__device__ __forceinline__ float lo2f(u32 w) { return __uint_as_float(w << 16); }
__device__ __forceinline__ float hi2f(u32 w) { return __uint_as_float(w & 0xffff0000u); }
__device__ __forceinline__ float gelu_t(float x) { float y = 1.5957691216057308f * (x + 0.044715f * x * x * x); return x * __builtin_amdgcn_rcpf(1.0f + __expf(-y)); }
__device__ __forceinline__ float silu_f(float x) { return x * __builtin_amdgcn_rcpf(1.0f + __expf(-x)); }
__device__ __forceinline__ float sigm_f(float x) { return __builtin_amdgcn_rcpf(1.0f + __expf(-x)); }
__device__ __forceinline__ f32x4 mfma16(bf16x8 a, bf16x8 b, f32x4 c) { return __builtin_amdgcn_mfma_f32_16x16x32_bf16(a, b, c, 0, 0, 0); }
__device__ __forceinline__ bf16x8 ld8(const u16* p) { return *(const bf16x8*)p; }
__device__ __forceinline__ bf16x8 ld44(const u16* p0, const u16* p1) {
  bf16x4 a = *(const bf16x4*)p0, b = *(const bf16x4*)p1;
  return __builtin_shufflevector(a, b, 0, 1, 2, 3, 4, 5, 6, 7);
}
__device__ __forceinline__ bf16x8 pk8(float a0, float a1, float a2, float a3, float a4, float a5, float a6, float a7) {
  union { uint4 u; bf16x8 v; } x;
  x.u = make_uint4(pack2(a0, a1), pack2(a2, a3), pack2(a4, a5), pack2(a6, a7));
  return x.v;
}
__device__ __forceinline__ bf16x8 scale8(bf16x8 v, float s) {
  union { uint4 u; bf16x8 v; } x; x.v = v;
  x.u.x = pack2(lo2f(x.u.x) * s, hi2f(x.u.x) * s); x.u.y = pack2(lo2f(x.u.y) * s, hi2f(x.u.y) * s);
  x.u.z = pack2(lo2f(x.u.z) * s, hi2f(x.u.z) * s); x.u.w = pack2(lo2f(x.u.w) * s, hi2f(x.u.w) * s);
  return x.v;
}
__device__ __forceinline__ void wave_lds_sync() { asm volatile("s_waitcnt lgkmcnt(0)" ::: "memory"); }

__device__ __forceinline__ int tid_fresh() { int t = threadIdx.x; asm volatile("" : "+v"(t)); return t; }
__device__ __forceinline__ int wmap(int n, int mode) {
  if (mode == 0) return n;
  int isb = n >= FF; int nn = isb ? n - FF : n;
  return (nn >> 4) * 32 + isb * 16 + (nn & 15);
}
__device__ __forceinline__ void wprep_matrix(const float* __restrict__ src, u16* __restrict__ dst, int K, int N, int mode, u16* smem, int vb, int nvb) {
  float* T = (float*)smem;
  const int tid = tid_fresh() & 255;
  const int tk = K >> 6, tn = (N + 63) >> 6, nt = tk * tn;
  for (int t = vb; t < nt; t += nvb) {
    const int k0 = (t % tk) * 64, n0 = (t / tk) * 64;
#pragma unroll
    for (int i = 0; i < 4; i++) {
      int kk = (tid >> 4) + 16 * i, n = n0 + (tid & 15) * 4;
      float4 v = make_float4(0.f, 0.f, 0.f, 0.f);
      if (n < N) v = *(const float4*)(src + (size_t)(k0 + kk) * N + n);
      float* tp = T + kk * 65 + (tid & 15) * 4;
      tp[0] = v.x; tp[1] = v.y; tp[2] = v.z; tp[3] = v.w;
    }
    __syncthreads();
    {
      int n = tid >> 2, kc = (tid & 3) * 16, nn = n0 + n;
      if (nn < N) {
        u32 w[8];
#pragma unroll
        for (int e = 0; e < 8; e++) w[e] = pack2(T[(kc + 2 * e) * 65 + n], T[(kc + 2 * e + 1) * 65 + n]);
        u16* dp = dst + (size_t)wmap(nn, mode) * K + k0 + kc;
        *(uint4*)dp = make_uint4(w[0], w[1], w[2], w[3]);
        *(uint4*)(dp + 8) = make_uint4(w[4], w[5], w[6], w[7]);
      }
    }
    __syncthreads();
  }
}
__device__ __forceinline__ void wprep_phase(const Params& p, int l, u16* smem, int vb, int nvb, bool skip_ffn1, bool skip_ffn2) {
  if (!skip_ffn1) wprep_matrix(p.ffn1_w1 + (size_t)l * 1024 * 5632, p.w1t_a, 1024, 5632, 1, smem, vb, nvb);
  if (!skip_ffn2) wprep_matrix(p.ffn2_w1 + (size_t)l * 1024 * 5632, p.w1t_b, 1024, 5632, 1, smem, vb, nvb);
  if (!skip_ffn1) wprep_matrix(p.ffn1_w2 + (size_t)l * FF * 1024, p.w2t_a, FF, 1024, 0, smem, vb, nvb);
  if (!skip_ffn2) wprep_matrix(p.ffn2_w2 + (size_t)l * FF * 1024, p.w2t_b, FF, 1024, 0, smem, vb, nvb);
  wprep_matrix(p.w_in + (size_t)l * 1024 * DIN, p.wint, 1024, DIN, 0, smem, vb, nvb);
  wprep_matrix(p.w_gate + (size_t)l * 1024 * 3072, p.wgt, 1024, 3072, 0, smem, vb, nvb);
  for (int m = 0; m < 3; m++)
    wprep_matrix(p.w_branch + (size_t)(l * 3 + m) * 512 * 1024, p.wbt + (size_t)m * 1024 * 512, 512, 1024, 0, smem, vb, nvb);
  wprep_matrix(p.w_o + (size_t)l * 1024 * 1024, p.wot, 1024, 1024, 0, smem, vb, nvb);
  for (int w = 0; w < 2; w++) {
    wprep_matrix(p.cmp_w1 + (size_t)(l * 2 + w) * 2048 * 128, p.cw1t + (size_t)w * 128 * 2048, 2048, 128, 0, smem, vb, nvb);
    wprep_matrix(p.cmp_w2 + (size_t)(l * 2 + w) * 128 * 64, p.cw2t + (size_t)w * 64 * 128, 128, 64, 0, smem, vb, nvb);
  }
}

__device__ __forceinline__ void norm_phase(const float* __restrict__ x, const float* __restrict__ g, u16* __restrict__ H) {
  const int tidf = tid_fresh();
  const int lane = tidf & 63;
  const int gw = blockIdx.x * 8 + (tidf >> 6), nw = gridDim.x * 8;
  float4 gg[4];
#pragma unroll
  for (int i = 0; i < 4; i++) gg[i] = ((const float4*)g)[lane + 64 * i];
  for (int row0 = gw * 4; row0 < S; row0 += nw * 4) {
    float4 v[4][4]; float ss[4];
#pragma unroll
    for (int rr = 0; rr < 4; rr++)
#pragma unroll
      for (int i = 0; i < 4; i++) v[rr][i] = ((const float4*)(x + (size_t)(row0 + rr) * 1024))[lane + 64 * i];
#pragma unroll
    for (int rr = 0; rr < 4; rr++) {
      float a = 0.f;
#pragma unroll
      for (int i = 0; i < 4; i++) a += v[rr][i].x * v[rr][i].x + v[rr][i].y * v[rr][i].y + v[rr][i].z * v[rr][i].z + v[rr][i].w * v[rr][i].w;
      ss[rr] = a;
    }
#pragma unroll
    for (int o = 32; o >= 1; o >>= 1)
#pragma unroll
      for (int rr = 0; rr < 4; rr++) ss[rr] += __shfl_xor(ss[rr], o);
#pragma unroll
    for (int rr = 0; rr < 4; rr++) {
      const float r = rsqrtf(ss[rr] * (1.0f / 1024.0f) + EPS);
#pragma unroll
      for (int i = 0; i < 4; i++) {
        uint2 o2 = make_uint2(pack2(v[rr][i].x * r * gg[i].x, v[rr][i].y * r * gg[i].y), pack2(v[rr][i].z * r * gg[i].z, v[rr][i].w * r * gg[i].w));
        *(uint2*)(H + (size_t)(row0 + rr) * 1024 + (lane + 64 * i) * 4) = o2;
      }
    }
  }
}
__device__ __forceinline__ void final_norm_phase(float* __restrict__ x, const float* __restrict__ g) {
  const int tidf = tid_fresh();
  const int lane = tidf & 63;
  const int gw = blockIdx.x * 8 + (tidf >> 6), nw = gridDim.x * 8;
  float4 gg[4];
#pragma unroll
  for (int i = 0; i < 4; i++) gg[i] = ((const float4*)g)[lane + 64 * i];
  for (int row0 = gw * 4; row0 < S; row0 += nw * 4) {
    float4 v[4][4]; float ss[4];
#pragma unroll
    for (int rr = 0; rr < 4; rr++)
#pragma unroll
      for (int i = 0; i < 4; i++) v[rr][i] = ((const float4*)(x + (size_t)(row0 + rr) * 1024))[lane + 64 * i];
#pragma unroll
    for (int rr = 0; rr < 4; rr++) {
      float a = 0.f;
#pragma unroll
      for (int i = 0; i < 4; i++) a += v[rr][i].x * v[rr][i].x + v[rr][i].y * v[rr][i].y + v[rr][i].z * v[rr][i].z + v[rr][i].w * v[rr][i].w;
      ss[rr] = a;
    }
#pragma unroll
    for (int o = 32; o >= 1; o >>= 1)
#pragma unroll
      for (int rr = 0; rr < 4; rr++) ss[rr] += __shfl_xor(ss[rr], o);
#pragma unroll
    for (int rr = 0; rr < 4; rr++) {
      const float r = rsqrtf(ss[rr] * (1.0f / 1024.0f) + EPS);
#pragma unroll
      for (int i = 0; i < 4; i++)
        ((float4*)(x + (size_t)(row0 + rr) * 1024))[lane + 64 * i] = make_float4(v[rr][i].x * r * gg[i].x, v[rr][i].y * r * gg[i].y, v[rr][i].z * r * gg[i].z, v[rr][i].w * r * gg[i].w);
    }
  }
}

#define LAS __attribute__((address_space(3)))
constexpr int G_BK = 64, G_HALF = 128, G_HTB = G_HALF * G_BK * 2, G_NXCD = 8, G_WGM = 8;
__device__ __forceinline__ int lds_byte(int r, int c) { const int st = (r >> 4) * 2 + (c >> 5), rr = r & 15, cc = c & 31, ob = rr * 64 + cc * 2; return st * 1024 + (ob ^ (((ob >> 9) & 1) << 5)); }
__device__ __forceinline__ void stage_rc(int b, int& R, int& C) { const int st = b / 1024, sb = b % 1024, swz = sb ^ (((sb >> 9) & 1) << 5); R = (st >> 1) * 16 + swz / 64; C = (st & 1) * 32 + (swz % 64) / 2; }
__device__ __forceinline__ int perm32(int rho) { const int n = rho >> 4, i = rho & 15; return 8 * (i >> 2) + 4 * n + (i & 3); }
struct Unit { int pm, pn; };
struct Gemm { const u16* A; const u16* Bt; int lda, ldb, M, N, K; };
struct StaticOrder {
  int nM, nN, nwg, G, c;
  __device__ void init(int M, int N, int G_, int c_) { nM = M / 256; nN = N / 256; nwg = nM * nN; G = G_; c = c_; }
  __device__ bool next(int i, Unit& u) const {
    const long L = (long)i * G + c; if (L >= nwg) return false;
    int wgid = (int)L; { const int q = nwg / G_NXCD, r = nwg % G_NXCD, xcd = wgid % G_NXCD, off = wgid / G_NXCD; wgid = (xcd < r ? xcd * (q + 1) : r * (q + 1) + (xcd - r) * q) + off; }
    const int nig = G_WGM * nN, gid = wgid / nig, fm = gid * G_WGM, gsz = (nM - fm) < G_WGM ? (nM - fm) : G_WGM;
    u.pm = fm + ((wgid % nig) % gsz); u.pn = (wgid % nig) / gsz; return true;
  }
};
typedef f32x4 AccT[2][2][4][2];
struct EpiSwiglu {
  static constexpr bool PERM = false;
  u16* ACT;
  __device__ __forceinline__ void operator()(const AccT& acc, const Unit& u, int wr, int wc, int fr, int fq) const {
    const int row0 = u.pm * 256 + wr * 64 + fr, col0 = u.pn * 128 + wc * 16 + 4 * fq;
#pragma unroll
    for (int ai = 0; ai < 2; ++ai)
#pragma unroll
      for (int m = 0; m < 4; ++m) {
        u16* rowp = ACT + (size_t)(row0 + ai * 128 + m * 16) * FF + col0;
#pragma unroll
        for (int bj = 0; bj < 2; ++bj) {
          const f32x4 a = acc[ai][bj][m][0], b = acc[ai][bj][m][1];
          *(uint2*)(rowp + bj * 64) = make_uint2(pack2(silu_f(a[0]) * b[0], silu_f(a[1]) * b[1]), pack2(silu_f(a[2]) * b[2], silu_f(a[3]) * b[3]));
        }
      }
  }
};
struct EpiResid {
  static constexpr bool PERM = false;
  const float* xsrc; float* xdst; float scale;
  __device__ __forceinline__ void operator()(const AccT& acc, const Unit& u, int wr, int wc, int fr, int fq) const {
    const int row0 = u.pm * 256 + wr * 64 + fr, col0 = u.pn * 256 + wc * 32 + 4 * fq;
#pragma unroll
    for (int ai = 0; ai < 2; ++ai) {
      f32x4 xv[4][2][2];
#pragma unroll
      for (int m = 0; m < 4; ++m)
#pragma unroll
        for (int bj = 0; bj < 2; ++bj)
#pragma unroll
          for (int n = 0; n < 2; ++n)
            xv[m][bj][n] = *(const f32x4*)(xsrc + (size_t)(row0 + ai * 128 + m * 16) * 1024 + col0 + bj * 128 + n * 16);
#pragma unroll
      for (int m = 0; m < 4; ++m)
#pragma unroll
        for (int bj = 0; bj < 2; ++bj)
#pragma unroll
          for (int n = 0; n < 2; ++n)
            *(f32x4*)(xdst + (size_t)(row0 + ai * 128 + m * 16) * 1024 + col0 + bj * 128 + n * 16) = xv[m][bj][n] + scale * acc[ai][bj][m][n];
    }
  }
};
struct EpiProj {
  static constexpr bool PERM = true;
  u16* proj;
  __device__ __forceinline__ void operator()(const AccT& acc, const Unit& u, int wr, int wc, int fr, int fq) const {
    const int row0 = u.pm * 256 + wr * 64 + fr, col0 = u.pn * 256 + wc * 32 + 8 * fq;
#pragma unroll
    for (int ai = 0; ai < 2; ++ai)
#pragma unroll
      for (int m = 0; m < 4; ++m) {
        u16* rowp = proj + (size_t)(row0 + ai * 128 + m * 16) * PS;
#pragma unroll
        for (int bj = 0; bj < 2; ++bj) {
          const int col = col0 + bj * 128;
          const f32x4 a = acc[ai][bj][m][0], b = acc[ai][bj][m][1];
          if (col < DIN) *(uint4*)(rowp + col) = make_uint4(pack2(a[0], a[1]), pack2(a[2], a[3]), pack2(b[0], b[1]), pack2(b[2], b[3]));
        }
      }
  }
};
struct EpiGate {
  static constexpr bool PERM = true;
  u16* gst; const float* bias; int tid;
  __device__ __forceinline__ void operator()(const AccT& acc, const Unit& u, int wr, int wc, int fr, int fq) const {
    u16* st = gst + (size_t)(u.pm * 4 + u.pn) * 65536 + tid * 8;
    const int col0 = u.pn * 256 + wc * 32 + 8 * fq;
#pragma unroll
    for (int bj = 0; bj < 2; ++bj) {
      const f32x4 b0 = *(const f32x4*)(bias + col0 + bj * 128), b1 = *(const f32x4*)(bias + col0 + bj * 128 + 4);
#pragma unroll
      for (int ai = 0; ai < 2; ++ai)
#pragma unroll
        for (int m = 0; m < 4; ++m) {
          const f32x4 a = acc[ai][bj][m][0] + b0, b = acc[ai][bj][m][1] + b1;
          *(uint4*)(st + ((ai * 2 + bj) * 4 + m) * 4096) = make_uint4(pack2(sigm_f(a[0]), sigm_f(a[1])), pack2(sigm_f(a[2]), sigm_f(a[3])),
                                                                     pack2(sigm_f(b[0]), sigm_f(b[1])), pack2(sigm_f(b[2]), sigm_f(b[3])));
        }
    }
  }
};
struct EpiBranch {
  static constexpr bool PERM = true;
  const u16* gst; u16* mix; int first; int tid;
  __device__ __forceinline__ void operator()(const AccT& acc, const Unit& u, int wr, int wc, int fr, int fq) const {
    const u16* st = gst + (size_t)(u.pm * 4 + u.pn) * 65536 + tid * 8;
    const int row0 = u.pm * 256 + wr * 64 + fr, col0 = u.pn * 256 + wc * 32 + 8 * fq;
#pragma unroll
    for (int ai = 0; ai < 2; ++ai) {
      uint4 gw[4][2], ov[4][2];
#pragma unroll
      for (int m = 0; m < 4; ++m)
#pragma unroll
        for (int bj = 0; bj < 2; ++bj) {
          gw[m][bj] = *(const uint4*)(st + ((ai * 2 + bj) * 4 + m) * 4096);
          ov[m][bj] = first ? make_uint4(0u, 0u, 0u, 0u) : *(const uint4*)(mix + (size_t)(row0 + ai * 128 + m * 16) * PS + col0 + bj * 128);
        }
#pragma unroll
      for (int m = 0; m < 4; ++m)
#pragma unroll
        for (int bj = 0; bj < 2; ++bj) {
          const uint4 g = gw[m][bj], o = ov[m][bj];
          const f32x4 a = acc[ai][bj][m][0], b = acc[ai][bj][m][1];
          const float v0 = lo2f(g.x) * a[0] + lo2f(o.x), v1 = hi2f(g.x) * a[1] + hi2f(o.x), v2 = lo2f(g.y) * a[2] + lo2f(o.y), v3 = hi2f(g.y) * a[3] + hi2f(o.y);
          const float v4 = lo2f(g.z) * b[0] + lo2f(o.z), v5 = hi2f(g.z) * b[1] + hi2f(o.z), v6 = lo2f(g.w) * b[2] + lo2f(o.w), v7 = hi2f(g.w) * b[3] + hi2f(o.w);
          *(uint4*)(mix + (size_t)(row0 + ai * 128 + m * 16) * PS + col0 + bj * 128) = make_uint4(pack2(v0, v1), pack2(v2, v3), pack2(v4, v5), pack2(v6, v7));
        }
    }
  }
};

template <class Epi, bool AFTER_DRAIN = false>
__device__ __forceinline__ void gemm_phase(LAS unsigned char* lds, const Gemm g, const Epi& E) {
  const int tid = tid_fresh(), wid = __builtin_amdgcn_readfirstlane(tid >> 6), lane = tid & 63, wr = wid >> 2, wc = wid & 3, fr = lane & 15, fq = lane >> 4;
  const int K = g.K, nt = K / G_BK;
  StaticOrder S; S.init(g.M, g.N, (int)gridDim.x, (int)blockIdx.x);
  unsigned voffA[2], voffB[2];
#pragma unroll
  for (int i = 0; i < 2; ++i) { int R, C; stage_rc(tid * 16 + i * 8192, R, C); const int Rb = Epi::PERM ? ((R & ~31) + perm32(R & 31)) : R;
    voffA[i] = (unsigned)(R * g.lda + C) * 2u; voffB[i] = (unsigned)(Rb * g.ldb + C) * 2u; }
  const size_t kstep = (size_t)(G_BK * 2);
  const size_t hstepA = (size_t)G_HALF * g.lda * 2, hstepB = (size_t)G_HALF * g.ldb * 2;
  const size_t tstepA = 2 * hstepA, tstepB = 2 * hstepB;
  const unsigned ldsw = (unsigned)wid * 1024u;
  const int aoff = lds_byte(wr * 64 + fr, fq * 8), boff = lds_byte(wc * 32 + fr, fq * 8);
#define PG8_SA(b, h) (((b) * 2 + (h)) * G_HTB)
#define PG8_SB(b, h) ((4 + (b) * 2 + (h)) * G_HTB)
#define PG8_STAGE(bufoff, gbase, voff) do { _Pragma("unroll") for (int _i = 0; _i < 2; ++_i) \
    __builtin_amdgcn_global_load_lds((const unsigned*)((const char*)(gbase) + (voff)[_i]), (LAS unsigned*)(lds + (bufoff) + ldsw + _i * 8192), 16, 0, 0); } while (0)
#define PG8_LDA(dst, b, h) do { _Pragma("unroll") for (int m = 0; m < 4; ++m) _Pragma("unroll") for (int k = 0; k < 2; ++k) dst[m][k] = *(const LAS bf16x8*)(lds + PG8_SA(b, h) + aoff + m * 2048 + k * 1024); } while (0)
#define PG8_LDB(dst, b, h) do { _Pragma("unroll") for (int n = 0; n < 2; ++n) _Pragma("unroll") for (int k = 0; k < 2; ++k) dst[n][k] = *(const LAS bf16x8*)(lds + PG8_SB(b, h) + boff + n * 2048 + k * 1024); } while (0)
#define PG8_MMA(ai, bj, At, Bt) do { __builtin_amdgcn_s_setprio(1); _Pragma("unroll") for (int m = 0; m < 4; ++m) _Pragma("unroll") for (int n = 0; n < 2; ++n) _Pragma("unroll") for (int k = 0; k < 2; ++k) \
    acc[ai][bj][m][n] = __builtin_amdgcn_mfma_f32_16x16x32_bf16(Bt[n][k], At[m][k], acc[ai][bj][m][n], 0, 0, 0); __builtin_amdgcn_s_setprio(0); } while (0)
#define PG8_WAIT_V(n) asm volatile("s_waitcnt vmcnt(" #n ")" ::: "memory")
#define PG8_WAIT_L(n) asm volatile("s_waitcnt lgkmcnt(" #n ")" ::: "memory")
#define PG8_BAR __builtin_amdgcn_s_barrier()
#define PG8_SCHED __builtin_amdgcn_sched_barrier(0)
  Unit cur, nxt; int ui = 0;
  if (!S.next(0, cur)) return;
  AccT acc;
#pragma unroll
  for (int a = 0; a < 2; ++a)
#pragma unroll
    for (int b = 0; b < 2; ++b)
#pragma unroll
      for (int m = 0; m < 4; ++m)
#pragma unroll
        for (int n = 0; n < 2; ++n) acc[a][b][m][n] = (f32x4){0.f, 0.f, 0.f, 0.f};
  bf16x8 At[4][2], B0[2][2], B1[2][2];
  const char* cA = (const char*)g.A + (size_t)cur.pm * tstepA; const char* cB = (const char*)g.Bt + (size_t)cur.pn * tstepB;
  PG8_STAGE(PG8_SB(0, 0), cB, voffB); PG8_STAGE(PG8_SA(0, 0), cA, voffA); PG8_STAGE(PG8_SB(0, 1), cB + hstepB, voffB); PG8_STAGE(PG8_SA(0, 1), cA + hstepA, voffA);
  if (wr == 1) PG8_BAR;
  PG8_WAIT_V(4); PG8_BAR;
  PG8_STAGE(PG8_SB(1, 0), cB + kstep, voffB); PG8_STAGE(PG8_SA(1, 0), cA + kstep, voffA); PG8_STAGE(PG8_SB(1, 1), cB + hstepB + kstep, voffB);
  PG8_WAIT_V(6); PG8_BAR;
  for (;;) {
    const bool has_next = S.next(ui + 1, nxt);
    const char* nA = has_next ? (const char*)g.A + (size_t)nxt.pm * tstepA : cA; const char* nB = has_next ? (const char*)g.Bt + (size_t)nxt.pn * tstepB : cB;
    for (int t = 0; t < nt; t += 2) {
      const bool last = (t == nt - 2);
      const char* a1 = cA + (size_t)(t + 1) * kstep;
      const char* a2 = last ? nA : cA + (size_t)(t + 2) * kstep; const char* b2 = last ? nB : cB + (size_t)(t + 2) * kstep;
      const char* a3 = a2 + kstep; const char* b3 = b2 + kstep;
      PG8_LDB(B0, 0, 0); PG8_SCHED; PG8_LDA(At, 0, 0); PG8_STAGE(PG8_SA(1, 1), a1 + hstepA, voffA);
      PG8_WAIT_L(8); PG8_BAR; PG8_WAIT_L(0); PG8_MMA(0, 0, At, B0); PG8_BAR; PG8_SCHED;
      PG8_LDB(B1, 0, 1); PG8_STAGE(PG8_SB(0, 0), b2, voffB);
      PG8_BAR; PG8_WAIT_L(0); PG8_MMA(0, 1, At, B1); PG8_BAR;
      PG8_LDA(At, 0, 1); PG8_STAGE(PG8_SA(0, 0), a2, voffA);
      PG8_BAR; PG8_WAIT_L(0); PG8_MMA(1, 0, At, B0); PG8_BAR; PG8_SCHED;
      PG8_STAGE(PG8_SB(0, 1), b2 + hstepB, voffB);
      PG8_WAIT_V(6); PG8_BAR; PG8_MMA(1, 1, At, B1); PG8_BAR;
      PG8_LDB(B0, 1, 0); PG8_SCHED; PG8_LDA(At, 1, 0); PG8_STAGE(PG8_SA(0, 1), a2 + hstepA, voffA);
      PG8_WAIT_L(8); PG8_BAR; PG8_WAIT_L(0); PG8_MMA(0, 0, At, B0); PG8_BAR; PG8_SCHED;
      PG8_LDB(B1, 1, 1); PG8_STAGE(PG8_SB(1, 0), b3, voffB);
      PG8_BAR; PG8_WAIT_L(0); PG8_MMA(0, 1, At, B1); PG8_BAR;
      PG8_LDA(At, 1, 1); PG8_STAGE(PG8_SA(1, 0), a3, voffA);
      PG8_BAR; PG8_WAIT_L(0); PG8_MMA(1, 0, At, B0); PG8_BAR; PG8_SCHED;
      PG8_STAGE(PG8_SB(1, 1), b3 + hstepB, voffB);
      PG8_WAIT_V(6); PG8_BAR; PG8_MMA(1, 1, At, B1); PG8_BAR;
    }
    if constexpr (!AFTER_DRAIN) E(acc, cur, wr, wc, fr, fq);
    if (!has_next) break;
#pragma unroll
    for (int a = 0; a < 2; ++a)
#pragma unroll
      for (int b = 0; b < 2; ++b)
#pragma unroll
        for (int m = 0; m < 4; ++m)
#pragma unroll
          for (int n = 0; n < 2; ++n) acc[a][b][m][n] = (f32x4){0.f, 0.f, 0.f, 0.f};
    cur = nxt; cA = nA; cB = nB; ++ui;
  }
  PG8_WAIT_V(0);
  if (wr == 0) PG8_BAR;
  PG8_BAR;
  if constexpr (AFTER_DRAIN) E.fused(acc, cur, wr, wc, fr, fq, lds);
#undef PG8_SA
#undef PG8_SB
#undef PG8_STAGE
#undef PG8_LDA
#undef PG8_LDB
#undef PG8_MMA
#undef PG8_WAIT_V
#undef PG8_WAIT_L
#undef PG8_BAR
#undef PG8_SCHED
}

struct ChainStep { const char* A; const char* B; unsigned lda2, ldb2; int nt; };
__device__ __forceinline__ ChainStep merge_step(const Params& p, int q, const Unit& u) {
  const int s6 = q % 6, br = s6 >> 1;
  ChainStep c;
  if ((s6 & 1) == 0) {
    c.A = (const char*)(p.H + (size_t)u.pm * 256 * 1024); c.lda2 = 2048u;
    c.B = (const char*)(p.wgt + (size_t)(br * 1024 + u.pn * 256) * 1024); c.ldb2 = 2048u; c.nt = 16;
  } else {
    const int ycol = br == 0 ? C_U : (br == 1 ? C_RG : C_NQ);
    c.A = (const char*)(p.BIG + ycol + (size_t)u.pm * 256 * PS); c.lda2 = (unsigned)PS * 2u;
    c.B = (const char*)(p.wbt + (size_t)(br * 1024 + u.pn * 256) * 512); c.ldb2 = 1024u; c.nt = 8;
  }
  return c;
}
__device__ __forceinline__ void gemm_merge_chain(LAS unsigned char* lds, const Params& p, int l) {
  const int tid = tid_fresh(), wid = __builtin_amdgcn_readfirstlane(tid >> 6), lane = tid & 63, wr = wid >> 2, wc = wid & 3, fr = lane & 15, fq = lane >> 4;
  StaticOrder S; S.init(16384, 1024, (int)gridDim.x, (int)blockIdx.x);
  unsigned rA[2], c2[2];
#pragma unroll
  for (int i = 0; i < 2; ++i) { int R, C; stage_rc(tid * 16 + i * 8192, R, C); rA[i] = (unsigned)R; c2[i] = (unsigned)C * 2u; }
  const size_t kstep = (size_t)(G_BK * 2);
  const unsigned ldsw = (unsigned)wid * 1024u;
  const int aoff = lds_byte(wr * 64 + fr, fq * 8), boff = lds_byte(wc * 32 + fr, fq * 8);
#define PG8_SA(b, h) (((b) * 2 + (h)) * G_HTB)
#define PG8_SB(b, h) ((4 + (b) * 2 + (h)) * G_HTB)
#define CH_ROW_rA(i) (rA[i])
#define CH_ROW_rB(i) ((rA[i] & ~31u) + (unsigned)perm32((int)(rA[i] & 31u)))
#define CH_STAGE(bufoff, gbase, rr, ld2) do { _Pragma("unroll") for (int _i = 0; _i < 2; ++_i) \
    __builtin_amdgcn_global_load_lds((const unsigned*)((const char*)(gbase) + (CH_ROW_##rr(_i) * (ld2) + c2[_i])), (LAS unsigned*)(lds + (bufoff) + ldsw + _i * 8192), 16, 0, 0); } while (0)
#define PG8_LDA(dst, b, h) do { _Pragma("unroll") for (int m = 0; m < 4; ++m) _Pragma("unroll") for (int k = 0; k < 2; ++k) dst[m][k] = *(const LAS bf16x8*)(lds + PG8_SA(b, h) + aoff + m * 2048 + k * 1024); } while (0)
#define PG8_LDB(dst, b, h) do { _Pragma("unroll") for (int n = 0; n < 2; ++n) _Pragma("unroll") for (int k = 0; k < 2; ++k) dst[n][k] = *(const LAS bf16x8*)(lds + PG8_SB(b, h) + boff + n * 2048 + k * 1024); } while (0)
#define PG8_MMA(ai, bj, At, Bt) do { __builtin_amdgcn_s_setprio(1); _Pragma("unroll") for (int m = 0; m < 4; ++m) _Pragma("unroll") for (int n = 0; n < 2; ++n) _Pragma("unroll") for (int k = 0; k < 2; ++k) \
    acc[ai][bj][m][n] = __builtin_amdgcn_mfma_f32_16x16x32_bf16(Bt[n][k], At[m][k], acc[ai][bj][m][n], 0, 0, 0); __builtin_amdgcn_s_setprio(0); } while (0)
#define PG8_WAIT_V(n) asm volatile("s_waitcnt vmcnt(" #n ")" ::: "memory")
#define PG8_WAIT_L(n) asm volatile("s_waitcnt lgkmcnt(" #n ")" ::: "memory")
#define PG8_BAR __builtin_amdgcn_s_barrier()
#define PG8_SCHED __builtin_amdgcn_sched_barrier(0)
  Unit cu, nu; int q = 0;
  if (!S.next(0, cu)) return;
  ChainStep cs = merge_step(p, 0, cu), ns;
  AccT acc;
#pragma unroll
  for (int a = 0; a < 2; ++a)
#pragma unroll
    for (int b = 0; b < 2; ++b)
#pragma unroll
      for (int m = 0; m < 4; ++m)
#pragma unroll
        for (int n = 0; n < 2; ++n) acc[a][b][m][n] = (f32x4){0.f, 0.f, 0.f, 0.f};
  bf16x8 At[4][2], B0[2][2], B1[2][2];
  {
    const size_t hA = (size_t)G_HALF * cs.lda2, hB = (size_t)G_HALF * cs.ldb2;
    CH_STAGE(PG8_SB(0, 0), cs.B, rB, cs.ldb2); CH_STAGE(PG8_SA(0, 0), cs.A, rA, cs.lda2); CH_STAGE(PG8_SB(0, 1), cs.B + hB, rB, cs.ldb2); CH_STAGE(PG8_SA(0, 1), cs.A + hA, rA, cs.lda2);
    if (wr == 1) PG8_BAR;
    PG8_WAIT_V(4); PG8_BAR;
    CH_STAGE(PG8_SB(1, 0), cs.B + kstep, rB, cs.ldb2); CH_STAGE(PG8_SA(1, 0), cs.A + kstep, rA, cs.lda2); CH_STAGE(PG8_SB(1, 1), cs.B + hB + kstep, rB, cs.ldb2);
    PG8_WAIT_V(6); PG8_BAR;
  }
  for (;;) {
    bool has_next;
    if ((q + 1) % 6 != 0) { nu = cu; has_next = true; } else has_next = S.next((q + 1) / 6, nu);
    ns = has_next ? merge_step(p, q + 1, nu) : cs;
    const size_t hA = (size_t)G_HALF * cs.lda2, hB = (size_t)G_HALF * cs.ldb2;
    const size_t nhA = (size_t)G_HALF * ns.lda2, nhB = (size_t)G_HALF * ns.ldb2;
    const int nt = cs.nt;
    for (int t = 0; t < nt; t += 2) {
      const bool last = (t == nt - 2);
      const char* a1 = cs.A + (size_t)(t + 1) * kstep;
      const char* a2 = last ? ns.A : cs.A + (size_t)(t + 2) * kstep; const char* b2 = last ? ns.B : cs.B + (size_t)(t + 2) * kstep;
      const char* a3 = a2 + kstep; const char* b3 = b2 + kstep;
      const unsigned la2 = last ? ns.lda2 : cs.lda2, lb2 = last ? ns.ldb2 : cs.ldb2;
      const size_t hA2 = last ? nhA : hA, hB2 = last ? nhB : hB;
      PG8_LDB(B0, 0, 0); PG8_SCHED; PG8_LDA(At, 0, 0); CH_STAGE(PG8_SA(1, 1), a1 + hA, rA, cs.lda2);
      PG8_WAIT_L(8); PG8_BAR; PG8_WAIT_L(0); PG8_MMA(0, 0, At, B0); PG8_BAR; PG8_SCHED;
      PG8_LDB(B1, 0, 1); CH_STAGE(PG8_SB(0, 0), b2, rB, lb2);
      PG8_BAR; PG8_WAIT_L(0); PG8_MMA(0, 1, At, B1); PG8_BAR;
      PG8_LDA(At, 0, 1); CH_STAGE(PG8_SA(0, 0), a2, rA, la2);
      PG8_BAR; PG8_WAIT_L(0); PG8_MMA(1, 0, At, B0); PG8_BAR; PG8_SCHED;
      CH_STAGE(PG8_SB(0, 1), b2 + hB2, rB, lb2);
      PG8_WAIT_V(6); PG8_BAR; PG8_MMA(1, 1, At, B1); PG8_BAR;
      PG8_LDB(B0, 1, 0); PG8_SCHED; PG8_LDA(At, 1, 0); CH_STAGE(PG8_SA(0, 1), a2 + hA2, rA, la2);
      PG8_WAIT_L(8); PG8_BAR; PG8_WAIT_L(0); PG8_MMA(0, 0, At, B0); PG8_BAR; PG8_SCHED;
      PG8_LDB(B1, 1, 1); CH_STAGE(PG8_SB(1, 0), b3, rB, lb2);
      PG8_BAR; PG8_WAIT_L(0); PG8_MMA(0, 1, At, B1); PG8_BAR;
      PG8_LDA(At, 1, 1); CH_STAGE(PG8_SA(1, 0), a3, rA, la2);
      PG8_BAR; PG8_WAIT_L(0); PG8_MMA(1, 0, At, B0); PG8_BAR; PG8_SCHED;
      CH_STAGE(PG8_SB(1, 1), b3 + hB2, rB, lb2);
      PG8_WAIT_V(6); PG8_BAR; PG8_MMA(1, 1, At, B1); PG8_BAR;
    }
    {
      const int s6 = q % 6, br = s6 >> 1;
      if ((s6 & 1) == 0) { EpiGate e{p.gst, p.b_gate + (size_t)l * 3072 + br * 1024, tid}; e(acc, cu, wr, wc, fr, fq); }
      else { EpiBranch e{p.gst, p.BIG + C_MIX, br == 0, tid}; e(acc, cu, wr, wc, fr, fq); }
    }
    if (!has_next) break;
#pragma unroll
    for (int a = 0; a < 2; ++a)
#pragma unroll
      for (int b = 0; b < 2; ++b)
#pragma unroll
        for (int m = 0; m < 4; ++m)
#pragma unroll
          for (int n = 0; n < 2; ++n) acc[a][b][m][n] = (f32x4){0.f, 0.f, 0.f, 0.f};
    cu = nu; cs = ns; ++q;
  }
  PG8_WAIT_V(0);
  if (wr == 0) PG8_BAR;
  PG8_BAR;
#undef PG8_SA
#undef PG8_SB
#undef CH_STAGE
#undef CH_ROW_rA
#undef CH_ROW_rB
#undef PG8_LDA
#undef PG8_LDB
#undef PG8_MMA
#undef PG8_WAIT_V
#undef PG8_WAIT_L
#undef PG8_BAR
#undef PG8_SCHED
}

__device__ __forceinline__ void gmlp_tile(const Params& p, int l, int tile, u16* smem) {
  const int c = tile >> 2, g = tile & 3, t0 = c * 128;
  u16* Ws = smem; u16* vT = smem + 128 * 136;
  const int tid = tid_fresh() & 255, lane = tid & 63, wave = tid >> 6, wm = wave >> 1, wn = wave & 1, lr = lane & 15, lq = lane >> 4;
  const int tok = tid >> 1, half = tid & 1;
  u16* prow = p.BIG + (size_t)(t0 + tok) * PS;
  float s = 0.f, ss = 0.f;
#pragma unroll 8
  for (int i = 0; i < 32; i++) {
    uint4 raw = *(const uint4*)(prow + C_V + half * 256 + i * 8);
    u32 w[4] = {raw.x, raw.y, raw.z, raw.w};
#pragma unroll
    for (int e = 0; e < 4; e++) { float a = gelu_t(lo2f(w[e])), b = gelu_t(hi2f(w[e])); s += a + b; ss += a * a + b * b; }
  }
  s += __shfl_xor(s, 1); ss += __shfl_xor(ss, 1);
  const float mean = s * (1.0f / 512.0f);
  const float rstd = rsqrtf(fmaxf(ss * (1.0f / 512.0f) - mean * mean, 0.f) + EPS);
  const float* lg = p.gm_ln_g + l * 512 + g * 128; const float* lb = p.gm_ln_b + l * 512 + g * 128;
#pragma unroll
  for (int i = 0; i < 8; i++) {
    uint4 raw = *(const uint4*)(prow + C_V + g * 128 + half * 64 + i * 8);
    u32 w[4] = {raw.x, raw.y, raw.z, raw.w};
#pragma unroll
    for (int e = 0; e < 4; e++) {
      int cc = half * 64 + i * 8 + 2 * e;
      vT[cc * 136 + tok] = f2bf((gelu_t(lo2f(w[e])) - mean) * rstd * lg[cc] + lb[cc]);
      vT[(cc + 1) * 136 + tok] = f2bf((gelu_t(hi2f(w[e])) - mean) * rstd * lg[cc + 1] + lb[cc + 1]);
    }
  }
  const float* wrow = p.gm_ws + ((size_t)(l * 4 + g) * 128 + tok) * 128 + half * 64;
#pragma unroll
  for (int i = 0; i < 16; i++) {
    float4 w = ((const float4*)wrow)[i];
    int s0 = half * 64 + i * 4;
    uint2 o = make_uint2(pack2(s0 <= tok ? w.x : 0.f, s0 + 1 <= tok ? w.y : 0.f), pack2(s0 + 2 <= tok ? w.z : 0.f, s0 + 3 <= tok ? w.w : 0.f));
    *(uint2*)(Ws + tok * 136 + s0) = o;
  }
  __syncthreads();
  f32x4 acc[4][4];
#pragma unroll
  for (int m = 0; m < 4; m++)
#pragma unroll
    for (int n = 0; n < 4; n++) acc[m][n] = (f32x4){0.f, 0.f, 0.f, 0.f};
#pragma unroll
  for (int kk = 0; kk < 4; kk++) {
    bf16x8 a[4], b[4];
#pragma unroll
    for (int m = 0; m < 4; m++) a[m] = ld8(Ws + (wm * 64 + m * 16 + lr) * 136 + kk * 32 + lq * 8);
#pragma unroll
    for (int n = 0; n < 4; n++) b[n] = ld8(vT + (wn * 64 + n * 16 + lr) * 136 + kk * 32 + lq * 8);
#pragma unroll
    for (int m = 0; m < 4; m++)
#pragma unroll
      for (int n = 0; n < 4; n++) acc[m][n] = mfma16(b[n], a[m], acc[m][n]);
  }
  const float* bsp = p.gm_bs + (size_t)(l * 4 + g) * 128;
  uint2 uv[4][4];
#pragma unroll
  for (int m = 0; m < 4; m++)
#pragma unroll
    for (int n = 0; n < 4; n++)
      uv[m][n] = *(const uint2*)(p.BIG + (size_t)(t0 + wm * 64 + m * 16 + lr) * PS + C_U + g * 128 + wn * 64 + n * 16 + lq * 4);
#pragma unroll
  for (int m = 0; m < 4; m++) {
    const float bias = bsp[wm * 64 + m * 16 + lr];
#pragma unroll
    for (int n = 0; n < 4; n++) {
      const uint2 u = uv[m][n];
      *(uint2*)(p.BIG + (size_t)(t0 + wm * 64 + m * 16 + lr) * PS + C_U + g * 128 + wn * 64 + n * 16 + lq * 4) =
          make_uint2(pack2(gelu_t(lo2f(u.x)) * (acc[m][n][0] + bias), gelu_t(hi2f(u.x)) * (acc[m][n][1] + bias)),
                     pack2(gelu_t(lo2f(u.y)) * (acc[m][n][2] + bias), gelu_t(hi2f(u.y)) * (acc[m][n][3] + bias)));
    }
  }
  __syncthreads();
}

__device__ __forceinline__ void ret_kv_tile(const Params& p, int tile, u16* smem) {
  const int c = tile >> 2, h = tile & 3, t0 = c * 128;
  u16* vT = smem; u16* kT = smem + 128 * 136;
  const int tid = tid_fresh() & 255, lane = tid & 63, wave = tid >> 6, lr = lane & 15, lq = lane >> 4;
  const int tok = tid >> 1, half = tid & 1;
  const float lg = logf(1.0f - exp2f(-5.0f - (float)h));
  const u16* prow = p.BIG + (size_t)(t0 + tok) * PS;
#pragma unroll
  for (int i = 0; i < 8; i++) {
    uint4 raw = *(const uint4*)(prow + C_RV + h * 128 + half * 64 + i * 8);
    u32 w[4] = {raw.x, raw.y, raw.z, raw.w};
#pragma unroll
    for (int e = 0; e < 4; e++) {
      int cc = half * 64 + i * 8 + 2 * e;
      vT[cc * 136 + tok] = (u16)(w[e] & 0xffff);
      vT[(cc + 1) * 136 + tok] = (u16)(w[e] >> 16);
    }
  }
  const float sc = 0.125f * expf(lg * (float)(127 - tok));
#pragma unroll
  for (int i = 0; i < 4; i++) {
    uint4 raw = *(const uint4*)(prow + C_RK + h * 64 + half * 32 + i * 8);
    u32 w[4] = {raw.x, raw.y, raw.z, raw.w};
#pragma unroll
    for (int e = 0; e < 4; e++) {
      int cc = half * 32 + i * 8 + 2 * e;
      kT[cc * 136 + tok] = f2bf(lo2f(w[e]) * sc);
      kT[(cc + 1) * 136 + tok] = f2bf(hi2f(w[e]) * sc);
    }
  }
  __syncthreads();
  f32x4 acc[2][4];
#pragma unroll
  for (int m = 0; m < 2; m++)
#pragma unroll
    for (int n = 0; n < 4; n++) acc[m][n] = (f32x4){0.f, 0.f, 0.f, 0.f};
#pragma unroll
  for (int kk = 0; kk < 4; kk++) {
    bf16x8 a[2], b[4];
#pragma unroll
    for (int m = 0; m < 2; m++) a[m] = ld8(vT + (wave * 32 + m * 16 + lr) * 136 + kk * 32 + lq * 8);
#pragma unroll
    for (int n = 0; n < 4; n++) b[n] = ld8(kT + (n * 16 + lr) * 136 + kk * 32 + lq * 8);
#pragma unroll
    for (int m = 0; m < 2; m++)
#pragma unroll
      for (int n = 0; n < 4; n++) acc[m][n] = mfma16(a[m], b[n], acc[m][n]);
  }
  float* rp = p.ret + (size_t)(c * 4 + h) * 8192;
#pragma unroll
  for (int m = 0; m < 2; m++)
#pragma unroll
    for (int n = 0; n < 4; n++)
#pragma unroll
      for (int j = 0; j < 4; j++) rp[(wave * 32 + m * 16 + lq * 4 + j) * 64 + n * 16 + lr] = acc[m][n][j];
  __syncthreads();
}
__device__ __forceinline__ void ret_scan_wg(const Params& p, unsigned char* sm) {
  const int tid = tid_fresh(), seg = tid >> 7, el = tid & 127;
  float* endv = (float*)sm;
  for (int e0 = blockIdx.x * 128; e0 < 32768; e0 += gridDim.x * 128) {
    const int h = e0 >> 13;
    const float cd = expf(logf(1.0f - exp2f(-5.0f - (float)h)) * 128.0f);
    const float cd2 = cd * cd, cd4 = cd2 * cd2, cd8 = cd4 * cd4, cd16 = cd8 * cd8, cd32 = cd16 * cd16;
    float* base = p.ret + (size_t)(seg * 32) * 32768 + e0 + el;
    float v[32];
#pragma unroll
    for (int i = 0; i < 32; i++) v[i] = base[(size_t)i * 32768];
    float st = 0.f;
#pragma unroll
    for (int i = 0; i < 32; i++) st = st * cd + v[i];
    endv[seg * 128 + el] = st;
    __syncthreads();
    float carry = 0.f;
    for (int s2 = 0; s2 < seg; s2++) carry = carry * cd32 + endv[s2 * 128 + el];
    __syncthreads();
    st = carry;
#pragma unroll
    for (int i = 0; i < 32; i++) { base[(size_t)i * 32768] = st; st = st * cd + v[i]; }
  }
}
__device__ __forceinline__ void ret_out_tile(const Params& p, int l, int tile, u16* smem) {
  const int c = tile >> 2, h = tile & 3, t0 = c * 128;
  u16* vT = smem;
  u16* kS = smem + 128 * 136;
  u16* pT = kS + 128 * 72;
  const int tid = tid_fresh() & 255, lane = tid & 63, wave = tid >> 6, lr = lane & 15, lq = lane >> 4;
  const int tok = tid >> 1, half = tid & 1;
  const float lg = logf(1.0f - exp2f(-5.0f - (float)h));
  {
    const u16* prow = p.BIG + (size_t)(t0 + tok) * PS;
#pragma unroll
    for (int i = 0; i < 8; i++) {
      uint4 raw = *(const uint4*)(prow + C_RV + h * 128 + half * 64 + i * 8);
      u32 w[4] = {raw.x, raw.y, raw.z, raw.w};
#pragma unroll
      for (int e = 0; e < 4; e++) {
        int cc = half * 64 + i * 8 + 2 * e;
        vT[cc * 136 + tok] = (u16)(w[e] & 0xffff);
        vT[(cc + 1) * 136 + tok] = (u16)(w[e] >> 16);
      }
    }
#pragma unroll
    for (int i = 0; i < 4; i++)
      *(uint4*)(kS + tok * 72 + half * 32 + i * 8) = *(const uint4*)(prow + C_RK + h * 64 + half * 32 + i * 8);
    const float* rp = p.ret + (size_t)(c * 4 + h) * 8192 + tok * 64 + half * 32;
#pragma unroll
    for (int i = 0; i < 4; i++) {
      float4 a = ((const float4*)rp)[2 * i], b = ((const float4*)rp)[2 * i + 1];
      *(uint4*)(pT + tok * 72 + half * 32 + i * 8) = make_uint4(pack2(a.x, a.y), pack2(a.z, a.w), pack2(b.x, b.y), pack2(b.z, b.w));
    }
  }
  __syncthreads();
#pragma unroll 1
  for (int it = 0; it < 2; it++) {
    const int i = wave * 32 + it * 16 + lr;
    const u16* qp = p.BIG + (size_t)(t0 + i) * PS + C_RQ + h * 64 + lq * 8;
    const bf16x8 q_lo = ld8(qp), q_hi = ld8(qp + 32);
    f32x4 Y[8];
#pragma unroll
    for (int e = 0; e < 8; e++) Y[e] = (f32x4){0.f, 0.f, 0.f, 0.f};
    const int nch = ((wave * 32 + it * 16 + 15) >> 5) + 1;
    for (int jc = 0; jc < nch; jc++) {
      f32x4 s0 = (f32x4){0.f, 0.f, 0.f, 0.f}, s1 = s0;
      const u16* kp = kS + (jc * 32 + lr) * 72 + lq * 8;
      s0 = mfma16(ld8(kp), q_lo, s0); s0 = mfma16(ld8(kp + 32), q_hi, s0);
      s1 = mfma16(ld8(kp + 16 * 72), q_lo, s1); s1 = mfma16(ld8(kp + 16 * 72 + 32), q_hi, s1);
      float pv[8];
#pragma unroll
      for (int j = 0; j < 4; j++) {
        int d0 = i - (jc * 32 + lq * 4 + j), d1 = d0 - 16;
        pv[j] = d0 >= 0 ? s0[j] * 0.125f * __expf(lg * (float)d0) : 0.f;
        pv[4 + j] = d1 >= 0 ? s1[j] * 0.125f * __expf(lg * (float)d1) : 0.f;
      }
      const bf16x8 pb = pk8(pv[0], pv[1], pv[2], pv[3], pv[4], pv[5], pv[6], pv[7]);
#pragma unroll
      for (int e = 0; e < 8; e++) {
        const u16* vp = vT + (e * 16 + lr) * 136 + jc * 32 + lq * 4;
        Y[e] = mfma16(ld44(vp, vp + 16), pb, Y[e]);
      }
    }
    {
      const float qd = __expf(lg * (float)(i + 1));
      const bf16x8 ql = scale8(q_lo, qd), qh = scale8(q_hi, qd);
#pragma unroll
      for (int e = 0; e < 8; e++) {
        const u16* pp = pT + (e * 16 + lr) * 72 + lq * 8;
        Y[e] = mfma16(ld8(pp), ql, Y[e]);
        Y[e] = mfma16(ld8(pp + 32), qh, Y[e]);
      }
    }
    float s = 0.f, ss = 0.f;
#pragma unroll
    for (int e = 0; e < 8; e++)
#pragma unroll
      for (int j = 0; j < 4; j++) { s += Y[e][j]; ss += Y[e][j] * Y[e][j]; }
    s += __shfl_xor(s, 16); ss += __shfl_xor(ss, 16);
    s += __shfl_xor(s, 32); ss += __shfl_xor(ss, 32);
    const float mean = s * (1.0f / 128.0f);
    const float rstd = rsqrtf(fmaxf(ss * (1.0f / 128.0f) - mean * mean, 0.f) + EPS);
    u16* gp = p.BIG + (size_t)(t0 + i) * PS + C_RG + h * 128;
    const float* gg = p.ret_gn_g + l * 512 + h * 128; const float* gb = p.ret_gn_b + l * 512 + h * 128;
    uint2 grawv[8];
#pragma unroll
    for (int e = 0; e < 8; e++) grawv[e] = *(const uint2*)(gp + e * 16 + lq * 4);
#pragma unroll
    for (int e = 0; e < 8; e++) {
      const int e0 = e * 16 + lq * 4;
      const uint2 graw = grawv[e];
      float4 g4 = *(const float4*)(gg + e0), b4 = *(const float4*)(gb + e0);
      float y0 = (Y[e][0] - mean) * rstd * g4.x + b4.x, y1 = (Y[e][1] - mean) * rstd * g4.y + b4.y;
      float y2 = (Y[e][2] - mean) * rstd * g4.z + b4.z, y3 = (Y[e][3] - mean) * rstd * g4.w + b4.w;
      *(uint2*)(gp + e0) = make_uint2(pack2(silu_f(lo2f(graw.x)) * y0, silu_f(hi2f(graw.x)) * y1),
                                      pack2(silu_f(lo2f(graw.y)) * y2, silu_f(hi2f(graw.y)) * y3));
    }
  }
  __syncthreads();
}

__device__ __forceinline__ void cmp_tile(const Params& p, int l, int tile, u16* smem) {
  const int which = tile >> 6, g = (tile >> 5) & 1, ci0 = (tile & 31) * 32;
  const int tid = tid_fresh() & 255, lane = tid & 63, wave = tid >> 6, lr = lane & 15, lq = lane >> 4;
  float* part = (float*)smem;
  u16* hid = smem + 32768;
  const int colbase = (which ? C_VC : C_KC) + g * 64;
  const float* pos = p.cmp_pos + (size_t)(l * 2 + which) * 32 * 64;
  const u16* w1t = p.cw1t + (size_t)which * 128 * 2048;
  f32x4 acc[2][8];
#pragma unroll
  for (int m = 0; m < 2; m++)
#pragma unroll
    for (int n = 0; n < 8; n++) acc[m][n] = (f32x4){0.f, 0.f, 0.f, 0.f};
  int cir0 = ci0 + lr, cir1 = ci0 + 16 + lr;
  if (cir0 > 1022) cir0 = 1022;
  if (cir1 > 1022) cir1 = 1022;
#pragma unroll 4
  for (int ks = 0; ks < 16; ks++) {
    const int kk = wave * 512 + ks * 32 + lq * 8, toff = kk >> 6, dim = kk & 63;
    const float4 p0 = *(const float4*)(pos + toff * 64 + dim), p1 = *(const float4*)(pos + toff * 64 + dim + 4);
    bf16x8 a[2], b[8];
#pragma unroll
    for (int m = 0; m < 2; m++) {
      const int cr = m == 0 ? cir0 : cir1;
      uint4 raw = *(const uint4*)(p.BIG + (size_t)(cr * 16 + toff) * PS + colbase + dim);
      a[m] = pk8(lo2f(raw.x) + p0.x, hi2f(raw.x) + p0.y, lo2f(raw.y) + p0.z, hi2f(raw.y) + p0.w,
                 lo2f(raw.z) + p1.x, hi2f(raw.z) + p1.y, lo2f(raw.w) + p1.z, hi2f(raw.w) + p1.w);
    }
#pragma unroll
    for (int n = 0; n < 8; n++) b[n] = ld8(w1t + (size_t)(n * 16 + lr) * 2048 + kk);
#pragma unroll
    for (int m = 0; m < 2; m++)
#pragma unroll
      for (int n = 0; n < 8; n++) acc[m][n] = mfma16(a[m], b[n], acc[m][n]);
  }
#pragma unroll
  for (int m = 0; m < 2; m++)
#pragma unroll
    for (int n = 0; n < 8; n++)
#pragma unroll
      for (int j = 0; j < 4; j++) part[wave * 4096 + (m * 16 + lq * 4 + j) * 128 + n * 16 + lr] = acc[m][n][j];
  __syncthreads();
  for (int e = tid; e < 4096; e += 256) {
    const float v = part[e] + part[4096 + e] + part[8192 + e] + part[12288 + e];
    hid[e] = f2bf(gelu_t(v));
  }
  __syncthreads();
  f32x4 o[2] = {(f32x4){0.f, 0.f, 0.f, 0.f}, (f32x4){0.f, 0.f, 0.f, 0.f}};
  const u16* w2t = p.cw2t + (size_t)which * 64 * 128;
#pragma unroll
  for (int kk = 0; kk < 4; kk++) {
    bf16x8 bb = ld8(w2t + (wave * 16 + lr) * 128 + kk * 32 + lq * 8);
#pragma unroll
    for (int m = 0; m < 2; m++) o[m] = mfma16(ld8(hid + (m * 16 + lr) * 128 + kk * 32 + lq * 8), bb, o[m]);
  }
#pragma unroll
  for (int m = 0; m < 2; m++)
#pragma unroll
    for (int j = 0; j < 4; j++) {
      int ci = ci0 + m * 16 + lq * 4 + j, d = wave * 16 + lr;
      u16 v = ci < 1023 ? f2bf(o[m][j]) : (u16)0;
      if (which == 0) p.kc[(size_t)(g * 1024 + ci) * 64 + d] = v;
      else p.vcT[(size_t)(g * 64 + d) * 1024 + ci] = v;
    }
  __syncthreads();
}
__device__ __forceinline__ void vt_tile(const Params& p, int tile, u16* smem) {
  const int sw = tile >> 9, g = (tile >> 8) & 1, t0 = (tile & 255) * 64;
  const int tid = tid_fresh() & 255;
  u16* T = smem;
  const int col = (sw ? C_VW : C_VS) + g * 64;
  {
    const int tok = tid >> 2, dq = (tid & 3) * 16;
    const u16* src = p.BIG + (size_t)(t0 + tok) * PS + col + dq;
    uint4 r0 = *(const uint4*)src, r1 = *(const uint4*)(src + 8);
    u32 w[8] = {r0.x, r0.y, r0.z, r0.w, r1.x, r1.y, r1.z, r1.w};
#pragma unroll
    for (int e = 0; e < 8; e++) { T[(dq + 2 * e) * 72 + tok] = (u16)(w[e] & 0xffff); T[(dq + 2 * e + 1) * 72 + tok] = (u16)(w[e] >> 16); }
  }
  __syncthreads();
  {
    const int d = tid >> 2, tq = (tid & 3) * 16;
    u16* dst = (sw ? p.vwT : p.vsT) + (size_t)(g * 64 + d) * S + t0 + tq;
    *(uint4*)dst = *(const uint4*)(T + d * 72 + tq);
    *(uint4*)(dst + 8) = *(const uint4*)(T + d * 72 + tq + 8);
  }
  __syncthreads();
}

constexpr int NT_ST = 72;
constexpr int NT_EL = 64 * NT_ST;
__device__ __forceinline__ float quad_sum(float x) {
  x += __uint_as_float((u32)__builtin_amdgcn_mov_dpp((int)__float_as_uint(x), 0xB1, 0xF, 0xF, true));
  x += __uint_as_float((u32)__builtin_amdgcn_mov_dpp((int)__float_as_uint(x), 0x4E, 0xF, 0xF, true));
  return x;
}
__device__ __forceinline__ void qk64(const u16* kt, int lr, int lq, bf16x8 q_lo, bf16x8 q_hi, f32x4 (&s)[2][2]) {
#pragma unroll
  for (int c = 0; c < 2; c++)
#pragma unroll
    for (int t = 0; t < 2; t++) {
      const u16* kp = kt + (c * 32 + t * 16 + lr) * NT_ST + lq * 8;
      f32x4 a = s[c][t];
      a = mfma16(ld8(kp), q_lo, a); a = mfma16(ld8(kp + 32), q_hi, a);
      s[c][t] = a;
    }
}
__device__ __forceinline__ float ex2(float x) { return __builtin_amdgcn_exp2f(x); }
template <bool FAST>
__device__ __forceinline__ void attend_tile(const u16* kt, const u16* vt, int lr, int lq, bf16x8 q_lo, bf16x8 q_hi, float slope2, int dbase,
                                            bool rowsel, int win, float& m, float& lsum, f32x4 (&O)[4]) {
  f32x4 s[2][2];
  float sv[16];
  float mx = -1e30f;
  if (FAST) {
    const float binit = rowsel ? -slope2 * (float)(dbase - lq * 4) : -1e30f;
#pragma unroll
    for (int c = 0; c < 2; c++)
#pragma unroll
      for (int t = 0; t < 2; t++)
#pragma unroll
        for (int j = 0; j < 4; j++) s[c][t][j] = __builtin_fmaf(slope2, (float)(c * 32 + t * 16 + j), binit);
    qk64(kt, lr, lq, q_lo, q_hi, s);
#pragma unroll
    for (int c = 0; c < 2; c++)
#pragma unroll
      for (int t = 0; t < 2; t++)
#pragma unroll
        for (int j = 0; j < 4; j++) { sv[(c * 2 + t) * 4 + j] = s[c][t][j]; mx = fmaxf(mx, s[c][t][j]); }
  } else {
#pragma unroll
    for (int c = 0; c < 2; c++)
#pragma unroll
      for (int t = 0; t < 2; t++) s[c][t] = (f32x4){0.f, 0.f, 0.f, 0.f};
    qk64(kt, lr, lq, q_lo, q_hi, s);
#pragma unroll
    for (int c = 0; c < 2; c++)
#pragma unroll
      for (int t = 0; t < 2; t++)
#pragma unroll
        for (int j = 0; j < 4; j++) {
          const int d = dbase - (c * 32 + t * 16 + lq * 4 + j);
          const bool o = rowsel && d >= 0 && d < win;
          const float v = o ? s[c][t][j] - slope2 * (float)d : -1e30f;
          sv[(c * 2 + t) * 4 + j] = v;
          mx = fmaxf(mx, v);
        }
  }
  if (__any(mx > m)) {
    mx = fmaxf(mx, __shfl_xor(mx, 16)); mx = fmaxf(mx, __shfl_xor(mx, 32));
    const float mnew = fmaxf(m, mx);
    const float alpha = ex2(m - mnew);
    m = mnew;
    lsum *= alpha;
#pragma unroll
    for (int dt = 0; dt < 4; dt++)
#pragma unroll
      for (int j = 0; j < 4; j++) O[dt][j] *= alpha;
  }
  const float mn = m;
  float ps = 0.f;
  bf16x8 pb[2];
#pragma unroll
  for (int c = 0; c < 2; c++) {
    float pv[8];
#pragma unroll
    for (int j = 0; j < 8; j++) {
      const float v = sv[c * 8 + j];
      pv[j] = FAST ? ex2(v - mn) : (v > -1e29f ? ex2(v - mn) : 0.f);
      ps += pv[j];
    }
    pb[c] = pk8(pv[0], pv[1], pv[2], pv[3], pv[4], pv[5], pv[6], pv[7]);
  }
  lsum += ps;
#pragma unroll
  for (int dt = 0; dt < 4; dt++)
#pragma unroll
    for (int c = 0; c < 2; c++) {
      const u16* vp = vt + (dt * 16 + lr) * NT_ST + c * 32 + lq * 4;
      O[dt] = mfma16(ld44(vp, vp + 16), pb[c], O[dt]);
    }
}

template <bool HASV, class KS, class VS, class CF>
__device__ __forceinline__ void tile_pipe2(int n, u16* ktb, u16* vtb, int soff, KS ksrc, VS vsrc, CF compute) {
  uint4 kE, vE, kO, vO;
  kE = vE = kO = vO = make_uint4(0u, 0u, 0u, 0u);
  if (n > 0) { kE = *(const uint4*)ksrc(0); if (HASV) vE = *(const uint4*)vsrc(0); }
  if (n > 1) { kO = *(const uint4*)ksrc(1); if (HASV) vO = *(const uint4*)vsrc(1); }
  if (n > 0) { *(uint4*)(ktb + soff) = kE; if (HASV) *(uint4*)(vtb + soff) = vE; }
  __syncthreads();
#pragma unroll 1
  for (int i = 0; i < n; i += 2) {
    if (i + 2 < n) { kE = *(const uint4*)ksrc(i + 2); if (HASV) vE = *(const uint4*)vsrc(i + 2); }
    compute(i, ktb, vtb);
    if (i + 1 < n) { *(uint4*)(ktb + NT_EL + soff) = kO; if (HASV) *(uint4*)(vtb + NT_EL + soff) = vO; }
    __syncthreads();
    if (i + 1 >= n) break;
    if (i + 3 < n) { kO = *(const uint4*)ksrc(i + 3); if (HASV) vO = *(const uint4*)vsrc(i + 3); }
    compute(i + 1, ktb + NT_EL, vtb + NT_EL);
    if (i + 2 < n) { *(uint4*)(ktb + soff) = kE; if (HASV) *(uint4*)(vtb + soff) = vE; }
    __syncthreads();
  }
}

__device__ __forceinline__ void nsa_wg(const Params& p, int g, int T0, unsigned char* sm) {
  const int tid = tid_fresh(), lane = tid & 63, lr = lane & 15, lq = lane >> 4;
  const int wv = __builtin_amdgcn_readfirstlane(tid >> 6);
  const int t0 = T0 + wv * 4;
  const int tok = lr >> 2, r = lr & 3, tpos = t0 + tok;
  const float slope = 1.4426950408889634f * exp2f(-(float)(g * 4 + r + 1));
  u16* proj = p.BIG;
  float* wl = (float*)sm + wv * 2112;
  float* impA = wl; float* impB = wl + 1024; u32* selm = (u32*)(wl + 1024 + 1040);
  u16* ktb = (u16*)(sm + 67584);
  u16* vtb = ktb + 2 * NT_EL;
  u32* wgm = (u32*)(vtb + 2 * NT_EL);
  u32* wgu = wgm + 64;
  int* blist = (int*)(wgu + 8);
  const int srow = tid >> 3, sseg = (tid & 7) * 8;
  const int soff = srow * NT_ST + sseg;
  bf16x8 q_lo, q_hi;
  {
    const u16* qp = proj + (size_t)tpos * PS + C_NQ + (g * 4 + r) * 64 + lq * 8;
    q_lo = scale8(ld8(qp), 0.125f * 1.4426950408889634f); q_hi = scale8(ld8(qp + 32), 0.125f * 1.4426950408889634f);
  }
  float g0, g1, g2;
  {
    const u16* gp = proj + (size_t)tpos * PS + C_NG + (g * 4 + r) * 3;
    g0 = sigm_f(bf2f(gp[0])); g1 = sigm_f(bf2f(gp[1])); g2 = sigm_f(bf2f(gp[2]));
  }
  f32x4 outacc[4];
#pragma unroll
  for (int dt = 0; dt < 4; dt++) outacc[dt] = (f32x4){0.f, 0.f, 0.f, 0.f};
  const int cur = T0 >> 6;

  for (int i = lane; i < 1024 + 1040; i += 64) wl[i] = 0.f;
  {
    const int ncmp = (T0 + 31 >= 31) ? ((T0 + 31 - 31) >> 4) + 1 : 0;
    const int nst = (ncmp + 63) >> 6;
    const u16* ksrc = p.kc + (size_t)g * 1024 * 64 + (size_t)srow * 64 + sseg;
    const u16* vsrc = p.vcT + (size_t)(g * 64 + srow) * 1024 + sseg;
    float m = -1e30f, lsum = 0.f;
    tile_pipe2<false>(nst, ktb, vtb, soff,
      [&](int i) { return ksrc + (size_t)(nst - 1 - i) * 4096; }, [&](int i) { return ksrc; },
      [&](int i, const u16* kt, const u16* vt) {
        const int st = nst - 1 - i;
        f32x4 s[2][2];
        float sv[16]; float mx = -1e30f;
        const bool fast = t0 - 31 - 16 * (st * 64 + 63) >= 0;
        if (fast) {
          const float binit = -slope * (float)(tpos - 31 - 16 * (st * 64 + lq * 4)), slope16 = slope * 16.0f;
#pragma unroll
          for (int c = 0; c < 2; c++)
#pragma unroll
            for (int t = 0; t < 2; t++)
#pragma unroll
              for (int j = 0; j < 4; j++) s[c][t][j] = __builtin_fmaf(slope16, (float)(c * 32 + t * 16 + j), binit);
          qk64(kt, lr, lq, q_lo, q_hi, s);
#pragma unroll
          for (int c = 0; c < 2; c++)
#pragma unroll
            for (int t = 0; t < 2; t++)
#pragma unroll
              for (int j = 0; j < 4; j++) { sv[(c * 2 + t) * 4 + j] = s[c][t][j]; mx = fmaxf(mx, s[c][t][j]); }
        } else {
#pragma unroll
          for (int c = 0; c < 2; c++)
#pragma unroll
            for (int t = 0; t < 2; t++) s[c][t] = (f32x4){0.f, 0.f, 0.f, 0.f};
          qk64(kt, lr, lq, q_lo, q_hi, s);
#pragma unroll
          for (int c = 0; c < 2; c++)
#pragma unroll
            for (int t = 0; t < 2; t++)
#pragma unroll
              for (int j = 0; j < 4; j++) {
                const int ci = st * 64 + c * 32 + t * 16 + lq * 4 + j;
                const int d = tpos - (ci * 16 + 31);
                const float v = d >= 0 ? s[c][t][j] - slope * (float)d : -1e30f;
                sv[(c * 2 + t) * 4 + j] = v; mx = fmaxf(mx, v);
              }
        }
        if (__any(mx > m)) {
          mx = fmaxf(mx, __shfl_xor(mx, 16)); mx = fmaxf(mx, __shfl_xor(mx, 32));
          const float mnew = fmaxf(m, mx);
          lsum *= ex2(m - mnew);
          m = mnew;
        }
        const float mn = m;
        float ps = 0.f;
        if (fast) {
#pragma unroll
          for (int j = 0; j < 16; j++) ps += ex2(sv[j] - mn);
        } else {
#pragma unroll
          for (int j = 0; j < 16; j++) ps += sv[j] > -1e29f ? ex2(sv[j] - mn) : 0.f;
        }
        lsum += ps;
      });
    lsum += __shfl_xor(lsum, 16); lsum += __shfl_xor(lsum, 32);
    const float invL = lsum > 0.f ? 1.0f / lsum : 0.f;
    f32x4 O[4];
#pragma unroll
    for (int dt = 0; dt < 4; dt++) O[dt] = (f32x4){0.f, 0.f, 0.f, 0.f};
    tile_pipe2<true>(nst, ktb, vtb, soff,
      [&](int st) { return ksrc + (size_t)st * 4096; }, [&](int st) { return vsrc + st * 64; },
      [&](int st, const u16* kt, const u16* vt) {
        f32x4 s[2][2];
        const bool fast = t0 - 31 - 16 * (st * 64 + 63) >= 0;
        if (fast) {
          const float binit = -slope * (float)(tpos - 31 - 16 * (st * 64 + lq * 4)) - m, slope16 = slope * 16.0f;
#pragma unroll
          for (int c = 0; c < 2; c++)
#pragma unroll
            for (int t = 0; t < 2; t++)
#pragma unroll
              for (int j = 0; j < 4; j++) s[c][t][j] = __builtin_fmaf(slope16, (float)(c * 32 + t * 16 + j), binit);
        } else {
#pragma unroll
          for (int c = 0; c < 2; c++)
#pragma unroll
            for (int t = 0; t < 2; t++) s[c][t] = (f32x4){0.f, 0.f, 0.f, 0.f};
        }
        qk64(kt, lr, lq, q_lo, q_hi, s);
        bf16x8 pb[2];
#pragma unroll
        for (int c = 0; c < 2; c++) {
          float p0[4], p1[4];
          if (fast) {
#pragma unroll
            for (int j = 0; j < 4; j++) { p0[j] = ex2(s[c][0][j]) * invL; p1[j] = ex2(s[c][1][j]) * invL; }
          } else {
#pragma unroll
            for (int j = 0; j < 4; j++) {
              const int ci = st * 64 + c * 32 + lq * 4 + j;
              const int d0 = tpos - (ci * 16 + 31), d1 = d0 - 256;
              p0[j] = d0 >= 0 ? ex2(s[c][0][j] - slope * (float)d0 - m) * invL : 0.f;
              p1[j] = d1 >= 0 ? ex2(s[c][1][j] - slope * (float)d1 - m) * invL : 0.f;
            }
          }
          float a0 = p0[0] + p0[1] + p0[2] + p0[3], b0 = p0[3], a1 = p1[0] + p1[1] + p1[2] + p1[3], b1 = p1[3];
          a0 = quad_sum(a0); b0 = quad_sum(b0); a1 = quad_sum(a1); b1 = quad_sum(b1);
          if (r == 0) {
            const int J0 = st * 16 + c * 8 + lq;
            impA[tok * 256 + J0] = a0; impB[tok * 260 + J0 + 1] = b0;
            impA[tok * 256 + J0 + 4] = a1; impB[tok * 260 + J0 + 5] = b1;
          }
          pb[c] = pk8(p0[0], p0[1], p0[2], p0[3], p1[0], p1[1], p1[2], p1[3]);
        }
#pragma unroll
        for (int dt = 0; dt < 4; dt++)
#pragma unroll
          for (int c = 0; c < 2; c++) {
            const u16* vp = vt + (dt * 16 + lr) * NT_ST + c * 32 + lq * 4;
            O[dt] = mfma16(ld44(vp, vp + 16), pb[c], O[dt]);
          }
      });
#pragma unroll
    for (int dt = 0; dt < 4; dt++)
#pragma unroll
      for (int j = 0; j < 4; j++) outacc[dt][j] += g0 * O[dt][j];
  }
  wave_lds_sync();

  if (cur < 16) {
    if (lane < 32) selm[lane] = ((lane & 7) == 0) ? ((2u << cur) - 1u) : 0u;
  } else {
    u32 kk[4][4];
#pragma unroll
    for (int tk = 0; tk < 4; tk++) {
      const float* ia = impA + tk * 256; const float* ib = impB + tk * 260;
#pragma unroll
      for (int i = 0; i < 4; i++) {
        const int j = lane + 64 * i;
        kk[tk][i] = (j >= 1 && j <= cur - 2) ? __float_as_uint(ia[j] + ib[j]) + 1u : 0u;
      }
    }
    u32 T[4] = {0u, 0u, 0u, 0u};
#pragma unroll 1
    for (int bit = 30; bit >= 0; bit--) {
#pragma unroll
      for (int tk = 0; tk < 4; tk++) {
        const u32 t = T[tk] | (1u << bit);
        const int cnt = __popcll(__ballot(kk[tk][0] >= t)) + __popcll(__ballot(kk[tk][1] >= t)) + __popcll(__ballot(kk[tk][2] >= t)) + __popcll(__ballot(kk[tk][3] >= t));
        if (cnt >= 13) T[tk] = t;
      }
    }
#pragma unroll
    for (int tk = 0; tk < 4; tk++) {
      const u32 k0 = kk[tk][0], k1 = kk[tk][1], k2 = kk[tk][2], k3 = kk[tk][3], Tt = T[tk];
      int need = 13 - (__popcll(__ballot(k0 > Tt)) + __popcll(__ballot(k1 > Tt)) + __popcll(__ballot(k2 > Tt)) + __popcll(__ballot(k3 > Tt)));
      u64 sel0, sel1, sel2, sel3;
      {
        u64 e = __ballot(k0 == Tt); int below = __builtin_amdgcn_mbcnt_hi((u32)(e >> 32), __builtin_amdgcn_mbcnt_lo((u32)e, 0u));
        sel0 = __ballot(k0 > Tt || (k0 == Tt && below < need)); need -= min(need, (int)__popcll(e));
        e = __ballot(k1 == Tt); below = __builtin_amdgcn_mbcnt_hi((u32)(e >> 32), __builtin_amdgcn_mbcnt_lo((u32)e, 0u));
        sel1 = __ballot(k1 > Tt || (k1 == Tt && below < need)); need -= min(need, (int)__popcll(e));
        e = __ballot(k2 == Tt); below = __builtin_amdgcn_mbcnt_hi((u32)(e >> 32), __builtin_amdgcn_mbcnt_lo((u32)e, 0u));
        sel2 = __ballot(k2 > Tt || (k2 == Tt && below < need)); need -= min(need, (int)__popcll(e));
        e = __ballot(k3 == Tt); below = __builtin_amdgcn_mbcnt_hi((u32)(e >> 32), __builtin_amdgcn_mbcnt_lo((u32)e, 0u));
        sel3 = __ballot(k3 > Tt || (k3 == Tt && below < need));
      }
      u32 myword = 0;
      if (lane == 0) myword = (u32)sel0; else if (lane == 1) myword = (u32)(sel0 >> 32);
      else if (lane == 2) myword = (u32)sel1; else if (lane == 3) myword = (u32)(sel1 >> 32);
      else if (lane == 4) myword = (u32)sel2; else if (lane == 5) myword = (u32)(sel2 >> 32);
      else if (lane == 6) myword = (u32)sel3; else if (lane == 7) myword = (u32)(sel3 >> 32);
      if (lane == 0) myword |= 1u;
      if (lane == ((cur - 1) >> 5)) myword |= 1u << ((cur - 1) & 31);
      if (lane == (cur >> 5)) myword |= 1u << (cur & 31);
      if (lane < 8) selm[tk * 8 + lane] = myword;
    }
  }
  wave_lds_sync();
  if (lane < 8) wgm[wv * 8 + lane] = selm[lane] | selm[8 + lane] | selm[16 + lane] | selm[24 + lane];
  __syncthreads();
  if (tid < 8) {
    u32 u = 0;
#pragma unroll
    for (int w = 0; w < 8; w++) u |= wgm[w * 8 + tid];
    const int lim = cur - tid * 32;
    if (lim < 0) u = 0; else if (lim < 31) u &= (2u << lim) - 1u;
    wgu[tid] = u;
  }
  __syncthreads();
  if (tid < 256) {
    const int w = tid >> 5, b = tid & 31;
    int idx = 0;
#pragma unroll
    for (int ww = 0; ww < 8; ww++) { const u32 x = wgu[ww]; idx += ww < w ? __builtin_popcount(x) : 0; }
    const u32 x = wgu[w];
    idx += __builtin_popcount(x & ((1u << b) - 1u));
    if ((x >> b) & 1u) blist[idx] = tid;
  }
  if (tid == 0) {
    int n = 0;
#pragma unroll
    for (int ww = 0; ww < 8; ww++) n += __builtin_popcount(wgu[ww]);
    blist[256] = n;
  }
  __syncthreads();

  {
    const int nblk = blist[256];
    const u16* ksrc = proj + C_KS + g * 64 + (size_t)srow * PS + sseg;
    const u16* vsrc = p.vsT + (size_t)(g * 64 + srow) * S + sseg;
    float m = -1e30f, lsum = 0.f;
    f32x4 O[4];
#pragma unroll
    for (int dt = 0; dt < 4; dt++) O[dt] = (f32x4){0.f, 0.f, 0.f, 0.f};
    tile_pipe2<true>(nblk, ktb, vtb, soff,
      [&](int i) { return ksrc + (size_t)blist[nblk - 1 - i] * 64 * PS; }, [&](int i) { return vsrc + blist[nblk - 1 - i] * 64; },
      [&](int i, const u16* kt, const u16* vt) {
        const int jb = blist[nblk - 1 - i];
        const u32 wany = wgm[wv * 8 + (jb >> 5)];
        if ((wany >> (jb & 31)) & 1u) {
          const bool rowsel = (selm[tok * 8 + (jb >> 5)] >> (jb & 31)) & 1u;
          if (jb < cur) attend_tile<true>(kt, vt, lr, lq, q_lo, q_hi, slope, tpos - jb * 64, rowsel, 1 << 30, m, lsum, O);
          else attend_tile<false>(kt, vt, lr, lq, q_lo, q_hi, slope, tpos - jb * 64, rowsel, 1 << 30, m, lsum, O);
        }
      });
    lsum += __shfl_xor(lsum, 16); lsum += __shfl_xor(lsum, 32);
    const float sc = g1 / fmaxf(lsum, 1e-30f);
#pragma unroll
    for (int dt = 0; dt < 4; dt++)
#pragma unroll
      for (int j = 0; j < 4; j++) outacc[dt][j] += sc * O[dt][j];
  }
  {
    int ks = T0 - 511; if (ks < 0) ks = 0; ks &= ~63;
    const int nst = ((T0 + 31 - ks) >> 6) + 1;
    const u16* ksrc = proj + C_KW + g * 64 + (size_t)(ks + srow) * PS + sseg;
    const u16* vsrc = p.vwT + (size_t)(g * 64 + srow) * S + ks + sseg;
    float m = -1e30f, lsum = 0.f;
    f32x4 O[4];
#pragma unroll
    for (int dt = 0; dt < 4; dt++) O[dt] = (f32x4){0.f, 0.f, 0.f, 0.f};
    tile_pipe2<true>(nst, ktb, vtb, soff,
      [&](int st) { return ksrc + (size_t)(nst - 1 - st) * 64 * PS; }, [&](int st) { return vsrc + (nst - 1 - st) * 64; },
      [&](int st, const u16* kt, const u16* vt) {
        const int kp0 = ks + (nst - 1 - st) * 64;
        if (t0 - (kp0 + 63) >= 0 && t0 + 3 - kp0 < 512) attend_tile<true>(kt, vt, lr, lq, q_lo, q_hi, slope, tpos - kp0, true, 512, m, lsum, O);
        else attend_tile<false>(kt, vt, lr, lq, q_lo, q_hi, slope, tpos - kp0, true, 512, m, lsum, O);
      });
    lsum += __shfl_xor(lsum, 16); lsum += __shfl_xor(lsum, 32);
    const float sc = g2 / fmaxf(lsum, 1e-30f);
#pragma unroll
    for (int dt = 0; dt < 4; dt++)
#pragma unroll
      for (int j = 0; j < 4; j++) outacc[dt][j] += sc * O[dt][j];
  }
  {
    u16* op = proj + (size_t)tpos * PS + C_NQ + (g * 4 + r) * 64 + lq * 4;
#pragma unroll
    for (int dt = 0; dt < 4; dt++)
      *(uint2*)(op + dt * 16) = make_uint2(pack2(outacc[dt][0], outacc[dt][1]), pack2(outacc[dt][2], outacc[dt][3]));
  }
  __syncthreads();
}

#define XB_TMO      128
#define XB_XCNT(j)  (256  + 64 * (j))
#define XB_XSUB(j)  (1280 + 64 * (j))
#define XB_XGEN(j)  (2304 + 64 * (j))
#define XB_TOP      3328
#define XB_TOPGEN   3392
#define XCD_BAR_WORDS 3456
#define XB_SPIN_CAP (1u << 18)
__device__ __forceinline__ unsigned xb_ld(unsigned* p)              { return __hip_atomic_load(p, __ATOMIC_RELAXED, __HIP_MEMORY_SCOPE_AGENT); }
__device__ __forceinline__ unsigned xb_add(unsigned* p, unsigned v) { return __hip_atomic_fetch_add(p, v, __ATOMIC_RELAXED, __HIP_MEMORY_SCOPE_AGENT); }
__device__ __forceinline__ unsigned xb_xcc_id() { return (unsigned)__builtin_amdgcn_s_getreg((3 << 11) | 20) & 0xFu; }
#define XB_SPIN(cond, bar) do { unsigned _sp = 0; while (cond) { __builtin_amdgcn_s_sleep(1); \
    if ((++_sp & 255u) == 0u) { if (xb_ld(&(bar)[XB_TMO])) break; if (_sp > XB_SPIN_CAP) { atomicAdd(&(bar)[XB_TMO], 1u); break; } } } } while (0)
struct XcdBarrier { unsigned* bar; unsigned x; volatile __attribute__((address_space(3))) unsigned* st; };
__device__ __forceinline__ XcdBarrier xcd_barrier_post(unsigned* bar, volatile __attribute__((address_space(3))) unsigned* st) {
  XcdBarrier b; b.bar = bar; b.x = xb_xcc_id(); b.st = st;
  if (threadIdx.x == 0) (void)xb_add(&bar[XB_XCNT(b.x)], 1u);
  return b;
}
__device__ __forceinline__ void xcd_barrier_complete(unsigned* bar, unsigned x, unsigned& nloc, unsigned& nx) {
  const unsigned G = gridDim.x * gridDim.y * gridDim.z;
  unsigned sum, cnt, mine, sp = 0u;
  for (;;) {
    sum = 0u; cnt = 0u; mine = 0u;
#pragma unroll
    for (unsigned j = 0; j < 16; ++j) { const unsigned c = xb_ld(&bar[XB_XCNT(j)]); sum += c; cnt += (c > 0u) ? 1u : 0u; mine = (j == x) ? c : mine; }
    if (sum == G) break;
    __builtin_amdgcn_s_sleep(1);
    if ((++sp & 255u) == 0u) { if (xb_ld(&bar[XB_TMO])) break; if (sp > XB_SPIN_CAP) { atomicAdd(&bar[XB_TMO], 1u); break; } }
  }
  nloc = mine > 0u ? mine : 1u; nx = cnt > 0u ? cnt : 1u;
}
__device__ __forceinline__ void xcd_barrier(const XcdBarrier& b) {
  asm volatile("s_waitcnt vmcnt(0)" ::: "memory");
  __syncthreads();
  if (threadIdx.x == 0) {
    unsigned* bar = b.bar;
    __builtin_amdgcn_s_waitcnt(0);
    unsigned nloc = b.st[0], nx = b.st[1];
    if (nloc == 0u) { xcd_barrier_complete(bar, b.x, nloc, nx); b.st[0] = nloc; b.st[1] = nx; }
    const unsigned old = xb_add(&bar[XB_XSUB(b.x)], 1u);
    const unsigned gen = old / nloc;
    if (old + 1u == (gen + 1u) * nloc) {
      __builtin_amdgcn_fence(__ATOMIC_RELEASE, "agent");
      asm volatile("s_waitcnt vmcnt(0)" ::: "memory");
      const unsigned og = xb_add(&bar[XB_TOP], 1u);
      const unsigned tg = og / nx;
      if (og + 1u == (tg + 1u) * nx) xb_add(&bar[XB_TOPGEN], 1u);
      else XB_SPIN(xb_ld(&bar[XB_TOPGEN]) == tg, bar);
      __builtin_amdgcn_fence(__ATOMIC_ACQUIRE, "agent");
      xb_add(&bar[XB_XGEN(b.x)], 1u);
      asm volatile("s_waitcnt vmcnt(0)" ::: "memory");
    } else {
      XB_SPIN(xb_ld(&bar[XB_XGEN(b.x)]) == gen, bar);
      __builtin_amdgcn_fence(__ATOMIC_ACQUIRE, "agent");
      asm volatile("s_waitcnt vmcnt(0)" ::: "memory");
    }
  }
  __syncthreads();
}

template <bool FINAL>
struct EpiResidNorm {
  static constexpr bool PERM = false;
  const float* xsrc; float* xdst; float scale; const float* gnext; u16* Hout; float* part; unsigned* cnt; unsigned* tmo;
  __device__ __forceinline__ void fused(AccT& acc, const Unit& u, int wr, int wc, int fr, int fq, LAS unsigned char* lds) const {
    volatile LAS float* ps = (volatile LAS float*)(lds + 131072);
    volatile LAS float* rr = (volatile LAS float*)(lds + 131072 + 4096);
    const int tid = tid_fresh();
    const int row0 = u.pm * 256 + wr * 64 + fr, col0 = u.pn * 256 + wc * 32 + 4 * fq;
#pragma unroll
    for (int ai = 0; ai < 2; ++ai) {
      f32x4 xv[4][2][2];
#pragma unroll
      for (int m = 0; m < 4; ++m)
#pragma unroll
        for (int bj = 0; bj < 2; ++bj)
#pragma unroll
          for (int n = 0; n < 2; ++n)
            xv[m][bj][n] = *(const f32x4*)(xsrc + (size_t)(row0 + ai * 128 + m * 16) * 1024 + col0 + bj * 128 + n * 16);
#pragma unroll
      for (int m = 0; m < 4; ++m) {
        float ss = 0.f;
#pragma unroll
        for (int bj = 0; bj < 2; ++bj)
#pragma unroll
          for (int n = 0; n < 2; ++n) {
            const f32x4 v = xv[m][bj][n] + scale * acc[ai][bj][m][n];
            if (!FINAL) *(f32x4*)(xdst + (size_t)(row0 + ai * 128 + m * 16) * 1024 + col0 + bj * 128 + n * 16) = v;
            acc[ai][bj][m][n] = v;
            ss += v[0] * v[0] + v[1] * v[1] + v[2] * v[2] + v[3] * v[3];
          }
        ss += __shfl_xor(ss, 16); ss += __shfl_xor(ss, 32);
        if (fq == 0) ps[wc * 256 + ai * 128 + wr * 64 + m * 16 + fr] = ss;
      }
    }
    __syncthreads();
    if (tid < 256) __hip_atomic_store(part + (size_t)(u.pm * 4 + u.pn) * 256 + tid, ps[tid] + ps[256 + tid] + ps[512 + tid] + ps[768 + tid], __ATOMIC_RELAXED, __HIP_MEMORY_SCOPE_AGENT);
    asm volatile("s_waitcnt vmcnt(0)" ::: "memory");
    __syncthreads();
    if (tid == 0) {
      (void)xb_add(cnt + u.pm, 1u);
      XB_SPIN(xb_ld(cnt + u.pm) < 4u, tmo);
      __builtin_amdgcn_fence(__ATOMIC_ACQUIRE, "agent");
      asm volatile("s_waitcnt vmcnt(0)" ::: "memory");
    }
    __syncthreads();
    if (tid < 256) {
      const float* pp = part + (size_t)(u.pm * 4) * 256 + tid;
      const float t0 = __hip_atomic_load(pp, __ATOMIC_RELAXED, __HIP_MEMORY_SCOPE_AGENT), t1 = __hip_atomic_load(pp + 256, __ATOMIC_RELAXED, __HIP_MEMORY_SCOPE_AGENT);
      const float t2 = __hip_atomic_load(pp + 512, __ATOMIC_RELAXED, __HIP_MEMORY_SCOPE_AGENT), t3 = __hip_atomic_load(pp + 768, __ATOMIC_RELAXED, __HIP_MEMORY_SCOPE_AGENT);
      rr[tid] = rsqrtf(((t0 + t1) + (t2 + t3)) * (1.0f / 1024.0f) + EPS);
    }
    __syncthreads();
    f32x4 gv[2][2];
#pragma unroll
    for (int bj = 0; bj < 2; ++bj)
#pragma unroll
      for (int n = 0; n < 2; ++n) gv[bj][n] = *(const f32x4*)(gnext + col0 + bj * 128 + n * 16);
#pragma unroll
    for (int ai = 0; ai < 2; ++ai)
#pragma unroll
      for (int m = 0; m < 4; ++m) {
        const float r = rr[ai * 128 + wr * 64 + m * 16 + fr];
#pragma unroll
        for (int bj = 0; bj < 2; ++bj)
#pragma unroll
          for (int n = 0; n < 2; ++n) {
            const f32x4 h = acc[ai][bj][m][n] * r * gv[bj][n];
            if (FINAL) *(f32x4*)(xdst + (size_t)(row0 + ai * 128 + m * 16) * 1024 + col0 + bj * 128 + n * 16) = h;
            else *(uint2*)(Hout + (size_t)(row0 + ai * 128 + m * 16) * 1024 + col0 + bj * 128 + n * 16) = make_uint2(pack2(h[0], h[1]), pack2(h[2], h[3]));
          }
      }
    __syncthreads();
  }
};

constexpr int SMEM_TOTAL = 147456;
__global__ void __launch_bounds__(512, 2) mega(Params p) {
  cg::grid_group grid = cg::this_grid();
  __shared__ __attribute__((aligned(16))) unsigned char smem_raw[SMEM_TOTAL + 16];
  LAS unsigned char* glds = (LAS unsigned char*)smem_raw;
  volatile LAS unsigned* xb_words = (volatile LAS unsigned*)(glds + SMEM_TOTAL);
  if (threadIdx.x == 0) { xb_words[0] = 0u; xb_words[1] = 0u; }
  if (blockIdx.x == 0) { for (int i = threadIdx.x; i < XCD_BAR_WORDS; i += 512) p.bar[i] = 0u; if (threadIdx.x < 384) p.ncnt[threadIdx.x] = 0u; }
  __syncthreads();
  XcdBarrier xb; xb.bar = p.bar; xb.x = 0; xb.st = xb_words;
#define VB_SETUP const int _tf = tid_fresh(); const int half = __builtin_amdgcn_readfirstlane(_tf >> 8); const int nb = gridDim.x * 2, bid = blockIdx.x * 2 + half; \
  u16* smem = (u16*)(smem_raw + half * SMEM_BYTES); const int vwave = __builtin_amdgcn_readfirstlane((_tf & 255) >> 6); (void)vwave; (void)nb; (void)bid; (void)smem;
#pragma unroll 1
  for (int l = 0; l < 2; l++) {
    const float* xsrc = l == 0 ? p.x_in : p.xout;
    const bool fusedn = gridDim.x == 256;
    if (l == 0 || !fusedn) norm_phase(xsrc, p.ffn1_norm + l * 1024, p.H);
    { VB_SETUP wprep_phase(p, l, smem, bid, nb, l == 1 && fusedn, fusedn); }
    if (l == 0) { grid.sync(); xb = xcd_barrier_post(p.bar, xb_words); } else xcd_barrier(xb);
    { Gemm g{p.H, p.w1t_a, 1024, 1024, S, 5632, 1024}; EpiSwiglu e{p.BIG}; gemm_phase(glds, g, e); }
    if (fusedn && blockIdx.x >= 128) {
      VB_SETUP
      wprep_matrix(p.ffn2_w1 + (size_t)l * 1024 * 5632, p.w1t_b, 1024, 5632, 1, smem, bid - 256, 256);
      wprep_matrix(p.ffn2_w2 + (size_t)l * FF * 1024, p.w2t_b, FF, 1024, 0, smem, bid - 256, 256);
    }
    xcd_barrier(xb);
    if (fusedn) {
      Gemm g{p.BIG, p.w2t_a, FF, FF, S, 1024, FF};
      EpiResidNorm<false> e{xsrc, p.xout, 0.5f, p.mix_norm + l * 1024, p.H, p.part + (size_t)(l * 2) * 65536, p.ncnt + (l * 2) * 64, p.bar};
      gemm_phase<EpiResidNorm<false>, true>(glds, g, e);
      xcd_barrier(xb);
    } else {
      { Gemm g{p.BIG, p.w2t_a, FF, FF, S, 1024, FF}; EpiResid e{xsrc, p.xout, 0.5f}; gemm_phase(glds, g, e); }
      xcd_barrier(xb);
      norm_phase(p.xout, p.mix_norm + l * 1024, p.H);
      xcd_barrier(xb);
    }
    { Gemm g{p.H, p.wint, 1024, 1024, S, 4096, 1024}; EpiProj e{p.BIG}; gemm_phase(glds, g, e); }
    xcd_barrier(xb);
    { VB_SETUP
    if (nb == 512) {
      if (bid < 128) { cmp_tile(p, l, bid, smem); ret_kv_tile(p, bid, smem); ret_kv_tile(p, 128 + bid, smem); }
      else {
        const int h2 = bid - 128;
        gmlp_tile(p, l, h2, smem);
        if (h2 < 128) { gmlp_tile(p, l, 384 + h2, smem); vt_tile(p, h2, smem); }
        else {
          const int ci = h2 - 128;
          ret_kv_tile(p, 256 + ci, smem);
          vt_tile(p, 128 + ci * 3, smem); vt_tile(p, 129 + ci * 3, smem); vt_tile(p, 130 + ci * 3, smem);
          if (ci < 128) vt_tile(p, 896 + ci, smem);
        }
      }
    } else {
    for (int t = bid; t < 128 + 512 + 512 + 1024; t += nb) {
      if (t < 128) cmp_tile(p, l, t, smem);
      else if (t < 640) gmlp_tile(p, l, t - 128, smem);
      else if (t < 1152) ret_kv_tile(p, t - 640, smem);
      else vt_tile(p, t - 1152, smem);
    } } }
    xcd_barrier(xb);
    {
      const int tf = tid_fresh();
      const int wv = __builtin_amdgcn_readfirstlane(tf >> 6);
      ret_scan_wg(p, smem_raw);
      const int xcd = blockIdx.x & 7, slot = blockIdx.x >> 3, nslot = gridDim.x >> 3;
      for (int i = slot; i < 128; i += nslot) {
        const int rsel = i >> 6, j = i & 63;
        const int range = rsel == 0 ? 15 - xcd : xcd;
        const int g = (j ^ (j >> 5)) & 1, w = range * 32 + 31 - (j >> 1);
        nsa_wg(p, g, w * 32, smem_raw);
      }
    }
    xcd_barrier(xb);
    { VB_SETUP for (int t = bid; t < 512; t += nb) ret_out_tile(p, l, t, smem); }
    xcd_barrier(xb);
    gemm_merge_chain(glds, p, l);
    xcd_barrier(xb);
    if (fusedn) {
      Gemm g{p.BIG + C_MIX, p.wot, PS, 1024, S, 1024, 1024};
      EpiResidNorm<false> e{p.xout, p.xout, 1.0f, p.ffn2_norm + l * 1024, p.H, p.part + (size_t)(l * 2 + 1) * 65536, p.ncnt + (l * 2 + 1) * 64, p.bar};
      gemm_phase<EpiResidNorm<false>, true>(glds, g, e);
      xcd_barrier(xb);
    } else {
      { Gemm g{p.BIG + C_MIX, p.wot, PS, 1024, S, 1024, 1024}; EpiResid e{p.xout, p.xout, 1.0f}; gemm_phase(glds, g, e); }
      xcd_barrier(xb);
      norm_phase(p.xout, p.ffn2_norm + l * 1024, p.H);
      xcd_barrier(xb);
    }
    { Gemm g{p.H, p.w1t_b, 1024, 1024, S, 5632, 1024}; EpiSwiglu e{p.BIG}; gemm_phase(glds, g, e); }
    if (l == 0 && fusedn && blockIdx.x >= 128) {
      VB_SETUP
      wprep_matrix(p.ffn1_w1 + (size_t)1024 * 5632, p.w1t_a, 1024, 5632, 1, smem, bid - 256, 256);
      wprep_matrix(p.ffn1_w2 + (size_t)FF * 1024, p.w2t_a, FF, 1024, 0, smem, bid - 256, 256);
    }
    xcd_barrier(xb);
    if (fusedn && l == 0) {
      Gemm g{p.BIG, p.w2t_b, FF, FF, S, 1024, FF};
      EpiResidNorm<false> e{p.xout, p.xout, 0.5f, p.ffn1_norm + 1024, p.H, p.part + (size_t)4 * 65536, p.ncnt + 4 * 64, p.bar};
      gemm_phase<EpiResidNorm<false>, true>(glds, g, e);
      xcd_barrier(xb);
    } else if (fusedn) {
      Gemm g{p.BIG, p.w2t_b, FF, FF, S, 1024, FF};
      EpiResidNorm<true> e{p.xout, p.xout, 0.5f, p.final_norm, p.H, p.part + (size_t)5 * 65536, p.ncnt + 5 * 64, p.bar};
      gemm_phase<EpiResidNorm<true>, true>(glds, g, e);
    } else {
      { Gemm g{p.BIG, p.w2t_b, FF, FF, S, 1024, FF}; EpiResid e{p.xout, p.xout, 0.5f}; gemm_phase(glds, g, e); }
      xcd_barrier(xb);
      if (l == 1) final_norm_phase(p.xout, p.final_norm);
    }
  }
}

extern "C" void kernel_launch(void* const* d_in, const int* in_sizes, int n_in, void* d_out, int out_size, void* d_ws,
                              size_t ws_size, hipStream_t stream) {
  static int grid_blocks = 0;
  if (!grid_blocks) {
    int dev = 0, cus = 0, per_cu = 0;
    (void)hipGetDevice(&dev);
    (void)hipDeviceGetAttribute(&cus, hipDeviceAttributeMultiprocessorCount, dev);
    (void)hipOccupancyMaxActiveBlocksPerMultiprocessor(&per_cu, mega, 512, 0);
    if (per_cu > 1) per_cu = 1;
    if (per_cu < 1) per_cu = 1;
    grid_blocks = cus * per_cu;
    grid_blocks &= ~7;
  }
  Params p{};
  p.x_in = (const float*)d_in[0];
  p.ffn1_norm = (const float*)d_in[1]; p.ffn1_w1 = (const float*)d_in[2]; p.ffn1_w2 = (const float*)d_in[3];
  p.mix_norm = (const float*)d_in[4]; p.w_in = (const float*)d_in[5]; p.gm_ln_g = (const float*)d_in[6];
  p.gm_ln_b = (const float*)d_in[7]; p.gm_ws = (const float*)d_in[8]; p.gm_bs = (const float*)d_in[9];
  p.ret_gn_g = (const float*)d_in[10]; p.ret_gn_b = (const float*)d_in[11]; p.cmp_pos = (const float*)d_in[12];
  p.cmp_w1 = (const float*)d_in[13]; p.cmp_w2 = (const float*)d_in[14]; p.w_branch = (const float*)d_in[15];
  p.w_gate = (const float*)d_in[16]; p.b_gate = (const float*)d_in[17]; p.w_o = (const float*)d_in[18];
  p.ffn2_norm = (const float*)d_in[19]; p.ffn2_w1 = (const float*)d_in[20]; p.ffn2_w2 = (const float*)d_in[21];
  p.final_norm = (const float*)d_in[22];
  p.xout = (float*)d_out;
  char* w = (char*)d_ws;
  auto take = [&](size_t bytes) { char* r = w; w += (bytes + 255) & ~(size_t)255; return r; };
  p.w1t_a = (u16*)take((size_t)5632 * 1024 * 2);
  p.w1t_b = (u16*)take((size_t)5632 * 1024 * 2);
  p.w2t_a = (u16*)take((size_t)1024 * FF * 2);
  p.w2t_b = (u16*)take((size_t)1024 * FF * 2);
  p.wint = (u16*)take((size_t)4096 * 1024 * 2);
  p.wgt = (u16*)take((size_t)3072 * 1024 * 2);
  p.wbt = (u16*)take((size_t)3 * 1024 * 512 * 2);
  p.wot = (u16*)take((size_t)1024 * 1024 * 2);
  p.cw1t = (u16*)take((size_t)2 * 128 * 2048 * 2);
  p.cw2t = (u16*)take((size_t)2 * 64 * 128 * 2);
  p.H = (u16*)take((size_t)S * 1024 * 2);
  p.BIG = (u16*)take((size_t)S * PS * 2);
  p.vsT = (u16*)take((size_t)2 * 64 * S * 2);
  p.vwT = (u16*)take((size_t)2 * 64 * S * 2);
  p.kc = (u16*)take((size_t)2 * 1024 * 64 * 2);
  p.vcT = (u16*)take((size_t)2 * 64 * 1024 * 2);
  p.ret = (float*)take((size_t)128 * 4 * 8192 * 4);
  p.gst = (u16*)take((size_t)256 * 65536 * 2);
  p.bar = (unsigned*)take((size_t)XCD_BAR_WORDS * 4);
  p.part = (float*)take((size_t)6 * 64 * 4 * 256 * 4);
  p.ncnt = (unsigned*)take((size_t)6 * 64 * 4);
  if ((size_t)(w - (char*)d_ws) > ws_size) { fprintf(stderr, "workspace too small: need %zu have %zu\n", (size_t)(w - (char*)d_ws), ws_size); return; }
  void* args[] = {&p};
  hipError_t e = hipLaunchCooperativeKernel((void*)mega, dim3(grid_blocks), dim3(512), args, 0, stream);
  if (e != hipSuccess) fprintf(stderr, "coop launch failed: %s (grid %d)\n", hipGetErrorString(e), grid_blocks);
}
```

```cpp
#include <hip/hip_runtime.h>
#include <hip/hip_cooperative_groups.h>
#include <cstdio>
#include <cstdint>
namespace cg = cooperative_groups;

typedef unsigned short u16;
typedef unsigned int u32;
typedef unsigned long long u64;
using bf16x8 = __attribute__((ext_vector_type(8))) short;
using bf16x4 = __attribute__((ext_vector_type(4))) short;
using f32x4 = __attribute__((ext_vector_type(4))) float;

constexpr int S = 16384, FF = 2816, DIN = 3864;
constexpr int PS = 3968;
constexpr int C_U = 0, C_V = 512, C_RQ = 1024, C_RK = 1280, C_RV = 1536, C_RG = 2048, C_NQ = 2560,
              C_KC = 3072, C_VC = 3200, C_KS = 3328, C_VS = 3456, C_KW = 3584, C_VW = 3712, C_NG = 3840, C_MIX = 512;
constexpr float EPS = 1e-6f;
constexpr int SMEM_BYTES = 73728;

struct Params {
  const float* x_in;
  const float *ffn1_norm, *ffn1_w1, *ffn1_w2, *mix_norm, *w_in, *gm_ln_g, *gm_ln_b, *gm_ws, *gm_bs, *ret_gn_g, *ret_gn_b,
      *cmp_pos, *cmp_w1, *cmp_w2, *w_branch, *w_gate, *b_gate, *w_o, *ffn2_norm, *ffn2_w1, *ffn2_w2, *final_norm;
  float* xout;
  u16 *w1t_a, *w2t_a, *wint, *wgt, *wbt, *wot, *w1t_b, *w2t_b, *cw1t, *cw2t;
  u16 *H, *BIG, *vsT, *vwT, *kc, *vcT;
  float* ret;
  u16* gst;
  unsigned* bar;
  float* part; unsigned* ncnt;
};

__device__ __forceinline__ u16 f2bf(float f) { __bf16 b = (__bf16)f; return __builtin_bit_cast(u16, b); }
__device__ __forceinline__ float bf2f(u16 h) { return __uint_as_float(((u32)h) << 16); }
typedef __bf16 bf16x2_t __attribute__((ext_vector_type(2)));
typedef float f32x2_t __attribute__((ext_vector_type(2)));
__device__ __forceinline__ u32 pack2(float a, float b) { f32x2_t v = {a, b}; bf16x2_t r = __builtin_convertvector(v, bf16x2_t); return __builtin_bit_cast(u32, r); }
__device__ __forceinline__ float lo2f(u32 w) { return __uint_as_float(w << 16); }
__device__ __forceinline__ float hi2f(u32 w) { return __uint_as_float(w & 0xffff0000u); }
__device__ __forceinline__ float gelu_t(float x) { float y = 1.5957691216057308f * (x + 0.044715f * x * x * x); return x * __builtin_amdgcn_rcpf(1.0f + __expf(-y)); }
__device__ __forceinline__ float silu_f(float x) { return x * __builtin_amdgcn_rcpf(1.0f + __expf(-x)); }
__device__ __forceinline__ float sigm_f(float x) { return __builtin_amdgcn_rcpf(1.0f + __expf(-x)); }
__device__ __forceinline__ f32x4 mfma16(bf16x8 a, bf16x8 b, f32x4 c) { return __builtin_amdgcn_mfma_f32_16x16x32_bf16(a, b, c, 0, 0, 0); }
__device__ __forceinline__ bf16x8 ld8(const u16* p) { return *(const bf16x8*)p; }
__device__ __forceinline__ bf16x8 ld44(const u16* p0, const u16* p1) {
  bf16x4 a = *(const bf16x4*)p0, b = *(const bf16x4*)p1;
  return __builtin_shufflevector(a, b, 0, 1, 2, 3, 4, 5, 6, 7);
}
__device__ __forceinline__ bf16x8 pk8(float a0, float a1, float a2, float a3, float a4, float a5, float a6, float a7) {
  union { uint4 u; bf16x8 v; } x;
  x.u = make_uint4(pack2(a0, a1), pack2(a2, a3), pack2(a4, a5), pack2(a6, a7));
  return x.v;
}
__device__ __forceinline__ bf16x8 scale8(bf16x8 v, float s) {
  union { uint4 u; bf16x8 v; } x; x.v = v;
  x.u.x = pack2(lo2f(x.u.x) * s, hi2f(x.u.x) * s); x.u.y = pack2(lo2f(x.u.y) * s, hi2f(x.u.y) * s);
  x.u.z = pack2(lo2f(x.u.z) * s, hi2f(x.u.z) * s); x.u.w = pack2(lo2f(x.u.w) * s, hi2f(x.u.w) * s);
  return x.v;
}
__device__ __forceinline__ void wave_lds_sync() { asm volatile("s_waitcnt lgkmcnt(0)" ::: "memory"); }

__device__ __forceinline__ int tid_fresh() { int t = threadIdx.x; asm volatile("" : "+v"(t)); return t; }
__device__ __forceinline__ int wmap(int n, int mode) {
  if (mode == 0) return n;
  int isb = n >= FF; int nn = isb ? n - FF : n;
  return (nn >> 4) * 32 + isb * 16 + (nn & 15);
}
__device__ __forceinline__ void wprep_matrix(const float* __restrict__ src, u16* __restrict__ dst, int K, int N, int mode, u16* smem, int vb, int nvb) {
  float* T = (float*)smem;
  const int tid = tid_fresh() & 255;
  const int tk = K >> 6, tn = (N + 63) >> 6, nt = tk * tn;
  for (int t = vb; t < nt; t += nvb) {
    const int k0 = (t % tk) * 64, n0 = (t / tk) * 64;
#pragma unroll
    for (int i = 0; i < 4; i++) {
      int kk = (tid >> 4) + 16 * i, n = n0 + (tid & 15) * 4;
      float4 v = make_float4(0.f, 0.f, 0.f, 0.f);
      if (n < N) v = *(const float4*)(src + (size_t)(k0 + kk) * N + n);
      float* tp = T + kk * 65 + (tid & 15) * 4;
      tp[0] = v.x; tp[1] = v.y; tp[2] = v.z; tp[3] = v.w;
    }
    __syncthreads();
    {
      int n = tid >> 2, kc = (tid & 3) * 16, nn = n0 + n;
      if (nn < N) {
        u32 w[8];
#pragma unroll
        for (int e = 0; e < 8; e++) w[e] = pack2(T[(kc + 2 * e) * 65 + n], T[(kc + 2 * e + 1) * 65 + n]);
        u16* dp = dst + (size_t)wmap(nn, mode) * K + k0 + kc;
        *(uint4*)dp = make_uint4(w[0], w[1], w[2], w[3]);
        *(uint4*)(dp + 8) = make_uint4(w[4], w[5], w[6], w[7]);
      }
    }
    __syncthreads();
  }
}
__device__ __forceinline__ void wprep_phase(const Params& p, int l, u16* smem, int vb, int nvb, bool skip_ffn1, bool skip_ffn2) {
  if (!skip_ffn1) wprep_matrix(p.ffn1_w1 + (size_t)l * 1024 * 5632, p.w1t_a, 1024, 5632, 1, smem, vb, nvb);
  if (!skip_ffn2) wprep_matrix(p.ffn2_w1 + (size_t)l * 1024 * 5632, p.w1t_b, 1024, 5632, 1, smem, vb, nvb);
  if (!skip_ffn1) wprep_matrix(p.ffn1_w2 + (size_t)l * FF * 1024, p.w2t_a, FF, 1024, 0, smem, vb, nvb);
  if (!skip_ffn2) wprep_matrix(p.ffn2_w2 + (size_t)l * FF * 1024, p.w2t_b, FF, 1024, 0, smem, vb, nvb);
  wprep_matrix(p.w_in + (size_t)l * 1024 * DIN, p.wint, 1024, DIN, 0, smem, vb, nvb);
  wprep_matrix(p.w_gate + (size_t)l * 1024 * 3072, p.wgt, 1024, 3072, 0, smem, vb, nvb);
  for (int m = 0; m < 3; m++)
    wprep_matrix(p.w_branch + (size_t)(l * 3 + m) * 512 * 1024, p.wbt + (size_t)m * 1024 * 512, 512, 1024, 0, smem, vb, nvb);
  wprep_matrix(p.w_o + (size_t)l * 1024 * 1024, p.wot, 1024, 1024, 0, smem, vb, nvb);
  for (int w = 0; w < 2; w++) {
    wprep_matrix(p.cmp_w1 + (size_t)(l * 2 + w) * 2048 * 128, p.cw1t + (size_t)w * 128 * 2048, 2048, 128, 0, smem, vb, nvb);
    wprep_matrix(p.cmp_w2 + (size_t)(l * 2 + w) * 128 * 64, p.cw2t + (size_t)w * 64 * 128, 128, 64, 0, smem, vb, nvb);
  }
}

__device__ __forceinline__ void norm_phase(const float* __restrict__ x, const float* __restrict__ g, u16* __restrict__ H) {
  const int tidf = tid_fresh();
  const int lane = tidf & 63;
  const int gw = blockIdx.x * 8 + (tidf >> 6), nw = gridDim.x * 8;
  float4 gg[4];
#pragma unroll
  for (int i = 0; i < 4; i++) gg[i] = ((const float4*)g)[lane + 64 * i];
  for (int row0 = gw * 4; row0 < S; row0 += nw * 4) {
    float4 v[4][4]; float ss[4];
#pragma unroll
    for (int rr = 0; rr < 4; rr++)
#pragma unroll
      for (int i = 0; i < 4; i++) v[rr][i] = ((const float4*)(x + (size_t)(row0 + rr) * 1024))[lane + 64 * i];
#pragma unroll
    for (int rr = 0; rr < 4; rr++) {
      float a = 0.f;
#pragma unroll
      for (int i = 0; i < 4; i++) a += v[rr][i].x * v[rr][i].x + v[rr][i].y * v[rr][i].y + v[rr][i].z * v[rr][i].z + v[rr][i].w * v[rr][i].w;
      ss[rr] = a;
    }
#pragma unroll
    for (int o = 32; o >= 1; o >>= 1)
#pragma unroll
      for (int rr = 0; rr < 4; rr++) ss[rr] += __shfl_xor(ss[rr], o);
#pragma unroll
    for (int rr = 0; rr < 4; rr++) {
      const float r = rsqrtf(ss[rr] * (1.0f / 1024.0f) + EPS);
#pragma unroll
      for (int i = 0; i < 4; i++) {
        uint2 o2 = make_uint2(pack2(v[rr][i].x * r * gg[i].x, v[rr][i].y * r * gg[i].y), pack2(v[rr][i].z * r * gg[i].z, v[rr][i].w * r * gg[i].w));
        *(uint2*)(H + (size_t)(row0 + rr) * 1024 + (lane + 64 * i) * 4) = o2;
      }
    }
  }
}
__device__ __forceinline__ void final_norm_phase(float* __restrict__ x, const float* __restrict__ g) {
  const int tidf = tid_fresh();
  const int lane = tidf & 63;
  const int gw = blockIdx.x * 8 + (tidf >> 6), nw = gridDim.x * 8;
  float4 gg[4];
#pragma unroll
  for (int i = 0; i < 4; i++) gg[i] = ((const float4*)g)[lane + 64 * i];
  for (int row0 = gw * 4; row0 < S; row0 += nw * 4) {
    float4 v[4][4]; float ss[4];
#pragma unroll
    for (int rr = 0; rr < 4; rr++)
#pragma unroll
      for (int i = 0; i < 4; i++) v[rr][i] = ((const float4*)(x + (size_t)(row0 + rr) * 1024))[lane + 64 * i];
#pragma unroll
    for (int rr = 0; rr < 4; rr++) {
      float a = 0.f;
#pragma unroll
      for (int i = 0; i < 4; i++) a += v[rr][i].x * v[rr][i].x + v[rr][i].y * v[rr][i].y + v[rr][i].z * v[rr][i].z + v[rr][i].w * v[rr][i].w;
      ss[rr] = a;
    }
#pragma unroll
    for (int o = 32; o >= 1; o >>= 1)
#pragma unroll
      for (int rr = 0; rr < 4; rr++) ss[rr] += __shfl_xor(ss[rr], o);
#pragma unroll
    for (int rr = 0; rr < 4; rr++) {
      const float r = rsqrtf(ss[rr] * (1.0f / 1024.0f) + EPS);
#pragma unroll
      for (int i = 0; i < 4; i++)
        ((float4*)(x + (size_t)(row0 + rr) * 1024))[lane + 64 * i] = make_float4(v[rr][i].x * r * gg[i].x, v[rr][i].y * r * gg[i].y, v[rr][i].z * r * gg[i].z, v[rr][i].w * r * gg[i].w);
    }
  }
}

#define LAS __attribute__((address_space(3)))
constexpr int G_BK = 64, G_HALF = 128, G_HTB = G_HALF * G_BK * 2, G_NXCD = 8, G_WGM = 8;
__device__ __forceinline__ int lds_byte(int r, int c) { const int st = (r >> 4) * 2 + (c >> 5), rr = r & 15, cc = c & 31, ob = rr * 64 + cc * 2; return st * 1024 + (ob ^ (((ob >> 9) & 1) << 5)); }
__device__ __forceinline__ void stage_rc(int b, int& R, int& C) { const int st = b / 1024, sb = b % 1024, swz = sb ^ (((sb >> 9) & 1) << 5); R = (st >> 1) * 16 + swz / 64; C = (st & 1) * 32 + (swz % 64) / 2; }
__device__ __forceinline__ int perm32(int rho) { const int n = rho >> 4, i = rho & 15; return 8 * (i >> 2) + 4 * n + (i & 3); }
struct Unit { int pm, pn; };
struct Gemm { const u16* A; const u16* Bt; int lda, ldb, M, N, K; };
struct StaticOrder {
  int nM, nN, nwg, G, c;
  __device__ void init(int M, int N, int G_, int c_) { nM = M / 256; nN = N / 256; nwg = nM * nN; G = G_; c = c_; }
  __device__ bool next(int i, Unit& u) const {
    const long L = (long)i * G + c; if (L >= nwg) return false;
    int wgid = (int)L; { const int q = nwg / G_NXCD, r = nwg % G_NXCD, xcd = wgid % G_NXCD, off = wgid / G_NXCD; wgid = (xcd < r ? xcd * (q + 1) : r * (q + 1) + (xcd - r) * q) + off; }
    const int nig = G_WGM * nN, gid = wgid / nig, fm = gid * G_WGM, gsz = (nM - fm) < G_WGM ? (nM - fm) : G_WGM;
    u.pm = fm + ((wgid % nig) % gsz); u.pn = (wgid % nig) / gsz; return true;
  }
};
typedef f32x4 AccT[2][2][4][2];
struct EpiSwiglu {
  static constexpr bool PERM = false;
  u16* ACT;
  __device__ __forceinline__ void operator()(const AccT& acc, const Unit& u, int wr, int wc, int fr, int fq) const {
    typedef unsigned u32x2s __attribute__((ext_vector_type(2)));
    const int row0 = u.pm * 256 + wr * 64 + fr;
    const int colw = u.pn * 128 + wc * 16 + ((fq & 1) ? 64 + 4 * (fq - 1) : 4 * fq);
#pragma unroll
    for (int ai = 0; ai < 2; ++ai)
#pragma unroll
      for (int m = 0; m < 4; ++m) {
        u16* rowp = ACT + (size_t)(row0 + ai * 128 + m * 16) * FF + colw;
        const f32x4 a0 = acc[ai][0][m][0], b0 = acc[ai][0][m][1], a1 = acc[ai][1][m][0], b1 = acc[ai][1][m][1];
        const u32 p0x = pack2(silu_f(a0[0]) * b0[0], silu_f(a0[1]) * b0[1]), p0y = pack2(silu_f(a0[2]) * b0[2], silu_f(a0[3]) * b0[3]);
        const u32 p1x = pack2(silu_f(a1[0]) * b1[0], silu_f(a1[1]) * b1[1]), p1y = pack2(silu_f(a1[2]) * b1[2], silu_f(a1[3]) * b1[3]);
        const u32x2s rx = __builtin_amdgcn_permlane16_swap(p0x, p1x, false, false);
        const u32x2s ry = __builtin_amdgcn_permlane16_swap(p0y, p1y, false, false);
        *(uint4*)rowp = make_uint4(rx.x, ry.x, rx.y, ry.y);
      }
  }
};
struct EpiResid {
  static constexpr bool PERM = false;
  const float* xsrc; float* xdst; float scale;
  __device__ __forceinline__ void operator()(const AccT& acc, const Unit& u, int wr, int wc, int fr, int fq) const {
    const int row0 = u.pm * 256 + wr * 64 + fr, col0 = u.pn * 256 + wc * 32 + 4 * fq;
#pragma unroll
    for (int ai = 0; ai < 2; ++ai) {
      f32x4 xv[4][2][2];
#pragma unroll
      for (int m = 0; m < 4; ++m)
#pragma unroll
        for (int bj = 0; bj < 2; ++bj)
#pragma unroll
          for (int n = 0; n < 2; ++n)
            xv[m][bj][n] = *(const f32x4*)(xsrc + (size_t)(row0 + ai * 128 + m * 16) * 1024 + col0 + bj * 128 + n * 16);
#pragma unroll
      for (int m = 0; m < 4; ++m)
#pragma unroll
        for (int bj = 0; bj < 2; ++bj)
#pragma unroll
          for (int n = 0; n < 2; ++n)
            *(f32x4*)(xdst + (size_t)(row0 + ai * 128 + m * 16) * 1024 + col0 + bj * 128 + n * 16) = xv[m][bj][n] + scale * acc[ai][bj][m][n];
    }
  }
};
struct EpiProj {
  static constexpr bool PERM = true;
  u16* proj;
  __device__ __forceinline__ void operator()(const AccT& acc, const Unit& u, int wr, int wc, int fr, int fq) const {
    const int row0 = u.pm * 256 + wr * 64 + fr, col0 = u.pn * 256 + wc * 32 + 8 * fq;
#pragma unroll
    for (int ai = 0; ai < 2; ++ai)
#pragma unroll
      for (int m = 0; m < 4; ++m) {
        u16* rowp = proj + (size_t)(row0 + ai * 128 + m * 16) * PS;
#pragma unroll
        for (int bj = 0; bj < 2; ++bj) {
          const int col = col0 + bj * 128;
          const f32x4 a = acc[ai][bj][m][0], b = acc[ai][bj][m][1];
          if (col < DIN) *(uint4*)(rowp + col) = make_uint4(pack2(a[0], a[1]), pack2(a[2], a[3]), pack2(b[0], b[1]), pack2(b[2], b[3]));
        }
      }
  }
};
struct EpiGate {
  static constexpr bool PERM = true;
  u16* gst; const float* bias; int tid;
  __device__ __forceinline__ void operator()(const AccT& acc, const Unit& u, int wr, int wc, int fr, int fq) const {
    u16* st = gst + (size_t)(u.pm * 4 + u.pn) * 65536 + tid * 8;
    const int col0 = u.pn * 256 + wc * 32 + 8 * fq;
#pragma unroll
    for (int bj = 0; bj < 2; ++bj) {
      const f32x4 b0 = *(const f32x4*)(bias + col0 + bj * 128), b1 = *(const f32x4*)(bias + col0 + bj * 128 + 4);
#pragma unroll
      for (int ai = 0; ai < 2; ++ai)
#pragma unroll
        for (int m = 0; m < 4; ++m) {
          const f32x4 a = acc[ai][bj][m][0] + b0, b = acc[ai][bj][m][1] + b1;
          *(uint4*)(st + ((ai * 2 + bj) * 4 + m) * 4096) = make_uint4(pack2(sigm_f(a[0]), sigm_f(a[1])), pack2(sigm_f(a[2]), sigm_f(a[3])),
                                                                     pack2(sigm_f(b[0]), sigm_f(b[1])), pack2(sigm_f(b[2]), sigm_f(b[3])));
        }
    }
  }
};
struct EpiBranch {
  static constexpr bool PERM = true;
  const u16* gst; u16* mix; int first; int tid;
  __device__ __forceinline__ void operator()(const AccT& acc, const Unit& u, int wr, int wc, int fr, int fq) const {
    const u16* st = gst + (size_t)(u.pm * 4 + u.pn) * 65536 + tid * 8;
    const int row0 = u.pm * 256 + wr * 64 + fr, col0 = u.pn * 256 + wc * 32 + 8 * fq;
#pragma unroll
    for (int ai = 0; ai < 2; ++ai) {
      uint4 gw[4][2], ov[4][2];
#pragma unroll
      for (int m = 0; m < 4; ++m)
#pragma unroll
        for (int bj = 0; bj < 2; ++bj) {
          gw[m][bj] = *(const uint4*)(st + ((ai * 2 + bj) * 4 + m) * 4096);
          ov[m][bj] = first ? make_uint4(0u, 0u, 0u, 0u) : *(const uint4*)(mix + (size_t)(row0 + ai * 128 + m * 16) * PS + col0 + bj * 128);
        }
#pragma unroll
      for (int m = 0; m < 4; ++m)
#pragma unroll
        for (int bj = 0; bj < 2; ++bj) {
          const uint4 g = gw[m][bj], o = ov[m][bj];
          const f32x4 a = acc[ai][bj][m][0], b = acc[ai][bj][m][1];
          const float v0 = lo2f(g.x) * a[0] + lo2f(o.x), v1 = hi2f(g.x) * a[1] + hi2f(o.x), v2 = lo2f(g.y) * a[2] + lo2f(o.y), v3 = hi2f(g.y) * a[3] + hi2f(o.y);
          const float v4 = lo2f(g.z) * b[0] + lo2f(o.z), v5 = hi2f(g.z) * b[1] + hi2f(o.z), v6 = lo2f(g.w) * b[2] + lo2f(o.w), v7 = hi2f(g.w) * b[3] + hi2f(o.w);
          *(uint4*)(mix + (size_t)(row0 + ai * 128 + m * 16) * PS + col0 + bj * 128) = make_uint4(pack2(v0, v1), pack2(v2, v3), pack2(v4, v5), pack2(v6, v7));
        }
    }
  }
};

template <class Epi, bool AFTER_DRAIN = false>
__device__ __forceinline__ void gemm_phase(LAS unsigned char* lds, const Gemm g, const Epi& E) {
  const int tid = tid_fresh(), wid = __builtin_amdgcn_readfirstlane(tid >> 6), lane = tid & 63, wr = wid >> 2, wc = wid & 3, fr = lane & 15, fq = lane >> 4;
  const int K = g.K, nt = K / G_BK;
  StaticOrder S; S.init(g.M, g.N, (int)gridDim.x, (int)blockIdx.x);
  unsigned voffA[2], voffB[2];
#pragma unroll
  for (int i = 0; i < 2; ++i) { int R, C; stage_rc(tid * 16 + i * 8192, R, C); const int Rb = Epi::PERM ? ((R & ~31) + perm32(R & 31)) : R;
    voffA[i] = (unsigned)(R * g.lda + C) * 2u; voffB[i] = (unsigned)(Rb * g.ldb + C) * 2u; }
  const size_t kstep = (size_t)(G_BK * 2);
  const size_t hstepA = (size_t)G_HALF * g.lda * 2, hstepB = (size_t)G_HALF * g.ldb * 2;
  const size_t tstepA = 2 * hstepA, tstepB = 2 * hstepB;
  const unsigned ldsw = (unsigned)wid * 1024u;
  const int aoff = lds_byte(wr * 64 + fr, fq * 8), boff = lds_byte(wc * 32 + fr, fq * 8);
#define PG8_SA(b, h) (((b) * 2 + (h)) * G_HTB)
#define PG8_SB(b, h) ((4 + (b) * 2 + (h)) * G_HTB)
#define PG8_STAGE(bufoff, gbase, voff) do { _Pragma("unroll") for (int _i = 0; _i < 2; ++_i) \
    __builtin_amdgcn_global_load_lds((const unsigned*)((const char*)(gbase) + (voff)[_i]), (LAS unsigned*)(lds + (bufoff) + ldsw + _i * 8192), 16, 0, 0); } while (0)
#define PG8_LDA(dst, b, h) do { _Pragma("unroll") for (int m = 0; m < 4; ++m) _Pragma("unroll") for (int k = 0; k < 2; ++k) dst[m][k] = *(const LAS bf16x8*)(lds + PG8_SA(b, h) + aoff + m * 2048 + k * 1024); } while (0)
#define PG8_LDB(dst, b, h) do { _Pragma("unroll") for (int n = 0; n < 2; ++n) _Pragma("unroll") for (int k = 0; k < 2; ++k) dst[n][k] = *(const LAS bf16x8*)(lds + PG8_SB(b, h) + boff + n * 2048 + k * 1024); } while (0)
#define PG8_MMA(ai, bj, At, Bt) do { __builtin_amdgcn_s_setprio(1); _Pragma("unroll") for (int m = 0; m < 4; ++m) _Pragma("unroll") for (int n = 0; n < 2; ++n) _Pragma("unroll") for (int k = 0; k < 2; ++k) \
    acc[ai][bj][m][n] = __builtin_amdgcn_mfma_f32_16x16x32_bf16(Bt[n][k], At[m][k], acc[ai][bj][m][n], 0, 0, 0); __builtin_amdgcn_s_setprio(0); } while (0)
#define PG8_WAIT_V(n) asm volatile("s_waitcnt vmcnt(" #n ")" ::: "memory")
#define PG8_WAIT_L(n) asm volatile("s_waitcnt lgkmcnt(" #n ")" ::: "memory")
#define PG8_BAR __builtin_amdgcn_s_barrier()
#define PG8_SCHED __builtin_amdgcn_sched_barrier(0)
  Unit cur, nxt; int ui = 0;
  if (!S.next(0, cur)) return;
  AccT acc;
#pragma unroll
  for (int a = 0; a < 2; ++a)
#pragma unroll
    for (int b = 0; b < 2; ++b)
#pragma unroll
      for (int m = 0; m < 4; ++m)
#pragma unroll
        for (int n = 0; n < 2; ++n) acc[a][b][m][n] = (f32x4){0.f, 0.f, 0.f, 0.f};
  bf16x8 At[4][2], B0[2][2], B1[2][2];
  const char* cA = (const char*)g.A + (size_t)cur.pm * tstepA; const char* cB = (const char*)g.Bt + (size_t)cur.pn * tstepB;
  PG8_STAGE(PG8_SB(0, 0), cB, voffB); PG8_STAGE(PG8_SA(0, 0), cA, voffA); PG8_STAGE(PG8_SB(0, 1), cB + hstepB, voffB); PG8_STAGE(PG8_SA(0, 1), cA + hstepA, voffA);
  if (wr == 1) PG8_BAR;
  PG8_WAIT_V(4); PG8_BAR;
  PG8_STAGE(PG8_SB(1, 0), cB + kstep, voffB); PG8_STAGE(PG8_SA(1, 0), cA + kstep, voffA); PG8_STAGE(PG8_SB(1, 1), cB + hstepB + kstep, voffB);
  PG8_WAIT_V(6); PG8_BAR;
  for (;;) {
    const bool has_next = S.next(ui + 1, nxt);
    const char* nA = has_next ? (const char*)g.A + (size_t)nxt.pm * tstepA : cA; const char* nB = has_next ? (const char*)g.Bt + (size_t)nxt.pn * tstepB : cB;
    for (int t = 0; t < nt; t += 2) {
      const bool last = (t == nt - 2);
      const char* a1 = cA + (size_t)(t + 1) * kstep;
      const char* a2 = last ? nA : cA + (size_t)(t + 2) * kstep; const char* b2 = last ? nB : cB + (size_t)(t + 2) * kstep;
      const char* a3 = a2 + kstep; const char* b3 = b2 + kstep;
      PG8_LDB(B0, 0, 0); PG8_SCHED; PG8_LDA(At, 0, 0); PG8_STAGE(PG8_SA(1, 1), a1 + hstepA, voffA);
      PG8_WAIT_L(8); PG8_BAR; PG8_WAIT_L(0); PG8_MMA(0, 0, At, B0); PG8_BAR; PG8_SCHED;
      PG8_LDB(B1, 0, 1); PG8_STAGE(PG8_SB(0, 0), b2, voffB);
      PG8_BAR; PG8_WAIT_L(0); PG8_MMA(0, 1, At, B1); PG8_BAR;
      PG8_LDA(At, 0, 1); PG8_STAGE(PG8_SA(0, 0), a2, voffA);
      PG8_BAR; PG8_WAIT_L(0); PG8_MMA(1, 0, At, B0); PG8_BAR; PG8_SCHED;
      PG8_STAGE(PG8_SB(0, 1), b2 + hstepB, voffB);
      PG8_WAIT_V(6); PG8_BAR; PG8_MMA(1, 1, At, B1); PG8_BAR;
      PG8_LDB(B0, 1, 0); PG8_SCHED; PG8_LDA(At, 1, 0); PG8_STAGE(PG8_SA(0, 1), a2 + hstepA, voffA);
      PG8_WAIT_L(8); PG8_BAR; PG8_WAIT_L(0); PG8_MMA(0, 0, At, B0); PG8_BAR; PG8_SCHED;
      PG8_LDB(B1, 1, 1); PG8_STAGE(PG8_SB(1, 0), b3, voffB);
      PG8_BAR; PG8_WAIT_L(0); PG8_MMA(0, 1, At, B1); PG8_BAR;
      PG8_LDA(At, 1, 1); PG8_STAGE(PG8_SA(1, 0), a3, voffA);
      PG8_BAR; PG8_WAIT_L(0); PG8_MMA(1, 0, At, B0); PG8_BAR; PG8_SCHED;
      PG8_STAGE(PG8_SB(1, 1), b3 + hstepB, voffB);
      PG8_WAIT_V(6); PG8_BAR; PG8_MMA(1, 1, At, B1); PG8_BAR;
    }
    if constexpr (!AFTER_DRAIN) E(acc, cur, wr, wc, fr, fq);
    if (!has_next) break;
#pragma unroll
    for (int a = 0; a < 2; ++a)
#pragma unroll
      for (int b = 0; b < 2; ++b)
#pragma unroll
        for (int m = 0; m < 4; ++m)
#pragma unroll
          for (int n = 0; n < 2; ++n) acc[a][b][m][n] = (f32x4){0.f, 0.f, 0.f, 0.f};
    cur = nxt; cA = nA; cB = nB; ++ui;
  }
  PG8_WAIT_V(0);
  if (wr == 0) PG8_BAR;
  PG8_BAR;
  if constexpr (AFTER_DRAIN) E.fused(acc, cur, wr, wc, fr, fq, lds);
#undef PG8_SA
#undef PG8_SB
#undef PG8_STAGE
#undef PG8_LDA
#undef PG8_LDB
#undef PG8_MMA
#undef PG8_WAIT_V
#undef PG8_WAIT_L
#undef PG8_BAR
#undef PG8_SCHED
}

struct ChainStep { const char* A; const char* B; unsigned lda2, ldb2; int nt; };
__device__ __forceinline__ ChainStep merge_step(const Params& p, int q, const Unit& u) {
  const int s6 = q % 6, br = s6 >> 1;
  ChainStep c;
  if ((s6 & 1) == 0) {
    c.A = (const char*)(p.H + (size_t)u.pm * 256 * 1024); c.lda2 = 2048u;
    c.B = (const char*)(p.wgt + (size_t)(br * 1024 + u.pn * 256) * 1024); c.ldb2 = 2048u; c.nt = 16;
  } else {
    const int ycol = br == 0 ? C_U : (br == 1 ? C_RG : C_NQ);
    c.A = (const char*)(p.BIG + ycol + (size_t)u.pm * 256 * PS); c.lda2 = (unsigned)PS * 2u;
    c.B = (const char*)(p.wbt + (size_t)(br * 1024 + u.pn * 256) * 512); c.ldb2 = 1024u; c.nt = 8;
  }
  return c;
}
__device__ __forceinline__ void gemm_merge_chain(LAS unsigned char* lds, const Params& p, int l) {
  const int tid = tid_fresh(), wid = __builtin_amdgcn_readfirstlane(tid >> 6), lane = tid & 63, wr = wid >> 2, wc = wid & 3, fr = lane & 15, fq = lane >> 4;
  StaticOrder S; S.init(16384, 1024, (int)gridDim.x, (int)blockIdx.x);
  unsigned rA[2], c2[2];
#pragma unroll
  for (int i = 0; i < 2; ++i) { int R, C; stage_rc(tid * 16 + i * 8192, R, C); rA[i] = (unsigned)R; c2[i] = (unsigned)C * 2u; }
  const size_t kstep = (size_t)(G_BK * 2);
  const unsigned ldsw = (unsigned)wid * 1024u;
  const int aoff = lds_byte(wr * 64 + fr, fq * 8), boff = lds_byte(wc * 32 + fr, fq * 8);
#define PG8_SA(b, h) (((b) * 2 + (h)) * G_HTB)
#define PG8_SB(b, h) ((4 + (b) * 2 + (h)) * G_HTB)
#define CH_ROW_rA(i) (rA[i])
#define CH_ROW_rB(i) ((rA[i] & ~31u) + (unsigned)perm32((int)(rA[i] & 31u)))
#define CH_STAGE(bufoff, gbase, rr, ld2) do { _Pragma("unroll") for (int _i = 0; _i < 2; ++_i) \
    __builtin_amdgcn_global_load_lds((const unsigned*)((const char*)(gbase) + (CH_ROW_##rr(_i) * (ld2) + c2[_i])), (LAS unsigned*)(lds + (bufoff) + ldsw + _i * 8192), 16, 0, 0); } while (0)
#define PG8_LDA(dst, b, h) do { _Pragma("unroll") for (int m = 0; m < 4; ++m) _Pragma("unroll") for (int k = 0; k < 2; ++k) dst[m][k] = *(const LAS bf16x8*)(lds + PG8_SA(b, h) + aoff + m * 2048 + k * 1024); } while (0)
#define PG8_LDB(dst, b, h) do { _Pragma("unroll") for (int n = 0; n < 2; ++n) _Pragma("unroll") for (int k = 0; k < 2; ++k) dst[n][k] = *(const LAS bf16x8*)(lds + PG8_SB(b, h) + boff + n * 2048 + k * 1024); } while (0)
#define PG8_MMA(ai, bj, At, Bt) do { __builtin_amdgcn_s_setprio(1); _Pragma("unroll") for (int m = 0; m < 4; ++m) _Pragma("unroll") for (int n = 0; n < 2; ++n) _Pragma("unroll") for (int k = 0; k < 2; ++k) \
    acc[ai][bj][m][n] = __builtin_amdgcn_mfma_f32_16x16x32_bf16(Bt[n][k], At[m][k], acc[ai][bj][m][n], 0, 0, 0); __builtin_amdgcn_s_setprio(0); } while (0)
#define PG8_WAIT_V(n) asm volatile("s_waitcnt vmcnt(" #n ")" ::: "memory")
#define PG8_WAIT_L(n) asm volatile("s_waitcnt lgkmcnt(" #n ")" ::: "memory")
#define PG8_BAR __builtin_amdgcn_s_barrier()
#define PG8_SCHED __builtin_amdgcn_sched_barrier(0)
  Unit cu, nu; int q = 0;
  if (!S.next(0, cu)) return;
  ChainStep cs = merge_step(p, 0, cu), ns;
  AccT acc;
#pragma unroll
  for (int a = 0; a < 2; ++a)
#pragma unroll
    for (int b = 0; b < 2; ++b)
#pragma unroll
      for (int m = 0; m < 4; ++m)
#pragma unroll
        for (int n = 0; n < 2; ++n) acc[a][b][m][n] = (f32x4){0.f, 0.f, 0.f, 0.f};
  bf16x8 At[4][2], B0[2][2], B1[2][2];
  {
    const size_t hA = (size_t)G_HALF * cs.lda2, hB = (size_t)G_HALF * cs.ldb2;
    CH_STAGE(PG8_SB(0, 0), cs.B, rB, cs.ldb2); CH_STAGE(PG8_SA(0, 0), cs.A, rA, cs.lda2); CH_STAGE(PG8_SB(0, 1), cs.B + hB, rB, cs.ldb2); CH_STAGE(PG8_SA(0, 1), cs.A + hA, rA, cs.lda2);
    if (wr == 1) PG8_BAR;
    PG8_WAIT_V(4); PG8_BAR;
    CH_STAGE(PG8_SB(1, 0), cs.B + kstep, rB, cs.ldb2); CH_STAGE(PG8_SA(1, 0), cs.A + kstep, rA, cs.lda2); CH_STAGE(PG8_SB(1, 1), cs.B + hB + kstep, rB, cs.ldb2);
    PG8_WAIT_V(6); PG8_BAR;
  }
  for (;;) {
    bool has_next;
    if ((q + 1) % 6 != 0) { nu = cu; has_next = true; } else has_next = S.next((q + 1) / 6, nu);
    ns = has_next ? merge_step(p, q + 1, nu) : cs;
    const size_t hA = (size_t)G_HALF * cs.lda2, hB = (size_t)G_HALF * cs.ldb2;
    const size_t nhA = (size_t)G_HALF * ns.lda2, nhB = (size_t)G_HALF * ns.ldb2;
    const int nt = cs.nt;
    for (int t = 0; t < nt; t += 2) {
      const bool last = (t == nt - 2);
      const char* a1 = cs.A + (size_t)(t + 1) * kstep;
      const char* a2 = last ? ns.A : cs.A + (size_t)(t + 2) * kstep; const char* b2 = last ? ns.B : cs.B + (size_t)(t + 2) * kstep;
      const char* a3 = a2 + kstep; const char* b3 = b2 + kstep;
      const unsigned la2 = last ? ns.lda2 : cs.lda2, lb2 = last ? ns.ldb2 : cs.ldb2;
      const size_t hA2 = last ? nhA : hA, hB2 = last ? nhB : hB;
      PG8_LDB(B0, 0, 0); PG8_SCHED; PG8_LDA(At, 0, 0); CH_STAGE(PG8_SA(1, 1), a1 + hA, rA, cs.lda2);
      PG8_WAIT_L(8); PG8_BAR; PG8_WAIT_L(0); PG8_MMA(0, 0, At, B0); PG8_BAR; PG8_SCHED;
      PG8_LDB(B1, 0, 1); CH_STAGE(PG8_SB(0, 0), b2, rB, lb2);
      PG8_BAR; PG8_WAIT_L(0); PG8_MMA(0, 1, At, B1); PG8_BAR;
      PG8_LDA(At, 0, 1); CH_STAGE(PG8_SA(0, 0), a2, rA, la2);
      PG8_BAR; PG8_WAIT_L(0); PG8_MMA(1, 0, At, B0); PG8_BAR; PG8_SCHED;
      CH_STAGE(PG8_SB(0, 1), b2 + hB2, rB, lb2);
      PG8_WAIT_V(6); PG8_BAR; PG8_MMA(1, 1, At, B1); PG8_BAR;
      PG8_LDB(B0, 1, 0); PG8_SCHED; PG8_LDA(At, 1, 0); CH_STAGE(PG8_SA(0, 1), a2 + hA2, rA, la2);
      PG8_WAIT_L(8); PG8_BAR; PG8_WAIT_L(0); PG8_MMA(0, 0, At, B0); PG8_BAR; PG8_SCHED;
      PG8_LDB(B1, 1, 1); CH_STAGE(PG8_SB(1, 0), b3, rB, lb2);
      PG8_BAR; PG8_WAIT_L(0); PG8_MMA(0, 1, At, B1); PG8_BAR;
      PG8_LDA(At, 1, 1); CH_STAGE(PG8_SA(1, 0), a3, rA, la2);
      PG8_BAR; PG8_WAIT_L(0); PG8_MMA(1, 0, At, B0); PG8_BAR; PG8_SCHED;
      CH_STAGE(PG8_SB(1, 1), b3 + hB2, rB, lb2);
      PG8_WAIT_V(6); PG8_BAR; PG8_MMA(1, 1, At, B1); PG8_BAR;
    }
    {
      const int s6 = q % 6, br = s6 >> 1;
      if ((s6 & 1) == 0) { EpiGate e{p.gst, p.b_gate + (size_t)l * 3072 + br * 1024, tid}; e(acc, cu, wr, wc, fr, fq); }
      else { EpiBranch e{p.gst, p.BIG + C_MIX, br == 0, tid}; e(acc, cu, wr, wc, fr, fq); }
    }
    if (!has_next) break;
#pragma unroll
    for (int a = 0; a < 2; ++a)
#pragma unroll
      for (int b = 0; b < 2; ++b)
#pragma unroll
        for (int m = 0; m < 4; ++m)
#pragma unroll
          for (int n = 0; n < 2; ++n) acc[a][b][m][n] = (f32x4){0.f, 0.f, 0.f, 0.f};
    cu = nu; cs = ns; ++q;
  }
  PG8_WAIT_V(0);
  if (wr == 0) PG8_BAR;
  PG8_BAR;
#undef PG8_SA
#undef PG8_SB
#undef CH_STAGE
#undef CH_ROW_rA
#undef CH_ROW_rB
#undef PG8_LDA
#undef PG8_LDB
#undef PG8_MMA
#undef PG8_WAIT_V
#undef PG8_WAIT_L
#undef PG8_BAR
#undef PG8_SCHED
}

__device__ __forceinline__ void gmlp_tile(const Params& p, int l, int tile, u16* smem) {
  const int c = tile >> 2, g = tile & 3, t0 = c * 128;
  u16* Ws = smem; u16* vT = smem + 128 * 136;
  const int tid = tid_fresh() & 255, lane = tid & 63, wave = tid >> 6, wm = wave >> 1, wn = wave & 1, lr = lane & 15, lq = lane >> 4;
  const int tok = tid >> 1, half = tid & 1;
  u16* prow = p.BIG + (size_t)(t0 + tok) * PS;
  float s = 0.f, ss = 0.f;
#pragma unroll 8
  for (int i = 0; i < 32; i++) {
    uint4 raw = *(const uint4*)(prow + C_V + half * 256 + i * 8);
    u32 w[4] = {raw.x, raw.y, raw.z, raw.w};
#pragma unroll
    for (int e = 0; e < 4; e++) { float a = gelu_t(lo2f(w[e])), b = gelu_t(hi2f(w[e])); s += a + b; ss += a * a + b * b; }
  }
  s += __shfl_xor(s, 1); ss += __shfl_xor(ss, 1);
  const float mean = s * (1.0f / 512.0f);
  const float rstd = rsqrtf(fmaxf(ss * (1.0f / 512.0f) - mean * mean, 0.f) + EPS);
  const float* lg = p.gm_ln_g + l * 512 + g * 128; const float* lb = p.gm_ln_b + l * 512 + g * 128;
#pragma unroll
  for (int i = 0; i < 8; i++) {
    uint4 raw = *(const uint4*)(prow + C_V + g * 128 + half * 64 + i * 8);
    u32 w[4] = {raw.x, raw.y, raw.z, raw.w};
#pragma unroll
    for (int e = 0; e < 4; e++) {
      int cc = half * 64 + i * 8 + 2 * e;
      vT[cc * 136 + tok] = f2bf((gelu_t(lo2f(w[e])) - mean) * rstd * lg[cc] + lb[cc]);
      vT[(cc + 1) * 136 + tok] = f2bf((gelu_t(hi2f(w[e])) - mean) * rstd * lg[cc + 1] + lb[cc + 1]);
    }
  }
  const float* wrow = p.gm_ws + ((size_t)(l * 4 + g) * 128 + tok) * 128 + half * 64;
#pragma unroll
  for (int i = 0; i < 16; i++) {
    float4 w = ((const float4*)wrow)[i];
    int s0 = half * 64 + i * 4;
    uint2 o = make_uint2(pack2(s0 <= tok ? w.x : 0.f, s0 + 1 <= tok ? w.y : 0.f), pack2(s0 + 2 <= tok ? w.z : 0.f, s0 + 3 <= tok ? w.w : 0.f));
    *(uint2*)(Ws + tok * 136 + s0) = o;
  }
  __syncthreads();
  f32x4 acc[4][4];
#pragma unroll
  for (int m = 0; m < 4; m++)
#pragma unroll
    for (int n = 0; n < 4; n++) acc[m][n] = (f32x4){0.f, 0.f, 0.f, 0.f};
#pragma unroll
  for (int kk = 0; kk < 4; kk++) {
    bf16x8 a[4], b[4];
#pragma unroll
    for (int m = 0; m < 4; m++) a[m] = ld8(Ws + (wm * 64 + m * 16 + lr) * 136 + kk * 32 + lq * 8);
#pragma unroll
    for (int n = 0; n < 4; n++) b[n] = ld8(vT + (wn * 64 + n * 16 + lr) * 136 + kk * 32 + lq * 8);
#pragma unroll
    for (int m = 0; m < 4; m++)
#pragma unroll
      for (int n = 0; n < 4; n++) acc[m][n] = mfma16(b[n], a[m], acc[m][n]);
  }
  const float* bsp = p.gm_bs + (size_t)(l * 4 + g) * 128;
  uint2 uv[4][4];
#pragma unroll
  for (int m = 0; m < 4; m++)
#pragma unroll
    for (int n = 0; n < 4; n++)
      uv[m][n] = *(const uint2*)(p.BIG + (size_t)(t0 + wm * 64 + m * 16 + lr) * PS + C_U + g * 128 + wn * 64 + n * 16 + lq * 4);
#pragma unroll
  for (int m = 0; m < 4; m++) {
    const float bias = bsp[wm * 64 + m * 16 + lr];
#pragma unroll
    for (int n = 0; n < 4; n++) {
      const uint2 u = uv[m][n];
      *(uint2*)(p.BIG + (size_t)(t0 + wm * 64 + m * 16 + lr) * PS + C_U + g * 128 + wn * 64 + n * 16 + lq * 4) =
          make_uint2(pack2(gelu_t(lo2f(u.x)) * (acc[m][n][0] + bias), gelu_t(hi2f(u.x)) * (acc[m][n][1] + bias)),
                     pack2(gelu_t(lo2f(u.y)) * (acc[m][n][2] + bias), gelu_t(hi2f(u.y)) * (acc[m][n][3] + bias)));
    }
  }
  __syncthreads();
}

__device__ __forceinline__ void ret_kv_tile(const Params& p, int tile, u16* smem) {
  const int c = tile >> 2, h = tile & 3, t0 = c * 128;
  u16* vT = smem; u16* kT = smem + 128 * 136;
  const int tid = tid_fresh() & 255, lane = tid & 63, wave = tid >> 6, lr = lane & 15, lq = lane >> 4;
  const int tok = tid >> 1, half = tid & 1;
  const float lg = logf(1.0f - exp2f(-5.0f - (float)h));
  const u16* prow = p.BIG + (size_t)(t0 + tok) * PS;
#pragma unroll
  for (int i = 0; i < 8; i++) {
    uint4 raw = *(const uint4*)(prow + C_RV + h * 128 + half * 64 + i * 8);
    u32 w[4] = {raw.x, raw.y, raw.z, raw.w};
#pragma unroll
    for (int e = 0; e < 4; e++) {
      int cc = half * 64 + i * 8 + 2 * e;
      vT[cc * 136 + tok] = (u16)(w[e] & 0xffff);
      vT[(cc + 1) * 136 + tok] = (u16)(w[e] >> 16);
    }
  }
  const float sc = 0.125f * expf(lg * (float)(127 - tok));
#pragma unroll
  for (int i = 0; i < 4; i++) {
    uint4 raw = *(const uint4*)(prow + C_RK + h * 64 + half * 32 + i * 8);
    u32 w[4] = {raw.x, raw.y, raw.z, raw.w};
#pragma unroll
    for (int e = 0; e < 4; e++) {
      int cc = half * 32 + i * 8 + 2 * e;
      kT[cc * 136 + tok] = f2bf(lo2f(w[e]) * sc);
      kT[(cc + 1) * 136 + tok] = f2bf(hi2f(w[e]) * sc);
    }
  }
  __syncthreads();
  f32x4 acc[2][4];
#pragma unroll
  for (int m = 0; m < 2; m++)
#pragma unroll
    for (int n = 0; n < 4; n++) acc[m][n] = (f32x4){0.f, 0.f, 0.f, 0.f};
#pragma unroll
  for (int kk = 0; kk < 4; kk++) {
    bf16x8 a[2], b[4];
#pragma unroll
    for (int m = 0; m < 2; m++) a[m] = ld8(vT + (wave * 32 + m * 16 + lr) * 136 + kk * 32 + lq * 8);
#pragma unroll
    for (int n = 0; n < 4; n++) b[n] = ld8(kT + (n * 16 + lr) * 136 + kk * 32 + lq * 8);
#pragma unroll
    for (int m = 0; m < 2; m++)
#pragma unroll
      for (int n = 0; n < 4; n++) acc[m][n] = mfma16(a[m], b[n], acc[m][n]);
  }
  float* rp = p.ret + (size_t)(c * 4 + h) * 8192;
#pragma unroll
  for (int m = 0; m < 2; m++)
#pragma unroll
    for (int n = 0; n < 4; n++)
#pragma unroll
      for (int j = 0; j < 4; j++) rp[(wave * 32 + m * 16 + lq * 4 + j) * 64 + n * 16 + lr] = acc[m][n][j];
  __syncthreads();
}
__device__ __forceinline__ void ret_scan_wg(const Params& p, unsigned char* sm) {
  const int tid = tid_fresh(), seg = tid >> 7, el = tid & 127;
  float* endv = (float*)sm;
  for (int e0 = blockIdx.x * 128; e0 < 32768; e0 += gridDim.x * 128) {
    const int h = e0 >> 13;
    const float cd = expf(logf(1.0f - exp2f(-5.0f - (float)h)) * 128.0f);
    const float cd2 = cd * cd, cd4 = cd2 * cd2, cd8 = cd4 * cd4, cd16 = cd8 * cd8, cd32 = cd16 * cd16;
    float* base = p.ret + (size_t)(seg * 32) * 32768 + e0 + el;
    float v[32];
#pragma unroll
    for (int i = 0; i < 32; i++) v[i] = base[(size_t)i * 32768];
    float st = 0.f;
#pragma unroll
    for (int i = 0; i < 32; i++) st = st * cd + v[i];
    endv[seg * 128 + el] = st;
    __syncthreads();
    float carry = 0.f;
    for (int s2 = 0; s2 < seg; s2++) carry = carry * cd32 + endv[s2 * 128 + el];
    __syncthreads();
    st = carry;
#pragma unroll
    for (int i = 0; i < 32; i++) { base[(size_t)i * 32768] = st; st = st * cd + v[i]; }
  }
}
__device__ __forceinline__ void ret_out_tile(const Params& p, int l, int tile, u16* smem) {
  const int c = tile >> 2, h = tile & 3, t0 = c * 128;
  u16* vT = smem;
  u16* kS = smem + 128 * 136;
  u16* pT = kS + 128 * 72;
  const int tid = tid_fresh() & 255, lane = tid & 63, wave = tid >> 6, lr = lane & 15, lq = lane >> 4;
  const int tok = tid >> 1, half = tid & 1;
  const float lg = logf(1.0f - exp2f(-5.0f - (float)h));
  {
    const u16* prow = p.BIG + (size_t)(t0 + tok) * PS;
#pragma unroll
    for (int i = 0; i < 8; i++) {
      uint4 raw = *(const uint4*)(prow + C_RV + h * 128 + half * 64 + i * 8);
      u32 w[4] = {raw.x, raw.y, raw.z, raw.w};
#pragma unroll
      for (int e = 0; e < 4; e++) {
        int cc = half * 64 + i * 8 + 2 * e;
        vT[cc * 136 + tok] = (u16)(w[e] & 0xffff);
        vT[(cc + 1) * 136 + tok] = (u16)(w[e] >> 16);
      }
    }
#pragma unroll
    for (int i = 0; i < 4; i++)
      *(uint4*)(kS + tok * 72 + half * 32 + i * 8) = *(const uint4*)(prow + C_RK + h * 64 + half * 32 + i * 8);
    const float* rp = p.ret + (size_t)(c * 4 + h) * 8192 + tok * 64 + half * 32;
#pragma unroll
    for (int i = 0; i < 4; i++) {
      float4 a = ((const float4*)rp)[2 * i], b = ((const float4*)rp)[2 * i + 1];
      *(uint4*)(pT + tok * 72 + half * 32 + i * 8) = make_uint4(pack2(a.x, a.y), pack2(a.z, a.w), pack2(b.x, b.y), pack2(b.z, b.w));
    }
  }
  __syncthreads();
#pragma unroll 1
  for (int it = 0; it < 2; it++) {
    const int i = wave * 32 + it * 16 + lr;
    const u16* qp = p.BIG + (size_t)(t0 + i) * PS + C_RQ + h * 64 + lq * 8;
    const bf16x8 q_lo = ld8(qp), q_hi = ld8(qp + 32);
    f32x4 Y[8];
#pragma unroll
    for (int e = 0; e < 8; e++) Y[e] = (f32x4){0.f, 0.f, 0.f, 0.f};
    const int nch = ((wave * 32 + it * 16 + 15) >> 5) + 1;
    for (int jc = 0; jc < nch; jc++) {
      f32x4 s0 = (f32x4){0.f, 0.f, 0.f, 0.f}, s1 = s0;
      const u16* kp = kS + (jc * 32 + lr) * 72 + lq * 8;
      s0 = mfma16(ld8(kp), q_lo, s0); s0 = mfma16(ld8(kp + 32), q_hi, s0);
      s1 = mfma16(ld8(kp + 16 * 72), q_lo, s1); s1 = mfma16(ld8(kp + 16 * 72 + 32), q_hi, s1);
      float pv[8];
#pragma unroll
      for (int j = 0; j < 4; j++) {
        int d0 = i - (jc * 32 + lq * 4 + j), d1 = d0 - 16;
        pv[j] = d0 >= 0 ? s0[j] * 0.125f * __expf(lg * (float)d0) : 0.f;
        pv[4 + j] = d1 >= 0 ? s1[j] * 0.125f * __expf(lg * (float)d1) : 0.f;
      }
      const bf16x8 pb = pk8(pv[0], pv[1], pv[2], pv[3], pv[4], pv[5], pv[6], pv[7]);
#pragma unroll
      for (int e = 0; e < 8; e++) {
        const u16* vp = vT + (e * 16 + lr) * 136 + jc * 32 + lq * 4;
        Y[e] = mfma16(ld44(vp, vp + 16), pb, Y[e]);
      }
    }
    {
      const float qd = __expf(lg * (float)(i + 1));
      const bf16x8 ql = scale8(q_lo, qd), qh = scale8(q_hi, qd);
#pragma unroll
      for (int e = 0; e < 8; e++) {
        const u16* pp = pT + (e * 16 + lr) * 72 + lq * 8;
        Y[e] = mfma16(ld8(pp), ql, Y[e]);
        Y[e] = mfma16(ld8(pp + 32), qh, Y[e]);
      }
    }
    float s = 0.f, ss = 0.f;
#pragma unroll
    for (int e = 0; e < 8; e++)
#pragma unroll
      for (int j = 0; j < 4; j++) { s += Y[e][j]; ss += Y[e][j] * Y[e][j]; }
    s += __shfl_xor(s, 16); ss += __shfl_xor(ss, 16);
    s += __shfl_xor(s, 32); ss += __shfl_xor(ss, 32);
    const float mean = s * (1.0f / 128.0f);
    const float rstd = rsqrtf(fmaxf(ss * (1.0f / 128.0f) - mean * mean, 0.f) + EPS);
    u16* gp = p.BIG + (size_t)(t0 + i) * PS + C_RG + h * 128;
    const float* gg = p.ret_gn_g + l * 512 + h * 128; const float* gb = p.ret_gn_b + l * 512 + h * 128;
    uint2 grawv[8];
#pragma unroll
    for (int e = 0; e < 8; e++) grawv[e] = *(const uint2*)(gp + e * 16 + lq * 4);
#pragma unroll
    for (int e = 0; e < 8; e++) {
      const int e0 = e * 16 + lq * 4;
      const uint2 graw = grawv[e];
      float4 g4 = *(const float4*)(gg + e0), b4 = *(const float4*)(gb + e0);
      float y0 = (Y[e][0] - mean) * rstd * g4.x + b4.x, y1 = (Y[e][1] - mean) * rstd * g4.y + b4.y;
      float y2 = (Y[e][2] - mean) * rstd * g4.z + b4.z, y3 = (Y[e][3] - mean) * rstd * g4.w + b4.w;
      *(uint2*)(gp + e0) = make_uint2(pack2(silu_f(lo2f(graw.x)) * y0, silu_f(hi2f(graw.x)) * y1),
                                      pack2(silu_f(lo2f(graw.y)) * y2, silu_f(hi2f(graw.y)) * y3));
    }
  }
  __syncthreads();
}

__device__ __forceinline__ void cmp_tile(const Params& p, int l, int tile, u16* smem) {
  const int which = tile >> 6, g = (tile >> 5) & 1, ci0 = (tile & 31) * 32;
  const int tid = tid_fresh() & 255, lane = tid & 63, wave = tid >> 6, lr = lane & 15, lq = lane >> 4;
  float* part = (float*)smem;
  u16* hid = smem + 32768;
  const int colbase = (which ? C_VC : C_KC) + g * 64;
  const float* pos = p.cmp_pos + (size_t)(l * 2 + which) * 32 * 64;
  const u16* w1t = p.cw1t + (size_t)which * 128 * 2048;
  f32x4 acc[2][8];
#pragma unroll
  for (int m = 0; m < 2; m++)
#pragma unroll
    for (int n = 0; n < 8; n++) acc[m][n] = (f32x4){0.f, 0.f, 0.f, 0.f};
  int cir0 = ci0 + lr, cir1 = ci0 + 16 + lr;
  if (cir0 > 1022) cir0 = 1022;
  if (cir1 > 1022) cir1 = 1022;
#pragma unroll 4
  for (int ks = 0; ks < 16; ks++) {
    const int kk = wave * 512 + ks * 32 + lq * 8, toff = kk >> 6, dim = kk & 63;
    const float4 p0 = *(const float4*)(pos + toff * 64 + dim), p1 = *(const float4*)(pos + toff * 64 + dim + 4);
    bf16x8 a[2], b[8];
#pragma unroll
    for (int m = 0; m < 2; m++) {
      const int cr = m == 0 ? cir0 : cir1;
      uint4 raw = *(const uint4*)(p.BIG + (size_t)(cr * 16 + toff) * PS + colbase + dim);
      a[m] = pk8(lo2f(raw.x) + p0.x, hi2f(raw.x) + p0.y, lo2f(raw.y) + p0.z, hi2f(raw.y) + p0.w,
                 lo2f(raw.z) + p1.x, hi2f(raw.z) + p1.y, lo2f(raw.w) + p1.z, hi2f(raw.w) + p1.w);
    }
#pragma unroll
    for (int n = 0; n < 8; n++) b[n] = ld8(w1t + (size_t)(n * 16 + lr) * 2048 + kk);
#pragma unroll
    for (int m = 0; m < 2; m++)
#pragma unroll
      for (int n = 0; n < 8; n++) acc[m][n] = mfma16(a[m], b[n], acc[m][n]);
  }
#pragma unroll
  for (int m = 0; m < 2; m++)
#pragma unroll
    for (int n = 0; n < 8; n++)
#pragma unroll
      for (int j = 0; j < 4; j++) part[wave * 4096 + (m * 16 + lq * 4 + j) * 128 + n * 16 + lr] = acc[m][n][j];
  __syncthreads();
  for (int e = tid; e < 4096; e += 256) {
    const float v = part[e] + part[4096 + e] + part[8192 + e] + part[12288 + e];
    hid[e] = f2bf(gelu_t(v));
  }
  __syncthreads();
  f32x4 o[2] = {(f32x4){0.f, 0.f, 0.f, 0.f}, (f32x4){0.f, 0.f, 0.f, 0.f}};
  const u16* w2t = p.cw2t + (size_t)which * 64 * 128;
#pragma unroll
  for (int kk = 0; kk < 4; kk++) {
    bf16x8 bb = ld8(w2t + (wave * 16 + lr) * 128 + kk * 32 + lq * 8);
#pragma unroll
    for (int m = 0; m < 2; m++) o[m] = mfma16(ld8(hid + (m * 16 + lr) * 128 + kk * 32 + lq * 8), bb, o[m]);
  }
#pragma unroll
  for (int m = 0; m < 2; m++)
#pragma unroll
    for (int j = 0; j < 4; j++) {
      int ci = ci0 + m * 16 + lq * 4 + j, d = wave * 16 + lr;
      u16 v = ci < 1023 ? f2bf(o[m][j]) : (u16)0;
      if (which == 0) p.kc[(size_t)(g * 1024 + ci) * 64 + d] = v;
      else p.vcT[(size_t)(g * 64 + d) * 1024 + ci] = v;
    }
  __syncthreads();
}
__device__ __forceinline__ void vt_tile(const Params& p, int tile, u16* smem) {
  const int sw = tile >> 9, g = (tile >> 8) & 1, t0 = (tile & 255) * 64;
  const int tid = tid_fresh() & 255;
  u16* T = smem;
  const int col = (sw ? C_VW : C_VS) + g * 64;
  {
    const int tok = tid >> 2, dq = (tid & 3) * 16;
    const u16* src = p.BIG + (size_t)(t0 + tok) * PS + col + dq;
    uint4 r0 = *(const uint4*)src, r1 = *(const uint4*)(src + 8);
    u32 w[8] = {r0.x, r0.y, r0.z, r0.w, r1.x, r1.y, r1.z, r1.w};
#pragma unroll
    for (int e = 0; e < 8; e++) { T[(dq + 2 * e) * 72 + tok] = (u16)(w[e] & 0xffff); T[(dq + 2 * e + 1) * 72 + tok] = (u16)(w[e] >> 16); }
  }
  __syncthreads();
  {
    const int d = tid >> 2, tq = (tid & 3) * 16;
    u16* dst = (sw ? p.vwT : p.vsT) + (size_t)(g * 64 + d) * S + t0 + tq;
    *(uint4*)dst = *(const uint4*)(T + d * 72 + tq);
    *(uint4*)(dst + 8) = *(const uint4*)(T + d * 72 + tq + 8);
  }
  __syncthreads();
}

constexpr int NT_ST = 72;
constexpr int NT_EL = 64 * NT_ST;
__device__ __forceinline__ float quad_sum(float x) {
  x += __uint_as_float((u32)__builtin_amdgcn_mov_dpp((int)__float_as_uint(x), 0xB1, 0xF, 0xF, true));
  x += __uint_as_float((u32)__builtin_amdgcn_mov_dpp((int)__float_as_uint(x), 0x4E, 0xF, 0xF, true));
  return x;
}
__device__ __forceinline__ void qk64(const u16* kt, int lr, int lq, bf16x8 q_lo, bf16x8 q_hi, f32x4 (&s)[2][2]) {
#pragma unroll
  for (int c = 0; c < 2; c++)
#pragma unroll
    for (int t = 0; t < 2; t++) {
      const u16* kp = kt + (c * 32 + t * 16 + lr) * NT_ST + lq * 8;
      f32x4 a = s[c][t];
      a = mfma16(ld8(kp), q_lo, a); a = mfma16(ld8(kp + 32), q_hi, a);
      s[c][t] = a;
    }
}
__device__ __forceinline__ float ex2(float x) { return __builtin_amdgcn_exp2f(x); }
template <bool FAST>
__device__ __forceinline__ void attend_tile(const u16* kt, const u16* vt, int lr, int lq, bf16x8 q_lo, bf16x8 q_hi, float slope2, int dbase,
                                            bool rowsel, int win, float& m, float& lsum, f32x4 (&O)[4]) {
  f32x4 s[2][2];
  float sv[16];
  float mx = -1e30f;
  if (FAST) {
    const float binit = rowsel ? -slope2 * (float)(dbase - lq * 4) : -1e30f;
#pragma unroll
    for (int c = 0; c < 2; c++)
#pragma unroll
      for (int t = 0; t < 2; t++)
#pragma unroll
        for (int j = 0; j < 4; j++) s[c][t][j] = __builtin_fmaf(slope2, (float)(c * 32 + t * 16 + j), binit);
    qk64(kt, lr, lq, q_lo, q_hi, s);
#pragma unroll
    for (int c = 0; c < 2; c++)
#pragma unroll
      for (int t = 0; t < 2; t++)
#pragma unroll
        for (int j = 0; j < 4; j++) { sv[(c * 2 + t) * 4 + j] = s[c][t][j]; mx = fmaxf(mx, s[c][t][j]); }
  } else {
#pragma unroll
    for (int c = 0; c < 2; c++)
#pragma unroll
      for (int t = 0; t < 2; t++) s[c][t] = (f32x4){0.f, 0.f, 0.f, 0.f};
    qk64(kt, lr, lq, q_lo, q_hi, s);
#pragma unroll
    for (int c = 0; c < 2; c++)
#pragma unroll
      for (int t = 0; t < 2; t++)
#pragma unroll
        for (int j = 0; j < 4; j++) {
          const int d = dbase - (c * 32 + t * 16 + lq * 4 + j);
          const bool o = rowsel && d >= 0 && d < win;
          const float v = o ? s[c][t][j] - slope2 * (float)d : -1e30f;
          sv[(c * 2 + t) * 4 + j] = v;
          mx = fmaxf(mx, v);
        }
  }
  if (__any(mx > m)) {
    mx = fmaxf(mx, __shfl_xor(mx, 16)); mx = fmaxf(mx, __shfl_xor(mx, 32));
    const float mnew = fmaxf(m, mx);
    const float alpha = ex2(m - mnew);
    m = mnew;
    lsum *= alpha;
#pragma unroll
    for (int dt = 0; dt < 4; dt++)
#pragma unroll
      for (int j = 0; j < 4; j++) O[dt][j] *= alpha;
  }
  const float mn = m;
  float ps = 0.f;
  bf16x8 pb[2];
#pragma unroll
  for (int c = 0; c < 2; c++) {
    float pv[8];
#pragma unroll
    for (int j = 0; j < 8; j++) {
      const float v = sv[c * 8 + j];
      pv[j] = FAST ? ex2(v - mn) : (v > -1e29f ? ex2(v - mn) : 0.f);
      ps += pv[j];
    }
    pb[c] = pk8(pv[0], pv[1], pv[2], pv[3], pv[4], pv[5], pv[6], pv[7]);
  }
  lsum += ps;
#pragma unroll
  for (int dt = 0; dt < 4; dt++)
#pragma unroll
    for (int c = 0; c < 2; c++) {
      const u16* vp = vt + (dt * 16 + lr) * NT_ST + c * 32 + lq * 4;
      O[dt] = mfma16(ld44(vp, vp + 16), pb[c], O[dt]);
    }
}

template <bool HASV, class KS, class VS, class CF>
__device__ __forceinline__ void tile_pipe2(int n, u16* ktb, u16* vtb, int soff, KS ksrc, VS vsrc, CF compute) {
  uint4 kE, vE, kO, vO;
  kE = vE = kO = vO = make_uint4(0u, 0u, 0u, 0u);
  if (n > 0) { kE = *(const uint4*)ksrc(0); if (HASV) vE = *(const uint4*)vsrc(0); }
  if (n > 1) { kO = *(const uint4*)ksrc(1); if (HASV) vO = *(const uint4*)vsrc(1); }
  if (n > 0) { *(uint4*)(ktb + soff) = kE; if (HASV) *(uint4*)(vtb + soff) = vE; }
  __syncthreads();
#pragma unroll 1
  for (int i = 0; i < n; i += 2) {
    if (i + 2 < n) { kE = *(const uint4*)ksrc(i + 2); if (HASV) vE = *(const uint4*)vsrc(i + 2); }
    compute(i, ktb, vtb);
    if (i + 1 < n) { *(uint4*)(ktb + NT_EL + soff) = kO; if (HASV) *(uint4*)(vtb + NT_EL + soff) = vO; }
    __syncthreads();
    if (i + 1 >= n) break;
    if (i + 3 < n) { kO = *(const uint4*)ksrc(i + 3); if (HASV) vO = *(const uint4*)vsrc(i + 3); }
    compute(i + 1, ktb + NT_EL, vtb + NT_EL);
    if (i + 2 < n) { *(uint4*)(ktb + soff) = kE; if (HASV) *(uint4*)(vtb + soff) = vE; }
    __syncthreads();
  }
}

__device__ __forceinline__ void nsa_wg(const Params& p, int g, int T0, unsigned char* sm) {
  const int tid = tid_fresh(), lane = tid & 63, lr = lane & 15, lq = lane >> 4;
  const int wv = __builtin_amdgcn_readfirstlane(tid >> 6);
  const int t0 = T0 + wv * 4;
  const int tok = lr >> 2, r = lr & 3, tpos = t0 + tok;
  const float slope = 1.4426950408889634f * exp2f(-(float)(g * 4 + r + 1));
  u16* proj = p.BIG;
  float* wl = (float*)sm + wv * 2112;
  float* impA = wl; float* impB = wl + 1024; u32* selm = (u32*)(wl + 1024 + 1040);
  u16* ktb = (u16*)(sm + 67584);
  u16* vtb = ktb + 2 * NT_EL;
  u32* wgm = (u32*)(vtb + 2 * NT_EL);
  u32* wgu = wgm + 64;
  int* blist = (int*)(wgu + 8);
  const int srow = tid >> 3, sseg = (tid & 7) * 8;
  const int soff = srow * NT_ST + sseg;
  bf16x8 q_lo, q_hi;
  {
    const u16* qp = proj + (size_t)tpos * PS + C_NQ + (g * 4 + r) * 64 + lq * 8;
    q_lo = scale8(ld8(qp), 0.125f * 1.4426950408889634f); q_hi = scale8(ld8(qp + 32), 0.125f * 1.4426950408889634f);
  }
  float g0, g1, g2;
  {
    const u16* gp = proj + (size_t)tpos * PS + C_NG + (g * 4 + r) * 3;
    g0 = sigm_f(bf2f(gp[0])); g1 = sigm_f(bf2f(gp[1])); g2 = sigm_f(bf2f(gp[2]));
  }
  f32x4 outacc[4];
#pragma unroll
  for (int dt = 0; dt < 4; dt++) outacc[dt] = (f32x4){0.f, 0.f, 0.f, 0.f};
  const int cur = T0 >> 6;

  for (int i = lane; i < 1024 + 1040; i += 64) wl[i] = 0.f;
  {
    const int ncmp = (T0 + 31 >= 31) ? ((T0 + 31 - 31) >> 4) + 1 : 0;
    const int nst = (ncmp + 63) >> 6;
    const u16* ksrc = p.kc + (size_t)g * 1024 * 64 + (size_t)srow * 64 + sseg;
    const u16* vsrc = p.vcT + (size_t)(g * 64 + srow) * 1024 + sseg;
    float m = -1e30f, lsum = 0.f;
    tile_pipe2<false>(nst, ktb, vtb, soff,
      [&](int i) { return ksrc + (size_t)(nst - 1 - i) * 4096; }, [&](int i) { return ksrc; },
      [&](int i, const u16* kt, const u16* vt) {
        const int st = nst - 1 - i;
        f32x4 s[2][2];
        float sv[16]; float mx = -1e30f;
        const bool fast = t0 - 31 - 16 * (st * 64 + 63) >= 0;
        if (fast) {
          const float binit = -slope * (float)(tpos - 31 - 16 * (st * 64 + lq * 4)), slope16 = slope * 16.0f;
#pragma unroll
          for (int c = 0; c < 2; c++)
#pragma unroll
            for (int t = 0; t < 2; t++)
#pragma unroll
              for (int j = 0; j < 4; j++) s[c][t][j] = __builtin_fmaf(slope16, (float)(c * 32 + t * 16 + j), binit);
          qk64(kt, lr, lq, q_lo, q_hi, s);
#pragma unroll
          for (int c = 0; c < 2; c++)
#pragma unroll
            for (int t = 0; t < 2; t++)
#pragma unroll
              for (int j = 0; j < 4; j++) { sv[(c * 2 + t) * 4 + j] = s[c][t][j]; mx = fmaxf(mx, s[c][t][j]); }
        } else {
#pragma unroll
          for (int c = 0; c < 2; c++)
#pragma unroll
            for (int t = 0; t < 2; t++) s[c][t] = (f32x4){0.f, 0.f, 0.f, 0.f};
          qk64(kt, lr, lq, q_lo, q_hi, s);
#pragma unroll
          for (int c = 0; c < 2; c++)
#pragma unroll
            for (int t = 0; t < 2; t++)
#pragma unroll
              for (int j = 0; j < 4; j++) {
                const int ci = st * 64 + c * 32 + t * 16 + lq * 4 + j;
                const int d = tpos - (ci * 16 + 31);
                const float v = d >= 0 ? s[c][t][j] - slope * (float)d : -1e30f;
                sv[(c * 2 + t) * 4 + j] = v; mx = fmaxf(mx, v);
              }
        }
        if (__any(mx > m)) {
          mx = fmaxf(mx, __shfl_xor(mx, 16)); mx = fmaxf(mx, __shfl_xor(mx, 32));
          const float mnew = fmaxf(m, mx);
          lsum *= ex2(m - mnew);
          m = mnew;
        }
        const float mn = m;
        float ps = 0.f;
        if (fast) {
#pragma unroll
          for (int j = 0; j < 16; j++) ps += ex2(sv[j] - mn);
        } else {
#pragma unroll
          for (int j = 0; j < 16; j++) ps += sv[j] > -1e29f ? ex2(sv[j] - mn) : 0.f;
        }
        lsum += ps;
      });
    lsum += __shfl_xor(lsum, 16); lsum += __shfl_xor(lsum, 32);
    const float invL = lsum > 0.f ? 1.0f / lsum : 0.f;
    f32x4 O[4];
#pragma unroll
    for (int dt = 0; dt < 4; dt++) O[dt] = (f32x4){0.f, 0.f, 0.f, 0.f};
    tile_pipe2<true>(nst, ktb, vtb, soff,
      [&](int st) { return ksrc + (size_t)st * 4096; }, [&](int st) { return vsrc + st * 64; },
      [&](int st, const u16* kt, const u16* vt) {
        f32x4 s[2][2];
        const bool fast = t0 - 31 - 16 * (st * 64 + 63) >= 0;
        if (fast) {
          const float binit = -slope * (float)(tpos - 31 - 16 * (st * 64 + lq * 4)) - m, slope16 = slope * 16.0f;
#pragma unroll
          for (int c = 0; c < 2; c++)
#pragma unroll
            for (int t = 0; t < 2; t++)
#pragma unroll
              for (int j = 0; j < 4; j++) s[c][t][j] = __builtin_fmaf(slope16, (float)(c * 32 + t * 16 + j), binit);
        } else {
#pragma unroll
          for (int c = 0; c < 2; c++)
#pragma unroll
            for (int t = 0; t < 2; t++) s[c][t] = (f32x4){0.f, 0.f, 0.f, 0.f};
        }
        qk64(kt, lr, lq, q_lo, q_hi, s);
        bf16x8 pb[2];
#pragma unroll
        for (int c = 0; c < 2; c++) {
          float p0[4], p1[4];
          if (fast) {
#pragma unroll
            for (int j = 0; j < 4; j++) { p0[j] = ex2(s[c][0][j]) * invL; p1[j] = ex2(s[c][1][j]) * invL; }
          } else {
#pragma unroll
            for (int j = 0; j < 4; j++) {
              const int ci = st * 64 + c * 32 + lq * 4 + j;
              const int d0 = tpos - (ci * 16 + 31), d1 = d0 - 256;
              p0[j] = d0 >= 0 ? ex2(s[c][0][j] - slope * (float)d0 - m) * invL : 0.f;
              p1[j] = d1 >= 0 ? ex2(s[c][1][j] - slope * (float)d1 - m) * invL : 0.f;
            }
          }
          float a0 = p0[0] + p0[1] + p0[2] + p0[3], b0 = p0[3], a1 = p1[0] + p1[1] + p1[2] + p1[3], b1 = p1[3];
          a0 = quad_sum(a0); b0 = quad_sum(b0); a1 = quad_sum(a1); b1 = quad_sum(b1);
          if (r == 0) {
            const int J0 = st * 16 + c * 8 + lq;
            impA[tok * 256 + J0] = a0; impB[tok * 260 + J0 + 1] = b0;
            impA[tok * 256 + J0 + 4] = a1; impB[tok * 260 + J0 + 5] = b1;
          }
          pb[c] = pk8(p0[0], p0[1], p0[2], p0[3], p1[0], p1[1], p1[2], p1[3]);
        }
#pragma unroll
        for (int dt = 0; dt < 4; dt++)
#pragma unroll
          for (int c = 0; c < 2; c++) {
            const u16* vp = vt + (dt * 16 + lr) * NT_ST + c * 32 + lq * 4;
            O[dt] = mfma16(ld44(vp, vp + 16), pb[c], O[dt]);
          }
      });
#pragma unroll
    for (int dt = 0; dt < 4; dt++)
#pragma unroll
      for (int j = 0; j < 4; j++) outacc[dt][j] += g0 * O[dt][j];
  }
  wave_lds_sync();

  if (cur < 16) {
    if (lane < 32) selm[lane] = ((lane & 7) == 0) ? ((2u << cur) - 1u) : 0u;
  } else {
    u32 kk[4][4];
#pragma unroll
    for (int tk = 0; tk < 4; tk++) {
      const float* ia = impA + tk * 256; const float* ib = impB + tk * 260;
#pragma unroll
      for (int i = 0; i < 4; i++) {
        const int j = lane + 64 * i;
        kk[tk][i] = (j >= 1 && j <= cur - 2) ? __float_as_uint(ia[j] + ib[j]) + 1u : 0u;
      }
    }
    u32 T[4] = {0u, 0u, 0u, 0u};
#pragma unroll 1
    for (int bit = 30; bit >= 0; bit--) {
#pragma unroll
      for (int tk = 0; tk < 4; tk++) {
        const u32 t = T[tk] | (1u << bit);
        const int cnt = __popcll(__ballot(kk[tk][0] >= t)) + __popcll(__ballot(kk[tk][1] >= t)) + __popcll(__ballot(kk[tk][2] >= t)) + __popcll(__ballot(kk[tk][3] >= t));
        if (cnt >= 13) T[tk] = t;
      }
    }
#pragma unroll
    for (int tk = 0; tk < 4; tk++) {
      const u32 k0 = kk[tk][0], k1 = kk[tk][1], k2 = kk[tk][2], k3 = kk[tk][3], Tt = T[tk];
      int need = 13 - (__popcll(__ballot(k0 > Tt)) + __popcll(__ballot(k1 > Tt)) + __popcll(__ballot(k2 > Tt)) + __popcll(__ballot(k3 > Tt)));
      u64 sel0, sel1, sel2, sel3;
      {
        u64 e = __ballot(k0 == Tt); int below = __builtin_amdgcn_mbcnt_hi((u32)(e >> 32), __builtin_amdgcn_mbcnt_lo((u32)e, 0u));
        sel0 = __ballot(k0 > Tt || (k0 == Tt && below < need)); need -= min(need, (int)__popcll(e));
        e = __ballot(k1 == Tt); below = __builtin_amdgcn_mbcnt_hi((u32)(e >> 32), __builtin_amdgcn_mbcnt_lo((u32)e, 0u));
        sel1 = __ballot(k1 > Tt || (k1 == Tt && below < need)); need -= min(need, (int)__popcll(e));
        e = __ballot(k2 == Tt); below = __builtin_amdgcn_mbcnt_hi((u32)(e >> 32), __builtin_amdgcn_mbcnt_lo((u32)e, 0u));
        sel2 = __ballot(k2 > Tt || (k2 == Tt && below < need)); need -= min(need, (int)__popcll(e));
        e = __ballot(k3 == Tt); below = __builtin_amdgcn_mbcnt_hi((u32)(e >> 32), __builtin_amdgcn_mbcnt_lo((u32)e, 0u));
        sel3 = __ballot(k3 > Tt || (k3 == Tt && below < need));
      }
      u32 myword = 0;
      if (lane == 0) myword = (u32)sel0; else if (lane == 1) myword = (u32)(sel0 >> 32);
      else if (lane == 2) myword = (u32)sel1; else if (lane == 3) myword = (u32)(sel1 >> 32);
      else if (lane == 4) myword = (u32)sel2; else if (lane == 5) myword = (u32)(sel2 >> 32);
      else if (lane == 6) myword = (u32)sel3; else if (lane == 7) myword = (u32)(sel3 >> 32);
      if (lane == 0) myword |= 1u;
      if (lane == ((cur - 1) >> 5)) myword |= 1u << ((cur - 1) & 31);
      if (lane == (cur >> 5)) myword |= 1u << (cur & 31);
      if (lane < 8) selm[tk * 8 + lane] = myword;
    }
  }
  wave_lds_sync();
  if (lane < 8) wgm[wv * 8 + lane] = selm[lane] | selm[8 + lane] | selm[16 + lane] | selm[24 + lane];
  __syncthreads();
  if (tid < 8) {
    u32 u = 0;
#pragma unroll
    for (int w = 0; w < 8; w++) u |= wgm[w * 8 + tid];
    const int lim = cur - tid * 32;
    if (lim < 0) u = 0; else if (lim < 31) u &= (2u << lim) - 1u;
    wgu[tid] = u;
  }
  __syncthreads();
  if (tid < 256) {
    const int w = tid >> 5, b = tid & 31;
    int idx = 0;
#pragma unroll
    for (int ww = 0; ww < 8; ww++) { const u32 x = wgu[ww]; idx += ww < w ? __builtin_popcount(x) : 0; }
    const u32 x = wgu[w];
    idx += __builtin_popcount(x & ((1u << b) - 1u));
    if ((x >> b) & 1u) blist[idx] = tid;
  }
  if (tid == 0) {
    int n = 0;
#pragma unroll
    for (int ww = 0; ww < 8; ww++) n += __builtin_popcount(wgu[ww]);
    blist[256] = n;
  }
  __syncthreads();

  {
    const int nblk = blist[256];
    const u16* ksrc = proj + C_KS + g * 64 + (size_t)srow * PS + sseg;
    const u16* vsrc = p.vsT + (size_t)(g * 64 + srow) * S + sseg;
    float m = -1e30f, lsum = 0.f;
    f32x4 O[4];
#pragma unroll
    for (int dt = 0; dt < 4; dt++) O[dt] = (f32x4){0.f, 0.f, 0.f, 0.f};
    tile_pipe2<true>(nblk, ktb, vtb, soff,
      [&](int i) { return ksrc + (size_t)blist[nblk - 1 - i] * 64 * PS; }, [&](int i) { return vsrc + blist[nblk - 1 - i] * 64; },
      [&](int i, const u16* kt, const u16* vt) {
        const int jb = blist[nblk - 1 - i];
        const u32 wany = wgm[wv * 8 + (jb >> 5)];
        if ((wany >> (jb & 31)) & 1u) {
          const bool rowsel = (selm[tok * 8 + (jb >> 5)] >> (jb & 31)) & 1u;
          if (jb < cur) attend_tile<true>(kt, vt, lr, lq, q_lo, q_hi, slope, tpos - jb * 64, rowsel, 1 << 30, m, lsum, O);
          else attend_tile<false>(kt, vt, lr, lq, q_lo, q_hi, slope, tpos - jb * 64, rowsel, 1 << 30, m, lsum, O);
        }
      });
    lsum += __shfl_xor(lsum, 16); lsum += __shfl_xor(lsum, 32);
    const float sc = g1 / fmaxf(lsum, 1e-30f);
#pragma unroll
    for (int dt = 0; dt < 4; dt++)
#pragma unroll
      for (int j = 0; j < 4; j++) outacc[dt][j] += sc * O[dt][j];
  }
  {
    int ks = T0 - 511; if (ks < 0) ks = 0; ks &= ~63;
    const int nst = ((T0 + 31 - ks) >> 6) + 1;
    const u16* ksrc = proj + C_KW + g * 64 + (size_t)(ks + srow) * PS + sseg;
    const u16* vsrc = p.vwT + (size_t)(g * 64 + srow) * S + ks + sseg;
    float m = -1e30f, lsum = 0.f;
    f32x4 O[4];
#pragma unroll
    for (int dt = 0; dt < 4; dt++) O[dt] = (f32x4){0.f, 0.f, 0.f, 0.f};
    tile_pipe2<true>(nst, ktb, vtb, soff,
      [&](int st) { return ksrc + (size_t)(nst - 1 - st) * 64 * PS; }, [&](int st) { return vsrc + (nst - 1 - st) * 64; },
      [&](int st, const u16* kt, const u16* vt) {
        const int kp0 = ks + (nst - 1 - st) * 64;
        if (t0 - (kp0 + 63) >= 0 && t0 + 3 - kp0 < 512) attend_tile<true>(kt, vt, lr, lq, q_lo, q_hi, slope, tpos - kp0, true, 512, m, lsum, O);
        else attend_tile<false>(kt, vt, lr, lq, q_lo, q_hi, slope, tpos - kp0, true, 512, m, lsum, O);
      });
    lsum += __shfl_xor(lsum, 16); lsum += __shfl_xor(lsum, 32);
    const float sc = g2 / fmaxf(lsum, 1e-30f);
#pragma unroll
    for (int dt = 0; dt < 4; dt++)
#pragma unroll
      for (int j = 0; j < 4; j++) outacc[dt][j] += sc * O[dt][j];
  }
  {
    u16* op = proj + (size_t)tpos * PS + C_NQ + (g * 4 + r) * 64 + lq * 4;
#pragma unroll
    for (int dt = 0; dt < 4; dt++)
      *(uint2*)(op + dt * 16) = make_uint2(pack2(outacc[dt][0], outacc[dt][1]), pack2(outacc[dt][2], outacc[dt][3]));
  }
  __syncthreads();
}

#define XB_TMO      128
#define XB_XCNT(j)  (256  + 64 * (j))
#define XB_XSUB(j)  (1280 + 64 * (j))
#define XB_XGEN(j)  (2304 + 64 * (j))
#define XB_TOP      3328
#define XB_TOPGEN   3392
#define XCD_BAR_WORDS 3456
#define XB_SPIN_CAP (1u << 18)
__device__ __forceinline__ unsigned xb_ld(unsigned* p)              { return __hip_atomic_load(p, __ATOMIC_RELAXED, __HIP_MEMORY_SCOPE_AGENT); }
__device__ __forceinline__ unsigned xb_add(unsigned* p, unsigned v) { return __hip_atomic_fetch_add(p, v, __ATOMIC_RELAXED, __HIP_MEMORY_SCOPE_AGENT); }
__device__ __forceinline__ unsigned xb_xcc_id() { return (unsigned)__builtin_amdgcn_s_getreg((3 << 11) | 20) & 0xFu; }
#define XB_SPIN(cond, bar) do { unsigned _sp = 0; while (cond) { __builtin_amdgcn_s_sleep(1); \
    if ((++_sp & 255u) == 0u) { if (xb_ld(&(bar)[XB_TMO])) break; if (_sp > XB_SPIN_CAP) { atomicAdd(&(bar)[XB_TMO], 1u); break; } } } } while (0)
struct XcdBarrier { unsigned* bar; unsigned x; volatile __attribute__((address_space(3))) unsigned* st; };
__device__ __forceinline__ XcdBarrier xcd_barrier_post(unsigned* bar, volatile __attribute__((address_space(3))) unsigned* st) {
  XcdBarrier b; b.bar = bar; b.x = xb_xcc_id(); b.st = st;
  if (threadIdx.x == 0) (void)xb_add(&bar[XB_XCNT(b.x)], 1u);
  return b;
}
__device__ __forceinline__ void xcd_barrier_complete(unsigned* bar, unsigned x, unsigned& nloc, unsigned& nx) {
  const unsigned G = gridDim.x * gridDim.y * gridDim.z;
  unsigned sum, cnt, mine, sp = 0u;
  for (;;) {
    sum = 0u; cnt = 0u; mine = 0u;
#pragma unroll
    for (unsigned j = 0; j < 16; ++j) { const unsigned c = xb_ld(&bar[XB_XCNT(j)]); sum += c; cnt += (c > 0u) ? 1u : 0u; mine = (j == x) ? c : mine; }
    if (sum == G) break;
    __builtin_amdgcn_s_sleep(1);
    if ((++sp & 255u) == 0u) { if (xb_ld(&bar[XB_TMO])) break; if (sp > XB_SPIN_CAP) { atomicAdd(&bar[XB_TMO], 1u); break; } }
  }
  nloc = mine > 0u ? mine : 1u; nx = cnt > 0u ? cnt : 1u;
}
__device__ __forceinline__ void xcd_barrier(const XcdBarrier& b) {
  asm volatile("s_waitcnt vmcnt(0)" ::: "memory");
  __syncthreads();
  if (threadIdx.x == 0) {
    unsigned* bar = b.bar;
    __builtin_amdgcn_s_waitcnt(0);
    unsigned nloc = b.st[0], nx = b.st[1];
    if (nloc == 0u) { xcd_barrier_complete(bar, b.x, nloc, nx); b.st[0] = nloc; b.st[1] = nx; }
    const unsigned old = xb_add(&bar[XB_XSUB(b.x)], 1u);
    const unsigned gen = old / nloc;
    if (old + 1u == (gen + 1u) * nloc) {
      __builtin_amdgcn_fence(__ATOMIC_RELEASE, "agent");
      asm volatile("s_waitcnt vmcnt(0)" ::: "memory");
      const unsigned og = xb_add(&bar[XB_TOP], 1u);
      const unsigned tg = og / nx;
      if (og + 1u == (tg + 1u) * nx) xb_add(&bar[XB_TOPGEN], 1u);
      else XB_SPIN(xb_ld(&bar[XB_TOPGEN]) == tg, bar);
      __builtin_amdgcn_fence(__ATOMIC_ACQUIRE, "agent");
      xb_add(&bar[XB_XGEN(b.x)], 1u);
      asm volatile("s_waitcnt vmcnt(0)" ::: "memory");
    } else {
      XB_SPIN(xb_ld(&bar[XB_XGEN(b.x)]) == gen, bar);
      __builtin_amdgcn_fence(__ATOMIC_ACQUIRE, "agent");
      asm volatile("s_waitcnt vmcnt(0)" ::: "memory");
    }
  }
  __syncthreads();
}

template <bool FINAL>
struct EpiResidNorm {
  static constexpr bool PERM = false;
  const float* xsrc; float* xdst; float scale; const float* gnext; u16* Hout; float* part; unsigned* cnt; unsigned* tmo;
  __device__ __forceinline__ void fused(AccT& acc, const Unit& u, int wr, int wc, int fr, int fq, LAS unsigned char* lds) const {
    volatile LAS float* ps = (volatile LAS float*)(lds + 131072);
    volatile LAS float* rr = (volatile LAS float*)(lds + 131072 + 4096);
    const int tid = tid_fresh();
    const int row0 = u.pm * 256 + wr * 64 + fr, col0 = u.pn * 256 + wc * 32 + 4 * fq;
#pragma unroll
    for (int ai = 0; ai < 2; ++ai) {
      f32x4 xv[4][2][2];
#pragma unroll
      for (int m = 0; m < 4; ++m)
#pragma unroll
        for (int bj = 0; bj < 2; ++bj)
#pragma unroll
          for (int n = 0; n < 2; ++n)
            xv[m][bj][n] = *(const f32x4*)(xsrc + (size_t)(row0 + ai * 128 + m * 16) * 1024 + col0 + bj * 128 + n * 16);
#pragma unroll
      for (int m = 0; m < 4; ++m) {
        float ss = 0.f;
#pragma unroll
        for (int bj = 0; bj < 2; ++bj)
#pragma unroll
          for (int n = 0; n < 2; ++n) {
            const f32x4 v = xv[m][bj][n] + scale * acc[ai][bj][m][n];
            if (!FINAL) *(f32x4*)(xdst + (size_t)(row0 + ai * 128 + m * 16) * 1024 + col0 + bj * 128 + n * 16) = v;
            acc[ai][bj][m][n] = v;
            ss += v[0] * v[0] + v[1] * v[1] + v[2] * v[2] + v[3] * v[3];
          }
        ss += __shfl_xor(ss, 16); ss += __shfl_xor(ss, 32);
        if (fq == 0) ps[wc * 256 + ai * 128 + wr * 64 + m * 16 + fr] = ss;
      }
    }
    __syncthreads();
    if (tid < 256) __hip_atomic_store(part + (size_t)(u.pm * 4 + u.pn) * 256 + tid, ps[tid] + ps[256 + tid] + ps[512 + tid] + ps[768 + tid], __ATOMIC_RELAXED, __HIP_MEMORY_SCOPE_AGENT);
    asm volatile("s_waitcnt vmcnt(0)" ::: "memory");
    __syncthreads();
    if (tid == 0) {
      (void)xb_add(cnt + u.pm, 1u);
      XB_SPIN(xb_ld(cnt + u.pm) < 4u, tmo);
      __builtin_amdgcn_fence(__ATOMIC_ACQUIRE, "agent");
      asm volatile("s_waitcnt vmcnt(0)" ::: "memory");
    }
    __syncthreads();
    if (tid < 256) {
      const float* pp = part + (size_t)(u.pm * 4) * 256 + tid;
      const float t0 = __hip_atomic_load(pp, __ATOMIC_RELAXED, __HIP_MEMORY_SCOPE_AGENT), t1 = __hip_atomic_load(pp + 256, __ATOMIC_RELAXED, __HIP_MEMORY_SCOPE_AGENT);
      const float t2 = __hip_atomic_load(pp + 512, __ATOMIC_RELAXED, __HIP_MEMORY_SCOPE_AGENT), t3 = __hip_atomic_load(pp + 768, __ATOMIC_RELAXED, __HIP_MEMORY_SCOPE_AGENT);
      rr[tid] = rsqrtf(((t0 + t1) + (t2 + t3)) * (1.0f / 1024.0f) + EPS);
    }
    __syncthreads();
    f32x4 gv[2][2];
#pragma unroll
    for (int bj = 0; bj < 2; ++bj)
#pragma unroll
      for (int n = 0; n < 2; ++n) gv[bj][n] = *(const f32x4*)(gnext + col0 + bj * 128 + n * 16);
#pragma unroll
    for (int ai = 0; ai < 2; ++ai)
#pragma unroll
      for (int m = 0; m < 4; ++m) {
        const float r = rr[ai * 128 + wr * 64 + m * 16 + fr];
#pragma unroll
        for (int bj = 0; bj < 2; ++bj)
#pragma unroll
          for (int n = 0; n < 2; ++n) {
            const f32x4 h = acc[ai][bj][m][n] * r * gv[bj][n];
            if (FINAL) *(f32x4*)(xdst + (size_t)(row0 + ai * 128 + m * 16) * 1024 + col0 + bj * 128 + n * 16) = h;
            else *(uint2*)(Hout + (size_t)(row0 + ai * 128 + m * 16) * 1024 + col0 + bj * 128 + n * 16) = make_uint2(pack2(h[0], h[1]), pack2(h[2], h[3]));
          }
      }
    __syncthreads();
  }
};

constexpr int SMEM_TOTAL = 147456;
__global__ void __launch_bounds__(512, 2) mega(Params p) {
  cg::grid_group grid = cg::this_grid();
  __shared__ __attribute__((aligned(16))) unsigned char smem_raw[SMEM_TOTAL + 16];
  LAS unsigned char* glds = (LAS unsigned char*)smem_raw;
  volatile LAS unsigned* xb_words = (volatile LAS unsigned*)(glds + SMEM_TOTAL);
  if (threadIdx.x == 0) { xb_words[0] = 0u; xb_words[1] = 0u; }
  if (blockIdx.x == 0) { for (int i = threadIdx.x; i < XCD_BAR_WORDS; i += 512) p.bar[i] = 0u; if (threadIdx.x < 384) p.ncnt[threadIdx.x] = 0u; }
  __syncthreads();
  XcdBarrier xb; xb.bar = p.bar; xb.x = 0; xb.st = xb_words;
#define VB_SETUP const int _tf = tid_fresh(); const int half = __builtin_amdgcn_readfirstlane(_tf >> 8); const int nb = gridDim.x * 2, bid = blockIdx.x * 2 + half; \
  u16* smem = (u16*)(smem_raw + half * SMEM_BYTES); const int vwave = __builtin_amdgcn_readfirstlane((_tf & 255) >> 6); (void)vwave; (void)nb; (void)bid; (void)smem;
#pragma unroll 1
  for (int l = 0; l < 2; l++) {
    const float* xsrc = l == 0 ? p.x_in : p.xout;
    const bool fusedn = gridDim.x == 256;
    if (l == 0 || !fusedn) norm_phase(xsrc, p.ffn1_norm + l * 1024, p.H);
    { VB_SETUP wprep_phase(p, l, smem, bid, nb, l == 1 && fusedn, fusedn); }
    if (l == 0) { grid.sync(); xb = xcd_barrier_post(p.bar, xb_words); } else xcd_barrier(xb);
    { Gemm g{p.H, p.w1t_a, 1024, 1024, S, 5632, 1024}; EpiSwiglu e{p.BIG}; gemm_phase(glds, g, e); }
    if (fusedn && blockIdx.x >= 128) {
      VB_SETUP
      wprep_matrix(p.ffn2_w1 + (size_t)l * 1024 * 5632, p.w1t_b, 1024, 5632, 1, smem, bid - 256, 256);
      wprep_matrix(p.ffn2_w2 + (size_t)l * FF * 1024, p.w2t_b, FF, 1024, 0, smem, bid - 256, 256);
    }
    xcd_barrier(xb);
    if (fusedn) {
      Gemm g{p.BIG, p.w2t_a, FF, FF, S, 1024, FF};
      EpiResidNorm<false> e{xsrc, p.xout, 0.5f, p.mix_norm + l * 1024, p.H, p.part + (size_t)(l * 2) * 65536, p.ncnt + (l * 2) * 64, p.bar};
      gemm_phase<EpiResidNorm<false>, true>(glds, g, e);
      xcd_barrier(xb);
    } else {
      { Gemm g{p.BIG, p.w2t_a, FF, FF, S, 1024, FF}; EpiResid e{xsrc, p.xout, 0.5f}; gemm_phase(glds, g, e); }
      xcd_barrier(xb);
      norm_phase(p.xout, p.mix_norm + l * 1024, p.H);
      xcd_barrier(xb);
    }
    { Gemm g{p.H, p.wint, 1024, 1024, S, 4096, 1024}; EpiProj e{p.BIG}; gemm_phase(glds, g, e); }
    xcd_barrier(xb);
    { VB_SETUP
    if (nb == 512) {
      if (bid < 128) { cmp_tile(p, l, bid, smem); ret_kv_tile(p, bid, smem); ret_kv_tile(p, 128 + bid, smem); }
      else {
        const int h2 = bid - 128;
        gmlp_tile(p, l, h2, smem);
        if (h2 < 128) { gmlp_tile(p, l, 384 + h2, smem); vt_tile(p, h2, smem); }
        else {
          const int ci = h2 - 128;
          ret_kv_tile(p, 256 + ci, smem);
          vt_tile(p, 128 + ci * 3, smem); vt_tile(p, 129 + ci * 3, smem); vt_tile(p, 130 + ci * 3, smem);
          if (ci < 128) vt_tile(p, 896 + ci, smem);
        }
      }
    } else {
    for (int t = bid; t < 128 + 512 + 512 + 1024; t += nb) {
      if (t < 128) cmp_tile(p, l, t, smem);
      else if (t < 640) gmlp_tile(p, l, t - 128, smem);
      else if (t < 1152) ret_kv_tile(p, t - 640, smem);
      else vt_tile(p, t - 1152, smem);
    } } }
    xcd_barrier(xb);
    {
      const int tf = tid_fresh();
      const int wv = __builtin_amdgcn_readfirstlane(tf >> 6);
      ret_scan_wg(p, smem_raw);
      const int xcd = blockIdx.x & 7, slot = blockIdx.x >> 3, nslot = gridDim.x >> 3;
      for (int i = slot; i < 128; i += nslot) {
        const int rsel = i >> 6, j = i & 63;
        const int range = rsel == 0 ? 15 - xcd : xcd;
        const int g = (j ^ (j >> 5)) & 1, w = range * 32 + 31 - (j >> 1);
        nsa_wg(p, g, w * 32, smem_raw);
      }
    }
    xcd_barrier(xb);
    { VB_SETUP for (int t = bid; t < 512; t += nb) ret_out_tile(p, l, t, smem); }
    xcd_barrier(xb);
    gemm_merge_chain(glds, p, l);
    xcd_barrier(xb);
    if (fusedn) {
      Gemm g{p.BIG + C_MIX, p.wot, PS, 1024, S, 1024, 1024};
      EpiResidNorm<false> e{p.xout, p.xout, 1.0f, p.ffn2_norm + l * 1024, p.H, p.part + (size_t)(l * 2 + 1) * 65536, p.ncnt + (l * 2 + 1) * 64, p.bar};
      gemm_phase<EpiResidNorm<false>, true>(glds, g, e);
      xcd_barrier(xb);
    } else {
      { Gemm g{p.BIG + C_MIX, p.wot, PS, 1024, S, 1024, 1024}; EpiResid e{p.xout, p.xout, 1.0f}; gemm_phase(glds, g, e); }
      xcd_barrier(xb);
      norm_phase(p.xout, p.ffn2_norm + l * 1024, p.H);
      xcd_barrier(xb);
    }
    { Gemm g{p.H, p.w1t_b, 1024, 1024, S, 5632, 1024}; EpiSwiglu e{p.BIG}; gemm_phase(glds, g, e); }
    if (l == 0 && fusedn && blockIdx.x >= 128) {
      VB_SETUP
      wprep_matrix(p.ffn1_w1 + (size_t)1024 * 5632, p.w1t_a, 1024, 5632, 1, smem, bid - 256, 256);
      wprep_matrix(p.ffn1_w2 + (size_t)FF * 1024, p.w2t_a, FF, 1024, 0, smem, bid - 256, 256);
    }
    xcd_barrier(xb);
    if (fusedn && l == 0) {
      Gemm g{p.BIG, p.w2t_b, FF, FF, S, 1024, FF};
      EpiResidNorm<false> e{p.xout, p.xout, 0.5f, p.ffn1_norm + 1024, p.H, p.part + (size_t)4 * 65536, p.ncnt + 4 * 64, p.bar};
      gemm_phase<EpiResidNorm<false>, true>(glds, g, e);
      xcd_barrier(xb);
    } else if (fusedn) {
      Gemm g{p.BIG, p.w2t_b, FF, FF, S, 1024, FF};
      EpiResidNorm<true> e{p.xout, p.xout, 0.5f, p.final_norm, p.H, p.part + (size_t)5 * 65536, p.ncnt + 5 * 64, p.bar};
      gemm_phase<EpiResidNorm<true>, true>(glds, g, e);
    } else {
      { Gemm g{p.BIG, p.w2t_b, FF, FF, S, 1024, FF}; EpiResid e{p.xout, p.xout, 0.5f}; gemm_phase(glds, g, e); }
      xcd_barrier(xb);
      if (l == 1) final_norm_phase(p.xout, p.final_norm);
    }
  }
}

extern "C" void kernel_launch(void* const* d_in, const int* in_sizes, int n_in, void* d_out, int out_size, void* d_ws,
                              size_t ws_size, hipStream_t stream) {
  static int grid_blocks = 0;
  if (!grid_blocks) {
    int dev = 0, cus = 0, per_cu = 0;
    (void)hipGetDevice(&dev);
    (void)hipDeviceGetAttribute(&cus, hipDeviceAttributeMultiprocessorCount, dev);
    (void)hipOccupancyMaxActiveBlocksPerMultiprocessor(&per_cu, mega, 512, 0);
    if (per_cu > 1) per_cu = 1;
    if (per_cu < 1) per_cu = 1;
    grid_blocks = cus * per_cu;
    grid_blocks &= ~7;
  }
  Params p{};
  p.x_in = (const float*)d_in[0];
  p.ffn1_norm = (const float*)d_in[1]; p.ffn1_w1 = (const float*)d_in[2]; p.ffn1_w2 = (const float*)d_in[3];
  p.mix_norm = (const float*)d_in[4]; p.w_in = (const float*)d_in[5]; p.gm_ln_g = (const float*)d_in[6];
  p.gm_ln_b = (const float*)d_in[7]; p.gm_ws = (const float*)d_in[8]; p.gm_bs = (const float*)d_in[9];
  p.ret_gn_g = (const float*)d_in[10]; p.ret_gn_b = (const float*)d_in[11]; p.cmp_pos = (const float*)d_in[12];
  p.cmp_w1 = (const float*)d_in[13]; p.cmp_w2 = (const float*)d_in[14]; p.w_branch = (const float*)d_in[15];
  p.w_gate = (const float*)d_in[16]; p.b_gate = (const float*)d_in[17]; p.w_o = (const float*)d_in[18];
  p.ffn2_norm = (const float*)d_in[19]; p.ffn2_w1 = (const float*)d_in[20]; p.ffn2_w2 = (const float*)d_in[21];
  p.final_norm = (const float*)d_in[22];
  p.xout = (float*)d_out;
  char* w = (char*)d_ws;
  auto take = [&](size_t bytes) { char* r = w; w += (bytes + 255) & ~(size_t)255; return r; };
  p.w1t_a = (u16*)take((size_t)5632 * 1024 * 2);
  p.w1t_b = (u16*)take((size_t)5632 * 1024 * 2);
  p.w2t_a = (u16*)take((size_t)1024 * FF * 2);
  p.w2t_b = (u16*)take((size_t)1024 * FF * 2);
  p.wint = (u16*)take((size_t)4096 * 1024 * 2);
  p.wgt = (u16*)take((size_t)3072 * 1024 * 2);
  p.wbt = (u16*)take((size_t)3 * 1024 * 512 * 2);
  p.wot = (u16*)take((size_t)1024 * 1024 * 2);
  p.cw1t = (u16*)take((size_t)2 * 128 * 2048 * 2);
  p.cw2t = (u16*)take((size_t)2 * 64 * 128 * 2);
  p.H = (u16*)take((size_t)S * 1024 * 2);
  p.BIG = (u16*)take((size_t)S * PS * 2);
  p.vsT = (u16*)take((size_t)2 * 64 * S * 2);
  p.vwT = (u16*)take((size_t)2 * 64 * S * 2);
  p.kc = (u16*)take((size_t)2 * 1024 * 64 * 2);
  p.vcT = (u16*)take((size_t)2 * 64 * 1024 * 2);
  p.ret = (float*)take((size_t)128 * 4 * 8192 * 4);
  p.gst = (u16*)take((size_t)256 * 65536 * 2);
  p.bar = (unsigned*)take((size_t)XCD_BAR_WORDS * 4);
  p.part = (float*)take((size_t)6 * 64 * 4 * 256 * 4);
  p.ncnt = (unsigned*)take((size_t)6 * 64 * 4);
  if ((size_t)(w - (char*)d_ws) > ws_size) { fprintf(stderr, "workspace too small: need %zu have %zu\n", (size_t)(w - (char*)d_ws), ws_size); return; }
  void* args[] = {&p};
  hipError_t e = hipLaunchCooperativeKernel((void*)mega, dim3(grid_blocks), dim3(512), args, 0, stream);
  if (e != hipSuccess) fprintf(stderr, "coop launch failed: %s (grid %d)\n", hipGetErrorString(e), grid_blocks);
}
```

```cpp
#include <hip/hip_runtime.h>
#include <hip/hip_cooperative_groups.h>
#include <cstdio>
#include <cstdint>
namespace cg = cooperative_groups;

typedef unsigned short u16;
typedef unsigned int u32;
typedef unsigned long long u64;
using bf16x8 = __attribute__((ext_vector_type(8))) short;
using bf16x4 = __attribute__((ext_vector_type(4))) short;
using f32x4 = __attribute__((ext_vector_type(4))) float;

constexpr int S = 16384, FF = 2816, DIN = 3864;
constexpr int PS = 3968;
constexpr int C_U = 0, C_V = 512, C_RQ = 1024, C_RK = 1280, C_RV = 1536, C_RG = 2048, C_NQ = 2560,
              C_KC = 3072, C_VC = 3200, C_KS = 3328, C_VS = 3456, C_KW = 3584, C_VW = 3712, C_NG = 3840, C_MIX = 512;
constexpr float EPS = 1e-6f;
constexpr int SMEM_BYTES = 73728;

struct Params {
  const float* x_in;
  const float *ffn1_norm, *ffn1_w1, *ffn1_w2, *mix_norm, *w_in, *gm_ln_g, *gm_ln_b, *gm_ws, *gm_bs, *ret_gn_g, *ret_gn_b,
      *cmp_pos, *cmp_w1, *cmp_w2, *w_branch, *w_gate, *b_gate, *w_o, *ffn2_norm, *ffn2_w1, *ffn2_w2, *final_norm;
  float* xout;
  u16 *w1t_a, *w2t_a, *wint, *wgt, *wbt, *wot, *w1t_b, *w2t_b, *cw1t, *cw2t;
  u16 *H, *BIG, *vsT, *vwT, *kc, *vcT;
  float* ret;
  u16* gst;
  unsigned* bar;
  float* part; unsigned* ncnt;
};

__device__ __forceinline__ u16 f2bf(float f) { __bf16 b = (__bf16)f; return __builtin_bit_cast(u16, b); }
__device__ __forceinline__ float bf2f(u16 h) { return __uint_as_float(((u32)h) << 16); }
typedef __bf16 bf16x2_t __attribute__((ext_vector_type(2)));
typedef float f32x2_t __attribute__((ext_vector_type(2)));
__device__ __forceinline__ u32 pack2(float a, float b) { f32x2_t v = {a, b}; bf16x2_t r = __builtin_convertvector(v, bf16x2_t); return __builtin_bit_cast(u32, r); }
__device__ __forceinline__ float lo2f(u32 w) { return __uint_as_float(w << 16); }
__device__ __forceinline__ float hi2f(u32 w) { return __uint_as_float(w & 0xffff0000u); }
__device__ __forceinline__ float gelu_t(float x) { float y = 1.5957691216057308f * (x + 0.044715f * x * x * x); return x * __builtin_amdgcn_rcpf(1.0f + __expf(-y)); }
__device__ __forceinline__ float silu_f(float x) { return x * __builtin_amdgcn_rcpf(1.0f + __expf(-x)); }
__device__ __forceinline__ float sigm_f(float x) { return __builtin_amdgcn_rcpf(1.0f + __expf(-x)); }
__device__ __forceinline__ f32x4 mfma16(bf16x8 a, bf16x8 b, f32x4 c) { return __builtin_amdgcn_mfma_f32_16x16x32_bf16(a, b, c, 0, 0, 0); }
__device__ __forceinline__ bf16x8 ld8(const u16* p) { return *(const bf16x8*)p; }
__device__ __forceinline__ bf16x8 ld44(const u16* p0, const u16* p1) {
  bf16x4 a = *(const bf16x4*)p0, b = *(const bf16x4*)p1;
  return __builtin_shufflevector(a, b, 0, 1, 2, 3, 4, 5, 6, 7);
}
__device__ __forceinline__ bf16x8 pk8(float a0, float a1, float a2, float a3, float a4, float a5, float a6, float a7) {
  union { uint4 u; bf16x8 v; } x;
  x.u = make_uint4(pack2(a0, a1), pack2(a2, a3), pack2(a4, a5), pack2(a6, a7));
  return x.v;
}
__device__ __forceinline__ bf16x8 scale8(bf16x8 v, float s) {
  union { uint4 u; bf16x8 v; } x; x.v = v;
  x.u.x = pack2(lo2f(x.u.x) * s, hi2f(x.u.x) * s); x.u.y = pack2(lo2f(x.u.y) * s, hi2f(x.u.y) * s);
  x.u.z = pack2(lo2f(x.u.z) * s, hi2f(x.u.z) * s); x.u.w = pack2(lo2f(x.u.w) * s, hi2f(x.u.w) * s);
  return x.v;
}
__device__ __forceinline__ void wave_lds_sync() { asm volatile("s_waitcnt lgkmcnt(0)" ::: "memory"); }

__device__ __forceinline__ int tid_fresh() { int t = threadIdx.x; asm volatile("" : "+v"(t)); return t; }
__device__ __forceinline__ int wmap(int n, int mode) {
  if (mode == 0) return n;
  int isb = n >= FF; int nn = isb ? n - FF : n;
  return (nn >> 4) * 32 + isb * 16 + (nn & 15);
}
__device__ __forceinline__ void wprep_matrix(const float* __restrict__ src, u16* __restrict__ dst, int K, int N, int mode, u16* smem, int vb, int nvb) {
  float* T = (float*)smem;
  const int tid = tid_fresh() & 255;
  const int tk = K >> 6, tn = (N + 63) >> 6, nt = tk * tn;
  for (int t = vb; t < nt; t += nvb) {
    const int k0 = (t % tk) * 64, n0 = (t / tk) * 64;
#pragma unroll
    for (int i = 0; i < 4; i++) {
      int kk = (tid >> 4) + 16 * i, n = n0 + (tid & 15) * 4;
      float4 v = make_float4(0.f, 0.f, 0.f, 0.f);
      if (n < N) v = *(const float4*)(src + (size_t)(k0 + kk) * N + n);
      float* tp = T + kk * 65 + (tid & 15) * 4;
      tp[0] = v.x; tp[1] = v.y; tp[2] = v.z; tp[3] = v.w;
    }
    __syncthreads();
    {
      int n = tid >> 2, kc = (tid & 3) * 16, nn = n0 + n;
      if (nn < N) {
        u32 w[8];
#pragma unroll
        for (int e = 0; e < 8; e++) w[e] = pack2(T[(kc + 2 * e) * 65 + n], T[(kc + 2 * e + 1) * 65 + n]);
        u16* dp = dst + (size_t)wmap(nn, mode) * K + k0 + kc;
        *(uint4*)dp = make_uint4(w[0], w[1], w[2], w[3]);
        *(uint4*)(dp + 8) = make_uint4(w[4], w[5], w[6], w[7]);
      }
    }
    __syncthreads();
  }
}
__device__ __forceinline__ void wprep_phase(const Params& p, int l, u16* smem, int vb, int nvb, bool skip_ffn1, bool skip_ffn2) {
  if (!skip_ffn1) wprep_matrix(p.ffn1_w1 + (size_t)l * 1024 * 5632, p.w1t_a, 1024, 5632, 1, smem, vb, nvb);
  if (!skip_ffn2) wprep_matrix(p.ffn2_w1 + (size_t)l * 1024 * 5632, p.w1t_b, 1024, 5632, 1, smem, vb, nvb);
  if (!skip_ffn1) wprep_matrix(p.ffn1_w2 + (size_t)l * FF * 1024, p.w2t_a, FF, 1024, 0, smem, vb, nvb);
  if (!skip_ffn2) wprep_matrix(p.ffn2_w2 + (size_t)l * FF * 1024, p.w2t_b, FF, 1024, 0, smem, vb, nvb);
  wprep_matrix(p.w_in + (size_t)l * 1024 * DIN, p.wint, 1024, DIN, 0, smem, vb, nvb);
  wprep_matrix(p.w_gate + (size_t)l * 1024 * 3072, p.wgt, 1024, 3072, 0, smem, vb, nvb);
  for (int m = 0; m < 3; m++)
    wprep_matrix(p.w_branch + (size_t)(l * 3 + m) * 512 * 1024, p.wbt + (size_t)m * 1024 * 512, 512, 1024, 0, smem, vb, nvb);
  wprep_matrix(p.w_o + (size_t)l * 1024 * 1024, p.wot, 1024, 1024, 0, smem, vb, nvb);
  for (int w = 0; w < 2; w++) {
    wprep_matrix(p.cmp_w1 + (size_t)(l * 2 + w) * 2048 * 128, p.cw1t + (size_t)w * 128 * 2048, 2048, 128, 0, smem, vb, nvb);
    wprep_matrix(p.cmp_w2 + (size_t)(l * 2 + w) * 128 * 64, p.cw2t + (size_t)w * 64 * 128, 128, 64, 0, smem, vb, nvb);
  }
}

__device__ __forceinline__ void norm_phase(const float* __restrict__ x, const float* __restrict__ g, u16* __restrict__ H) {
  const int tidf = tid_fresh();
  const int lane = tidf & 63;
  const int gw = blockIdx.x * 8 + (tidf >> 6), nw = gridDim.x * 8;
  float4 gg[4];
#pragma unroll
  for (int i = 0; i < 4; i++) gg[i] = ((const float4*)g)[lane + 64 * i];
  for (int row0 = gw * 4; row0 < S; row0 += nw * 4) {
    float4 v[4][4]; float ss[4];
#pragma unroll
    for (int rr = 0; rr < 4; rr++)
#pragma unroll
      for (int i = 0; i < 4; i++) v[rr][i] = ((const float4*)(x + (size_t)(row0 + rr) * 1024))[lane + 64 * i];
#pragma unroll
    for (int rr = 0; rr < 4; rr++) {
      float a = 0.f;
#pragma unroll
      for (int i = 0; i < 4; i++) a += v[rr][i].x * v[rr][i].x + v[rr][i].y * v[rr][i].y + v[rr][i].z * v[rr][i].z + v[rr][i].w * v[rr][i].w;
      ss[rr] = a;
    }
#pragma unroll
    for (int o = 32; o >= 1; o >>= 1)
#pragma unroll
      for (int rr = 0; rr < 4; rr++) ss[rr] += __shfl_xor(ss[rr], o);
#pragma unroll
    for (int rr = 0; rr < 4; rr++) {
      const float r = rsqrtf(ss[rr] * (1.0f / 1024.0f) + EPS);
#pragma unroll
      for (int i = 0; i < 4; i++) {
        uint2 o2 = make_uint2(pack2(v[rr][i].x * r * gg[i].x, v[rr][i].y * r * gg[i].y), pack2(v[rr][i].z * r * gg[i].z, v[rr][i].w * r * gg[i].w));
        *(uint2*)(H + (size_t)(row0 + rr) * 1024 + (lane + 64 * i) * 4) = o2;
      }
    }
  }
}
__device__ __forceinline__ void final_norm_phase(float* __restrict__ x, const float* __restrict__ g) {
  const int tidf = tid_fresh();
  const int lane = tidf & 63;
  const int gw = blockIdx.x * 8 + (tidf >> 6), nw = gridDim.x * 8;
  float4 gg[4];
#pragma unroll
  for (int i = 0; i < 4; i++) gg[i] = ((const float4*)g)[lane + 64 * i];
  for (int row0 = gw * 4; row0 < S; row0 += nw * 4) {
    float4 v[4][4]; float ss[4];
#pragma unroll
    for (int rr = 0; rr < 4; rr++)
#pragma unroll
      for (int i = 0; i < 4; i++) v[rr][i] = ((const float4*)(x + (size_t)(row0 + rr) * 1024))[lane + 64 * i];
#pragma unroll
    for (int rr = 0; rr < 4; rr++) {
      float a = 0.f;
#pragma unroll
      for (int i = 0; i < 4; i++) a += v[rr][i].x * v[rr][i].x + v[rr][i].y * v[rr][i].y + v[rr][i].z * v[rr][i].z + v[rr][i].w * v[rr][i].w;
      ss[rr] = a;
    }
#pragma unroll
    for (int o = 32; o >= 1; o >>= 1)
#pragma unroll
      for (int rr = 0; rr < 4; rr++) ss[rr] += __shfl_xor(ss[rr], o);
#pragma unroll
    for (int rr = 0; rr < 4; rr++) {
      const float r = rsqrtf(ss[rr] * (1.0f / 1024.0f) + EPS);
#pragma unroll
      for (int i = 0; i < 4; i++)
        ((float4*)(x + (size_t)(row0 + rr) * 1024))[lane + 64 * i] = make_float4(v[rr][i].x * r * gg[i].x, v[rr][i].y * r * gg[i].y, v[rr][i].z * r * gg[i].z, v[rr][i].w * r * gg[i].w);
    }
  }
}

#define LAS __attribute__((address_space(3)))
constexpr int G_BK = 64, G_HALF = 128, G_HTB = G_HALF * G_BK * 2, G_NXCD = 8, G_WGM = 8;
__device__ __forceinline__ int lds_byte(int r, int c) { const int st = (r >> 4) * 2 + (c >> 5), rr = r & 15, cc = c & 31, ob = rr * 64 + cc * 2; return st * 1024 + (ob ^ (((ob >> 9) & 1) << 5)); }
__device__ __forceinline__ void stage_rc(int b, int& R, int& C) { const int st = b / 1024, sb = b % 1024, swz = sb ^ (((sb >> 9) & 1) << 5); R = (st >> 1) * 16 + swz / 64; C = (st & 1) * 32 + (swz % 64) / 2; }
__device__ __forceinline__ int perm32(int rho) { const int n = rho >> 4, i = rho & 15; return 8 * (i >> 2) + 4 * n + (i & 3); }
struct Unit { int pm, pn; };
struct Gemm { const u16* A; const u16* Bt; int lda, ldb, M, N, K; };
struct StaticOrder {
  int nM, nN, nwg, G, c;
  __device__ void init(int M, int N, int G_, int c_) { nM = M / 256; nN = N / 256; nwg = nM * nN; G = G_; c = c_; }
  __device__ bool next(int i, Unit& u) const {
    const long L = (long)i * G + c; if (L >= nwg) return false;
    int wgid = (int)L; { const int q = nwg / G_NXCD, r = nwg % G_NXCD, xcd = wgid % G_NXCD, off = wgid / G_NXCD; wgid = (xcd < r ? xcd * (q + 1) : r * (q + 1) + (xcd - r) * q) + off; }
    const int nig = G_WGM * nN, gid = wgid / nig, fm = gid * G_WGM, gsz = (nM - fm) < G_WGM ? (nM - fm) : G_WGM;
    u.pm = fm + ((wgid % nig) % gsz); u.pn = (wgid % nig) / gsz; return true;
  }
};
typedef f32x4 AccT[2][2][4][2];
struct EpiSwiglu {
  static constexpr bool PERM = false;
  u16* ACT;
  __device__ __forceinline__ void operator()(const AccT& acc, const Unit& u, int wr, int wc, int fr, int fq) const {
    typedef unsigned u32x2s __attribute__((ext_vector_type(2)));
    const int row0 = u.pm * 256 + wr * 64 + fr;
    const int colw = u.pn * 128 + wc * 16 + ((fq & 1) ? 64 + 4 * (fq - 1) : 4 * fq);
#pragma unroll
    for (int ai = 0; ai < 2; ++ai)
#pragma unroll
      for (int m = 0; m < 4; ++m) {
        u16* rowp = ACT + (size_t)(row0 + ai * 128 + m * 16) * FF + colw;
        const f32x4 a0 = acc[ai][0][m][0], b0 = acc[ai][0][m][1], a1 = acc[ai][1][m][0], b1 = acc[ai][1][m][1];
        const u32 p0x = pack2(silu_f(a0[0]) * b0[0], silu_f(a0[1]) * b0[1]), p0y = pack2(silu_f(a0[2]) * b0[2], silu_f(a0[3]) * b0[3]);
        const u32 p1x = pack2(silu_f(a1[0]) * b1[0], silu_f(a1[1]) * b1[1]), p1y = pack2(silu_f(a1[2]) * b1[2], silu_f(a1[3]) * b1[3]);
        const u32x2s rx = __builtin_amdgcn_permlane16_swap(p0x, p1x, false, false);
        const u32x2s ry = __builtin_amdgcn_permlane16_swap(p0y, p1y, false, false);
        *(uint4*)rowp = make_uint4(rx.x, ry.x, rx.y, ry.y);
      }
  }
};
struct EpiResid {
  static constexpr bool PERM = false;
  const float* xsrc; float* xdst; float scale;
  __device__ __forceinline__ void operator()(const AccT& acc, const Unit& u, int wr, int wc, int fr, int fq) const {
    const int row0 = u.pm * 256 + wr * 64 + fr, col0 = u.pn * 256 + wc * 32 + 4 * fq;
#pragma unroll
    for (int ai = 0; ai < 2; ++ai) {
      f32x4 xv[4][2][2];
#pragma unroll
      for (int m = 0; m < 4; ++m)
#pragma unroll
        for (int bj = 0; bj < 2; ++bj)
#pragma unroll
          for (int n = 0; n < 2; ++n)
            xv[m][bj][n] = *(const f32x4*)(xsrc + (size_t)(row0 + ai * 128 + m * 16) * 1024 + col0 + bj * 128 + n * 16);
#pragma unroll
      for (int m = 0; m < 4; ++m)
#pragma unroll
        for (int bj = 0; bj < 2; ++bj)
#pragma unroll
          for (int n = 0; n < 2; ++n)
            *(f32x4*)(xdst + (size_t)(row0 + ai * 128 + m * 16) * 1024 + col0 + bj * 128 + n * 16) = xv[m][bj][n] + scale * acc[ai][bj][m][n];
    }
  }
};
struct EpiProj {
  static constexpr bool PERM = true;
  u16* proj;
  __device__ __forceinline__ void operator()(const AccT& acc, const Unit& u, int wr, int wc, int fr, int fq) const {
    const int row0 = u.pm * 256 + wr * 64 + fr, col0 = u.pn * 256 + wc * 32 + 8 * fq;
#pragma unroll
    for (int ai = 0; ai < 2; ++ai)
#pragma unroll
      for (int m = 0; m < 4; ++m) {
        u16* rowp = proj + (size_t)(row0 + ai * 128 + m * 16) * PS;
#pragma unroll
        for (int bj = 0; bj < 2; ++bj) {
          const int col = col0 + bj * 128;
          const f32x4 a = acc[ai][bj][m][0], b = acc[ai][bj][m][1];
          if (col < DIN) *(uint4*)(rowp + col) = make_uint4(pack2(a[0], a[1]), pack2(a[2], a[3]), pack2(b[0], b[1]), pack2(b[2], b[3]));
        }
      }
  }
};
struct EpiGate {
  static constexpr bool PERM = true;
  u16* gst; const float* bias; int tid;
  __device__ __forceinline__ void operator()(const AccT& acc, const Unit& u, int wr, int wc, int fr, int fq) const {
    u16* st = gst + (size_t)(u.pm * 4 + u.pn) * 65536 + tid * 8;
    const int col0 = u.pn * 256 + wc * 32 + 8 * fq;
#pragma unroll
    for (int bj = 0; bj < 2; ++bj) {
      const f32x4 b0 = *(const f32x4*)(bias + col0 + bj * 128), b1 = *(const f32x4*)(bias + col0 + bj * 128 + 4);
#pragma unroll
      for (int ai = 0; ai < 2; ++ai)
#pragma unroll
        for (int m = 0; m < 4; ++m) {
          const f32x4 a = acc[ai][bj][m][0] + b0, b = acc[ai][bj][m][1] + b1;
          *(uint4*)(st + ((ai * 2 + bj) * 4 + m) * 4096) = make_uint4(pack2(sigm_f(a[0]), sigm_f(a[1])), pack2(sigm_f(a[2]), sigm_f(a[3])),
                                                                     pack2(sigm_f(b[0]), sigm_f(b[1])), pack2(sigm_f(b[2]), sigm_f(b[3])));
        }
    }
  }
};
struct EpiBranch {
  static constexpr bool PERM = true;
  const u16* gst; u16* mix; int first; int tid;
  __device__ __forceinline__ void operator()(const AccT& acc, const Unit& u, int wr, int wc, int fr, int fq) const {
    const u16* st = gst + (size_t)(u.pm * 4 + u.pn) * 65536 + tid * 8;
    const int row0 = u.pm * 256 + wr * 64 + fr, col0 = u.pn * 256 + wc * 32 + 8 * fq;
#pragma unroll
    for (int ai = 0; ai < 2; ++ai) {
      uint4 gw[4][2], ov[4][2];
#pragma unroll
      for (int m = 0; m < 4; ++m)
#pragma unroll
        for (int bj = 0; bj < 2; ++bj) {
          gw[m][bj] = *(const uint4*)(st + ((ai * 2 + bj) * 4 + m) * 4096);
          ov[m][bj] = first ? make_uint4(0u, 0u, 0u, 0u) : *(const uint4*)(mix + (size_t)(row0 + ai * 128 + m * 16) * PS + col0 + bj * 128);
        }
#pragma unroll
      for (int m = 0; m < 4; ++m)
#pragma unroll
        for (int bj = 0; bj < 2; ++bj) {
          const uint4 g = gw[m][bj], o = ov[m][bj];
          const f32x4 a = acc[ai][bj][m][0], b = acc[ai][bj][m][1];
          const float v0 = lo2f(g.x) * a[0] + lo2f(o.x), v1 = hi2f(g.x) * a[1] + hi2f(o.x), v2 = lo2f(g.y) * a[2] + lo2f(o.y), v3 = hi2f(g.y) * a[3] + hi2f(o.y);
          const float v4 = lo2f(g.z) * b[0] + lo2f(o.z), v5 = hi2f(g.z) * b[1] + hi2f(o.z), v6 = lo2f(g.w) * b[2] + lo2f(o.w), v7 = hi2f(g.w) * b[3] + hi2f(o.w);
          *(uint4*)(mix + (size_t)(row0 + ai * 128 + m * 16) * PS + col0 + bj * 128) = make_uint4(pack2(v0, v1), pack2(v2, v3), pack2(v4, v5), pack2(v6, v7));
        }
    }
  }
};

template <class Epi, bool AFTER_DRAIN = false>
__device__ __forceinline__ void gemm_phase(LAS unsigned char* lds, const Gemm g, const Epi& E) {
  const int tid = tid_fresh(), wid = __builtin_amdgcn_readfirstlane(tid >> 6), lane = tid & 63, wr = wid >> 2, wc = wid & 3, fr = lane & 15, fq = lane >> 4;
  const int K = g.K, nt = K / G_BK;
  StaticOrder S; S.init(g.M, g.N, (int)gridDim.x, (int)blockIdx.x);
  unsigned voffA[2], voffB[2];
#pragma unroll
  for (int i = 0; i < 2; ++i) { int R, C; stage_rc(tid * 16 + i * 8192, R, C); const int Rb = Epi::PERM ? ((R & ~31) + perm32(R & 31)) : R;
    voffA[i] = (unsigned)(R * g.lda + C) * 2u; voffB[i] = (unsigned)(Rb * g.ldb + C) * 2u; }
  const size_t kstep = (size_t)(G_BK * 2);
  const size_t hstepA = (size_t)G_HALF * g.lda * 2, hstepB = (size_t)G_HALF * g.ldb * 2;
  const size_t tstepA = 2 * hstepA, tstepB = 2 * hstepB;
  const unsigned ldsw = (unsigned)wid * 1024u;
  const int aoff = lds_byte(wr * 64 + fr, fq * 8), boff = lds_byte(wc * 32 + fr, fq * 8);
#define PG8_SA(b, h) (((b) * 2 + (h)) * G_HTB)
#define PG8_SB(b, h) ((4 + (b) * 2 + (h)) * G_HTB)
#define PG8_STAGE(bufoff, gbase, voff) do { _Pragma("unroll") for (int _i = 0; _i < 2; ++_i) \
    __builtin_amdgcn_global_load_lds((const unsigned*)((const char*)(gbase) + (voff)[_i]), (LAS unsigned*)(lds + (bufoff) + ldsw + _i * 8192), 16, 0, 0); } while (0)
#define PG8_LDA(dst, b, h) do { _Pragma("unroll") for (int m = 0; m < 4; ++m) _Pragma("unroll") for (int k = 0; k < 2; ++k) dst[m][k] = *(const LAS bf16x8*)(lds + PG8_SA(b, h) + aoff + m * 2048 + k * 1024); } while (0)
#define PG8_LDB(dst, b, h) do { _Pragma("unroll") for (int n = 0; n < 2; ++n) _Pragma("unroll") for (int k = 0; k < 2; ++k) dst[n][k] = *(const LAS bf16x8*)(lds + PG8_SB(b, h) + boff + n * 2048 + k * 1024); } while (0)
#define PG8_MMA(ai, bj, At, Bt) do { __builtin_amdgcn_s_setprio(1); _Pragma("unroll") for (int m = 0; m < 4; ++m) _Pragma("unroll") for (int n = 0; n < 2; ++n) _Pragma("unroll") for (int k = 0; k < 2; ++k) \
    acc[ai][bj][m][n] = __builtin_amdgcn_mfma_f32_16x16x32_bf16(Bt[n][k], At[m][k], acc[ai][bj][m][n], 0, 0, 0); __builtin_amdgcn_s_setprio(0); } while (0)
#define PG8_WAIT_V(n) asm volatile("s_waitcnt vmcnt(" #n ")" ::: "memory")
#define PG8_WAIT_L(n) asm volatile("s_waitcnt lgkmcnt(" #n ")" ::: "memory")
#define PG8_BAR __builtin_amdgcn_s_barrier()
#define PG8_SCHED __builtin_amdgcn_sched_barrier(0)
  Unit cur, nxt; int ui = 0;
  if (!S.next(0, cur)) return;
  AccT acc;
#pragma unroll
  for (int a = 0; a < 2; ++a)
#pragma unroll
    for (int b = 0; b < 2; ++b)
#pragma unroll
      for (int m = 0; m < 4; ++m)
#pragma unroll
        for (int n = 0; n < 2; ++n) acc[a][b][m][n] = (f32x4){0.f, 0.f, 0.f, 0.f};
  bf16x8 At[4][2], B0[2][2], B1[2][2];
  const char* cA = (const char*)g.A + (size_t)cur.pm * tstepA; const char* cB = (const char*)g.Bt + (size_t)cur.pn * tstepB;
  PG8_STAGE(PG8_SB(0, 0), cB, voffB); PG8_STAGE(PG8_SA(0, 0), cA, voffA); PG8_STAGE(PG8_SB(0, 1), cB + hstepB, voffB); PG8_STAGE(PG8_SA(0, 1), cA + hstepA, voffA);
  if (wr == 1) PG8_BAR;
  PG8_WAIT_V(4); PG8_BAR;
  PG8_STAGE(PG8_SB(1, 0), cB + kstep, voffB); PG8_STAGE(PG8_SA(1, 0), cA + kstep, voffA); PG8_STAGE(PG8_SB(1, 1), cB + hstepB + kstep, voffB);
  PG8_WAIT_V(6); PG8_BAR;
  for (;;) {
    const bool has_next = S.next(ui + 1, nxt);
    const char* nA = has_next ? (const char*)g.A + (size_t)nxt.pm * tstepA : cA; const char* nB = has_next ? (const char*)g.Bt + (size_t)nxt.pn * tstepB : cB;
    for (int t = 0; t < nt; t += 2) {
      const bool last = (t == nt - 2);
      const char* a1 = cA + (size_t)(t + 1) * kstep;
      const char* a2 = last ? nA : cA + (size_t)(t + 2) * kstep; const char* b2 = last ? nB : cB + (size_t)(t + 2) * kstep;
      const char* a3 = a2 + kstep; const char* b3 = b2 + kstep;
      PG8_LDB(B0, 0, 0); PG8_SCHED; PG8_LDA(At, 0, 0); PG8_STAGE(PG8_SA(1, 1), a1 + hstepA, voffA);
      PG8_WAIT_L(8); PG8_BAR; PG8_WAIT_L(0); PG8_MMA(0, 0, At, B0); PG8_BAR; PG8_SCHED;
      PG8_LDB(B1, 0, 1); PG8_STAGE(PG8_SB(0, 0), b2, voffB);
      PG8_BAR; PG8_WAIT_L(0); PG8_MMA(0, 1, At, B1); PG8_BAR;
      PG8_LDA(At, 0, 1); PG8_STAGE(PG8_SA(0, 0), a2, voffA);
      PG8_BAR; PG8_WAIT_L(0); PG8_MMA(1, 0, At, B0); PG8_BAR; PG8_SCHED;
      PG8_STAGE(PG8_SB(0, 1), b2 + hstepB, voffB);
      PG8_WAIT_V(6); PG8_BAR; PG8_MMA(1, 1, At, B1); PG8_BAR;
      PG8_LDB(B0, 1, 0); PG8_SCHED; PG8_LDA(At, 1, 0); PG8_STAGE(PG8_SA(0, 1), a2 + hstepA, voffA);
      PG8_WAIT_L(8); PG8_BAR; PG8_WAIT_L(0); PG8_MMA(0, 0, At, B0); PG8_BAR; PG8_SCHED;
      PG8_LDB(B1, 1, 1); PG8_STAGE(PG8_SB(1, 0), b3, voffB);
      PG8_BAR; PG8_WAIT_L(0); PG8_MMA(0, 1, At, B1); PG8_BAR;
      PG8_LDA(At, 1, 1); PG8_STAGE(PG8_SA(1, 0), a3, voffA);
      PG8_BAR; PG8_WAIT_L(0); PG8_MMA(1, 0, At, B0); PG8_BAR; PG8_SCHED;
      PG8_STAGE(PG8_SB(1, 1), b3 + hstepB, voffB);
      PG8_WAIT_V(6); PG8_BAR; PG8_MMA(1, 1, At, B1); PG8_BAR;
    }
    if constexpr (!AFTER_DRAIN) E(acc, cur, wr, wc, fr, fq);
    if (!has_next) break;
#pragma unroll
    for (int a = 0; a < 2; ++a)
#pragma unroll
      for (int b = 0; b < 2; ++b)
#pragma unroll
        for (int m = 0; m < 4; ++m)
#pragma unroll
          for (int n = 0; n < 2; ++n) acc[a][b][m][n] = (f32x4){0.f, 0.f, 0.f, 0.f};
    cur = nxt; cA = nA; cB = nB; ++ui;
  }
  PG8_WAIT_V(0);
  if (wr == 0) PG8_BAR;
  PG8_BAR;
  if constexpr (AFTER_DRAIN) E.fused(acc, cur, wr, wc, fr, fq, lds);
#undef PG8_SA
#undef PG8_SB
#undef PG8_STAGE
#undef PG8_LDA
#undef PG8_LDB
#undef PG8_MMA
#undef PG8_WAIT_V
#undef PG8_WAIT_L
#undef PG8_BAR
#undef PG8_SCHED
}

struct ChainStep { const char* A; const char* B; unsigned lda2, ldb2; int nt; };
__device__ __forceinline__ ChainStep merge_step(const Params& p, int q, const Unit& u) {
  const int s6 = q % 6, br = s6 >> 1;
  ChainStep c;
  if ((s6 & 1) == 0) {
    c.A = (const char*)(p.H + (size_t)u.pm * 256 * 1024); c.lda2 = 2048u;
    c.B = (const char*)(p.wgt + (size_t)(br * 1024 + u.pn * 256) * 1024); c.ldb2 = 2048u; c.nt = 16;
  } else {
    const int ycol = br == 0 ? C_U : (br == 1 ? C_RG : C_NQ);
    c.A = (const char*)(p.BIG + ycol + (size_t)u.pm * 256 * PS); c.lda2 = (unsigned)PS * 2u;
    c.B = (const char*)(p.wbt + (size_t)(br * 1024 + u.pn * 256) * 512); c.ldb2 = 1024u; c.nt = 8;
  }
  return c;
}
__device__ __forceinline__ void gemm_merge_chain(LAS unsigned char* lds, const Params& p, int l) {
  const int tid = tid_fresh(), wid = __builtin_amdgcn_readfirstlane(tid >> 6), lane = tid & 63, wr = wid >> 2, wc = wid & 3, fr = lane & 15, fq = lane >> 4;
  StaticOrder S; S.init(16384, 1024, (int)gridDim.x, (int)blockIdx.x);
  unsigned rA[2], c2[2];
#pragma unroll
  for (int i = 0; i < 2; ++i) { int R, C; stage_rc(tid * 16 + i * 8192, R, C); rA[i] = (unsigned)R; c2[i] = (unsigned)C * 2u; }
  const size_t kstep = (size_t)(G_BK * 2);
  const unsigned ldsw = (unsigned)wid * 1024u;
  const int aoff = lds_byte(wr * 64 + fr, fq * 8), boff = lds_byte(wc * 32 + fr, fq * 8);
#define PG8_SA(b, h) (((b) * 2 + (h)) * G_HTB)
#define PG8_SB(b, h) ((4 + (b) * 2 + (h)) * G_HTB)
#define CH_ROW_rA(i) (rA[i])
#define CH_ROW_rB(i) ((rA[i] & ~31u) + (unsigned)perm32((int)(rA[i] & 31u)))
#define CH_STAGE(bufoff, gbase, rr, ld2) do { _Pragma("unroll") for (int _i = 0; _i < 2; ++_i) \
    __builtin_amdgcn_global_load_lds((const unsigned*)((const char*)(gbase) + (CH_ROW_##rr(_i) * (ld2) + c2[_i])), (LAS unsigned*)(lds + (bufoff) + ldsw + _i * 8192), 16, 0, 0); } while (0)
#define PG8_LDA(dst, b, h) do { _Pragma("unroll") for (int m = 0; m < 4; ++m) _Pragma("unroll") for (int k = 0; k < 2; ++k) dst[m][k] = *(const LAS bf16x8*)(lds + PG8_SA(b, h) + aoff + m * 2048 + k * 1024); } while (0)
#define PG8_LDB(dst, b, h) do { _Pragma("unroll") for (int n = 0; n < 2; ++n) _Pragma("unroll") for (int k = 0; k < 2; ++k) dst[n][k] = *(const LAS bf16x8*)(lds + PG8_SB(b, h) + boff + n * 2048 + k * 1024); } while (0)
#define PG8_MMA(ai, bj, At, Bt) do { __builtin_amdgcn_s_setprio(1); _Pragma("unroll") for (int m = 0; m < 4; ++m) _Pragma("unroll") for (int n = 0; n < 2; ++n) _Pragma("unroll") for (int k = 0; k < 2; ++k) \
    acc[ai][bj][m][n] = __builtin_amdgcn_mfma_f32_16x16x32_bf16(Bt[n][k], At[m][k], acc[ai][bj][m][n], 0, 0, 0); __builtin_amdgcn_s_setprio(0); } while (0)
#define PG8_WAIT_V(n) asm volatile("s_waitcnt vmcnt(" #n ")" ::: "memory")
#define PG8_WAIT_L(n) asm volatile("s_waitcnt lgkmcnt(" #n ")" ::: "memory")
#define PG8_BAR __builtin_amdgcn_s_barrier()
#define PG8_SCHED __builtin_amdgcn_sched_barrier(0)
  Unit cu, nu; int q = 0;
  if (!S.next(0, cu)) return;
  ChainStep cs = merge_step(p, 0, cu), ns;
  AccT acc;
#pragma unroll
  for (int a = 0; a < 2; ++a)
#pragma unroll
    for (int b = 0; b < 2; ++b)
#pragma unroll
      for (int m = 0; m < 4; ++m)
#pragma unroll
        for (int n = 0; n < 2; ++n) acc[a][b][m][n] = (f32x4){0.f, 0.f, 0.f, 0.f};
  bf16x8 At[4][2], B0[2][2], B1[2][2];
  {
    const size_t hA = (size_t)G_HALF * cs.lda2, hB = (size_t)G_HALF * cs.ldb2;
    CH_STAGE(PG8_SB(0, 0), cs.B, rB, cs.ldb2); CH_STAGE(PG8_SA(0, 0), cs.A, rA, cs.lda2); CH_STAGE(PG8_SB(0, 1), cs.B + hB, rB, cs.ldb2); CH_STAGE(PG8_SA(0, 1), cs.A + hA, rA, cs.lda2);
    if (wr == 1) PG8_BAR;
    PG8_WAIT_V(4); PG8_BAR;
    CH_STAGE(PG8_SB(1, 0), cs.B + kstep, rB, cs.ldb2); CH_STAGE(PG8_SA(1, 0), cs.A + kstep, rA, cs.lda2); CH_STAGE(PG8_SB(1, 1), cs.B + hB + kstep, rB, cs.ldb2);
    PG8_WAIT_V(6); PG8_BAR;
  }
  for (;;) {
    bool has_next;
    if ((q + 1) % 6 != 0) { nu = cu; has_next = true; } else has_next = S.next((q + 1) / 6, nu);
    ns = has_next ? merge_step(p, q + 1, nu) : cs;
    const size_t hA = (size_t)G_HALF * cs.lda2, hB = (size_t)G_HALF * cs.ldb2;
    const size_t nhA = (size_t)G_HALF * ns.lda2, nhB = (size_t)G_HALF * ns.ldb2;
    const int nt = cs.nt;
    for (int t = 0; t < nt; t += 2) {
      const bool last = (t == nt - 2);
      const char* a1 = cs.A + (size_t)(t + 1) * kstep;
      const char* a2 = last ? ns.A : cs.A + (size_t)(t + 2) * kstep; const char* b2 = last ? ns.B : cs.B + (size_t)(t + 2) * kstep;
      const char* a3 = a2 + kstep; const char* b3 = b2 + kstep;
      const unsigned la2 = last ? ns.lda2 : cs.lda2, lb2 = last ? ns.ldb2 : cs.ldb2;
      const size_t hA2 = last ? nhA : hA, hB2 = last ? nhB : hB;
      PG8_LDB(B0, 0, 0); PG8_SCHED; PG8_LDA(At, 0, 0); CH_STAGE(PG8_SA(1, 1), a1 + hA, rA, cs.lda2);
      PG8_WAIT_L(8); PG8_BAR; PG8_WAIT_L(0); PG8_MMA(0, 0, At, B0); PG8_BAR; PG8_SCHED;
      PG8_LDB(B1, 0, 1); CH_STAGE(PG8_SB(0, 0), b2, rB, lb2);
      PG8_BAR; PG8_WAIT_L(0); PG8_MMA(0, 1, At, B1); PG8_BAR;
      PG8_LDA(At, 0, 1); CH_STAGE(PG8_SA(0, 0), a2, rA, la2);
      PG8_BAR; PG8_WAIT_L(0); PG8_MMA(1, 0, At, B0); PG8_BAR; PG8_SCHED;
      CH_STAGE(PG8_SB(0, 1), b2 + hB2, rB, lb2);
      PG8_WAIT_V(6); PG8_BAR; PG8_MMA(1, 1, At, B1); PG8_BAR;
      PG8_LDB(B0, 1, 0); PG8_SCHED; PG8_LDA(At, 1, 0); CH_STAGE(PG8_SA(0, 1), a2 + hA2, rA, la2);
      PG8_WAIT_L(8); PG8_BAR; PG8_WAIT_L(0); PG8_MMA(0, 0, At, B0); PG8_BAR; PG8_SCHED;
      PG8_LDB(B1, 1, 1); CH_STAGE(PG8_SB(1, 0), b3, rB, lb2);
      PG8_BAR; PG8_WAIT_L(0); PG8_MMA(0, 1, At, B1); PG8_BAR;
      PG8_LDA(At, 1, 1); CH_STAGE(PG8_SA(1, 0), a3, rA, la2);
      PG8_BAR; PG8_WAIT_L(0); PG8_MMA(1, 0, At, B0); PG8_BAR; PG8_SCHED;
      CH_STAGE(PG8_SB(1, 1), b3 + hB2, rB, lb2);
      PG8_WAIT_V(6); PG8_BAR; PG8_MMA(1, 1, At, B1); PG8_BAR;
    }
    {
      const int s6 = q % 6, br = s6 >> 1;
      if ((s6 & 1) == 0) { EpiGate e{p.gst, p.b_gate + (size_t)l * 3072 + br * 1024, tid}; e(acc, cu, wr, wc, fr, fq); }
      else { EpiBranch e{p.gst, p.BIG + C_MIX, br == 0, tid}; e(acc, cu, wr, wc, fr, fq); }
    }
    if (!has_next) break;
#pragma unroll
    for (int a = 0; a < 2; ++a)
#pragma unroll
      for (int b = 0; b < 2; ++b)
#pragma unroll
        for (int m = 0; m < 4; ++m)
#pragma unroll
          for (int n = 0; n < 2; ++n) acc[a][b][m][n] = (f32x4){0.f, 0.f, 0.f, 0.f};
    cu = nu; cs = ns; ++q;
  }
  PG8_WAIT_V(0);
  if (wr == 0) PG8_BAR;
  PG8_BAR;
#undef PG8_SA
#undef PG8_SB
#undef CH_STAGE
#undef CH_ROW_rA
#undef CH_ROW_rB
#undef PG8_LDA
#undef PG8_LDB
#undef PG8_MMA
#undef PG8_WAIT_V
#undef PG8_WAIT_L
#undef PG8_BAR
#undef PG8_SCHED
}

__device__ __forceinline__ void gmlp_tile(const Params& p, int l, int tile, u16* smem) {
  const int c = tile >> 2, g = tile & 3, t0 = c * 128;
  u16* Ws = smem; u16* vT = smem + 128 * 136;
  const int tid = tid_fresh() & 255, lane = tid & 63, wave = tid >> 6, wm = wave >> 1, wn = wave & 1, lr = lane & 15, lq = lane >> 4;
  const int tok = tid >> 1, half = tid & 1;
  u16* prow = p.BIG + (size_t)(t0 + tok) * PS;
  float s = 0.f, ss = 0.f;
#pragma unroll 8
  for (int i = 0; i < 32; i++) {
    uint4 raw = *(const uint4*)(prow + C_V + half * 256 + i * 8);
    u32 w[4] = {raw.x, raw.y, raw.z, raw.w};
#pragma unroll
    for (int e = 0; e < 4; e++) { float a = gelu_t(lo2f(w[e])), b = gelu_t(hi2f(w[e])); s += a + b; ss += a * a + b * b; }
  }
  s += __shfl_xor(s, 1); ss += __shfl_xor(ss, 1);
  const float mean = s * (1.0f / 512.0f);
  const float rstd = rsqrtf(fmaxf(ss * (1.0f / 512.0f) - mean * mean, 0.f) + EPS);
  const float* lg = p.gm_ln_g + l * 512 + g * 128; const float* lb = p.gm_ln_b + l * 512 + g * 128;
#pragma unroll
  for (int i = 0; i < 8; i++) {
    uint4 raw = *(const uint4*)(prow + C_V + g * 128 + half * 64 + i * 8);
    u32 w[4] = {raw.x, raw.y, raw.z, raw.w};
#pragma unroll
    for (int e = 0; e < 4; e++) {
      int cc = half * 64 + i * 8 + 2 * e;
      vT[cc * 136 + tok] = f2bf((gelu_t(lo2f(w[e])) - mean) * rstd * lg[cc] + lb[cc]);
      vT[(cc + 1) * 136 + tok] = f2bf((gelu_t(hi2f(w[e])) - mean) * rstd * lg[cc + 1] + lb[cc + 1]);
    }
  }
  const float* wrow = p.gm_ws + ((size_t)(l * 4 + g) * 128 + tok) * 128 + half * 64;
#pragma unroll
  for (int i = 0; i < 16; i++) {
    float4 w = ((const float4*)wrow)[i];
    int s0 = half * 64 + i * 4;
    uint2 o = make_uint2(pack2(s0 <= tok ? w.x : 0.f, s0 + 1 <= tok ? w.y : 0.f), pack2(s0 + 2 <= tok ? w.z : 0.f, s0 + 3 <= tok ? w.w : 0.f));
    *(uint2*)(Ws + tok * 136 + s0) = o;
  }
  __syncthreads();
  f32x4 acc[4][4];
#pragma unroll
  for (int m = 0; m < 4; m++)
#pragma unroll
    for (int n = 0; n < 4; n++) acc[m][n] = (f32x4){0.f, 0.f, 0.f, 0.f};
#pragma unroll
  for (int kk = 0; kk < 4; kk++) {
    bf16x8 a[4], b[4];
#pragma unroll
    for (int m = 0; m < 4; m++) a[m] = ld8(Ws + (wm * 64 + m * 16 + lr) * 136 + kk * 32 + lq * 8);
#pragma unroll
    for (int n = 0; n < 4; n++) b[n] = ld8(vT + (wn * 64 + n * 16 + lr) * 136 + kk * 32 + lq * 8);
#pragma unroll
    for (int m = 0; m < 4; m++)
#pragma unroll
      for (int n = 0; n < 4; n++) acc[m][n] = mfma16(b[n], a[m], acc[m][n]);
  }
  const float* bsp = p.gm_bs + (size_t)(l * 4 + g) * 128;
  uint2 uv[4][4];
#pragma unroll
  for (int m = 0; m < 4; m++)
#pragma unroll
    for (int n = 0; n < 4; n++)
      uv[m][n] = *(const uint2*)(p.BIG + (size_t)(t0 + wm * 64 + m * 16 + lr) * PS + C_U + g * 128 + wn * 64 + n * 16 + lq * 4);
#pragma unroll
  for (int m = 0; m < 4; m++) {
    const float bias = bsp[wm * 64 + m * 16 + lr];
#pragma unroll
    for (int n = 0; n < 4; n++) {
      const uint2 u = uv[m][n];
      *(uint2*)(p.BIG + (size_t)(t0 + wm * 64 + m * 16 + lr) * PS + C_U + g * 128 + wn * 64 + n * 16 + lq * 4) =
          make_uint2(pack2(gelu_t(lo2f(u.x)) * (acc[m][n][0] + bias), gelu_t(hi2f(u.x)) * (acc[m][n][1] + bias)),
                     pack2(gelu_t(lo2f(u.y)) * (acc[m][n][2] + bias), gelu_t(hi2f(u.y)) * (acc[m][n][3] + bias)));
    }
  }
  __syncthreads();
}

__device__ __forceinline__ void ret_kv_tile(const Params& p, int tile, u16* smem) {
  const int c = tile >> 2, h = tile & 3, t0 = c * 128;
  u16* vT = smem; u16* kT = smem + 128 * 136;
  const int tid = tid_fresh() & 255, lane = tid & 63, wave = tid >> 6, lr = lane & 15, lq = lane >> 4;
  const int tok = tid >> 1, half = tid & 1;
  const float lg = logf(1.0f - exp2f(-5.0f - (float)h));
  const u16* prow = p.BIG + (size_t)(t0 + tok) * PS;
#pragma unroll
  for (int i = 0; i < 8; i++) {
    uint4 raw = *(const uint4*)(prow + C_RV + h * 128 + half * 64 + i * 8);
    u32 w[4] = {raw.x, raw.y, raw.z, raw.w};
#pragma unroll
    for (int e = 0; e < 4; e++) {
      int cc = half * 64 + i * 8 + 2 * e;
      vT[cc * 136 + tok] = (u16)(w[e] & 0xffff);
      vT[(cc + 1) * 136 + tok] = (u16)(w[e] >> 16);
    }
  }
  const float sc = 0.125f * expf(lg * (float)(127 - tok));
#pragma unroll
  for (int i = 0; i < 4; i++) {
    uint4 raw = *(const uint4*)(prow + C_RK + h * 64 + half * 32 + i * 8);
    u32 w[4] = {raw.x, raw.y, raw.z, raw.w};
#pragma unroll
    for (int e = 0; e < 4; e++) {
      int cc = half * 32 + i * 8 + 2 * e;
      kT[cc * 136 + tok] = f2bf(lo2f(w[e]) * sc);
      kT[(cc + 1) * 136 + tok] = f2bf(hi2f(w[e]) * sc);
    }
  }
  __syncthreads();
  f32x4 acc[2][4];
#pragma unroll
  for (int m = 0; m < 2; m++)
#pragma unroll
    for (int n = 0; n < 4; n++) acc[m][n] = (f32x4){0.f, 0.f, 0.f, 0.f};
#pragma unroll
  for (int kk = 0; kk < 4; kk++) {
    bf16x8 a[2], b[4];
#pragma unroll
    for (int m = 0; m < 2; m++) a[m] = ld8(vT + (wave * 32 + m * 16 + lr) * 136 + kk * 32 + lq * 8);
#pragma unroll
    for (int n = 0; n < 4; n++) b[n] = ld8(kT + (n * 16 + lr) * 136 + kk * 32 + lq * 8);
#pragma unroll
    for (int m = 0; m < 2; m++)
#pragma unroll
      for (int n = 0; n < 4; n++) acc[m][n] = mfma16(a[m], b[n], acc[m][n]);
  }
  float* rp = p.ret + (size_t)(c * 4 + h) * 8192;
#pragma unroll
  for (int m = 0; m < 2; m++)
#pragma unroll
    for (int n = 0; n < 4; n++)
#pragma unroll
      for (int j = 0; j < 4; j++) rp[(wave * 32 + m * 16 + lq * 4 + j) * 64 + n * 16 + lr] = acc[m][n][j];
  __syncthreads();
}
__device__ __forceinline__ void ret_scan_wg(const Params& p, unsigned char* sm) {
  const int tid = tid_fresh(), seg = tid >> 7, el = tid & 127;
  float* endv = (float*)sm;
  for (int e0 = blockIdx.x * 128; e0 < 32768; e0 += gridDim.x * 128) {
    const int h = e0 >> 13;
    const float cd = expf(logf(1.0f - exp2f(-5.0f - (float)h)) * 128.0f);
    const float cd2 = cd * cd, cd4 = cd2 * cd2, cd8 = cd4 * cd4, cd16 = cd8 * cd8, cd32 = cd16 * cd16;
    float* base = p.ret + (size_t)(seg * 32) * 32768 + e0 + el;
    float v[32];
#pragma unroll
    for (int i = 0; i < 32; i++) v[i] = base[(size_t)i * 32768];
    float st = 0.f;
#pragma unroll
    for (int i = 0; i < 32; i++) st = st * cd + v[i];
    endv[seg * 128 + el] = st;
    __syncthreads();
    float carry = 0.f;
    for (int s2 = 0; s2 < seg; s2++) carry = carry * cd32 + endv[s2 * 128 + el];
    __syncthreads();
    st = carry;
#pragma unroll
    for (int i = 0; i < 32; i++) { base[(size_t)i * 32768] = st; st = st * cd + v[i]; }
  }
}
__device__ __forceinline__ void ret_out_tile(const Params& p, int l, int tile, u16* smem) {
  const int c = tile >> 2, h = tile & 3, t0 = c * 128;
  u16* vT = smem;
  u16* kS = smem + 128 * 136;
  u16* pT = kS + 128 * 72;
  const int tid = tid_fresh() & 255, lane = tid & 63, wave = tid >> 6, lr = lane & 15, lq = lane >> 4;
  const int tok = tid >> 1, half = tid & 1;
  const float lg = logf(1.0f - exp2f(-5.0f - (float)h));
  {
    const u16* prow = p.BIG + (size_t)(t0 + tok) * PS;
#pragma unroll
    for (int i = 0; i < 8; i++) {
      uint4 raw = *(const uint4*)(prow + C_RV + h * 128 + half * 64 + i * 8);
      u32 w[4] = {raw.x, raw.y, raw.z, raw.w};
#pragma unroll
      for (int e = 0; e < 4; e++) {
        int cc = half * 64 + i * 8 + 2 * e;
        vT[cc * 136 + tok] = (u16)(w[e] & 0xffff);
        vT[(cc + 1) * 136 + tok] = (u16)(w[e] >> 16);
      }
    }
#pragma unroll
    for (int i = 0; i < 4; i++)
      *(uint4*)(kS + tok * 72 + half * 32 + i * 8) = *(const uint4*)(prow + C_RK + h * 64 + half * 32 + i * 8);
    const float* rp = p.ret + (size_t)(c * 4 + h) * 8192 + tok * 64 + half * 32;
#pragma unroll
    for (int i = 0; i < 4; i++) {
      float4 a = ((const float4*)rp)[2 * i], b = ((const float4*)rp)[2 * i + 1];
      *(uint4*)(pT + tok * 72 + half * 32 + i * 8) = make_uint4(pack2(a.x, a.y), pack2(a.z, a.w), pack2(b.x, b.y), pack2(b.z, b.w));
    }
  }
  __syncthreads();
#pragma unroll 1
  for (int it = 0; it < 2; it++) {
    const int i = wave * 32 + it * 16 + lr;
    const u16* qp = p.BIG + (size_t)(t0 + i) * PS + C_RQ + h * 64 + lq * 8;
    const bf16x8 q_lo = ld8(qp), q_hi = ld8(qp + 32);
    f32x4 Y[8];
#pragma unroll
    for (int e = 0; e < 8; e++) Y[e] = (f32x4){0.f, 0.f, 0.f, 0.f};
    const int nch = ((wave * 32 + it * 16 + 15) >> 5) + 1;
    for (int jc = 0; jc < nch; jc++) {
      f32x4 s0 = (f32x4){0.f, 0.f, 0.f, 0.f}, s1 = s0;
      const u16* kp = kS + (jc * 32 + lr) * 72 + lq * 8;
      s0 = mfma16(ld8(kp), q_lo, s0); s0 = mfma16(ld8(kp + 32), q_hi, s0);
      s1 = mfma16(ld8(kp + 16 * 72), q_lo, s1); s1 = mfma16(ld8(kp + 16 * 72 + 32), q_hi, s1);
      float pv[8];
#pragma unroll
      for (int j = 0; j < 4; j++) {
        int d0 = i - (jc * 32 + lq * 4 + j), d1 = d0 - 16;
        pv[j] = d0 >= 0 ? s0[j] * 0.125f * __expf(lg * (float)d0) : 0.f;
        pv[4 + j] = d1 >= 0 ? s1[j] * 0.125f * __expf(lg * (float)d1) : 0.f;
      }
      const bf16x8 pb = pk8(pv[0], pv[1], pv[2], pv[3], pv[4], pv[5], pv[6], pv[7]);
#pragma unroll
      for (int e = 0; e < 8; e++) {
        const u16* vp = vT + (e * 16 + lr) * 136 + jc * 32 + lq * 4;
        Y[e] = mfma16(ld44(vp, vp + 16), pb, Y[e]);
      }
    }
    {
      const float qd = __expf(lg * (float)(i + 1));
      const bf16x8 ql = scale8(q_lo, qd), qh = scale8(q_hi, qd);
#pragma unroll
      for (int e = 0; e < 8; e++) {
        const u16* pp = pT + (e * 16 + lr) * 72 + lq * 8;
        Y[e] = mfma16(ld8(pp), ql, Y[e]);
        Y[e] = mfma16(ld8(pp + 32), qh, Y[e]);
      }
    }
    float s = 0.f, ss = 0.f;
#pragma unroll
    for (int e = 0; e < 8; e++)
#pragma unroll
      for (int j = 0; j < 4; j++) { s += Y[e][j]; ss += Y[e][j] * Y[e][j]; }
    s += __shfl_xor(s, 16); ss += __shfl_xor(ss, 16);
    s += __shfl_xor(s, 32); ss += __shfl_xor(ss, 32);
    const float mean = s * (1.0f / 128.0f);
    const float rstd = rsqrtf(fmaxf(ss * (1.0f / 128.0f) - mean * mean, 0.f) + EPS);
    u16* gp = p.BIG + (size_t)(t0 + i) * PS + C_RG + h * 128;
    const float* gg = p.ret_gn_g + l * 512 + h * 128; const float* gb = p.ret_gn_b + l * 512 + h * 128;
    uint2 grawv[8];
#pragma unroll
    for (int e = 0; e < 8; e++) grawv[e] = *(const uint2*)(gp + e * 16 + lq * 4);
#pragma unroll
    for (int e = 0; e < 8; e++) {
      const int e0 = e * 16 + lq * 4;
      const uint2 graw = grawv[e];
      float4 g4 = *(const float4*)(gg + e0), b4 = *(const float4*)(gb + e0);
      float y0 = (Y[e][0] - mean) * rstd * g4.x + b4.x, y1 = (Y[e][1] - mean) * rstd * g4.y + b4.y;
      float y2 = (Y[e][2] - mean) * rstd * g4.z + b4.z, y3 = (Y[e][3] - mean) * rstd * g4.w + b4.w;
      *(uint2*)(gp + e0) = make_uint2(pack2(silu_f(lo2f(graw.x)) * y0, silu_f(hi2f(graw.x)) * y1),
                                      pack2(silu_f(lo2f(graw.y)) * y2, silu_f(hi2f(graw.y)) * y3));
    }
  }
  __syncthreads();
}

__device__ __forceinline__ void cmp_tile(const Params& p, int l, int tile, u16* smem) {
  const int which = tile >> 6, g = (tile >> 5) & 1, ci0 = (tile & 31) * 32;
  const int tid = tid_fresh() & 255, lane = tid & 63, wave = tid >> 6, lr = lane & 15, lq = lane >> 4;
  float* part = (float*)smem;
  u16* hid = smem + 32768;
  const int colbase = (which ? C_VC : C_KC) + g * 64;
  const float* pos = p.cmp_pos + (size_t)(l * 2 + which) * 32 * 64;
  const u16* w1t = p.cw1t + (size_t)which * 128 * 2048;
  f32x4 acc[2][8];
#pragma unroll
  for (int m = 0; m < 2; m++)
#pragma unroll
    for (int n = 0; n < 8; n++) acc[m][n] = (f32x4){0.f, 0.f, 0.f, 0.f};
  int cir0 = ci0 + lr, cir1 = ci0 + 16 + lr;
  if (cir0 > 1022) cir0 = 1022;
  if (cir1 > 1022) cir1 = 1022;
#pragma unroll 4
  for (int ks = 0; ks < 16; ks++) {
    const int kk = wave * 512 + ks * 32 + lq * 8, toff = kk >> 6, dim = kk & 63;
    const float4 p0 = *(const float4*)(pos + toff * 64 + dim), p1 = *(const float4*)(pos + toff * 64 + dim + 4);
    bf16x8 a[2], b[8];
#pragma unroll
    for (int m = 0; m < 2; m++) {
      const int cr = m == 0 ? cir0 : cir1;
      uint4 raw = *(const uint4*)(p.BIG + (size_t)(cr * 16 + toff) * PS + colbase + dim);
      a[m] = pk8(lo2f(raw.x) + p0.x, hi2f(raw.x) + p0.y, lo2f(raw.y) + p0.z, hi2f(raw.y) + p0.w,
                 lo2f(raw.z) + p1.x, hi2f(raw.z) + p1.y, lo2f(raw.w) + p1.z, hi2f(raw.w) + p1.w);
    }
#pragma unroll
    for (int n = 0; n < 8; n++) b[n] = ld8(w1t + (size_t)(n * 16 + lr) * 2048 + kk);
#pragma unroll
    for (int m = 0; m < 2; m++)
#pragma unroll
      for (int n = 0; n < 8; n++) acc[m][n] = mfma16(a[m], b[n], acc[m][n]);
  }
#pragma unroll
  for (int m = 0; m < 2; m++)
#pragma unroll
    for (int n = 0; n < 8; n++)
#pragma unroll
      for (int j = 0; j < 4; j++) part[wave * 4096 + (m * 16 + lq * 4 + j) * 128 + n * 16 + lr] = acc[m][n][j];
  __syncthreads();
  for (int e = tid; e < 4096; e += 256) {
    const float v = part[e] + part[4096 + e] + part[8192 + e] + part[12288 + e];
    hid[e] = f2bf(gelu_t(v));
  }
  __syncthreads();
  f32x4 o[2] = {(f32x4){0.f, 0.f, 0.f, 0.f}, (f32x4){0.f, 0.f, 0.f, 0.f}};
  const u16* w2t = p.cw2t + (size_t)which * 64 * 128;
#pragma unroll
  for (int kk = 0; kk < 4; kk++) {
    bf16x8 bb = ld8(w2t + (wave * 16 + lr) * 128 + kk * 32 + lq * 8);
#pragma unroll
    for (int m = 0; m < 2; m++) o[m] = mfma16(ld8(hid + (m * 16 + lr) * 128 + kk * 32 + lq * 8), bb, o[m]);
  }
#pragma unroll
  for (int m = 0; m < 2; m++)
#pragma unroll
    for (int j = 0; j < 4; j++) {
      int ci = ci0 + m * 16 + lq * 4 + j, d = wave * 16 + lr;
      u16 v = ci < 1023 ? f2bf(o[m][j]) : (u16)0;
      if (which == 0) p.kc[(size_t)(g * 1024 + ci) * 64 + d] = v;
      else p.vcT[(size_t)(g * 64 + d) * 1024 + ci] = v;
    }
  __syncthreads();
}
__device__ __forceinline__ void vt_tile(const Params& p, int tile, u16* smem) {
  const int sw = tile >> 9, g = (tile >> 8) & 1, t0 = (tile & 255) * 64;
  const int tid = tid_fresh() & 255;
  u16* T = smem;
  const int col = (sw ? C_VW : C_VS) + g * 64;
  {
    const int tok = tid >> 2, dq = (tid & 3) * 16;
    const u16* src = p.BIG + (size_t)(t0 + tok) * PS + col + dq;
    uint4 r0 = *(const uint4*)src, r1 = *(const uint4*)(src + 8);
    u32 w[8] = {r0.x, r0.y, r0.z, r0.w, r1.x, r1.y, r1.z, r1.w};
#pragma unroll
    for (int e = 0; e < 8; e++) { T[(dq + 2 * e) * 72 + tok] = (u16)(w[e] & 0xffff); T[(dq + 2 * e + 1) * 72 + tok] = (u16)(w[e] >> 16); }
  }
  __syncthreads();
  {
    const int d = tid >> 2, tq = (tid & 3) * 16;
    u16* dst = (sw ? p.vwT : p.vsT) + (size_t)(g * 64 + d) * S + t0 + tq;
    *(uint4*)dst = *(const uint4*)(T + d * 72 + tq);
    *(uint4*)(dst + 8) = *(const uint4*)(T + d * 72 + tq + 8);
  }
  __syncthreads();
}

constexpr int NT_ST = 72;
constexpr int NT_EL = 64 * NT_ST;
__device__ __forceinline__ float quad_sum(float x) {
  x += __uint_as_float((u32)__builtin_amdgcn_mov_dpp((int)__float_as_uint(x), 0xB1, 0xF, 0xF, true));
  x += __uint_as_float((u32)__builtin_amdgcn_mov_dpp((int)__float_as_uint(x), 0x4E, 0xF, 0xF, true));
  return x;
}
__device__ __forceinline__ void qk64(const u16* kt, int lr, int lq, bf16x8 q_lo, bf16x8 q_hi, f32x4 (&s)[2][2]) {
#pragma unroll
  for (int c = 0; c < 2; c++)
#pragma unroll
    for (int t = 0; t < 2; t++) {
      const u16* kp = kt + (c * 32 + t * 16 + lr) * NT_ST + lq * 8;
      f32x4 a = s[c][t];
      a = mfma16(ld8(kp), q_lo, a); a = mfma16(ld8(kp + 32), q_hi, a);
      s[c][t] = a;
    }
}
__device__ __forceinline__ float ex2(float x) { return __builtin_amdgcn_exp2f(x); }
template <bool FAST>
__device__ __forceinline__ void attend_tile(const u16* kt, const u16* vt, int lr, int lq, bf16x8 q_lo, bf16x8 q_hi, float slope2, int dbase,
                                            bool rowsel, int win, float& m, float& lsum, f32x4 (&O)[4]) {
  f32x4 s[2][2];
  float sv[16];
  float mx = -1e30f;
  if (FAST) {
    const float binit = rowsel ? -slope2 * (float)(dbase - lq * 4) : -1e30f;
#pragma unroll
    for (int c = 0; c < 2; c++)
#pragma unroll
      for (int t = 0; t < 2; t++)
#pragma unroll
        for (int j = 0; j < 4; j++) s[c][t][j] = __builtin_fmaf(slope2, (float)(c * 32 + t * 16 + j), binit);
    qk64(kt, lr, lq, q_lo, q_hi, s);
#pragma unroll
    for (int c = 0; c < 2; c++)
#pragma unroll
      for (int t = 0; t < 2; t++)
#pragma unroll
        for (int j = 0; j < 4; j++) { sv[(c * 2 + t) * 4 + j] = s[c][t][j]; mx = fmaxf(mx, s[c][t][j]); }
  } else {
#pragma unroll
    for (int c = 0; c < 2; c++)
#pragma unroll
      for (int t = 0; t < 2; t++) s[c][t] = (f32x4){0.f, 0.f, 0.f, 0.f};
    qk64(kt, lr, lq, q_lo, q_hi, s);
#pragma unroll
    for (int c = 0; c < 2; c++)
#pragma unroll
      for (int t = 0; t < 2; t++)
#pragma unroll
        for (int j = 0; j < 4; j++) {
          const int d = dbase - (c * 32 + t * 16 + lq * 4 + j);
          const bool o = rowsel && d >= 0 && d < win;
          const float v = o ? s[c][t][j] - slope2 * (float)d : -1e30f;
          sv[(c * 2 + t) * 4 + j] = v;
          mx = fmaxf(mx, v);
        }
  }
  if (__any(mx > m)) {
    mx = fmaxf(mx, __shfl_xor(mx, 16)); mx = fmaxf(mx, __shfl_xor(mx, 32));
    const float mnew = fmaxf(m, mx);
    const float alpha = ex2(m - mnew);
    m = mnew;
    lsum *= alpha;
#pragma unroll
    for (int dt = 0; dt < 4; dt++)
#pragma unroll
      for (int j = 0; j < 4; j++) O[dt][j] *= alpha;
  }
  const float mn = m;
  float ps = 0.f;
  bf16x8 pb[2];
#pragma unroll
  for (int c = 0; c < 2; c++) {
    float pv[8];
#pragma unroll
    for (int j = 0; j < 8; j++) {
      const float v = sv[c * 8 + j];
      pv[j] = FAST ? ex2(v - mn) : (v > -1e29f ? ex2(v - mn) : 0.f);
      ps += pv[j];
    }
    pb[c] = pk8(pv[0], pv[1], pv[2], pv[3], pv[4], pv[5], pv[6], pv[7]);
  }
  lsum += ps;
#pragma unroll
  for (int dt = 0; dt < 4; dt++)
#pragma unroll
    for (int c = 0; c < 2; c++) {
      const u16* vp = vt + (dt * 16 + lr) * NT_ST + c * 32 + lq * 4;
      O[dt] = mfma16(ld44(vp, vp + 16), pb[c], O[dt]);
    }
}

template <bool HASV, class KS, class VS, class CF>
__device__ __forceinline__ void tile_pipe2(int n, u16* ktb, u16* vtb, int soff, KS ksrc, VS vsrc, CF compute) {
  uint4 kE, vE, kO, vO;
  kE = vE = kO = vO = make_uint4(0u, 0u, 0u, 0u);
  if (n > 0) { kE = *(const uint4*)ksrc(0); if (HASV) vE = *(const uint4*)vsrc(0); }
  if (n > 1) { kO = *(const uint4*)ksrc(1); if (HASV) vO = *(const uint4*)vsrc(1); }
  if (n > 0) { *(uint4*)(ktb + soff) = kE; if (HASV) *(uint4*)(vtb + soff) = vE; }
  __syncthreads();
#pragma unroll 1
  for (int i = 0; i < n; i += 2) {
    if (i + 2 < n) { kE = *(const uint4*)ksrc(i + 2); if (HASV) vE = *(const uint4*)vsrc(i + 2); }
    compute(i, ktb, vtb);
    if (i + 1 < n) { *(uint4*)(ktb + NT_EL + soff) = kO; if (HASV) *(uint4*)(vtb + NT_EL + soff) = vO; }
    __syncthreads();
    if (i + 1 >= n) break;
    if (i + 3 < n) { kO = *(const uint4*)ksrc(i + 3); if (HASV) vO = *(const uint4*)vsrc(i + 3); }
    compute(i + 1, ktb + NT_EL, vtb + NT_EL);
    if (i + 2 < n) { *(uint4*)(ktb + soff) = kE; if (HASV) *(uint4*)(vtb + soff) = vE; }
    __syncthreads();
  }
}

__device__ __forceinline__ void nsa_wg(const Params& p, int g, int T0, unsigned char* sm) {
  const int tid = tid_fresh(), lane = tid & 63, lr = lane & 15, lq = lane >> 4;
  const int wv = __builtin_amdgcn_readfirstlane(tid >> 6);
  const int t0 = T0 + wv * 4;
  const int tok = lr >> 2, r = lr & 3, tpos = t0 + tok;
  const float slope = 1.4426950408889634f * exp2f(-(float)(g * 4 + r + 1));
  u16* proj = p.BIG;
  float* wl = (float*)sm + wv * 2112;
  float* impA = wl; float* impB = wl + 1024; u32* selm = (u32*)(wl + 1024 + 1040);
  u16* ktb = (u16*)(sm + 67584);
  u16* vtb = ktb + 2 * NT_EL;
  u32* wgm = (u32*)(vtb + 2 * NT_EL);
  u32* wgu = wgm + 64;
  int* blist = (int*)(wgu + 8);
  const int srow = tid >> 3, sseg = (tid & 7) * 8;
  const int soff = srow * NT_ST + sseg;
  bf16x8 q_lo, q_hi;
  {
    const u16* qp = proj + (size_t)tpos * PS + C_NQ + (g * 4 + r) * 64 + lq * 8;
    q_lo = scale8(ld8(qp), 0.125f * 1.4426950408889634f); q_hi = scale8(ld8(qp + 32), 0.125f * 1.4426950408889634f);
  }
  float g0, g1, g2;
  {
    const u16* gp = proj + (size_t)tpos * PS + C_NG + (g * 4 + r) * 3;
    g0 = sigm_f(bf2f(gp[0])); g1 = sigm_f(bf2f(gp[1])); g2 = sigm_f(bf2f(gp[2]));
  }
  f32x4 outacc[4];
#pragma unroll
  for (int dt = 0; dt < 4; dt++) outacc[dt] = (f32x4){0.f, 0.f, 0.f, 0.f};
  const int cur = T0 >> 6;

  for (int i = lane; i < 1024 + 1040; i += 64) wl[i] = 0.f;
  {
    const int ncmp = (T0 + 31 >= 31) ? ((T0 + 31 - 31) >> 4) + 1 : 0;
    const int nst = (ncmp + 63) >> 6;
    const u16* ksrc = p.kc + (size_t)g * 1024 * 64 + (size_t)srow * 64 + sseg;
    const u16* vsrc = p.vcT + (size_t)(g * 64 + srow) * 1024 + sseg;
    float m = -1e30f, lsum = 0.f;
    tile_pipe2<false>(nst, ktb, vtb, soff,
      [&](int i) { return ksrc + (size_t)(nst - 1 - i) * 4096; }, [&](int i) { return ksrc; },
      [&](int i, const u16* kt, const u16* vt) {
        const int st = nst - 1 - i;
        f32x4 s[2][2];
        float sv[16]; float mx = -1e30f;
        const bool fast = t0 - 31 - 16 * (st * 64 + 63) >= 0;
        if (fast) {
          const float binit = -slope * (float)(tpos - 31 - 16 * (st * 64 + lq * 4)), slope16 = slope * 16.0f;
#pragma unroll
          for (int c = 0; c < 2; c++)
#pragma unroll
            for (int t = 0; t < 2; t++)
#pragma unroll
              for (int j = 0; j < 4; j++) s[c][t][j] = __builtin_fmaf(slope16, (float)(c * 32 + t * 16 + j), binit);
          qk64(kt, lr, lq, q_lo, q_hi, s);
#pragma unroll
          for (int c = 0; c < 2; c++)
#pragma unroll
            for (int t = 0; t < 2; t++)
#pragma unroll
              for (int j = 0; j < 4; j++) { sv[(c * 2 + t) * 4 + j] = s[c][t][j]; mx = fmaxf(mx, s[c][t][j]); }
        } else {
#pragma unroll
          for (int c = 0; c < 2; c++)
#pragma unroll
            for (int t = 0; t < 2; t++) s[c][t] = (f32x4){0.f, 0.f, 0.f, 0.f};
          qk64(kt, lr, lq, q_lo, q_hi, s);
#pragma unroll
          for (int c = 0; c < 2; c++)
#pragma unroll
            for (int t = 0; t < 2; t++)
#pragma unroll
              for (int j = 0; j < 4; j++) {
                const int ci = st * 64 + c * 32 + t * 16 + lq * 4 + j;
                const int d = tpos - (ci * 16 + 31);
                const float v = d >= 0 ? s[c][t][j] - slope * (float)d : -1e30f;
                sv[(c * 2 + t) * 4 + j] = v; mx = fmaxf(mx, v);
              }
        }
        if (__any(mx > m)) {
          mx = fmaxf(mx, __shfl_xor(mx, 16)); mx = fmaxf(mx, __shfl_xor(mx, 32));
          const float mnew = fmaxf(m, mx);
          lsum *= ex2(m - mnew);
          m = mnew;
        }
        const float mn = m;
        float ps = 0.f;
        if (fast) {
#pragma unroll
          for (int j = 0; j < 16; j++) ps += ex2(sv[j] - mn);
        } else {
#pragma unroll
          for (int j = 0; j < 16; j++) ps += sv[j] > -1e29f ? ex2(sv[j] - mn) : 0.f;
        }
        lsum += ps;
      });
    lsum += __shfl_xor(lsum, 16); lsum += __shfl_xor(lsum, 32);
    const float invL = lsum > 0.f ? 1.0f / lsum : 0.f;
    f32x4 O[4];
#pragma unroll
    for (int dt = 0; dt < 4; dt++) O[dt] = (f32x4){0.f, 0.f, 0.f, 0.f};
    tile_pipe2<true>(nst, ktb, vtb, soff,
      [&](int st) { return ksrc + (size_t)st * 4096; }, [&](int st) { return vsrc + st * 64; },
      [&](int st, const u16* kt, const u16* vt) {
        f32x4 s[2][2];
        const bool fast = t0 - 31 - 16 * (st * 64 + 63) >= 0;
        if (fast) {
          const float binit = -slope * (float)(tpos - 31 - 16 * (st * 64 + lq * 4)) - m, slope16 = slope * 16.0f;
#pragma unroll
          for (int c = 0; c < 2; c++)
#pragma unroll
            for (int t = 0; t < 2; t++)
#pragma unroll
              for (int j = 0; j < 4; j++) s[c][t][j] = __builtin_fmaf(slope16, (float)(c * 32 + t * 16 + j), binit);
        } else {
#pragma unroll
          for (int c = 0; c < 2; c++)
#pragma unroll
            for (int t = 0; t < 2; t++) s[c][t] = (f32x4){0.f, 0.f, 0.f, 0.f};
        }
        qk64(kt, lr, lq, q_lo, q_hi, s);
        bf16x8 pb[2];
#pragma unroll
        for (int c = 0; c < 2; c++) {
          float p0[4], p1[4];
          if (fast) {
#pragma unroll
            for (int j = 0; j < 4; j++) { p0[j] = ex2(s[c][0][j]) * invL; p1[j] = ex2(s[c][1][j]) * invL; }
          } else {
#pragma unroll
            for (int j = 0; j < 4; j++) {
              const int ci = st * 64 + c * 32 + lq * 4 + j;
              const int d0 = tpos - (ci * 16 + 31), d1 = d0 - 256;
              p0[j] = d0 >= 0 ? ex2(s[c][0][j] - slope * (float)d0 - m) * invL : 0.f;
              p1[j] = d1 >= 0 ? ex2(s[c][1][j] - slope * (float)d1 - m) * invL : 0.f;
            }
          }
          float a0 = p0[0] + p0[1] + p0[2] + p0[3], b0 = p0[3], a1 = p1[0] + p1[1] + p1[2] + p1[3], b1 = p1[3];
          a0 = quad_sum(a0); b0 = quad_sum(b0); a1 = quad_sum(a1); b1 = quad_sum(b1);
          if (r == 0) {
            const int J0 = st * 16 + c * 8 + lq;
            impA[tok * 256 + J0] = a0; impB[tok * 260 + J0 + 1] = b0;
            impA[tok * 256 + J0 + 4] = a1; impB[tok * 260 + J0 + 5] = b1;
          }
          pb[c] = pk8(p0[0], p0[1], p0[2], p0[3], p1[0], p1[1], p1[2], p1[3]);
        }
#pragma unroll
        for (int dt = 0; dt < 4; dt++)
#pragma unroll
          for (int c = 0; c < 2; c++) {
            const u16* vp = vt + (dt * 16 + lr) * NT_ST + c * 32 + lq * 4;
            O[dt] = mfma16(ld44(vp, vp + 16), pb[c], O[dt]);
          }
      });
#pragma unroll
    for (int dt = 0; dt < 4; dt++)
#pragma unroll
      for (int j = 0; j < 4; j++) outacc[dt][j] += g0 * O[dt][j];
  }
  wave_lds_sync();

  if (cur < 16) {
    if (lane < 32) selm[lane] = ((lane & 7) == 0) ? ((2u << cur) - 1u) : 0u;
  } else {
    u32 kk[4][4];
#pragma unroll
    for (int tk = 0; tk < 4; tk++) {
      const float* ia = impA + tk * 256; const float* ib = impB + tk * 260;
#pragma unroll
      for (int i = 0; i < 4; i++) {
        const int j = lane + 64 * i;
        kk[tk][i] = (j >= 1 && j <= cur - 2) ? __float_as_uint(ia[j] + ib[j]) + 1u : 0u;
      }
    }
    u32 T[4] = {0u, 0u, 0u, 0u};
#pragma unroll 1
    for (int bit = 30; bit >= 0; bit--) {
#pragma unroll
      for (int tk = 0; tk < 4; tk++) {
        const u32 t = T[tk] | (1u << bit);
        const int cnt = __popcll(__ballot(kk[tk][0] >= t)) + __popcll(__ballot(kk[tk][1] >= t)) + __popcll(__ballot(kk[tk][2] >= t)) + __popcll(__ballot(kk[tk][3] >= t));
        if (cnt >= 13) T[tk] = t;
      }
    }
#pragma unroll
    for (int tk = 0; tk < 4; tk++) {
      const u32 k0 = kk[tk][0], k1 = kk[tk][1], k2 = kk[tk][2], k3 = kk[tk][3], Tt = T[tk];
      int need = 13 - (__popcll(__ballot(k0 > Tt)) + __popcll(__ballot(k1 > Tt)) + __popcll(__ballot(k2 > Tt)) + __popcll(__ballot(k3 > Tt)));
      u64 sel0, sel1, sel2, sel3;
      {
        u64 e = __ballot(k0 == Tt); int below = __builtin_amdgcn_mbcnt_hi((u32)(e >> 32), __builtin_amdgcn_mbcnt_lo((u32)e, 0u));
        sel0 = __ballot(k0 > Tt || (k0 == Tt && below < need)); need -= min(need, (int)__popcll(e));
        e = __ballot(k1 == Tt); below = __builtin_amdgcn_mbcnt_hi((u32)(e >> 32), __builtin_amdgcn_mbcnt_lo((u32)e, 0u));
        sel1 = __ballot(k1 > Tt || (k1 == Tt && below < need)); need -= min(need, (int)__popcll(e));
        e = __ballot(k2 == Tt); below = __builtin_amdgcn_mbcnt_hi((u32)(e >> 32), __builtin_amdgcn_mbcnt_lo((u32)e, 0u));
        sel2 = __ballot(k2 > Tt || (k2 == Tt && below < need)); need -= min(need, (int)__popcll(e));
        e = __ballot(k3 == Tt); below = __builtin_amdgcn_mbcnt_hi((u32)(e >> 32), __builtin_amdgcn_mbcnt_lo((u32)e, 0u));
        sel3 = __ballot(k3 > Tt || (k3 == Tt && below < need));
      }
      u32 myword = 0;
      if (lane == 0) myword = (u32)sel0; else if (lane == 1) myword = (u32)(sel0 >> 32);
      else if (lane == 2) myword = (u32)sel1; else if (lane == 3) myword = (u32)(sel1 >> 32);
      else if (lane == 4) myword = (u32)sel2; else if (lane == 5) myword = (u32)(sel2 >> 32);
      else if (lane == 6) myword = (u32)sel3; else if (lane == 7) myword = (u32)(sel3 >> 32);
      if (lane == 0) myword |= 1u;
      if (lane == ((cur - 1) >> 5)) myword |= 1u << ((cur - 1) & 31);
      if (lane == (cur >> 5)) myword |= 1u << (cur & 31);
      if (lane < 8) selm[tk * 8 + lane] = myword;
    }
  }
  wave_lds_sync();
  if (lane < 8) wgm[wv * 8 + lane] = selm[lane] | selm[8 + lane] | selm[16 + lane] | selm[24 + lane];
  __syncthreads();
  if (tid < 8) {
    u32 u = 0;
#pragma unroll
    for (int w = 0; w < 8; w++) u |= wgm[w * 8 + tid];
    const int lim = cur - tid * 32;
    if (lim < 0) u = 0; else if (lim < 31) u &= (2u << lim) - 1u;
    wgu[tid] = u;
  }
  __syncthreads();
  if (tid < 256) {
    const int w = tid >> 5, b = tid & 31;
    int idx = 0;
#pragma unroll
    for (int ww = 0; ww < 8; ww++) { const u32 x = wgu[ww]; idx += ww < w ? __builtin_popcount(x) : 0; }
    const u32 x = wgu[w];
    idx += __builtin_popcount(x & ((1u << b) - 1u));
    if ((x >> b) & 1u) blist[idx] = tid;
  }
  if (tid == 0) {
    int n = 0;
#pragma unroll
    for (int ww = 0; ww < 8; ww++) n += __builtin_popcount(wgu[ww]);
    blist[256] = n;
  }
  __syncthreads();

  {
    const int nblk = blist[256];
    const u16* ksrc = proj + C_KS + g * 64 + (size_t)srow * PS + sseg;
    const u16* vsrc = p.vsT + (size_t)(g * 64 + srow) * S + sseg;
    float m = -1e30f, lsum = 0.f;
    f32x4 O[4];
#pragma unroll
    for (int dt = 0; dt < 4; dt++) O[dt] = (f32x4){0.f, 0.f, 0.f, 0.f};
    tile_pipe2<true>(nblk, ktb, vtb, soff,
      [&](int i) { return ksrc + (size_t)blist[nblk - 1 - i] * 64 * PS; }, [&](int i) { return vsrc + blist[nblk - 1 - i] * 64; },
      [&](int i, const u16* kt, const u16* vt) {
        const int jb = blist[nblk - 1 - i];
        const u32 wany = wgm[wv * 8 + (jb >> 5)];
        if ((wany >> (jb & 31)) & 1u) {
          const bool rowsel = (selm[tok * 8 + (jb >> 5)] >> (jb & 31)) & 1u;
          if (jb < cur) attend_tile<true>(kt, vt, lr, lq, q_lo, q_hi, slope, tpos - jb * 64, rowsel, 1 << 30, m, lsum, O);
          else attend_tile<false>(kt, vt, lr, lq, q_lo, q_hi, slope, tpos - jb * 64, rowsel, 1 << 30, m, lsum, O);
        }
      });
    lsum += __shfl_xor(lsum, 16); lsum += __shfl_xor(lsum, 32);
    const float sc = g1 / fmaxf(lsum, 1e-30f);
#pragma unroll
    for (int dt = 0; dt < 4; dt++)
#pragma unroll
      for (int j = 0; j < 4; j++) outacc[dt][j] += sc * O[dt][j];
  }
  {
    int ks = T0 - 511; if (ks < 0) ks = 0; ks &= ~63;
    const int nst = ((T0 + 31 - ks) >> 6) + 1;
    const u16* ksrc = proj + C_KW + g * 64 + (size_t)(ks + srow) * PS + sseg;
    const u16* vsrc = p.vwT + (size_t)(g * 64 + srow) * S + ks + sseg;
    float m = -1e30f, lsum = 0.f;
    f32x4 O[4];
#pragma unroll
    for (int dt = 0; dt < 4; dt++) O[dt] = (f32x4){0.f, 0.f, 0.f, 0.f};
    tile_pipe2<true>(nst, ktb, vtb, soff,
      [&](int st) { return ksrc + (size_t)(nst - 1 - st) * 64 * PS; }, [&](int st) { return vsrc + (nst - 1 - st) * 64; },
      [&](int st, const u16* kt, const u16* vt) {
        const int kp0 = ks + (nst - 1 - st) * 64;
        if (t0 - (kp0 + 63) >= 0 && t0 + 3 - kp0 < 512) attend_tile<true>(kt, vt, lr, lq, q_lo, q_hi, slope, tpos - kp0, true, 512, m, lsum, O);
        else attend_tile<false>(kt, vt, lr, lq, q_lo, q_hi, slope, tpos - kp0, true, 512, m, lsum, O);
      });
    lsum += __shfl_xor(lsum, 16); lsum += __shfl_xor(lsum, 32);
    const float sc = g2 / fmaxf(lsum, 1e-30f);
#pragma unroll
    for (int dt = 0; dt < 4; dt++)
#pragma unroll
      for (int j = 0; j < 4; j++) outacc[dt][j] += sc * O[dt][j];
  }
  {
    u16* op = proj + (size_t)tpos * PS + C_NQ + (g * 4 + r) * 64 + lq * 4;
#pragma unroll
    for (int dt = 0; dt < 4; dt++)
      *(uint2*)(op + dt * 16) = make_uint2(pack2(outacc[dt][0], outacc[dt][1]), pack2(outacc[dt][2], outacc[dt][3]));
  }
  __syncthreads();
}

#define XB_TMO      128
#define XB_XCNT(j)  (256  + 64 * (j))
#define XB_XSUB(j)  (1280 + 64 * (j))
#define XB_XGEN(j)  (2304 + 64 * (j))
#define XB_TOP      3328
#define XB_TOPGEN   3392
#define XCD_BAR_WORDS 3456
#define XB_SPIN_CAP (1u << 18)
__device__ __forceinline__ unsigned xb_ld(unsigned* p)              { return __hip_atomic_load(p, __ATOMIC_RELAXED, __HIP_MEMORY_SCOPE_AGENT); }
__device__ __forceinline__ unsigned xb_add(unsigned* p, unsigned v) { return __hip_atomic_fetch_add(p, v, __ATOMIC_RELAXED, __HIP_MEMORY_SCOPE_AGENT); }
__device__ __forceinline__ unsigned xb_xcc_id() { return (unsigned)__builtin_amdgcn_s_getreg((3 << 11) | 20) & 0xFu; }
#define XB_SPIN(cond, bar) do { unsigned _sp = 0; while (cond) { __builtin_amdgcn_s_sleep(1); \
    if ((++_sp & 255u) == 0u) { if (xb_ld(&(bar)[XB_TMO])) break; if (_sp > XB_SPIN_CAP) { atomicAdd(&(bar)[XB_TMO], 1u); break; } } } } while (0)
struct XcdBarrier { unsigned* bar; unsigned x; volatile __attribute__((address_space(3))) unsigned* st; };
__device__ __forceinline__ XcdBarrier xcd_barrier_post(unsigned* bar, volatile __attribute__((address_space(3))) unsigned* st) {
  XcdBarrier b; b.bar = bar; b.x = xb_xcc_id(); b.st = st;
  if (threadIdx.x == 0) (void)xb_add(&bar[XB_XCNT(b.x)], 1u);
  return b;
}
__device__ __forceinline__ void xcd_barrier_complete(unsigned* bar, unsigned x, unsigned& nloc, unsigned& nx) {
  const unsigned G = gridDim.x * gridDim.y * gridDim.z;
  unsigned sum, cnt, mine, sp = 0u;
  for (;;) {
    sum = 0u; cnt = 0u; mine = 0u;
#pragma unroll
    for (unsigned j = 0; j < 16; ++j) { const unsigned c = xb_ld(&bar[XB_XCNT(j)]); sum += c; cnt += (c > 0u) ? 1u : 0u; mine = (j == x) ? c : mine; }
    if (sum == G) break;
    __builtin_amdgcn_s_sleep(1);
    if ((++sp & 255u) == 0u) { if (xb_ld(&bar[XB_TMO])) break; if (sp > XB_SPIN_CAP) { atomicAdd(&bar[XB_TMO], 1u); break; } }
  }
  nloc = mine > 0u ? mine : 1u; nx = cnt > 0u ? cnt : 1u;
}
__device__ __forceinline__ void xcd_barrier(const XcdBarrier& b) {
  asm volatile("s_waitcnt vmcnt(0)" ::: "memory");
  __syncthreads();
  if (threadIdx.x == 0) {
    unsigned* bar = b.bar;
    __builtin_amdgcn_s_waitcnt(0);
    unsigned nloc = b.st[0], nx = b.st[1];
    if (nloc == 0u) { xcd_barrier_complete(bar, b.x, nloc, nx); b.st[0] = nloc; b.st[1] = nx; }
    const unsigned old = xb_add(&bar[XB_XSUB(b.x)], 1u);
    const unsigned gen = old / nloc;
    if (old + 1u == (gen + 1u) * nloc) {
      __builtin_amdgcn_fence(__ATOMIC_RELEASE, "agent");
      asm volatile("s_waitcnt vmcnt(0)" ::: "memory");
      const unsigned og = xb_add(&bar[XB_TOP], 1u);
      const unsigned tg = og / nx;
      if (og + 1u == (tg + 1u) * nx) xb_add(&bar[XB_TOPGEN], 1u);
      else XB_SPIN(xb_ld(&bar[XB_TOPGEN]) == tg, bar);
      __builtin_amdgcn_fence(__ATOMIC_ACQUIRE, "agent");
      xb_add(&bar[XB_XGEN(b.x)], 1u);
      asm volatile("s_waitcnt vmcnt(0)" ::: "memory");
    } else {
      XB_SPIN(xb_ld(&bar[XB_XGEN(b.x)]) == gen, bar);
      __builtin_amdgcn_fence(__ATOMIC_ACQUIRE, "agent");
      asm volatile("s_waitcnt vmcnt(0)" ::: "memory");
    }
  }
  __syncthreads();
}

template <bool FINAL>
struct EpiResidNorm {
  static constexpr bool PERM = false;
  const float* xsrc; float* xdst; float scale; const float* gnext; u16* Hout; float* part; unsigned* cnt; unsigned* tmo;
  __device__ __forceinline__ void fused(AccT& acc, const Unit& u, int wr, int wc, int fr, int fq, LAS unsigned char* lds) const {
    volatile LAS float* ps = (volatile LAS float*)(lds + 131072);
    volatile LAS float* rr = (volatile LAS float*)(lds + 131072 + 4096);
    const int tid = tid_fresh();
    const int row0 = u.pm * 256 + wr * 64 + fr, col0 = u.pn * 256 + wc * 32 + 4 * fq;
#pragma unroll
    for (int ai = 0; ai < 2; ++ai) {
      f32x4 xv[4][2][2];
#pragma unroll
      for (int m = 0; m < 4; ++m)
#pragma unroll
        for (int bj = 0; bj < 2; ++bj)
#pragma unroll
          for (int n = 0; n < 2; ++n)
            xv[m][bj][n] = *(const f32x4*)(xsrc + (size_t)(row0 + ai * 128 + m * 16) * 1024 + col0 + bj * 128 + n * 16);
#pragma unroll
      for (int m = 0; m < 4; ++m) {
        float ss = 0.f;
#pragma unroll
        for (int bj = 0; bj < 2; ++bj)
#pragma unroll
          for (int n = 0; n < 2; ++n) {
            const f32x4 v = xv[m][bj][n] + scale * acc[ai][bj][m][n];
            if (!FINAL) *(f32x4*)(xdst + (size_t)(row0 + ai * 128 + m * 16) * 1024 + col0 + bj * 128 + n * 16) = v;
            acc[ai][bj][m][n] = v;
            ss += v[0] * v[0] + v[1] * v[1] + v[2] * v[2] + v[3] * v[3];
          }
        ss += __shfl_xor(ss, 16); ss += __shfl_xor(ss, 32);
        if (fq == 0) ps[wc * 256 + ai * 128 + wr * 64 + m * 16 + fr] = ss;
      }
    }
    __syncthreads();
    if (tid < 256) __hip_atomic_store(part + (size_t)(u.pm * 4 + u.pn) * 256 + tid, ps[tid] + ps[256 + tid] + ps[512 + tid] + ps[768 + tid], __ATOMIC_RELAXED, __HIP_MEMORY_SCOPE_AGENT);
    asm volatile("s_waitcnt vmcnt(0)" ::: "memory");
    __syncthreads();
    if (tid == 0) {
      (void)xb_add(cnt + u.pm, 1u);
      XB_SPIN(xb_ld(cnt + u.pm) < 4u, tmo);
      __builtin_amdgcn_fence(__ATOMIC_ACQUIRE, "agent");
      asm volatile("s_waitcnt vmcnt(0)" ::: "memory");
    }
    __syncthreads();
    if (tid < 256) {
      const float* pp = part + (size_t)(u.pm * 4) * 256 + tid;
      const float t0 = __hip_atomic_load(pp, __ATOMIC_RELAXED, __HIP_MEMORY_SCOPE_AGENT), t1 = __hip_atomic_load(pp + 256, __ATOMIC_RELAXED, __HIP_MEMORY_SCOPE_AGENT);
      const float t2 = __hip_atomic_load(pp + 512, __ATOMIC_RELAXED, __HIP_MEMORY_SCOPE_AGENT), t3 = __hip_atomic_load(pp + 768, __ATOMIC_RELAXED, __HIP_MEMORY_SCOPE_AGENT);
      rr[tid] = rsqrtf(((t0 + t1) + (t2 + t3)) * (1.0f / 1024.0f) + EPS);
    }
    __syncthreads();
    f32x4 gv[2][2];
#pragma unroll
    for (int bj = 0; bj < 2; ++bj)
#pragma unroll
      for (int n = 0; n < 2; ++n) gv[bj][n] = *(const f32x4*)(gnext + col0 + bj * 128 + n * 16);
#pragma unroll
    for (int ai = 0; ai < 2; ++ai)
#pragma unroll
      for (int m = 0; m < 4; ++m) {
        const float r = rr[ai * 128 + wr * 64 + m * 16 + fr];
#pragma unroll
        for (int bj = 0; bj < 2; ++bj) {
          const f32x4 h0 = acc[ai][bj][m][0] * r * gv[bj][0], h1 = acc[ai][bj][m][1] * r * gv[bj][1];
          if (FINAL) {
            *(f32x4*)(xdst + (size_t)(row0 + ai * 128 + m * 16) * 1024 + col0 + bj * 128) = h0;
            *(f32x4*)(xdst + (size_t)(row0 + ai * 128 + m * 16) * 1024 + col0 + bj * 128 + 16) = h1;
          } else {
            typedef unsigned u32x2s __attribute__((ext_vector_type(2)));
            const u32x2s rx = __builtin_amdgcn_permlane16_swap(pack2(h0[0], h0[1]), pack2(h1[0], h1[1]), false, false);
            const u32x2s ry = __builtin_amdgcn_permlane16_swap(pack2(h0[2], h0[3]), pack2(h1[2], h1[3]), false, false);
            const int colw = u.pn * 256 + wc * 32 + bj * 128 + ((fq & 1) ? 16 + 4 * (fq - 1) : 4 * fq);
            *(uint4*)(Hout + (size_t)(row0 + ai * 128 + m * 16) * 1024 + colw) = make_uint4(rx.x, ry.x, rx.y, ry.y);
          }
        }
      }
    __syncthreads();
  }
};

constexpr int SMEM_TOTAL = 147456;
__global__ void __launch_bounds__(512, 2) mega(Params p) {
  cg::grid_group grid = cg::this_grid();
  __shared__ __attribute__((aligned(16))) unsigned char smem_raw[SMEM_TOTAL + 16];
  LAS unsigned char* glds = (LAS unsigned char*)smem_raw;
  volatile LAS unsigned* xb_words = (volatile LAS unsigned*)(glds + SMEM_TOTAL);
  if (threadIdx.x == 0) { xb_words[0] = 0u; xb_words[1] = 0u; }
  if (blockIdx.x == 0) { for (int i = threadIdx.x; i < XCD_BAR_WORDS; i += 512) p.bar[i] = 0u; if (threadIdx.x < 384) p.ncnt[threadIdx.x] = 0u; }
  __syncthreads();
  XcdBarrier xb; xb.bar = p.bar; xb.x = 0; xb.st = xb_words;
#define VB_SETUP const int _tf = tid_fresh(); const int half = __builtin_amdgcn_readfirstlane(_tf >> 8); const int nb = gridDim.x * 2, bid = blockIdx.x * 2 + half; \
  u16* smem = (u16*)(smem_raw + half * SMEM_BYTES); const int vwave = __builtin_amdgcn_readfirstlane((_tf & 255) >> 6); (void)vwave; (void)nb; (void)bid; (void)smem;
#pragma unroll 1
  for (int l = 0; l < 2; l++) {
    const float* xsrc = l == 0 ? p.x_in : p.xout;
    const bool fusedn = gridDim.x == 256;
    if (l == 0 || !fusedn) norm_phase(xsrc, p.ffn1_norm + l * 1024, p.H);
    { VB_SETUP wprep_phase(p, l, smem, bid, nb, l == 1 && fusedn, fusedn); }
    if (l == 0) { grid.sync(); xb = xcd_barrier_post(p.bar, xb_words); } else xcd_barrier(xb);
    { Gemm g{p.H, p.w1t_a, 1024, 1024, S, 5632, 1024}; EpiSwiglu e{p.BIG}; gemm_phase(glds, g, e); }
    if (fusedn && blockIdx.x >= 128) {
      VB_SETUP
      wprep_matrix(p.ffn2_w1 + (size_t)l * 1024 * 5632, p.w1t_b, 1024, 5632, 1, smem, bid - 256, 256);
      wprep_matrix(p.ffn2_w2 + (size_t)l * FF * 1024, p.w2t_b, FF, 1024, 0, smem, bid - 256, 256);
    }
    xcd_barrier(xb);
    if (fusedn) {
      Gemm g{p.BIG, p.w2t_a, FF, FF, S, 1024, FF};
      EpiResidNorm<false> e{xsrc, p.xout, 0.5f, p.mix_norm + l * 1024, p.H, p.part + (size_t)(l * 2) * 65536, p.ncnt + (l * 2) * 64, p.bar};
      gemm_phase<EpiResidNorm<false>, true>(glds, g, e);
      xcd_barrier(xb);
    } else {
      { Gemm g{p.BIG, p.w2t_a, FF, FF, S, 1024, FF}; EpiResid e{xsrc, p.xout, 0.5f}; gemm_phase(glds, g, e); }
      xcd_barrier(xb);
      norm_phase(p.xout, p.mix_norm + l * 1024, p.H);
      xcd_barrier(xb);
    }
    { Gemm g{p.H, p.wint, 1024, 1024, S, 4096, 1024}; EpiProj e{p.BIG}; gemm_phase(glds, g, e); }
    xcd_barrier(xb);
    { VB_SETUP
    if (nb == 512) {
      if (bid < 128) { cmp_tile(p, l, bid, smem); ret_kv_tile(p, bid, smem); ret_kv_tile(p, 128 + bid, smem); }
      else {
        const int h2 = bid - 128;
        gmlp_tile(p, l, h2, smem);
        if (h2 < 128) { gmlp_tile(p, l, 384 + h2, smem); vt_tile(p, h2, smem); }
        else {
          const int ci = h2 - 128;
          ret_kv_tile(p, 256 + ci, smem);
          vt_tile(p, 128 + ci * 3, smem); vt_tile(p, 129 + ci * 3, smem); vt_tile(p, 130 + ci * 3, smem);
          if (ci < 128) vt_tile(p, 896 + ci, smem);
        }
      }
    } else {
    for (int t = bid; t < 128 + 512 + 512 + 1024; t += nb) {
      if (t < 128) cmp_tile(p, l, t, smem);
      else if (t < 640) gmlp_tile(p, l, t - 128, smem);
      else if (t < 1152) ret_kv_tile(p, t - 640, smem);
      else vt_tile(p, t - 1152, smem);
    } } }
    xcd_barrier(xb);
    {
      const int tf = tid_fresh();
      const int wv = __builtin_amdgcn_readfirstlane(tf >> 6);
      ret_scan_wg(p, smem_raw);
      const int xcd = blockIdx.x & 7, slot = blockIdx.x >> 3, nslot = gridDim.x >> 3;
      for (int i = slot; i < 128; i += nslot) {
        const int rsel = i >> 6, j = i & 63;
        const int range = rsel == 0 ? 15 - xcd : xcd;
        const int g = (j ^ (j >> 5)) & 1, w = range * 32 + 31 - (j >> 1);
        nsa_wg(p, g, w * 32, smem_raw);
      }
    }
    xcd_barrier(xb);
    { VB_SETUP for (int t = bid; t < 512; t += nb) ret_out_tile(p, l, t, smem); }
    xcd_barrier(xb);
    gemm_merge_chain(glds, p, l);
    xcd_barrier(xb);
    if (fusedn) {
      Gemm g{p.BIG + C_MIX, p.wot, PS, 1024, S, 1024, 1024};
      EpiResidNorm<false> e{p.xout, p.xout, 1.0f, p.ffn2_norm + l * 1024, p.H, p.part + (size_t)(l * 2 + 1) * 65536, p.ncnt + (l * 2 + 1) * 64, p.bar};
      gemm_phase<EpiResidNorm<false>, true>(glds, g, e);
      xcd_barrier(xb);
    } else {
      { Gemm g{p.BIG + C_MIX, p.wot, PS, 1024, S, 1024, 1024}; EpiResid e{p.xout, p.xout, 1.0f}; gemm_phase(glds, g, e); }
      xcd_barrier(xb);
      norm_phase(p.xout, p.ffn2_norm + l * 1024, p.H);
      xcd_barrier(xb);
    }
    { Gemm g{p.H, p.w1t_b, 1024, 1024, S, 5632, 1024}; EpiSwiglu e{p.BIG}; gemm_phase(glds, g, e); }
    if (l == 0 && fusedn && blockIdx.x >= 128) {
      VB_SETUP
      wprep_matrix(p.ffn1_w1 + (size_t)1024 * 5632, p.w1t_a, 1024, 5632, 1, smem, bid - 256, 256);
      wprep_matrix(p.ffn1_w2 + (size_t)FF * 1024, p.w2t_a, FF, 1024, 0, smem, bid - 256, 256);
    }
    xcd_barrier(xb);
    if (fusedn && l == 0) {
      Gemm g{p.BIG, p.w2t_b, FF, FF, S, 1024, FF};
      EpiResidNorm<false> e{p.xout, p.xout, 0.5f, p.ffn1_norm + 1024, p.H, p.part + (size_t)4 * 65536, p.ncnt + 4 * 64, p.bar};
      gemm_phase<EpiResidNorm<false>, true>(glds, g, e);
      xcd_barrier(xb);
    } else if (fusedn) {
      Gemm g{p.BIG, p.w2t_b, FF, FF, S, 1024, FF};
      EpiResidNorm<true> e{p.xout, p.xout, 0.5f, p.final_norm, p.H, p.part + (size_t)5 * 65536, p.ncnt + 5 * 64, p.bar};
      gemm_phase<EpiResidNorm<true>, true>(glds, g, e);
    } else {
      { Gemm g{p.BIG, p.w2t_b, FF, FF, S, 1024, FF}; EpiResid e{p.xout, p.xout, 0.5f}; gemm_phase(glds, g, e); }
      xcd_barrier(xb);
      if (l == 1) final_norm_phase(p.xout, p.final_norm);
    }
  }
}

extern "C" void kernel_launch(void* const* d_in, const int* in_sizes, int n_in, void* d_out, int out_size, void* d_ws,
                              size_t ws_size, hipStream_t stream) {
  static int grid_blocks = 0;
  if (!grid_blocks) {
    int dev = 0, cus = 0, per_cu = 0;
    (void)hipGetDevice(&dev);
    (void)hipDeviceGetAttribute(&cus, hipDeviceAttributeMultiprocessorCount, dev);
    (void)hipOccupancyMaxActiveBlocksPerMultiprocessor(&per_cu, mega, 512, 0);
    if (per_cu > 1) per_cu = 1;
    if (per_cu < 1) per_cu = 1;
    grid_blocks = cus * per_cu;
    grid_blocks &= ~7;
  }
  Params p{};
  p.x_in = (const float*)d_in[0];
  p.ffn1_norm = (const float*)d_in[1]; p.ffn1_w1 = (const float*)d_in[2]; p.ffn1_w2 = (const float*)d_in[3];
  p.mix_norm = (const float*)d_in[4]; p.w_in = (const float*)d_in[5]; p.gm_ln_g = (const float*)d_in[6];
  p.gm_ln_b = (const float*)d_in[7]; p.gm_ws = (const float*)d_in[8]; p.gm_bs = (const float*)d_in[9];
  p.ret_gn_g = (const float*)d_in[10]; p.ret_gn_b = (const float*)d_in[11]; p.cmp_pos = (const float*)d_in[12];
  p.cmp_w1 = (const float*)d_in[13]; p.cmp_w2 = (const float*)d_in[14]; p.w_branch = (const float*)d_in[15];
  p.w_gate = (const float*)d_in[16]; p.b_gate = (const float*)d_in[17]; p.w_o = (const float*)d_in[18];
  p.ffn2_norm = (const float*)d_in[19]; p.ffn2_w1 = (const float*)d_in[20]; p.ffn2_w2 = (const float*)d_in[21];
  p.final_norm = (const float*)d_in[22];
  p.xout = (float*)d_out;
  char* w = (char*)d_ws;
  auto take = [&](size_t bytes) { char* r = w; w += (bytes + 255) & ~(size_t)255; return r; };
  p.w1t_a = (u16*)take((size_t)5632 * 1024 * 2);
  p.w1t_b = (u16*)take((size_t)5632 * 1024 * 2);
  p.w2t_a = (u16*)take((size_t)1024 * FF * 2);
  p.w2t_b = (u16*)take((size_t)1024 * FF * 2);
  p.wint = (u16*)take((size_t)4096 * 1024 * 2);
  p.wgt = (u16*)take((size_t)3072 * 1024 * 2);
  p.wbt = (u16*)take((size_t)3 * 1024 * 512 * 2);
  p.wot = (u16*)take((size_t)1024 * 1024 * 2);
  p.cw1t = (u16*)take((size_t)2 * 128 * 2048 * 2);
  p.cw2t = (u16*)take((size_t)2 * 64 * 128 * 2);
  p.H = (u16*)take((size_t)S * 1024 * 2);
  p.BIG = (u16*)take((size_t)S * PS * 2);
  p.vsT = (u16*)take((size_t)2 * 64 * S * 2);
  p.vwT = (u16*)take((size_t)2 * 64 * S * 2);
  p.kc = (u16*)take((size_t)2 * 1024 * 64 * 2);
  p.vcT = (u16*)take((size_t)2 * 64 * 1024 * 2);
  p.ret = (float*)take((size_t)128 * 4 * 8192 * 4);
  p.gst = (u16*)take((size_t)256 * 65536 * 2);
  p.bar = (unsigned*)take((size_t)XCD_BAR_WORDS * 4);
  p.part = (float*)take((size_t)6 * 64 * 4 * 256 * 4);
  p.ncnt = (unsigned*)take((size_t)6 * 64 * 4);
  if ((size_t)(w - (char*)d_ws) > ws_size) { fprintf(stderr, "workspace too small: need %zu have %zu\n", (size_t)(w - (char*)d_ws), ws_size); return; }
  void* args[] = {&p};
  hipError_t e = hipLaunchCooperativeKernel((void*)mega, dim3(grid_blocks), dim3(512), args, 0, stream);
  if (e != hipSuccess) fprintf(stderr, "coop launch failed: %s (grid %d)\n", hipGetErrorString(e), grid_blocks);
}
```

```cpp
#include <hip/hip_runtime.h>
#include <hip/hip_cooperative_groups.h>
#include <cstdio>
#include <cstdint>
namespace cg = cooperative_groups;

typedef unsigned short u16;
typedef unsigned int u32;
typedef unsigned long long u64;
using bf16x8 = __attribute__((ext_vector_type(8))) short;
using bf16x4 = __attribute__((ext_vector_type(4))) short;
using f32x4 = __attribute__((ext_vector_type(4))) float;

constexpr int S = 16384, FF = 2816, DIN = 3864;
constexpr int PS = 3968;
constexpr int C_U = 0, C_V = 512, C_RQ = 1024, C_RK = 1280, C_RV = 1536, C_RG = 2048, C_NQ = 2560,
              C_KC = 3072, C_VC = 3200, C_KS = 3328, C_VS = 3456, C_KW = 3584, C_VW = 3712, C_NG = 3840, C_MIX = 512;
constexpr float EPS = 1e-6f;
constexpr int SMEM_BYTES = 73728;

struct Params {
  const float* x_in;
  const float *ffn1_norm, *ffn1_w1, *ffn1_w2, *mix_norm, *w_in, *gm_ln_g, *gm_ln_b, *gm_ws, *gm_bs, *ret_gn_g, *ret_gn_b,
      *cmp_pos, *cmp_w1, *cmp_w2, *w_branch, *w_gate, *b_gate, *w_o, *ffn2_norm, *ffn2_w1, *ffn2_w2, *final_norm;
  float* xout;
  u16 *w1t_a, *w2t_a, *wint, *wgt, *wbt, *wot, *w1t_b, *w2t_b, *cw1t, *cw2t;
  u16 *H, *BIG, *vsT, *vwT, *kc, *vcT;
  float* ret;
  u16* gst;
  unsigned* bar;
  float* part; unsigned* ncnt;
};

__device__ __forceinline__ u16 f2bf(float f) { __bf16 b = (__bf16)f; return __builtin_bit_cast(u16, b); }
__device__ __forceinline__ float bf2f(u16 h) { return __uint_as_float(((u32)h) << 16); }
typedef __bf16 bf16x2_t __attribute__((ext_vector_type(2)));
typedef float f32x2_t __attribute__((ext_vector_type(2)));
__device__ __forceinline__ u32 pack2(float a, float b) { f32x2_t v = {a, b}; bf16x2_t r = __builtin_convertvector(v, bf16x2_t); return __builtin_bit_cast(u32, r); }
__device__ __forceinline__ float lo2f(u32 w) { return __uint_as_float(w << 16); }
__device__ __forceinline__ float hi2f(u32 w) { return __uint_as_float(w & 0xffff0000u); }
__device__ __forceinline__ float gelu_t(float x) { float y = 1.5957691216057308f * (x + 0.044715f * x * x * x); return x * __builtin_amdgcn_rcpf(1.0f + __expf(-y)); }
__device__ __forceinline__ float silu_f(float x) { return x * __builtin_amdgcn_rcpf(1.0f + __expf(-x)); }
__device__ __forceinline__ float sigm_f(float x) { return __builtin_amdgcn_rcpf(1.0f + __expf(-x)); }
__device__ __forceinline__ f32x4 mfma16(bf16x8 a, bf16x8 b, f32x4 c) { return __builtin_amdgcn_mfma_f32_16x16x32_bf16(a, b, c, 0, 0, 0); }
__device__ __forceinline__ bf16x8 ld8(const u16* p) { return *(const bf16x8*)p; }
__device__ __forceinline__ bf16x8 ld44(const u16* p0, const u16* p1) {
  bf16x4 a = *(const bf16x4*)p0, b = *(const bf16x4*)p1;
  return __builtin_shufflevector(a, b, 0, 1, 2, 3, 4, 5, 6, 7);
}
__device__ __forceinline__ bf16x8 pk8(float a0, float a1, float a2, float a3, float a4, float a5, float a6, float a7) {
  union { uint4 u; bf16x8 v; } x;
  x.u = make_uint4(pack2(a0, a1), pack2(a2, a3), pack2(a4, a5), pack2(a6, a7));
  return x.v;
}
__device__ __forceinline__ bf16x8 scale8(bf16x8 v, float s) {
  union { uint4 u; bf16x8 v; } x; x.v = v;
  x.u.x = pack2(lo2f(x.u.x) * s, hi2f(x.u.x) * s); x.u.y = pack2(lo2f(x.u.y) * s, hi2f(x.u.y) * s);
  x.u.z = pack2(lo2f(x.u.z) * s, hi2f(x.u.z) * s); x.u.w = pack2(lo2f(x.u.w) * s, hi2f(x.u.w) * s);
  return x.v;
}
__device__ __forceinline__ void wave_lds_sync() { asm volatile("s_waitcnt lgkmcnt(0)" ::: "memory"); }

__device__ __forceinline__ int tid_fresh() { int t = threadIdx.x; asm volatile("" : "+v"(t)); return t; }
__device__ __forceinline__ int wmap(int n, int mode) {
  if (mode == 0) return n;
  int isb = n >= FF; int nn = isb ? n - FF : n;
  return (nn >> 4) * 32 + isb * 16 + (nn & 15);
}
__device__ __forceinline__ void wprep_matrix(const float* __restrict__ src, u16* __restrict__ dst, int K, int N, int mode, u16* smem, int vb, int nvb) {
  float* T = (float*)smem;
  const int tid = tid_fresh() & 255;
  const int tk = K >> 6, tn = (N + 63) >> 6, nt = tk * tn;
  for (int t = vb; t < nt; t += nvb) {
    const int k0 = (t % tk) * 64, n0 = (t / tk) * 64;
#pragma unroll
    for (int i = 0; i < 4; i++) {
      int kk = (tid >> 4) + 16 * i, n = n0 + (tid & 15) * 4;
      float4 v = make_float4(0.f, 0.f, 0.f, 0.f);
      if (n < N) v = *(const float4*)(src + (size_t)(k0 + kk) * N + n);
      float* tp = T + kk * 65 + (tid & 15) * 4;
      tp[0] = v.x; tp[1] = v.y; tp[2] = v.z; tp[3] = v.w;
    }
    __syncthreads();
    {
      int n = tid >> 2, kc = (tid & 3) * 16, nn = n0 + n;
      if (nn < N) {
        u32 w[8];
#pragma unroll
        for (int e = 0; e < 8; e++) w[e] = pack2(T[(kc + 2 * e) * 65 + n], T[(kc + 2 * e + 1) * 65 + n]);
        u16* dp = dst + (size_t)wmap(nn, mode) * K + k0 + kc;
        *(uint4*)dp = make_uint4(w[0], w[1], w[2], w[3]);
        *(uint4*)(dp + 8) = make_uint4(w[4], w[5], w[6], w[7]);
      }
    }
    __syncthreads();
  }
}
__device__ __forceinline__ void wprep_phase(const Params& p, int l, u16* smem, int vb, int nvb, bool skip_ffn1, bool skip_ffn2) {
  if (!skip_ffn1) wprep_matrix(p.ffn1_w1 + (size_t)l * 1024 * 5632, p.w1t_a, 1024, 5632, 1, smem, vb, nvb);
  if (!skip_ffn2) wprep_matrix(p.ffn2_w1 + (size_t)l * 1024 * 5632, p.w1t_b, 1024, 5632, 1, smem, vb, nvb);
  if (!skip_ffn1) wprep_matrix(p.ffn1_w2 + (size_t)l * FF * 1024, p.w2t_a, FF, 1024, 0, smem, vb, nvb);
  if (!skip_ffn2) wprep_matrix(p.ffn2_w2 + (size_t)l * FF * 1024, p.w2t_b, FF, 1024, 0, smem, vb, nvb);
  wprep_matrix(p.w_in + (size_t)l * 1024 * DIN, p.wint, 1024, DIN, 0, smem, vb, nvb);
  wprep_matrix(p.w_gate + (size_t)l * 1024 * 3072, p.wgt, 1024, 3072, 0, smem, vb, nvb);
  for (int m = 0; m < 3; m++)
    wprep_matrix(p.w_branch + (size_t)(l * 3 + m) * 512 * 1024, p.wbt + (size_t)m * 1024 * 512, 512, 1024, 0, smem, vb, nvb);
  wprep_matrix(p.w_o + (size_t)l * 1024 * 1024, p.wot, 1024, 1024, 0, smem, vb, nvb);
  for (int w = 0; w < 2; w++) {
    wprep_matrix(p.cmp_w1 + (size_t)(l * 2 + w) * 2048 * 128, p.cw1t + (size_t)w * 128 * 2048, 2048, 128, 0, smem, vb, nvb);
    wprep_matrix(p.cmp_w2 + (size_t)(l * 2 + w) * 128 * 64, p.cw2t + (size_t)w * 64 * 128, 128, 64, 0, smem, vb, nvb);
  }
}

__device__ __forceinline__ void norm_phase(const float* __restrict__ x, const float* __restrict__ g, u16* __restrict__ H) {
  const int tidf = tid_fresh();
  const int lane = tidf & 63;
  const int gw = blockIdx.x * 8 + (tidf >> 6), nw = gridDim.x * 8;
  float4 gg[4];
#pragma unroll
  for (int i = 0; i < 4; i++) gg[i] = ((const float4*)g)[lane + 64 * i];
  for (int row0 = gw * 4; row0 < S; row0 += nw * 4) {
    float4 v[4][4]; float ss[4];
#pragma unroll
    for (int rr = 0; rr < 4; rr++)
#pragma unroll
      for (int i = 0; i < 4; i++) v[rr][i] = ((const float4*)(x + (size_t)(row0 + rr) * 1024))[lane + 64 * i];
#pragma unroll
    for (int rr = 0; rr < 4; rr++) {
      float a = 0.f;
#pragma unroll
      for (int i = 0; i < 4; i++) a += v[rr][i].x * v[rr][i].x + v[rr][i].y * v[rr][i].y + v[rr][i].z * v[rr][i].z + v[rr][i].w * v[rr][i].w;
      ss[rr] = a;
    }
#pragma unroll
    for (int o = 32; o >= 1; o >>= 1)
#pragma unroll
      for (int rr = 0; rr < 4; rr++) ss[rr] += __shfl_xor(ss[rr], o);
#pragma unroll
    for (int rr = 0; rr < 4; rr++) {
      const float r = rsqrtf(ss[rr] * (1.0f / 1024.0f) + EPS);
#pragma unroll
      for (int i = 0; i < 4; i++) {
        uint2 o2 = make_uint2(pack2(v[rr][i].x * r * gg[i].x, v[rr][i].y * r * gg[i].y), pack2(v[rr][i].z * r * gg[i].z, v[rr][i].w * r * gg[i].w));
        *(uint2*)(H + (size_t)(row0 + rr) * 1024 + (lane + 64 * i) * 4) = o2;
      }
    }
  }
}
__device__ __forceinline__ void final_norm_phase(float* __restrict__ x, const float* __restrict__ g) {
  const int tidf = tid_fresh();
  const int lane = tidf & 63;
  const int gw = blockIdx.x * 8 + (tidf >> 6), nw = gridDim.x * 8;
  float4 gg[4];
#pragma unroll
  for (int i = 0; i < 4; i++) gg[i] = ((const float4*)g)[lane + 64 * i];
  for (int row0 = gw * 4; row0 < S; row0 += nw * 4) {
    float4 v[4][4]; float ss[4];
#pragma unroll
    for (int rr = 0; rr < 4; rr++)
#pragma unroll
      for (int i = 0; i < 4; i++) v[rr][i] = ((const float4*)(x + (size_t)(row0 + rr) * 1024))[lane + 64 * i];
#pragma unroll
    for (int rr = 0; rr < 4; rr++) {
      float a = 0.f;
#pragma unroll
      for (int i = 0; i < 4; i++) a += v[rr][i].x * v[rr][i].x + v[rr][i].y * v[rr][i].y + v[rr][i].z * v[rr][i].z + v[rr][i].w * v[rr][i].w;
      ss[rr] = a;
    }
#pragma unroll
    for (int o = 32; o >= 1; o >>= 1)
#pragma unroll
      for (int rr = 0; rr < 4; rr++) ss[rr] += __shfl_xor(ss[rr], o);
#pragma unroll
    for (int rr = 0; rr < 4; rr++) {
      const float r = rsqrtf(ss[rr] * (1.0f / 1024.0f) + EPS);
#pragma unroll
      for (int i = 0; i < 4; i++)
        ((float4*)(x + (size_t)(row0 + rr) * 1024))[lane + 64 * i] = make_float4(v[rr][i].x * r * gg[i].x, v[rr][i].y * r * gg[i].y, v[rr][i].z * r * gg[i].z, v[rr][i].w * r * gg[i].w);
    }
  }
}

#define LAS __attribute__((address_space(3)))
constexpr int G_BK = 64, G_HALF = 128, G_HTB = G_HALF * G_BK * 2, G_NXCD = 8, G_WGM = 8;
__device__ __forceinline__ int lds_byte(int r, int c) { const int st = (r >> 4) * 2 + (c >> 5), rr = r & 15, cc = c & 31, ob = rr * 64 + cc * 2; return st * 1024 + (ob ^ (((ob >> 9) & 1) << 5)); }
__device__ __forceinline__ void stage_rc(int b, int& R, int& C) { const int st = b / 1024, sb = b % 1024, swz = sb ^ (((sb >> 9) & 1) << 5); R = (st >> 1) * 16 + swz / 64; C = (st & 1) * 32 + (swz % 64) / 2; }
__device__ __forceinline__ int perm32(int rho) { const int n = rho >> 4, i = rho & 15; return 8 * (i >> 2) + 4 * n + (i & 3); }
struct Unit { int pm, pn; };
struct Gemm { const u16* A; const u16* Bt; int lda, ldb, M, N, K; };
struct StaticOrder {
  int nM, nN, nwg, G, c;
  __device__ void init(int M, int N, int G_, int c_) { nM = M / 256; nN = N / 256; nwg = nM * nN; G = G_; c = c_; }
  __device__ bool next(int i, Unit& u) const {
    const long L = (long)i * G + c; if (L >= nwg) return false;
    int wgid = (int)L; { const int q = nwg / G_NXCD, r = nwg % G_NXCD, xcd = wgid % G_NXCD, off = wgid / G_NXCD; wgid = (xcd < r ? xcd * (q + 1) : r * (q + 1) + (xcd - r) * q) + off; }
    const int nig = G_WGM * nN, gid = wgid / nig, fm = gid * G_WGM, gsz = (nM - fm) < G_WGM ? (nM - fm) : G_WGM;
    u.pm = fm + ((wgid % nig) % gsz); u.pn = (wgid % nig) / gsz; return true;
  }
};
typedef f32x4 AccT[2][2][4][2];
struct EpiSwiglu {
  static constexpr bool PERM = false;
  u16* ACT;
  __device__ __forceinline__ void operator()(const AccT& acc, const Unit& u, int wr, int wc, int fr, int fq) const {
    typedef unsigned u32x2s __attribute__((ext_vector_type(2)));
    const int row0 = u.pm * 256 + wr * 64 + fr;
    const int colw = u.pn * 128 + wc * 16 + ((fq & 1) ? 64 + 4 * (fq - 1) : 4 * fq);
#pragma unroll
    for (int ai = 0; ai < 2; ++ai)
#pragma unroll
      for (int m = 0; m < 4; ++m) {
        u16* rowp = ACT + (size_t)(row0 + ai * 128 + m * 16) * FF + colw;
        const f32x4 a0 = acc[ai][0][m][0], b0 = acc[ai][0][m][1], a1 = acc[ai][1][m][0], b1 = acc[ai][1][m][1];
        const u32 p0x = pack2(silu_f(a0[0]) * b0[0], silu_f(a0[1]) * b0[1]), p0y = pack2(silu_f(a0[2]) * b0[2], silu_f(a0[3]) * b0[3]);
        const u32 p1x = pack2(silu_f(a1[0]) * b1[0], silu_f(a1[1]) * b1[1]), p1y = pack2(silu_f(a1[2]) * b1[2], silu_f(a1[3]) * b1[3]);
        const u32x2s rx = __builtin_amdgcn_permlane16_swap(p0x, p1x, false, false);
        const u32x2s ry = __builtin_amdgcn_permlane16_swap(p0y, p1y, false, false);
        *(uint4*)rowp = make_uint4(rx.x, ry.x, rx.y, ry.y);
      }
  }
};
struct EpiResid {
  static constexpr bool PERM = false;
  const float* xsrc; float* xdst; float scale;
  __device__ __forceinline__ void operator()(const AccT& acc, const Unit& u, int wr, int wc, int fr, int fq) const {
    const int row0 = u.pm * 256 + wr * 64 + fr, col0 = u.pn * 256 + wc * 32 + 4 * fq;
#pragma unroll
    for (int ai = 0; ai < 2; ++ai) {
      f32x4 xv[4][2][2];
#pragma unroll
      for (int m = 0; m < 4; ++m)
#pragma unroll
        for (int bj = 0; bj < 2; ++bj)
#pragma unroll
          for (int n = 0; n < 2; ++n)
            xv[m][bj][n] = *(const f32x4*)(xsrc + (size_t)(row0 + ai * 128 + m * 16) * 1024 + col0 + bj * 128 + n * 16);
#pragma unroll
      for (int m = 0; m < 4; ++m)
#pragma unroll
        for (int bj = 0; bj < 2; ++bj)
#pragma unroll
          for (int n = 0; n < 2; ++n)
            *(f32x4*)(xdst + (size_t)(row0 + ai * 128 + m * 16) * 1024 + col0 + bj * 128 + n * 16) = xv[m][bj][n] + scale * acc[ai][bj][m][n];
    }
  }
};
struct EpiProj {
  static constexpr bool PERM = true;
  u16* proj;
  __device__ __forceinline__ void operator()(const AccT& acc, const Unit& u, int wr, int wc, int fr, int fq) const {
    const int row0 = u.pm * 256 + wr * 64 + fr, col0 = u.pn * 256 + wc * 32 + 8 * fq;
#pragma unroll
    for (int ai = 0; ai < 2; ++ai)
#pragma unroll
      for (int m = 0; m < 4; ++m) {
        u16* rowp = proj + (size_t)(row0 + ai * 128 + m * 16) * PS;
#pragma unroll
        for (int bj = 0; bj < 2; ++bj) {
          const int col = col0 + bj * 128;
          const f32x4 a = acc[ai][bj][m][0], b = acc[ai][bj][m][1];
          if (col < DIN) *(uint4*)(rowp + col) = make_uint4(pack2(a[0], a[1]), pack2(a[2], a[3]), pack2(b[0], b[1]), pack2(b[2], b[3]));
        }
      }
  }
};
struct EpiGate {
  static constexpr bool PERM = true;
  u16* gst; const float* bias; int tid;
  __device__ __forceinline__ void operator()(const AccT& acc, const Unit& u, int wr, int wc, int fr, int fq) const {
    u16* st = gst + (size_t)(u.pm * 4 + u.pn) * 65536 + tid * 8;
    const int col0 = u.pn * 256 + wc * 32 + 8 * fq;
#pragma unroll
    for (int bj = 0; bj < 2; ++bj) {
      const f32x4 b0 = *(const f32x4*)(bias + col0 + bj * 128), b1 = *(const f32x4*)(bias + col0 + bj * 128 + 4);
#pragma unroll
      for (int ai = 0; ai < 2; ++ai)
#pragma unroll
        for (int m = 0; m < 4; ++m) {
          const f32x4 a = acc[ai][bj][m][0] + b0, b = acc[ai][bj][m][1] + b1;
          *(uint4*)(st + ((ai * 2 + bj) * 4 + m) * 4096) = make_uint4(pack2(sigm_f(a[0]), sigm_f(a[1])), pack2(sigm_f(a[2]), sigm_f(a[3])),
                                                                     pack2(sigm_f(b[0]), sigm_f(b[1])), pack2(sigm_f(b[2]), sigm_f(b[3])));
        }
    }
  }
};
struct EpiBranch {
  static constexpr bool PERM = true;
  const u16* gst; u16* mix; int first; int tid;
  __device__ __forceinline__ void operator()(const AccT& acc, const Unit& u, int wr, int wc, int fr, int fq) const {
    const u16* st = gst + (size_t)(u.pm * 4 + u.pn) * 65536 + tid * 8;
    const int row0 = u.pm * 256 + wr * 64 + fr, col0 = u.pn * 256 + wc * 32 + 8 * fq;
#pragma unroll
    for (int ai = 0; ai < 2; ++ai) {
      uint4 gw[4][2], ov[4][2];
#pragma unroll
      for (int m = 0; m < 4; ++m)
#pragma unroll
        for (int bj = 0; bj < 2; ++bj) {
          gw[m][bj] = *(const uint4*)(st + ((ai * 2 + bj) * 4 + m) * 4096);
          ov[m][bj] = first ? make_uint4(0u, 0u, 0u, 0u) : *(const uint4*)(mix + (size_t)(row0 + ai * 128 + m * 16) * PS + col0 + bj * 128);
        }
#pragma unroll
      for (int m = 0; m < 4; ++m)
#pragma unroll
        for (int bj = 0; bj < 2; ++bj) {
          const uint4 g = gw[m][bj], o = ov[m][bj];
          const f32x4 a = acc[ai][bj][m][0], b = acc[ai][bj][m][1];
          const float v0 = lo2f(g.x) * a[0] + lo2f(o.x), v1 = hi2f(g.x) * a[1] + hi2f(o.x), v2 = lo2f(g.y) * a[2] + lo2f(o.y), v3 = hi2f(g.y) * a[3] + hi2f(o.y);
          const float v4 = lo2f(g.z) * b[0] + lo2f(o.z), v5 = hi2f(g.z) * b[1] + hi2f(o.z), v6 = lo2f(g.w) * b[2] + lo2f(o.w), v7 = hi2f(g.w) * b[3] + hi2f(o.w);
          *(uint4*)(mix + (size_t)(row0 + ai * 128 + m * 16) * PS + col0 + bj * 128) = make_uint4(pack2(v0, v1), pack2(v2, v3), pack2(v4, v5), pack2(v6, v7));
        }
    }
  }
};

template <class Epi, bool AFTER_DRAIN = false>
__device__ __forceinline__ void gemm_phase(LAS unsigned char* lds, const Gemm g, const Epi& E) {
  const int tid = tid_fresh(), wid = __builtin_amdgcn_readfirstlane(tid >> 6), lane = tid & 63, wr = wid >> 2, wc = wid & 3, fr = lane & 15, fq = lane >> 4;
  const int K = g.K, nt = K / G_BK;
  StaticOrder S; S.init(g.M, g.N, (int)gridDim.x, (int)blockIdx.x);
  unsigned voffA[2], voffB[2];
#pragma unroll
  for (int i = 0; i < 2; ++i) { int R, C; stage_rc(tid * 16 + i * 8192, R, C); const int Rb = Epi::PERM ? ((R & ~31) + perm32(R & 31)) : R;
    voffA[i] = (unsigned)(R * g.lda + C) * 2u; voffB[i] = (unsigned)(Rb * g.ldb + C) * 2u; }
  const size_t kstep = (size_t)(G_BK * 2);
  const size_t hstepA = (size_t)G_HALF * g.lda * 2, hstepB = (size_t)G_HALF * g.ldb * 2;
  const size_t tstepA = 2 * hstepA, tstepB = 2 * hstepB;
  const unsigned ldsw = (unsigned)wid * 1024u;
  const int aoff = lds_byte(wr * 64 + fr, fq * 8), boff = lds_byte(wc * 32 + fr, fq * 8);
#define PG8_SA(b, h) (((b) * 2 + (h)) * G_HTB)
#define PG8_SB(b, h) ((4 + (b) * 2 + (h)) * G_HTB)
#define PG8_STAGE(bufoff, gbase, voff) do { _Pragma("unroll") for (int _i = 0; _i < 2; ++_i) \
    __builtin_amdgcn_global_load_lds((const unsigned*)((const char*)(gbase) + (voff)[_i]), (LAS unsigned*)(lds + (bufoff) + ldsw + _i * 8192), 16, 0, 0); } while (0)
#define PG8_LDA(dst, b, h) do { _Pragma("unroll") for (int m = 0; m < 4; ++m) _Pragma("unroll") for (int k = 0; k < 2; ++k) dst[m][k] = *(const LAS bf16x8*)(lds + PG8_SA(b, h) + aoff + m * 2048 + k * 1024); } while (0)
#define PG8_LDB(dst, b, h) do { _Pragma("unroll") for (int n = 0; n < 2; ++n) _Pragma("unroll") for (int k = 0; k < 2; ++k) dst[n][k] = *(const LAS bf16x8*)(lds + PG8_SB(b, h) + boff + n * 2048 + k * 1024); } while (0)
#define PG8_MMA(ai, bj, At, Bt) do { __builtin_amdgcn_s_setprio(1); _Pragma("unroll") for (int m = 0; m < 4; ++m) _Pragma("unroll") for (int n = 0; n < 2; ++n) _Pragma("unroll") for (int k = 0; k < 2; ++k) \
    acc[ai][bj][m][n] = __builtin_amdgcn_mfma_f32_16x16x32_bf16(Bt[n][k], At[m][k], acc[ai][bj][m][n], 0, 0, 0); __builtin_amdgcn_s_setprio(0); } while (0)
#define PG8_WAIT_V(n) asm volatile("s_waitcnt vmcnt(" #n ")" ::: "memory")
#define PG8_WAIT_L(n) asm volatile("s_waitcnt lgkmcnt(" #n ")" ::: "memory")
#define PG8_BAR __builtin_amdgcn_s_barrier()
#define PG8_SCHED __builtin_amdgcn_sched_barrier(0)
  Unit cur, nxt; int ui = 0;
  if (!S.next(0, cur)) return;
  AccT acc;
#pragma unroll
  for (int a = 0; a < 2; ++a)
#pragma unroll
    for (int b = 0; b < 2; ++b)
#pragma unroll
      for (int m = 0; m < 4; ++m)
#pragma unroll
        for (int n = 0; n < 2; ++n) acc[a][b][m][n] = (f32x4){0.f, 0.f, 0.f, 0.f};
  bf16x8 At[4][2], B0[2][2], B1[2][2];
  const char* cA = (const char*)g.A + (size_t)cur.pm * tstepA; const char* cB = (const char*)g.Bt + (size_t)cur.pn * tstepB;
  PG8_STAGE(PG8_SB(0, 0), cB, voffB); PG8_STAGE(PG8_SA(0, 0), cA, voffA); PG8_STAGE(PG8_SB(0, 1), cB + hstepB, voffB); PG8_STAGE(PG8_SA(0, 1), cA + hstepA, voffA);
  if (wr == 1) PG8_BAR;
  PG8_WAIT_V(4); PG8_BAR;
  PG8_STAGE(PG8_SB(1, 0), cB + kstep, voffB); PG8_STAGE(PG8_SA(1, 0), cA + kstep, voffA); PG8_STAGE(PG8_SB(1, 1), cB + hstepB + kstep, voffB);
  PG8_WAIT_V(6); PG8_BAR;
  for (;;) {
    const bool has_next = S.next(ui + 1, nxt);
    const char* nA = has_next ? (const char*)g.A + (size_t)nxt.pm * tstepA : cA; const char* nB = has_next ? (const char*)g.Bt + (size_t)nxt.pn * tstepB : cB;
    for (int t = 0; t < nt; t += 2) {
      const bool last = (t == nt - 2);
      const char* a1 = cA + (size_t)(t + 1) * kstep;
      const char* a2 = last ? nA : cA + (size_t)(t + 2) * kstep; const char* b2 = last ? nB : cB + (size_t)(t + 2) * kstep;
      const char* a3 = a2 + kstep; const char* b3 = b2 + kstep;
      PG8_LDB(B0, 0, 0); PG8_SCHED; PG8_LDA(At, 0, 0); PG8_STAGE(PG8_SA(1, 1), a1 + hstepA, voffA);
      PG8_WAIT_L(8); PG8_BAR; PG8_WAIT_L(0); PG8_MMA(0, 0, At, B0); PG8_BAR; PG8_SCHED;
      PG8_LDB(B1, 0, 1); PG8_STAGE(PG8_SB(0, 0), b2, voffB);
      PG8_BAR; PG8_WAIT_L(0); PG8_MMA(0, 1, At, B1); PG8_BAR;
      PG8_LDA(At, 0, 1); PG8_STAGE(PG8_SA(0, 0), a2, voffA);
      PG8_BAR; PG8_WAIT_L(0); PG8_MMA(1, 0, At, B0); PG8_BAR; PG8_SCHED;
      PG8_STAGE(PG8_SB(0, 1), b2 + hstepB, voffB);
      PG8_WAIT_V(6); PG8_BAR; PG8_MMA(1, 1, At, B1); PG8_BAR;
      PG8_LDB(B0, 1, 0); PG8_SCHED; PG8_LDA(At, 1, 0); PG8_STAGE(PG8_SA(0, 1), a2 + hstepA, voffA);
      PG8_WAIT_L(8); PG8_BAR; PG8_WAIT_L(0); PG8_MMA(0, 0, At, B0); PG8_BAR; PG8_SCHED;
      PG8_LDB(B1, 1, 1); PG8_STAGE(PG8_SB(1, 0), b3, voffB);
      PG8_BAR; PG8_WAIT_L(0); PG8_MMA(0, 1, At, B1); PG8_BAR;
      PG8_LDA(At, 1, 1); PG8_STAGE(PG8_SA(1, 0), a3, voffA);
      PG8_BAR; PG8_WAIT_L(0); PG8_MMA(1, 0, At, B0); PG8_BAR; PG8_SCHED;
      PG8_STAGE(PG8_SB(1, 1), b3 + hstepB, voffB);
      PG8_WAIT_V(6); PG8_BAR; PG8_MMA(1, 1, At, B1); PG8_BAR;
    }
    if constexpr (!AFTER_DRAIN) E(acc, cur, wr, wc, fr, fq);
    if (!has_next) break;
#pragma unroll
    for (int a = 0; a < 2; ++a)
#pragma unroll
      for (int b = 0; b < 2; ++b)
#pragma unroll
        for (int m = 0; m < 4; ++m)
#pragma unroll
          for (int n = 0; n < 2; ++n) acc[a][b][m][n] = (f32x4){0.f, 0.f, 0.f, 0.f};
    cur = nxt; cA = nA; cB = nB; ++ui;
  }
  PG8_WAIT_V(0);
  if (wr == 0) PG8_BAR;
  PG8_BAR;
  if constexpr (AFTER_DRAIN) E.fused(acc, cur, wr, wc, fr, fq, lds);
#undef PG8_SA
#undef PG8_SB
#undef PG8_STAGE
#undef PG8_LDA
#undef PG8_LDB
#undef PG8_MMA
#undef PG8_WAIT_V
#undef PG8_WAIT_L
#undef PG8_BAR
#undef PG8_SCHED
}

struct ChainStep { const char* A; const char* B; unsigned lda2, ldb2; int nt; };
__device__ __forceinline__ ChainStep merge_step(const Params& p, int q, const Unit& u) {
  const int s6 = q % 6, br = s6 >> 1;
  ChainStep c;
  if ((s6 & 1) == 0) {
    c.A = (const char*)(p.H + (size_t)u.pm * 256 * 1024); c.lda2 = 2048u;
    c.B = (const char*)(p.wgt + (size_t)(br * 1024 + u.pn * 256) * 1024); c.ldb2 = 2048u; c.nt = 16;
  } else {
    const int ycol = br == 0 ? C_U : (br == 1 ? C_RG : C_NQ);
    c.A = (const char*)(p.BIG + ycol + (size_t)u.pm * 256 * PS); c.lda2 = (unsigned)PS * 2u;
    c.B = (const char*)(p.wbt + (size_t)(br * 1024 + u.pn * 256) * 512); c.ldb2 = 1024u; c.nt = 8;
  }
  return c;
}
__device__ __forceinline__ void gemm_merge_chain(LAS unsigned char* lds, const Params& p, int l) {
  const int tid = tid_fresh(), wid = __builtin_amdgcn_readfirstlane(tid >> 6), lane = tid & 63, wr = wid >> 2, wc = wid & 3, fr = lane & 15, fq = lane >> 4;
  StaticOrder S; S.init(16384, 1024, (int)gridDim.x, (int)blockIdx.x);
  unsigned rA[2], c2[2];
#pragma unroll
  for (int i = 0; i < 2; ++i) { int R, C; stage_rc(tid * 16 + i * 8192, R, C); rA[i] = (unsigned)R; c2[i] = (unsigned)C * 2u; }
  const size_t kstep = (size_t)(G_BK * 2);
  const unsigned ldsw = (unsigned)wid * 1024u;
  const int aoff = lds_byte(wr * 64 + fr, fq * 8), boff = lds_byte(wc * 32 + fr, fq * 8);
#define PG8_SA(b, h) (((b) * 2 + (h)) * G_HTB)
#define PG8_SB(b, h) ((4 + (b) * 2 + (h)) * G_HTB)
#define CH_ROW_rA(i) (rA[i])
#define CH_ROW_rB(i) ((rA[i] & ~31u) + (unsigned)perm32((int)(rA[i] & 31u)))
#define CH_STAGE(bufoff, gbase, rr, ld2) do { _Pragma("unroll") for (int _i = 0; _i < 2; ++_i) \
    __builtin_amdgcn_global_load_lds((const unsigned*)((const char*)(gbase) + (CH_ROW_##rr(_i) * (ld2) + c2[_i])), (LAS unsigned*)(lds + (bufoff) + ldsw + _i * 8192), 16, 0, 0); } while (0)
#define PG8_LDA(dst, b, h) do { _Pragma("unroll") for (int m = 0; m < 4; ++m) _Pragma("unroll") for (int k = 0; k < 2; ++k) dst[m][k] = *(const LAS bf16x8*)(lds + PG8_SA(b, h) + aoff + m * 2048 + k * 1024); } while (0)
#define PG8_LDB(dst, b, h) do { _Pragma("unroll") for (int n = 0; n < 2; ++n) _Pragma("unroll") for (int k = 0; k < 2; ++k) dst[n][k] = *(const LAS bf16x8*)(lds + PG8_SB(b, h) + boff + n * 2048 + k * 1024); } while (0)
#define PG8_MMA(ai, bj, At, Bt) do { __builtin_amdgcn_s_setprio(1); _Pragma("unroll") for (int m = 0; m < 4; ++m) _Pragma("unroll") for (int n = 0; n < 2; ++n) _Pragma("unroll") for (int k = 0; k < 2; ++k) \
    acc[ai][bj][m][n] = __builtin_amdgcn_mfma_f32_16x16x32_bf16(Bt[n][k], At[m][k], acc[ai][bj][m][n], 0, 0, 0); __builtin_amdgcn_s_setprio(0); } while (0)
#define PG8_WAIT_V(n) asm volatile("s_waitcnt vmcnt(" #n ")" ::: "memory")
#define PG8_WAIT_L(n) asm volatile("s_waitcnt lgkmcnt(" #n ")" ::: "memory")
#define PG8_BAR __builtin_amdgcn_s_barrier()
#define PG8_SCHED __builtin_amdgcn_sched_barrier(0)
  Unit cu, nu; int q = 0;
  if (!S.next(0, cu)) return;
  ChainStep cs = merge_step(p, 0, cu), ns;
  AccT acc;
#pragma unroll
  for (int a = 0; a < 2; ++a)
#pragma unroll
    for (int b = 0; b < 2; ++b)
#pragma unroll
      for (int m = 0; m < 4; ++m)
#pragma unroll
        for (int n = 0; n < 2; ++n) acc[a][b][m][n] = (f32x4){0.f, 0.f, 0.f, 0.f};
  bf16x8 At[4][2], B0[2][2], B1[2][2];
  {
    const size_t hA = (size_t)G_HALF * cs.lda2, hB = (size_t)G_HALF * cs.ldb2;
    CH_STAGE(PG8_SB(0, 0), cs.B, rB, cs.ldb2); CH_STAGE(PG8_SA(0, 0), cs.A, rA, cs.lda2); CH_STAGE(PG8_SB(0, 1), cs.B + hB, rB, cs.ldb2); CH_STAGE(PG8_SA(0, 1), cs.A + hA, rA, cs.lda2);
    if (wr == 1) PG8_BAR;
    PG8_WAIT_V(4); PG8_BAR;
    CH_STAGE(PG8_SB(1, 0), cs.B + kstep, rB, cs.ldb2); CH_STAGE(PG8_SA(1, 0), cs.A + kstep, rA, cs.lda2); CH_STAGE(PG8_SB(1, 1), cs.B + hB + kstep, rB, cs.ldb2);
    PG8_WAIT_V(6); PG8_BAR;
  }
  for (;;) {
    bool has_next;
    if ((q + 1) % 6 != 0) { nu = cu; has_next = true; } else has_next = S.next((q + 1) / 6, nu);
    ns = has_next ? merge_step(p, q + 1, nu) : cs;
    const size_t hA = (size_t)G_HALF * cs.lda2, hB = (size_t)G_HALF * cs.ldb2;
    const size_t nhA = (size_t)G_HALF * ns.lda2, nhB = (size_t)G_HALF * ns.ldb2;
    const int nt = cs.nt;
    for (int t = 0; t < nt; t += 2) {
      const bool last = (t == nt - 2);
      const char* a1 = cs.A + (size_t)(t + 1) * kstep;
      const char* a2 = last ? ns.A : cs.A + (size_t)(t + 2) * kstep; const char* b2 = last ? ns.B : cs.B + (size_t)(t + 2) * kstep;
      const char* a3 = a2 + kstep; const char* b3 = b2 + kstep;
      const unsigned la2 = last ? ns.lda2 : cs.lda2, lb2 = last ? ns.ldb2 : cs.ldb2;
      const size_t hA2 = last ? nhA : hA, hB2 = last ? nhB : hB;
      PG8_LDB(B0, 0, 0); PG8_SCHED; PG8_LDA(At, 0, 0); CH_STAGE(PG8_SA(1, 1), a1 + hA, rA, cs.lda2);
      PG8_WAIT_L(8); PG8_BAR; PG8_WAIT_L(0); PG8_MMA(0, 0, At, B0); PG8_BAR; PG8_SCHED;
      PG8_LDB(B1, 0, 1); CH_STAGE(PG8_SB(0, 0), b2, rB, lb2);
      PG8_BAR; PG8_WAIT_L(0); PG8_MMA(0, 1, At, B1); PG8_BAR;
      PG8_LDA(At, 0, 1); CH_STAGE(PG8_SA(0, 0), a2, rA, la2);
      PG8_BAR; PG8_WAIT_L(0); PG8_MMA(1, 0, At, B0); PG8_BAR; PG8_SCHED;
      CH_STAGE(PG8_SB(0, 1), b2 + hB2, rB, lb2);
      PG8_WAIT_V(6); PG8_BAR; PG8_MMA(1, 1, At, B1); PG8_BAR;
      PG8_LDB(B0, 1, 0); PG8_SCHED; PG8_LDA(At, 1, 0); CH_STAGE(PG8_SA(0, 1), a2 + hA2, rA, la2);
      PG8_WAIT_L(8); PG8_BAR; PG8_WAIT_L(0); PG8_MMA(0, 0, At, B0); PG8_BAR; PG8_SCHED;
      PG8_LDB(B1, 1, 1); CH_STAGE(PG8_SB(1, 0), b3, rB, lb2);
      PG8_BAR; PG8_WAIT_L(0); PG8_MMA(0, 1, At, B1); PG8_BAR;
      PG8_LDA(At, 1, 1); CH_STAGE(PG8_SA(1, 0), a3, rA, la2);
      PG8_BAR; PG8_WAIT_L(0); PG8_MMA(1, 0, At, B0); PG8_BAR; PG8_SCHED;
      CH_STAGE(PG8_SB(1, 1), b3 + hB2, rB, lb2);
      PG8_WAIT_V(6); PG8_BAR; PG8_MMA(1, 1, At, B1); PG8_BAR;
    }
    {
      const int s6 = q % 6, br = s6 >> 1;
      if ((s6 & 1) == 0) { EpiGate e{p.gst, p.b_gate + (size_t)l * 3072 + br * 1024, tid}; e(acc, cu, wr, wc, fr, fq); }
      else { EpiBranch e{p.gst, p.BIG + C_MIX, br == 0, tid}; e(acc, cu, wr, wc, fr, fq); }
    }
    if (!has_next) break;
#pragma unroll
    for (int a = 0; a < 2; ++a)
#pragma unroll
      for (int b = 0; b < 2; ++b)
#pragma unroll
        for (int m = 0; m < 4; ++m)
#pragma unroll
          for (int n = 0; n < 2; ++n) acc[a][b][m][n] = (f32x4){0.f, 0.f, 0.f, 0.f};
    cu = nu; cs = ns; ++q;
  }
  PG8_WAIT_V(0);
  if (wr == 0) PG8_BAR;
  PG8_BAR;
#undef PG8_SA
#undef PG8_SB
#undef CH_STAGE
#undef CH_ROW_rA
#undef CH_ROW_rB
#undef PG8_LDA
#undef PG8_LDB
#undef PG8_MMA
#undef PG8_WAIT_V
#undef PG8_WAIT_L
#undef PG8_BAR
#undef PG8_SCHED
}

__device__ __forceinline__ void gmlp_tile(const Params& p, int l, int tile, u16* smem) {
  const int c = tile >> 2, g = tile & 3, t0 = c * 128;
  u16* Ws = smem; u16* vT = smem + 128 * 136;
  const int tid = tid_fresh() & 255, lane = tid & 63, wave = tid >> 6, wm = wave >> 1, wn = wave & 1, lr = lane & 15, lq = lane >> 4;
  const int tok = tid >> 1, half = tid & 1;
  u16* prow = p.BIG + (size_t)(t0 + tok) * PS;
  float s = 0.f, ss = 0.f;
#pragma unroll 8
  for (int i = 0; i < 32; i++) {
    uint4 raw = *(const uint4*)(prow + C_V + half * 256 + i * 8);
    u32 w[4] = {raw.x, raw.y, raw.z, raw.w};
#pragma unroll
    for (int e = 0; e < 4; e++) { float a = gelu_t(lo2f(w[e])), b = gelu_t(hi2f(w[e])); s += a + b; ss += a * a + b * b; }
  }
  s += __shfl_xor(s, 1); ss += __shfl_xor(ss, 1);
  const float mean = s * (1.0f / 512.0f);
  const float rstd = rsqrtf(fmaxf(ss * (1.0f / 512.0f) - mean * mean, 0.f) + EPS);
  const float* lg = p.gm_ln_g + l * 512 + g * 128; const float* lb = p.gm_ln_b + l * 512 + g * 128;
#pragma unroll
  for (int i = 0; i < 8; i++) {
    uint4 raw = *(const uint4*)(prow + C_V + g * 128 + half * 64 + i * 8);
    u32 w[4] = {raw.x, raw.y, raw.z, raw.w};
#pragma unroll
    for (int e = 0; e < 4; e++) {
      int cc = half * 64 + i * 8 + 2 * e;
      vT[cc * 136 + tok] = f2bf((gelu_t(lo2f(w[e])) - mean) * rstd * lg[cc] + lb[cc]);
      vT[(cc + 1) * 136 + tok] = f2bf((gelu_t(hi2f(w[e])) - mean) * rstd * lg[cc + 1] + lb[cc + 1]);
    }
  }
  const float* wrow = p.gm_ws + ((size_t)(l * 4 + g) * 128 + tok) * 128 + half * 64;
#pragma unroll
  for (int i = 0; i < 16; i++) {
    float4 w = ((const float4*)wrow)[i];
    int s0 = half * 64 + i * 4;
    uint2 o = make_uint2(pack2(s0 <= tok ? w.x : 0.f, s0 + 1 <= tok ? w.y : 0.f), pack2(s0 + 2 <= tok ? w.z : 0.f, s0 + 3 <= tok ? w.w : 0.f));
    *(uint2*)(Ws + tok * 136 + s0) = o;
  }
  __syncthreads();
  f32x4 acc[4][4];
#pragma unroll
  for (int m = 0; m < 4; m++)
#pragma unroll
    for (int n = 0; n < 4; n++) acc[m][n] = (f32x4){0.f, 0.f, 0.f, 0.f};
#pragma unroll
  for (int kk = 0; kk < 4; kk++) {
    bf16x8 a[4], b[4];
#pragma unroll
    for (int m = 0; m < 4; m++) a[m] = ld8(Ws + (wm * 64 + m * 16 + lr) * 136 + kk * 32 + lq * 8);
#pragma unroll
    for (int n = 0; n < 4; n++) b[n] = ld8(vT + (wn * 64 + n * 16 + lr) * 136 + kk * 32 + lq * 8);
#pragma unroll
    for (int m = 0; m < 4; m++)
#pragma unroll
      for (int n = 0; n < 4; n++) acc[m][n] = mfma16(b[n], a[m], acc[m][n]);
  }
  const float* bsp = p.gm_bs + (size_t)(l * 4 + g) * 128;
  uint2 uv[4][4];
#pragma unroll
  for (int m = 0; m < 4; m++)
#pragma unroll
    for (int n = 0; n < 4; n++)
      uv[m][n] = *(const uint2*)(p.BIG + (size_t)(t0 + wm * 64 + m * 16 + lr) * PS + C_U + g * 128 + wn * 64 + n * 16 + lq * 4);
#pragma unroll
  for (int m = 0; m < 4; m++) {
    const float bias = bsp[wm * 64 + m * 16 + lr];
#pragma unroll
    for (int n = 0; n < 4; n++) {
      const uint2 u = uv[m][n];
      *(uint2*)(p.BIG + (size_t)(t0 + wm * 64 + m * 16 + lr) * PS + C_U + g * 128 + wn * 64 + n * 16 + lq * 4) =
          make_uint2(pack2(gelu_t(lo2f(u.x)) * (acc[m][n][0] + bias), gelu_t(hi2f(u.x)) * (acc[m][n][1] + bias)),
                     pack2(gelu_t(lo2f(u.y)) * (acc[m][n][2] + bias), gelu_t(hi2f(u.y)) * (acc[m][n][3] + bias)));
    }
  }
  __syncthreads();
}

__device__ __forceinline__ void ret_kv_tile(const Params& p, int tile, u16* smem) {
  const int c = tile >> 2, h = tile & 3, t0 = c * 128;
  u16* vT = smem; u16* kT = smem + 128 * 136;
  const int tid = tid_fresh() & 255, lane = tid & 63, wave = tid >> 6, lr = lane & 15, lq = lane >> 4;
  const int tok = tid >> 1, half = tid & 1;
  const float lg = logf(1.0f - exp2f(-5.0f - (float)h));
  const u16* prow = p.BIG + (size_t)(t0 + tok) * PS;
#pragma unroll
  for (int i = 0; i < 8; i++) {
    uint4 raw = *(const uint4*)(prow + C_RV + h * 128 + half * 64 + i * 8);
    u32 w[4] = {raw.x, raw.y, raw.z, raw.w};
#pragma unroll
    for (int e = 0; e < 4; e++) {
      int cc = half * 64 + i * 8 + 2 * e;
      vT[cc * 136 + tok] = (u16)(w[e] & 0xffff);
      vT[(cc + 1) * 136 + tok] = (u16)(w[e] >> 16);
    }
  }
  const float sc = 0.125f * expf(lg * (float)(127 - tok));
#pragma unroll
  for (int i = 0; i < 4; i++) {
    uint4 raw = *(const uint4*)(prow + C_RK + h * 64 + half * 32 + i * 8);
    u32 w[4] = {raw.x, raw.y, raw.z, raw.w};
#pragma unroll
    for (int e = 0; e < 4; e++) {
      int cc = half * 32 + i * 8 + 2 * e;
      kT[cc * 136 + tok] = f2bf(lo2f(w[e]) * sc);
      kT[(cc + 1) * 136 + tok] = f2bf(hi2f(w[e]) * sc);
    }
  }
  __syncthreads();
  f32x4 acc[2][4];
#pragma unroll
  for (int m = 0; m < 2; m++)
#pragma unroll
    for (int n = 0; n < 4; n++) acc[m][n] = (f32x4){0.f, 0.f, 0.f, 0.f};
#pragma unroll
  for (int kk = 0; kk < 4; kk++) {
    bf16x8 a[2], b[4];
#pragma unroll
    for (int m = 0; m < 2; m++) a[m] = ld8(vT + (wave * 32 + m * 16 + lr) * 136 + kk * 32 + lq * 8);
#pragma unroll
    for (int n = 0; n < 4; n++) b[n] = ld8(kT + (n * 16 + lr) * 136 + kk * 32 + lq * 8);
#pragma unroll
    for (int m = 0; m < 2; m++)
#pragma unroll
      for (int n = 0; n < 4; n++) acc[m][n] = mfma16(a[m], b[n], acc[m][n]);
  }
  float* rp = p.ret + (size_t)(c * 4 + h) * 8192;
#pragma unroll
  for (int m = 0; m < 2; m++)
#pragma unroll
    for (int n = 0; n < 4; n++)
#pragma unroll
      for (int j = 0; j < 4; j++) rp[(wave * 32 + m * 16 + lq * 4 + j) * 64 + n * 16 + lr] = acc[m][n][j];
  __syncthreads();
}
__device__ __forceinline__ void ret_scan_wg(const Params& p, unsigned char* sm) {
  const int tid = tid_fresh(), seg = tid >> 7, el = tid & 127;
  float* endv = (float*)sm;
  for (int e0 = blockIdx.x * 128; e0 < 32768; e0 += gridDim.x * 128) {
    const int h = e0 >> 13;
    const float cd = expf(logf(1.0f - exp2f(-5.0f - (float)h)) * 128.0f);
    const float cd2 = cd * cd, cd4 = cd2 * cd2, cd8 = cd4 * cd4, cd16 = cd8 * cd8, cd32 = cd16 * cd16;
    float* base = p.ret + (size_t)(seg * 32) * 32768 + e0 + el;
    float v[32];
#pragma unroll
    for (int i = 0; i < 32; i++) v[i] = base[(size_t)i * 32768];
    float st = 0.f;
#pragma unroll
    for (int i = 0; i < 32; i++) st = st * cd + v[i];
    endv[seg * 128 + el] = st;
    __syncthreads();
    float carry = 0.f;
    for (int s2 = 0; s2 < seg; s2++) carry = carry * cd32 + endv[s2 * 128 + el];
    __syncthreads();
    st = carry;
#pragma unroll
    for (int i = 0; i < 32; i++) { base[(size_t)i * 32768] = st; st = st * cd + v[i]; }
  }
}
__device__ __forceinline__ void ret_out_tile(const Params& p, int l, int tile, u16* smem) {
  const int c = tile >> 2, h = tile & 3, t0 = c * 128;
  u16* vT = smem;
  u16* kS = smem + 128 * 136;
  u16* pT = kS + 128 * 72;
  const int tid = tid_fresh() & 255, lane = tid & 63, wave = tid >> 6, lr = lane & 15, lq = lane >> 4;
  const int tok = tid >> 1, half = tid & 1;
  const float lg = logf(1.0f - exp2f(-5.0f - (float)h));
  {
    const u16* prow = p.BIG + (size_t)(t0 + tok) * PS;
#pragma unroll
    for (int i = 0; i < 8; i++) {
      uint4 raw = *(const uint4*)(prow + C_RV + h * 128 + half * 64 + i * 8);
      u32 w[4] = {raw.x, raw.y, raw.z, raw.w};
#pragma unroll
      for (int e = 0; e < 4; e++) {
        int cc = half * 64 + i * 8 + 2 * e;
        vT[cc * 136 + tok] = (u16)(w[e] & 0xffff);
        vT[(cc + 1) * 136 + tok] = (u16)(w[e] >> 16);
      }
    }
#pragma unroll
    for (int i = 0; i < 4; i++)
      *(uint4*)(kS + tok * 72 + half * 32 + i * 8) = *(const uint4*)(prow + C_RK + h * 64 + half * 32 + i * 8);
    const float* rp = p.ret + (size_t)(c * 4 + h) * 8192 + tok * 64 + half * 32;
#pragma unroll
    for (int i = 0; i < 4; i++) {
      float4 a = ((const float4*)rp)[2 * i], b = ((const float4*)rp)[2 * i + 1];
      *(uint4*)(pT + tok * 72 + half * 32 + i * 8) = make_uint4(pack2(a.x, a.y), pack2(a.z, a.w), pack2(b.x, b.y), pack2(b.z, b.w));
    }
  }
  __syncthreads();
#pragma unroll 1
  for (int it = 0; it < 2; it++) {
    const int i = wave * 32 + it * 16 + lr;
    const u16* qp = p.BIG + (size_t)(t0 + i) * PS + C_RQ + h * 64 + lq * 8;
    const bf16x8 q_lo = ld8(qp), q_hi = ld8(qp + 32);
    f32x4 Y[8];
#pragma unroll
    for (int e = 0; e < 8; e++) Y[e] = (f32x4){0.f, 0.f, 0.f, 0.f};
    const int nch = ((wave * 32 + it * 16 + 15) >> 5) + 1;
    for (int jc = 0; jc < nch; jc++) {
      f32x4 s0 = (f32x4){0.f, 0.f, 0.f, 0.f}, s1 = s0;
      const u16* kp = kS + (jc * 32 + lr) * 72 + lq * 8;
      s0 = mfma16(ld8(kp), q_lo, s0); s0 = mfma16(ld8(kp + 32), q_hi, s0);
      s1 = mfma16(ld8(kp + 16 * 72), q_lo, s1); s1 = mfma16(ld8(kp + 16 * 72 + 32), q_hi, s1);
      float pv[8];
#pragma unroll
      for (int j = 0; j < 4; j++) {
        int d0 = i - (jc * 32 + lq * 4 + j), d1 = d0 - 16;
        pv[j] = d0 >= 0 ? s0[j] * 0.125f * __expf(lg * (float)d0) : 0.f;
        pv[4 + j] = d1 >= 0 ? s1[j] * 0.125f * __expf(lg * (float)d1) : 0.f;
      }
      const bf16x8 pb = pk8(pv[0], pv[1], pv[2], pv[3], pv[4], pv[5], pv[6], pv[7]);
#pragma unroll
      for (int e = 0; e < 8; e++) {
        const u16* vp = vT + (e * 16 + lr) * 136 + jc * 32 + lq * 4;
        Y[e] = mfma16(ld44(vp, vp + 16), pb, Y[e]);
      }
    }
    {
      const float qd = __expf(lg * (float)(i + 1));
      const bf16x8 ql = scale8(q_lo, qd), qh = scale8(q_hi, qd);
#pragma unroll
      for (int e = 0; e < 8; e++) {
        const u16* pp = pT + (e * 16 + lr) * 72 + lq * 8;
        Y[e] = mfma16(ld8(pp), ql, Y[e]);
        Y[e] = mfma16(ld8(pp + 32), qh, Y[e]);
      }
    }
    float s = 0.f, ss = 0.f;
#pragma unroll
    for (int e = 0; e < 8; e++)
#pragma unroll
      for (int j = 0; j < 4; j++) { s += Y[e][j]; ss += Y[e][j] * Y[e][j]; }
    s += __shfl_xor(s, 16); ss += __shfl_xor(ss, 16);
    s += __shfl_xor(s, 32); ss += __shfl_xor(ss, 32);
    const float mean = s * (1.0f / 128.0f);
    const float rstd = rsqrtf(fmaxf(ss * (1.0f / 128.0f) - mean * mean, 0.f) + EPS);
    u16* gp = p.BIG + (size_t)(t0 + i) * PS + C_RG + h * 128;
    const float* gg = p.ret_gn_g + l * 512 + h * 128; const float* gb = p.ret_gn_b + l * 512 + h * 128;
    uint2 grawv[8];
#pragma unroll
    for (int e = 0; e < 8; e++) grawv[e] = *(const uint2*)(gp + e * 16 + lq * 4);
#pragma unroll
    for (int e = 0; e < 8; e++) {
      const int e0 = e * 16 + lq * 4;
      const uint2 graw = grawv[e];
      float4 g4 = *(const float4*)(gg + e0), b4 = *(const float4*)(gb + e0);
      float y0 = (Y[e][0] - mean) * rstd * g4.x + b4.x, y1 = (Y[e][1] - mean) * rstd * g4.y + b4.y;
      float y2 = (Y[e][2] - mean) * rstd * g4.z + b4.z, y3 = (Y[e][3] - mean) * rstd * g4.w + b4.w;
      *(uint2*)(gp + e0) = make_uint2(pack2(silu_f(lo2f(graw.x)) * y0, silu_f(hi2f(graw.x)) * y1),
                                      pack2(silu_f(lo2f(graw.y)) * y2, silu_f(hi2f(graw.y)) * y3));
    }
  }
  __syncthreads();
}

__device__ __forceinline__ void cmp_tile(const Params& p, int l, int tile, u16* smem) {
  const int which = tile >> 6, g = (tile >> 5) & 1, ci0 = (tile & 31) * 32;
  const int tid = tid_fresh() & 255, lane = tid & 63, wave = tid >> 6, lr = lane & 15, lq = lane >> 4;
  float* part = (float*)smem;
  u16* hid = smem + 32768;
  const int colbase = (which ? C_VC : C_KC) + g * 64;
  const float* pos = p.cmp_pos + (size_t)(l * 2 + which) * 32 * 64;
  const u16* w1t = p.cw1t + (size_t)which * 128 * 2048;
  f32x4 acc[2][8];
#pragma unroll
  for (int m = 0; m < 2; m++)
#pragma unroll
    for (int n = 0; n < 8; n++) acc[m][n] = (f32x4){0.f, 0.f, 0.f, 0.f};
  int cir0 = ci0 + lr, cir1 = ci0 + 16 + lr;
  if (cir0 > 1022) cir0 = 1022;
  if (cir1 > 1022) cir1 = 1022;
#pragma unroll 4
  for (int ks = 0; ks < 16; ks++) {
    const int kk = wave * 512 + ks * 32 + lq * 8, toff = kk >> 6, dim = kk & 63;
    const float4 p0 = *(const float4*)(pos + toff * 64 + dim), p1 = *(const float4*)(pos + toff * 64 + dim + 4);
    bf16x8 a[2], b[8];
#pragma unroll
    for (int m = 0; m < 2; m++) {
      const int cr = m == 0 ? cir0 : cir1;
      uint4 raw = *(const uint4*)(p.BIG + (size_t)(cr * 16 + toff) * PS + colbase + dim);
      a[m] = pk8(lo2f(raw.x) + p0.x, hi2f(raw.x) + p0.y, lo2f(raw.y) + p0.z, hi2f(raw.y) + p0.w,
                 lo2f(raw.z) + p1.x, hi2f(raw.z) + p1.y, lo2f(raw.w) + p1.z, hi2f(raw.w) + p1.w);
    }
#pragma unroll
    for (int n = 0; n < 8; n++) b[n] = ld8(w1t + (size_t)(n * 16 + lr) * 2048 + kk);
#pragma unroll
    for (int m = 0; m < 2; m++)
#pragma unroll
      for (int n = 0; n < 8; n++) acc[m][n] = mfma16(a[m], b[n], acc[m][n]);
  }
#pragma unroll
  for (int m = 0; m < 2; m++)
#pragma unroll
    for (int n = 0; n < 8; n++)
#pragma unroll
      for (int j = 0; j < 4; j++) part[wave * 4096 + (m * 16 + lq * 4 + j) * 128 + n * 16 + lr] = acc[m][n][j];
  __syncthreads();
  for (int e = tid; e < 4096; e += 256) {
    const float v = part[e] + part[4096 + e] + part[8192 + e] + part[12288 + e];
    hid[e] = f2bf(gelu_t(v));
  }
  __syncthreads();
  f32x4 o[2] = {(f32x4){0.f, 0.f, 0.f, 0.f}, (f32x4){0.f, 0.f, 0.f, 0.f}};
  const u16* w2t = p.cw2t + (size_t)which * 64 * 128;
#pragma unroll
  for (int kk = 0; kk < 4; kk++) {
    bf16x8 bb = ld8(w2t + (wave * 16 + lr) * 128 + kk * 32 + lq * 8);
#pragma unroll
    for (int m = 0; m < 2; m++) o[m] = mfma16(ld8(hid + (m * 16 + lr) * 128 + kk * 32 + lq * 8), bb, o[m]);
  }
#pragma unroll
  for (int m = 0; m < 2; m++)
#pragma unroll
    for (int j = 0; j < 4; j++) {
      int ci = ci0 + m * 16 + lq * 4 + j, d = wave * 16 + lr;
      u16 v = ci < 1023 ? f2bf(o[m][j]) : (u16)0;
      if (which == 0) p.kc[(size_t)(g * 1024 + ci) * 64 + d] = v;
      else p.vcT[(size_t)(g * 64 + d) * 1024 + ci] = v;
    }
  __syncthreads();
}
__device__ __forceinline__ void vt_tile(const Params& p, int tile, u16* smem) {
  const int sw = tile >> 9, g = (tile >> 8) & 1, t0 = (tile & 255) * 64;
  const int tid = tid_fresh() & 255;
  u16* T = smem;
  const int col = (sw ? C_VW : C_VS) + g * 64;
  {
    const int tok = tid >> 2, dq = (tid & 3) * 16;
    const u16* src = p.BIG + (size_t)(t0 + tok) * PS + col + dq;
    uint4 r0 = *(const uint4*)src, r1 = *(const uint4*)(src + 8);
    u32 w[8] = {r0.x, r0.y, r0.z, r0.w, r1.x, r1.y, r1.z, r1.w};
#pragma unroll
    for (int e = 0; e < 8; e++) { T[(dq + 2 * e) * 72 + tok] = (u16)(w[e] & 0xffff); T[(dq + 2 * e + 1) * 72 + tok] = (u16)(w[e] >> 16); }
  }
  __syncthreads();
  {
    const int d = tid >> 2, tq = (tid & 3) * 16;
    u16* dst = (sw ? p.vwT : p.vsT) + (size_t)(g * 64 + d) * S + t0 + tq;
    *(uint4*)dst = *(const uint4*)(T + d * 72 + tq);
    *(uint4*)(dst + 8) = *(const uint4*)(T + d * 72 + tq + 8);
  }
  __syncthreads();
}

constexpr int NT_ST = 72;
constexpr int NT_EL = 64 * NT_ST;
__device__ __forceinline__ float quad_sum(float x) {
  x += __uint_as_float((u32)__builtin_amdgcn_mov_dpp((int)__float_as_uint(x), 0xB1, 0xF, 0xF, true));
  x += __uint_as_float((u32)__builtin_amdgcn_mov_dpp((int)__float_as_uint(x), 0x4E, 0xF, 0xF, true));
  return x;
}
__device__ __forceinline__ void qk64(const u16* kt, int lr, int lq, bf16x8 q_lo, bf16x8 q_hi, f32x4 (&s)[2][2]) {
#pragma unroll
  for (int c = 0; c < 2; c++)
#pragma unroll
    for (int t = 0; t < 2; t++) {
      const u16* kp = kt + (c * 32 + t * 16 + lr) * NT_ST + lq * 8;
      f32x4 a = s[c][t];
      a = mfma16(ld8(kp), q_lo, a); a = mfma16(ld8(kp + 32), q_hi, a);
      s[c][t] = a;
    }
}
__device__ __forceinline__ float ex2(float x) { return __builtin_amdgcn_exp2f(x); }
template <bool FAST>
__device__ __forceinline__ void attend_tile(const u16* kt, const u16* vt, int lr, int lq, bf16x8 q_lo, bf16x8 q_hi, float slope2, int dbase,
                                            bool rowsel, int win, float& m, float& lsum, f32x4 (&O)[4]) {
  f32x4 s[2][2];
  float sv[16];
  float mx = -1e30f;
  if (FAST) {
    const float binit = rowsel ? -slope2 * (float)(dbase - lq * 4) : -1e30f;
#pragma unroll
    for (int c = 0; c < 2; c++)
#pragma unroll
      for (int t = 0; t < 2; t++)
#pragma unroll
        for (int j = 0; j < 4; j++) s[c][t][j] = __builtin_fmaf(slope2, (float)(c * 32 + t * 16 + j), binit);
    qk64(kt, lr, lq, q_lo, q_hi, s);
#pragma unroll
    for (int c = 0; c < 2; c++)
#pragma unroll
      for (int t = 0; t < 2; t++)
#pragma unroll
        for (int j = 0; j < 4; j++) { sv[(c * 2 + t) * 4 + j] = s[c][t][j]; mx = fmaxf(mx, s[c][t][j]); }
  } else {
#pragma unroll
    for (int c = 0; c < 2; c++)
#pragma unroll
      for (int t = 0; t < 2; t++) s[c][t] = (f32x4){0.f, 0.f, 0.f, 0.f};
    qk64(kt, lr, lq, q_lo, q_hi, s);
#pragma unroll
    for (int c = 0; c < 2; c++)
#pragma unroll
      for (int t = 0; t < 2; t++)
#pragma unroll
        for (int j = 0; j < 4; j++) {
          const int d = dbase - (c * 32 + t * 16 + lq * 4 + j);
          const bool o = rowsel && d >= 0 && d < win;
          const float v = o ? s[c][t][j] - slope2 * (float)d : -1e30f;
          sv[(c * 2 + t) * 4 + j] = v;
          mx = fmaxf(mx, v);
        }
  }
  if (__any(mx > m)) {
    mx = fmaxf(mx, __shfl_xor(mx, 16)); mx = fmaxf(mx, __shfl_xor(mx, 32));
    const float mnew = fmaxf(m, mx);
    const float alpha = ex2(m - mnew);
    m = mnew;
    lsum *= alpha;
#pragma unroll
    for (int dt = 0; dt < 4; dt++)
#pragma unroll
      for (int j = 0; j < 4; j++) O[dt][j] *= alpha;
  }
  const float mn = m;
  float ps = 0.f;
  bf16x8 pb[2];
#pragma unroll
  for (int c = 0; c < 2; c++) {
    float pv[8];
#pragma unroll
    for (int j = 0; j < 8; j++) {
      const float v = sv[c * 8 + j];
      pv[j] = FAST ? ex2(v - mn) : (v > -1e29f ? ex2(v - mn) : 0.f);
      ps += pv[j];
    }
    pb[c] = pk8(pv[0], pv[1], pv[2], pv[3], pv[4], pv[5], pv[6], pv[7]);
  }
  lsum += ps;
#pragma unroll
  for (int dt = 0; dt < 4; dt++)
#pragma unroll
    for (int c = 0; c < 2; c++) {
      const u16* vp = vt + (dt * 16 + lr) * NT_ST + c * 32 + lq * 4;
      O[dt] = mfma16(ld44(vp, vp + 16), pb[c], O[dt]);
    }
}

template <bool HASV, class KS, class VS, class CF>
__device__ __forceinline__ void tile_pipe2(int n, u16* ktb, u16* vtb, int soff, KS ksrc, VS vsrc, CF compute) {
  uint4 kE, vE, kO, vO;
  kE = vE = kO = vO = make_uint4(0u, 0u, 0u, 0u);
  if (n > 0) { kE = *(const uint4*)ksrc(0); if (HASV) vE = *(const uint4*)vsrc(0); }
  if (n > 1) { kO = *(const uint4*)ksrc(1); if (HASV) vO = *(const uint4*)vsrc(1); }
  if (n > 0) { *(uint4*)(ktb + soff) = kE; if (HASV) *(uint4*)(vtb + soff) = vE; }
  __syncthreads();
#pragma unroll 1
  for (int i = 0; i < n; i += 2) {
    if (i + 2 < n) { kE = *(const uint4*)ksrc(i + 2); if (HASV) vE = *(const uint4*)vsrc(i + 2); }
    compute(i, ktb, vtb);
    if (i + 1 < n) { *(uint4*)(ktb + NT_EL + soff) = kO; if (HASV) *(uint4*)(vtb + NT_EL + soff) = vO; }
    __syncthreads();
    if (i + 1 >= n) break;
    if (i + 3 < n) { kO = *(const uint4*)ksrc(i + 3); if (HASV) vO = *(const uint4*)vsrc(i + 3); }
    compute(i + 1, ktb + NT_EL, vtb + NT_EL);
    if (i + 2 < n) { *(uint4*)(ktb + soff) = kE; if (HASV) *(uint4*)(vtb + soff) = vE; }
    __syncthreads();
  }
}

__device__ __forceinline__ void nsa_wg(const Params& p, int g, int T0, unsigned char* sm) {
  const int tid = tid_fresh(), lane = tid & 63, lr = lane & 15, lq = lane >> 4;
  const int wv = __builtin_amdgcn_readfirstlane(tid >> 6);
  const int t0 = T0 + wv * 4;
  const int tok = lr >> 2, r = lr & 3, tpos = t0 + tok;
  const float slope = 1.4426950408889634f * exp2f(-(float)(g * 4 + r + 1));
  u16* proj = p.BIG;
  float* wl = (float*)sm + wv * 2112;
  float* impA = wl; float* impB = wl + 1024; u32* selm = (u32*)(wl + 1024 + 1040);
  u16* ktb = (u16*)(sm + 67584);
  u16* vtb = ktb + 2 * NT_EL;
  u32* wgm = (u32*)(vtb + 2 * NT_EL);
  u32* wgu = wgm + 64;
  int* blist = (int*)(wgu + 8);
  const int srow = tid >> 3, sseg = (tid & 7) * 8;
  const int soff = srow * NT_ST + sseg;
  bf16x8 q_lo, q_hi;
  {
    const u16* qp = proj + (size_t)tpos * PS + C_NQ + (g * 4 + r) * 64 + lq * 8;
    q_lo = scale8(ld8(qp), 0.125f * 1.4426950408889634f); q_hi = scale8(ld8(qp + 32), 0.125f * 1.4426950408889634f);
  }
  float g0, g1, g2;
  {
    const u16* gp = proj + (size_t)tpos * PS + C_NG + (g * 4 + r) * 3;
    g0 = sigm_f(bf2f(gp[0])); g1 = sigm_f(bf2f(gp[1])); g2 = sigm_f(bf2f(gp[2]));
  }
  f32x4 outacc[4];
#pragma unroll
  for (int dt = 0; dt < 4; dt++) outacc[dt] = (f32x4){0.f, 0.f, 0.f, 0.f};
  const int cur = T0 >> 6;

  for (int i = lane; i < 1024 + 1040; i += 64) wl[i] = 0.f;
  {
    const int ncmp = (T0 + 31 >= 31) ? ((T0 + 31 - 31) >> 4) + 1 : 0;
    const int nst = (ncmp + 63) >> 6;
    const u16* ksrc = p.kc + (size_t)g * 1024 * 64 + (size_t)srow * 64 + sseg;
    const u16* vsrc = p.vcT + (size_t)(g * 64 + srow) * 1024 + sseg;
    float m = -1e30f, lsum = 0.f;
    tile_pipe2<false>(nst, ktb, vtb, soff,
      [&](int i) { return ksrc + (size_t)(nst - 1 - i) * 4096; }, [&](int i) { return ksrc; },
      [&](int i, const u16* kt, const u16* vt) {
        const int st = nst - 1 - i;
        f32x4 s[2][2];
        float sv[16]; float mx = -1e30f;
        const bool fast = t0 - 31 - 16 * (st * 64 + 63) >= 0;
        if (fast) {
          const float binit = -slope * (float)(tpos - 31 - 16 * (st * 64 + lq * 4)), slope16 = slope * 16.0f;
#pragma unroll
          for (int c = 0; c < 2; c++)
#pragma unroll
            for (int t = 0; t < 2; t++)
#pragma unroll
              for (int j = 0; j < 4; j++) s[c][t][j] = __builtin_fmaf(slope16, (float)(c * 32 + t * 16 + j), binit);
          qk64(kt, lr, lq, q_lo, q_hi, s);
#pragma unroll
          for (int c = 0; c < 2; c++)
#pragma unroll
            for (int t = 0; t < 2; t++)
#pragma unroll
              for (int j = 0; j < 4; j++) { sv[(c * 2 + t) * 4 + j] = s[c][t][j]; mx = fmaxf(mx, s[c][t][j]); }
        } else {
#pragma unroll
          for (int c = 0; c < 2; c++)
#pragma unroll
            for (int t = 0; t < 2; t++) s[c][t] = (f32x4){0.f, 0.f, 0.f, 0.f};
          qk64(kt, lr, lq, q_lo, q_hi, s);
#pragma unroll
          for (int c = 0; c < 2; c++)
#pragma unroll
            for (int t = 0; t < 2; t++)
#pragma unroll
              for (int j = 0; j < 4; j++) {
                const int ci = st * 64 + c * 32 + t * 16 + lq * 4 + j;
                const int d = tpos - (ci * 16 + 31);
                const float v = d >= 0 ? s[c][t][j] - slope * (float)d : -1e30f;
                sv[(c * 2 + t) * 4 + j] = v; mx = fmaxf(mx, v);
              }
        }
        if (__any(mx > m)) {
          mx = fmaxf(mx, __shfl_xor(mx, 16)); mx = fmaxf(mx, __shfl_xor(mx, 32));
          const float mnew = fmaxf(m, mx);
          lsum *= ex2(m - mnew);
          m = mnew;
        }
        const float mn = m;
        float ps = 0.f;
        if (fast) {
#pragma unroll
          for (int j = 0; j < 16; j++) ps += ex2(sv[j] - mn);
        } else {
#pragma unroll
          for (int j = 0; j < 16; j++) ps += sv[j] > -1e29f ? ex2(sv[j] - mn) : 0.f;
        }
        lsum += ps;
      });
    lsum += __shfl_xor(lsum, 16); lsum += __shfl_xor(lsum, 32);
    const float invL = lsum > 0.f ? 1.0f / lsum : 0.f;
    f32x4 O[4];
#pragma unroll
    for (int dt = 0; dt < 4; dt++) O[dt] = (f32x4){0.f, 0.f, 0.f, 0.f};
    tile_pipe2<true>(nst, ktb, vtb, soff,
      [&](int st) { return ksrc + (size_t)st * 4096; }, [&](int st) { return vsrc + st * 64; },
      [&](int st, const u16* kt, const u16* vt) {
        f32x4 s[2][2];
        const bool fast = t0 - 31 - 16 * (st * 64 + 63) >= 0;
        if (fast) {
          const float binit = -slope * (float)(tpos - 31 - 16 * (st * 64 + lq * 4)) - m, slope16 = slope * 16.0f;
#pragma unroll
          for (int c = 0; c < 2; c++)
#pragma unroll
            for (int t = 0; t < 2; t++)
#pragma unroll
              for (int j = 0; j < 4; j++) s[c][t][j] = __builtin_fmaf(slope16, (float)(c * 32 + t * 16 + j), binit);
        } else {
#pragma unroll
          for (int c = 0; c < 2; c++)
#pragma unroll
            for (int t = 0; t < 2; t++) s[c][t] = (f32x4){0.f, 0.f, 0.f, 0.f};
        }
        qk64(kt, lr, lq, q_lo, q_hi, s);
        bf16x8 pb[2];
#pragma unroll
        for (int c = 0; c < 2; c++) {
          float p0[4], p1[4];
          if (fast) {
#pragma unroll
            for (int j = 0; j < 4; j++) { p0[j] = ex2(s[c][0][j]) * invL; p1[j] = ex2(s[c][1][j]) * invL; }
          } else {
#pragma unroll
            for (int j = 0; j < 4; j++) {
              const int ci = st * 64 + c * 32 + lq * 4 + j;
              const int d0 = tpos - (ci * 16 + 31), d1 = d0 - 256;
              p0[j] = d0 >= 0 ? ex2(s[c][0][j] - slope * (float)d0 - m) * invL : 0.f;
              p1[j] = d1 >= 0 ? ex2(s[c][1][j] - slope * (float)d1 - m) * invL : 0.f;
            }
          }
          float a0 = p0[0] + p0[1] + p0[2] + p0[3], b0 = p0[3], a1 = p1[0] + p1[1] + p1[2] + p1[3], b1 = p1[3];
          a0 = quad_sum(a0); b0 = quad_sum(b0); a1 = quad_sum(a1); b1 = quad_sum(b1);
          if (r == 0) {
            const int J0 = st * 16 + c * 8 + lq;
            impA[tok * 256 + J0] = a0; impB[tok * 260 + J0 + 1] = b0;
            impA[tok * 256 + J0 + 4] = a1; impB[tok * 260 + J0 + 5] = b1;
          }
          pb[c] = pk8(p0[0], p0[1], p0[2], p0[3], p1[0], p1[1], p1[2], p1[3]);
        }
#pragma unroll
        for (int dt = 0; dt < 4; dt++)
#pragma unroll
          for (int c = 0; c < 2; c++) {
            const u16* vp = vt + (dt * 16 + lr) * NT_ST + c * 32 + lq * 4;
            O[dt] = mfma16(ld44(vp, vp + 16), pb[c], O[dt]);
          }
      });
#pragma unroll
    for (int dt = 0; dt < 4; dt++)
#pragma unroll
      for (int j = 0; j < 4; j++) outacc[dt][j] += g0 * O[dt][j];
  }
  wave_lds_sync();

  if (cur < 16) {
    if (lane < 32) selm[lane] = ((lane & 7) == 0) ? ((2u << cur) - 1u) : 0u;
  } else {
    u32 kk[4][4];
#pragma unroll
    for (int tk = 0; tk < 4; tk++) {
      const float* ia = impA + tk * 256; const float* ib = impB + tk * 260;
#pragma unroll
      for (int i = 0; i < 4; i++) {
        const int j = lane + 64 * i;
        kk[tk][i] = (j >= 1 && j <= cur - 2) ? __float_as_uint(ia[j] + ib[j]) + 1u : 0u;
      }
    }
    u32 T[4] = {0u, 0u, 0u, 0u};
#pragma unroll 1
    for (int bit = 30; bit >= 0; bit--) {
#pragma unroll
      for (int tk = 0; tk < 4; tk++) {
        const u32 t = T[tk] | (1u << bit);
        const int cnt = __popcll(__ballot(kk[tk][0] >= t)) + __popcll(__ballot(kk[tk][1] >= t)) + __popcll(__ballot(kk[tk][2] >= t)) + __popcll(__ballot(kk[tk][3] >= t));
        if (cnt >= 13) T[tk] = t;
      }
    }
#pragma unroll
    for (int tk = 0; tk < 4; tk++) {
      const u32 k0 = kk[tk][0], k1 = kk[tk][1], k2 = kk[tk][2], k3 = kk[tk][3], Tt = T[tk];
      int need = 13 - (__popcll(__ballot(k0 > Tt)) + __popcll(__ballot(k1 > Tt)) + __popcll(__ballot(k2 > Tt)) + __popcll(__ballot(k3 > Tt)));
      u64 sel0, sel1, sel2, sel3;
      {
        u64 e = __ballot(k0 == Tt); int below = __builtin_amdgcn_mbcnt_hi((u32)(e >> 32), __builtin_amdgcn_mbcnt_lo((u32)e, 0u));
        sel0 = __ballot(k0 > Tt || (k0 == Tt && below < need)); need -= min(need, (int)__popcll(e));
        e = __ballot(k1 == Tt); below = __builtin_amdgcn_mbcnt_hi((u32)(e >> 32), __builtin_amdgcn_mbcnt_lo((u32)e, 0u));
        sel1 = __ballot(k1 > Tt || (k1 == Tt && below < need)); need -= min(need, (int)__popcll(e));
        e = __ballot(k2 == Tt); below = __builtin_amdgcn_mbcnt_hi((u32)(e >> 32), __builtin_amdgcn_mbcnt_lo((u32)e, 0u));
        sel2 = __ballot(k2 > Tt || (k2 == Tt && below < need)); need -= min(need, (int)__popcll(e));
        e = __ballot(k3 == Tt); below = __builtin_amdgcn_mbcnt_hi((u32)(e >> 32), __builtin_amdgcn_mbcnt_lo((u32)e, 0u));
        sel3 = __ballot(k3 > Tt || (k3 == Tt && below < need));
      }
      u32 myword = 0;
      if (lane == 0) myword = (u32)sel0; else if (lane == 1) myword = (u32)(sel0 >> 32);
      else if (lane == 2) myword = (u32)sel1; else if (lane == 3) myword = (u32)(sel1 >> 32);
      else if (lane == 4) myword = (u32)sel2; else if (lane == 5) myword = (u32)(sel2 >> 32);
      else if (lane == 6) myword = (u32)sel3; else if (lane == 7) myword = (u32)(sel3 >> 32);
      if (lane == 0) myword |= 1u;
      if (lane == ((cur - 1) >> 5)) myword |= 1u << ((cur - 1) & 31);
      if (lane == (cur >> 5)) myword |= 1u << (cur & 31);
      if (lane < 8) selm[tk * 8 + lane] = myword;
    }
  }
  wave_lds_sync();
  if (lane < 8) wgm[wv * 8 + lane] = selm[lane] | selm[8 + lane] | selm[16 + lane] | selm[24 + lane];
  __syncthreads();
  if (tid < 8) {
    u32 u = 0;
#pragma unroll
    for (int w = 0; w < 8; w++) u |= wgm[w * 8 + tid];
    const int lim = cur - tid * 32;
    if (lim < 0) u = 0; else if (lim < 31) u &= (2u << lim) - 1u;
    wgu[tid] = u;
  }
  __syncthreads();
  if (tid < 256) {
    const int w = tid >> 5, b = tid & 31;
    int idx = 0;
#pragma unroll
    for (int ww = 0; ww < 8; ww++) { const u32 x = wgu[ww]; idx += ww < w ? __builtin_popcount(x) : 0; }
    const u32 x = wgu[w];
    idx += __builtin_popcount(x & ((1u << b) - 1u));
    if ((x >> b) & 1u) blist[idx] = tid;
  }
  if (tid == 0) {
    int n = 0;
#pragma unroll
    for (int ww = 0; ww < 8; ww++) n += __builtin_popcount(wgu[ww]);
    blist[256] = n;
  }
  __syncthreads();

  {
    const int nblk = blist[256];
    const u16* ksrc = proj + C_KS + g * 64 + (size_t)srow * PS + sseg;
    const u16* vsrc = p.vsT + (size_t)(g * 64 + srow) * S + sseg;
    float m = -1e30f, lsum = 0.f;
    f32x4 O[4];
#pragma unroll
    for (int dt = 0; dt < 4; dt++) O[dt] = (f32x4){0.f, 0.f, 0.f, 0.f};
    tile_pipe2<true>(nblk, ktb, vtb, soff,
      [&](int i) { return ksrc + (size_t)blist[nblk - 1 - i] * 64 * PS; }, [&](int i) { return vsrc + blist[nblk - 1 - i] * 64; },
      [&](int i, const u16* kt, const u16* vt) {
        const int jb = blist[nblk - 1 - i];
        const u32 wany = wgm[wv * 8 + (jb >> 5)];
        if ((wany >> (jb & 31)) & 1u) {
          const bool rowsel = (selm[tok * 8 + (jb >> 5)] >> (jb & 31)) & 1u;
          if (jb < cur) attend_tile<true>(kt, vt, lr, lq, q_lo, q_hi, slope, tpos - jb * 64, rowsel, 1 << 30, m, lsum, O);
          else attend_tile<false>(kt, vt, lr, lq, q_lo, q_hi, slope, tpos - jb * 64, rowsel, 1 << 30, m, lsum, O);
        }
      });
    lsum += __shfl_xor(lsum, 16); lsum += __shfl_xor(lsum, 32);
    const float sc = g1 / fmaxf(lsum, 1e-30f);
#pragma unroll
    for (int dt = 0; dt < 4; dt++)
#pragma unroll
      for (int j = 0; j < 4; j++) outacc[dt][j] += sc * O[dt][j];
  }
  {
    int ks = T0 - 511; if (ks < 0) ks = 0; ks &= ~63;
    const int nst = ((T0 + 31 - ks) >> 6) + 1;
    const u16* ksrc = proj + C_KW + g * 64 + (size_t)(ks + srow) * PS + sseg;
    const u16* vsrc = p.vwT + (size_t)(g * 64 + srow) * S + ks + sseg;
    float m = -1e30f, lsum = 0.f;
    f32x4 O[4];
#pragma unroll
    for (int dt = 0; dt < 4; dt++) O[dt] = (f32x4){0.f, 0.f, 0.f, 0.f};
    tile_pipe2<true>(nst, ktb, vtb, soff,
      [&](int st) { return ksrc + (size_t)(nst - 1 - st) * 64 * PS; }, [&](int st) { return vsrc + (nst - 1 - st) * 64; },
      [&](int st, const u16* kt, const u16* vt) {
        const int kp0 = ks + (nst - 1 - st) * 64;
        if (t0 - (kp0 + 63) >= 0 && t0 + 3 - kp0 < 512) attend_tile<true>(kt, vt, lr, lq, q_lo, q_hi, slope, tpos - kp0, true, 512, m, lsum, O);
        else attend_tile<false>(kt, vt, lr, lq, q_lo, q_hi, slope, tpos - kp0, true, 512, m, lsum, O);
      });
    lsum += __shfl_xor(lsum, 16); lsum += __shfl_xor(lsum, 32);
    const float sc = g2 / fmaxf(lsum, 1e-30f);
#pragma unroll
    for (int dt = 0; dt < 4; dt++)
#pragma unroll
      for (int j = 0; j < 4; j++) outacc[dt][j] += sc * O[dt][j];
  }
  {
    u16* op = proj + (size_t)tpos * PS + C_NQ + (g * 4 + r) * 64 + lq * 4;
#pragma unroll
    for (int dt = 0; dt < 4; dt++)
      *(uint2*)(op + dt * 16) = make_uint2(pack2(outacc[dt][0], outacc[dt][1]), pack2(outacc[dt][2], outacc[dt][3]));
  }
  __syncthreads();
}

#define XB_TMO      128
#define XB_XCNT(j)  (256  + 64 * (j))
#define XB_XSUB(j)  (1280 + 64 * (j))
#define XB_XGEN(j)  (2304 + 64 * (j))
#define XB_TOP      3328
#define XB_TOPGEN   3392
#define XCD_BAR_WORDS 3456
#define XB_SPIN_CAP (1u << 18)
__device__ __forceinline__ unsigned xb_ld(unsigned* p)              { return __hip_atomic_load(p, __ATOMIC_RELAXED, __HIP_MEMORY_SCOPE_AGENT); }
__device__ __forceinline__ unsigned xb_add(unsigned* p, unsigned v) { return __hip_atomic_fetch_add(p, v, __ATOMIC_RELAXED, __HIP_MEMORY_SCOPE_AGENT); }
__device__ __forceinline__ unsigned xb_xcc_id() { return (unsigned)__builtin_amdgcn_s_getreg((3 << 11) | 20) & 0xFu; }
#define XB_SPIN(cond, bar) do { unsigned _sp = 0; while (cond) { __builtin_amdgcn_s_sleep(1); \
    if ((++_sp & 255u) == 0u) { if (xb_ld(&(bar)[XB_TMO])) break; if (_sp > XB_SPIN_CAP) { atomicAdd(&(bar)[XB_TMO], 1u); break; } } } } while (0)
struct XcdBarrier { unsigned* bar; unsigned x; volatile __attribute__((address_space(3))) unsigned* st; };
__device__ __forceinline__ XcdBarrier xcd_barrier_post(unsigned* bar, volatile __attribute__((address_space(3))) unsigned* st) {
  XcdBarrier b; b.bar = bar; b.x = xb_xcc_id(); b.st = st;
  if (threadIdx.x == 0) (void)xb_add(&bar[XB_XCNT(b.x)], 1u);
  return b;
}
__device__ __forceinline__ void xcd_barrier_complete(unsigned* bar, unsigned x, unsigned& nloc, unsigned& nx) {
  const unsigned G = gridDim.x * gridDim.y * gridDim.z;
  unsigned sum, cnt, mine, sp = 0u;
  for (;;) {
    sum = 0u; cnt = 0u; mine = 0u;
#pragma unroll
    for (unsigned j = 0; j < 16; ++j) { const unsigned c = xb_ld(&bar[XB_XCNT(j)]); sum += c; cnt += (c > 0u) ? 1u : 0u; mine = (j == x) ? c : mine; }
    if (sum == G) break;
    __builtin_amdgcn_s_sleep(1);
    if ((++sp & 255u) == 0u) { if (xb_ld(&bar[XB_TMO])) break; if (sp > XB_SPIN_CAP) { atomicAdd(&bar[XB_TMO], 1u); break; } }
  }
  nloc = mine > 0u ? mine : 1u; nx = cnt > 0u ? cnt : 1u;
}
__device__ __forceinline__ void xcd_barrier(const XcdBarrier& b) {
  asm volatile("s_waitcnt vmcnt(0)" ::: "memory");
  __syncthreads();
  if (threadIdx.x == 0) {
    unsigned* bar = b.bar;
    __builtin_amdgcn_s_waitcnt(0);
    unsigned nloc = b.st[0], nx = b.st[1];
    if (nloc == 0u) { xcd_barrier_complete(bar, b.x, nloc, nx); b.st[0] = nloc; b.st[1] = nx; }
    const unsigned old = xb_add(&bar[XB_XSUB(b.x)], 1u);
    const unsigned gen = old / nloc;
    if (old + 1u == (gen + 1u) * nloc) {
      __builtin_amdgcn_fence(__ATOMIC_RELEASE, "agent");
      asm volatile("s_waitcnt vmcnt(0)" ::: "memory");
      const unsigned og = xb_add(&bar[XB_TOP], 1u);
      const unsigned tg = og / nx;
      if (og + 1u == (tg + 1u) * nx) xb_add(&bar[XB_TOPGEN], 1u);
      else XB_SPIN(xb_ld(&bar[XB_TOPGEN]) == tg, bar);
      __builtin_amdgcn_fence(__ATOMIC_ACQUIRE, "agent");
      xb_add(&bar[XB_XGEN(b.x)], 1u);
      asm volatile("s_waitcnt vmcnt(0)" ::: "memory");
    } else {
      XB_SPIN(xb_ld(&bar[XB_XGEN(b.x)]) == gen, bar);
      __builtin_amdgcn_fence(__ATOMIC_ACQUIRE, "agent");
      asm volatile("s_waitcnt vmcnt(0)" ::: "memory");
    }
  }
  __syncthreads();
}

template <bool FINAL>
struct EpiResidNorm {
  static constexpr bool PERM = false;
  const float* xsrc; float* xdst; float scale; const float* gnext; u16* Hout; float* part; unsigned* cnt; unsigned* tmo;
  __device__ __forceinline__ void fused(AccT& acc, const Unit& u, int wr, int wc, int fr, int fq, LAS unsigned char* lds) const {
    volatile LAS float* ps = (volatile LAS float*)(lds + 131072);
    volatile LAS float* rr = (volatile LAS float*)(lds + 131072 + 4096);
    const int tid = tid_fresh();
    const int row0 = u.pm * 256 + wr * 64 + fr, col0 = u.pn * 256 + wc * 32 + 4 * fq;
#pragma unroll
    for (int ai = 0; ai < 2; ++ai) {
      f32x4 xv[4][2][2];
#pragma unroll
      for (int m = 0; m < 4; ++m)
#pragma unroll
        for (int bj = 0; bj < 2; ++bj)
#pragma unroll
          for (int n = 0; n < 2; ++n)
            xv[m][bj][n] = *(const f32x4*)(xsrc + (size_t)(row0 + ai * 128 + m * 16) * 1024 + col0 + bj * 128 + n * 16);
#pragma unroll
      for (int m = 0; m < 4; ++m) {
        float ss = 0.f;
#pragma unroll
        for (int bj = 0; bj < 2; ++bj)
#pragma unroll
          for (int n = 0; n < 2; ++n) {
            const f32x4 v = xv[m][bj][n] + scale * acc[ai][bj][m][n];
            acc[ai][bj][m][n] = v;
            ss += v[0] * v[0] + v[1] * v[1] + v[2] * v[2] + v[3] * v[3];
          }
        ss += __shfl_xor(ss, 16); ss += __shfl_xor(ss, 32);
        if (fq == 0) ps[wc * 256 + ai * 128 + wr * 64 + m * 16 + fr] = ss;
      }
    }
    __syncthreads();
    if (tid < 256) __hip_atomic_store(part + (size_t)(u.pm * 4 + u.pn) * 256 + tid, ps[tid] + ps[256 + tid] + ps[512 + tid] + ps[768 + tid], __ATOMIC_RELAXED, __HIP_MEMORY_SCOPE_AGENT);
    asm volatile("s_waitcnt vmcnt(0)" ::: "memory");
    __syncthreads();
    if (tid == 0) (void)xb_add(cnt + u.pm, 1u);
    f32x4 gv[2][2];
#pragma unroll
    for (int bj = 0; bj < 2; ++bj)
#pragma unroll
      for (int n = 0; n < 2; ++n) gv[bj][n] = *(const f32x4*)(gnext + col0 + bj * 128 + n * 16);
    if (!FINAL) {
#pragma unroll
      for (int ai = 0; ai < 2; ++ai)
#pragma unroll
        for (int m = 0; m < 4; ++m)
#pragma unroll
          for (int bj = 0; bj < 2; ++bj)
#pragma unroll
            for (int n = 0; n < 2; ++n)
              *(f32x4*)(xdst + (size_t)(row0 + ai * 128 + m * 16) * 1024 + col0 + bj * 128 + n * 16) = acc[ai][bj][m][n];
    }
    if (tid == 0) {
      XB_SPIN(xb_ld(cnt + u.pm) < 4u, tmo);
      __builtin_amdgcn_fence(__ATOMIC_ACQUIRE, "agent");
      asm volatile("s_waitcnt vmcnt(0)" ::: "memory");
    }
    __syncthreads();
    if (tid < 256) {
      const float* pp = part + (size_t)(u.pm * 4) * 256 + tid;
      const float t0 = __hip_atomic_load(pp, __ATOMIC_RELAXED, __HIP_MEMORY_SCOPE_AGENT), t1 = __hip_atomic_load(pp + 256, __ATOMIC_RELAXED, __HIP_MEMORY_SCOPE_AGENT);
      const float t2 = __hip_atomic_load(pp + 512, __ATOMIC_RELAXED, __HIP_MEMORY_SCOPE_AGENT), t3 = __hip_atomic_load(pp + 768, __ATOMIC_RELAXED, __HIP_MEMORY_SCOPE_AGENT);
      rr[tid] = rsqrtf(((t0 + t1) + (t2 + t3)) * (1.0f / 1024.0f) + EPS);
    }
    __syncthreads();
#pragma unroll
    for (int ai = 0; ai < 2; ++ai)
#pragma unroll
      for (int m = 0; m < 4; ++m) {
        const float r = rr[ai * 128 + wr * 64 + m * 16 + fr];
#pragma unroll
        for (int bj = 0; bj < 2; ++bj) {
          const f32x4 h0 = acc[ai][bj][m][0] * r * gv[bj][0], h1 = acc[ai][bj][m][1] * r * gv[bj][1];
          if (FINAL) {
            *(f32x4*)(xdst + (size_t)(row0 + ai * 128 + m * 16) * 1024 + col0 + bj * 128) = h0;
            *(f32x4*)(xdst + (size_t)(row0 + ai * 128 + m * 16) * 1024 + col0 + bj * 128 + 16) = h1;
          } else {
            typedef unsigned u32x2s __attribute__((ext_vector_type(2)));
            const u32x2s rx = __builtin_amdgcn_permlane16_swap(pack2(h0[0], h0[1]), pack2(h1[0], h1[1]), false, false);
            const u32x2s ry = __builtin_amdgcn_permlane16_swap(pack2(h0[2], h0[3]), pack2(h1[2], h1[3]), false, false);
            const int colw = u.pn * 256 + wc * 32 + bj * 128 + ((fq & 1) ? 16 + 4 * (fq - 1) : 4 * fq);
            *(uint4*)(Hout + (size_t)(row0 + ai * 128 + m * 16) * 1024 + colw) = make_uint4(rx.x, ry.x, rx.y, ry.y);
          }
        }
      }
    __syncthreads();
  }
};

constexpr int SMEM_TOTAL = 147456;
__global__ void __launch_bounds__(512, 2) mega(Params p) {
  cg::grid_group grid = cg::this_grid();
  __shared__ __attribute__((aligned(16))) unsigned char smem_raw[SMEM_TOTAL + 16];
  LAS unsigned char* glds = (LAS unsigned char*)smem_raw;
  volatile LAS unsigned* xb_words = (volatile LAS unsigned*)(glds + SMEM_TOTAL);
  if (threadIdx.x == 0) { xb_words[0] = 0u; xb_words[1] = 0u; }
  if (blockIdx.x == 0) { for (int i = threadIdx.x; i < XCD_BAR_WORDS; i += 512) p.bar[i] = 0u; if (threadIdx.x < 384) p.ncnt[threadIdx.x] = 0u; }
  __syncthreads();
  XcdBarrier xb; xb.bar = p.bar; xb.x = 0; xb.st = xb_words;
#define VB_SETUP const int _tf = tid_fresh(); const int half = __builtin_amdgcn_readfirstlane(_tf >> 8); const int nb = gridDim.x * 2, bid = blockIdx.x * 2 + half; \
  u16* smem = (u16*)(smem_raw + half * SMEM_BYTES); const int vwave = __builtin_amdgcn_readfirstlane((_tf & 255) >> 6); (void)vwave; (void)nb; (void)bid; (void)smem;
#pragma unroll 1
  for (int l = 0; l < 2; l++) {
    const float* xsrc = l == 0 ? p.x_in : p.xout;
    const bool fusedn = gridDim.x == 256;
    if (l == 0 || !fusedn) norm_phase(xsrc, p.ffn1_norm + l * 1024, p.H);
    { VB_SETUP wprep_phase(p, l, smem, bid, nb, l == 1 && fusedn, fusedn); }
    if (l == 0) { grid.sync(); xb = xcd_barrier_post(p.bar, xb_words); } else xcd_barrier(xb);
    { Gemm g{p.H, p.w1t_a, 1024, 1024, S, 5632, 1024}; EpiSwiglu e{p.BIG}; gemm_phase(glds, g, e); }
    if (fusedn && blockIdx.x >= 128) {
      VB_SETUP
      wprep_matrix(p.ffn2_w1 + (size_t)l * 1024 * 5632, p.w1t_b, 1024, 5632, 1, smem, bid - 256, 256);
      wprep_matrix(p.ffn2_w2 + (size_t)l * FF * 1024, p.w2t_b, FF, 1024, 0, smem, bid - 256, 256);
    }
    xcd_barrier(xb);
    if (fusedn) {
      Gemm g{p.BIG, p.w2t_a, FF, FF, S, 1024, FF};
      EpiResidNorm<false> e{xsrc, p.xout, 0.5f, p.mix_norm + l * 1024, p.H, p.part + (size_t)(l * 2) * 65536, p.ncnt + (l * 2) * 64, p.bar};
      gemm_phase<EpiResidNorm<false>, true>(glds, g, e);
      xcd_barrier(xb);
    } else {
      { Gemm g{p.BIG, p.w2t_a, FF, FF, S, 1024, FF}; EpiResid e{xsrc, p.xout, 0.5f}; gemm_phase(glds, g, e); }
      xcd_barrier(xb);
      norm_phase(p.xout, p.mix_norm + l * 1024, p.H);
      xcd_barrier(xb);
    }
    { Gemm g{p.H, p.wint, 1024, 1024, S, 4096, 1024}; EpiProj e{p.BIG}; gemm_phase(glds, g, e); }
    xcd_barrier(xb);
    { VB_SETUP
    if (nb == 512) {
      if (bid < 128) { cmp_tile(p, l, bid, smem); ret_kv_tile(p, bid, smem); ret_kv_tile(p, 128 + bid, smem); }
      else {
        const int h2 = bid - 128;
        gmlp_tile(p, l, h2, smem);
        if (h2 < 128) { gmlp_tile(p, l, 384 + h2, smem); vt_tile(p, h2, smem); }
        else {
          const int ci = h2 - 128;
          ret_kv_tile(p, 256 + ci, smem);
          vt_tile(p, 128 + ci * 3, smem); vt_tile(p, 129 + ci * 3, smem); vt_tile(p, 130 + ci * 3, smem);
          if (ci < 128) vt_tile(p, 896 + ci, smem);
        }
      }
    } else {
    for (int t = bid; t < 128 + 512 + 512 + 1024; t += nb) {
      if (t < 128) cmp_tile(p, l, t, smem);
      else if (t < 640) gmlp_tile(p, l, t - 128, smem);
      else if (t < 1152) ret_kv_tile(p, t - 640, smem);
      else vt_tile(p, t - 1152, smem);
    } } }
    xcd_barrier(xb);
    {
      const int tf = tid_fresh();
      const int wv = __builtin_amdgcn_readfirstlane(tf >> 6);
      ret_scan_wg(p, smem_raw);
      const int xcd = blockIdx.x & 7, slot = blockIdx.x >> 3, nslot = gridDim.x >> 3;
      for (int i = slot; i < 128; i += nslot) {
        const int rsel = i >> 6, j = i & 63;
        const int range = rsel == 0 ? 15 - xcd : xcd;
        const int g = (j ^ (j >> 5)) & 1, w = range * 32 + 31 - (j >> 1);
        nsa_wg(p, g, w * 32, smem_raw);
      }
    }
    xcd_barrier(xb);
    { VB_SETUP for (int t = bid; t < 512; t += nb) ret_out_tile(p, l, t, smem); }
    xcd_barrier(xb);
    gemm_merge_chain(glds, p, l);
    xcd_barrier(xb);
    if (fusedn) {
      Gemm g{p.BIG + C_MIX, p.wot, PS, 1024, S, 1024, 1024};
      EpiResidNorm<false> e{p.xout, p.xout, 1.0f, p.ffn2_norm + l * 1024, p.H, p.part + (size_t)(l * 2 + 1) * 65536, p.ncnt + (l * 2 + 1) * 64, p.bar};
      gemm_phase<EpiResidNorm<false>, true>(glds, g, e);
      xcd_barrier(xb);
    } else {
      { Gemm g{p.BIG + C_MIX, p.wot, PS, 1024, S, 1024, 1024}; EpiResid e{p.xout, p.xout, 1.0f}; gemm_phase(glds, g, e); }
      xcd_barrier(xb);
      norm_phase(p.xout, p.ffn2_norm + l * 1024, p.H);
      xcd_barrier(xb);
    }
    { Gemm g{p.H, p.w1t_b, 1024, 1024, S, 5632, 1024}; EpiSwiglu e{p.BIG}; gemm_phase(glds, g, e); }
    if (l == 0 && fusedn && blockIdx.x >= 128) {
      VB_SETUP
      wprep_matrix(p.ffn1_w1 + (size_t)1024 * 5632, p.w1t_a, 1024, 5632, 1, smem, bid - 256, 256);
      wprep_matrix(p.ffn1_w2 + (size_t)FF * 1024, p.w2t_a, FF, 1024, 0, smem, bid - 256, 256);
    }
    xcd_barrier(xb);
    if (fusedn && l == 0) {
      Gemm g{p.BIG, p.w2t_b, FF, FF, S, 1024, FF};
      EpiResidNorm<false> e{p.xout, p.xout, 0.5f, p.ffn1_norm + 1024, p.H, p.part + (size_t)4 * 65536, p.ncnt + 4 * 64, p.bar};
      gemm_phase<EpiResidNorm<false>, true>(glds, g, e);
      xcd_barrier(xb);
    } else if (fusedn) {
      Gemm g{p.BIG, p.w2t_b, FF, FF, S, 1024, FF};
      EpiResidNorm<true> e{p.xout, p.xout, 0.5f, p.final_norm, p.H, p.part + (size_t)5 * 65536, p.ncnt + 5 * 64, p.bar};
      gemm_phase<EpiResidNorm<true>, true>(glds, g, e);
    } else {
      { Gemm g{p.BIG, p.w2t_b, FF, FF, S, 1024, FF}; EpiResid e{p.xout, p.xout, 0.5f}; gemm_phase(glds, g, e); }
      xcd_barrier(xb);
      if (l == 1) final_norm_phase(p.xout, p.final_norm);
    }
  }
}

extern "C" void kernel_launch(void* const* d_in, const int* in_sizes, int n_in, void* d_out, int out_size, void* d_ws,
                              size_t ws_size, hipStream_t stream) {
  static int grid_blocks = 0;
  if (!grid_blocks) {
    int dev = 0, cus = 0, per_cu = 0;
    (void)hipGetDevice(&dev);
    (void)hipDeviceGetAttribute(&cus, hipDeviceAttributeMultiprocessorCount, dev);
    (void)hipOccupancyMaxActiveBlocksPerMultiprocessor(&per_cu, mega, 512, 0);
    if (per_cu > 1) per_cu = 1;
    if (per_cu < 1) per_cu = 1;
    grid_blocks = cus * per_cu;
    grid_blocks &= ~7;
  }
  Params p{};
  p.x_in = (const float*)d_in[0];
  p.ffn1_norm = (const float*)d_in[1]; p.ffn1_w1 = (const float*)d_in[2]; p.ffn1_w2 = (const float*)d_in[3];
  p.mix_norm = (const float*)d_in[4]; p.w_in = (const float*)d_in[5]; p.gm_ln_g = (const float*)d_in[6];
  p.gm_ln_b = (const float*)d_in[7]; p.gm_ws = (const float*)d_in[8]; p.gm_bs = (const float*)d_in[9];
  p.ret_gn_g = (const float*)d_in[10]; p.ret_gn_b = (const float*)d_in[11]; p.cmp_pos = (const float*)d_in[12];
  p.cmp_w1 = (const float*)d_in[13]; p.cmp_w2 = (const float*)d_in[14]; p.w_branch = (const float*)d_in[15];
  p.w_gate = (const float*)d_in[16]; p.b_gate = (const float*)d_in[17]; p.w_o = (const float*)d_in[18];
  p.ffn2_norm = (const float*)d_in[19]; p.ffn2_w1 = (const float*)d_in[20]; p.ffn2_w2 = (const float*)d_in[21];
  p.final_norm = (const float*)d_in[22];
  p.xout = (float*)d_out;
  char* w = (char*)d_ws;
  auto take = [&](size_t bytes) { char* r = w; w += (bytes + 255) & ~(size_t)255; return r; };
  p.w1t_a = (u16*)take((size_t)5632 * 1024 * 2);
  p.w1t_b = (u16*)take((size_t)5632 * 1024 * 2);
  p.w2t_a = (u16*)take((size_t)1024 * FF * 2);
  p.w2t_b = (u16*)take((size_t)1024 * FF * 2);
  p.wint = (u16*)take((size_t)4096 * 1024 * 2);
  p.wgt = (u16*)take((size_t)3072 * 1024 * 2);
  p.wbt = (u16*)take((size_t)3 * 1024 * 512 * 2);
  p.wot = (u16*)take((size_t)1024 * 1024 * 2);
  p.cw1t = (u16*)take((size_t)2 * 128 * 2048 * 2);
  p.cw2t = (u16*)take((size_t)2 * 64 * 128 * 2);
  p.H = (u16*)take((size_t)S * 1024 * 2);
  p.BIG = (u16*)take((size_t)S * PS * 2);
  p.vsT = (u16*)take((size_t)2 * 64 * S * 2);
  p.vwT = (u16*)take((size_t)2 * 64 * S * 2);
  p.kc = (u16*)take((size_t)2 * 1024 * 64 * 2);
  p.vcT = (u16*)take((size_t)2 * 64 * 1024 * 2);
  p.ret = (float*)take((size_t)128 * 4 * 8192 * 4);
  p.gst = (u16*)take((size_t)256 * 65536 * 2);
  p.bar = (unsigned*)take((size_t)XCD_BAR_WORDS * 4);
  p.part = (float*)take((size_t)6 * 64 * 4 * 256 * 4);
  p.ncnt = (unsigned*)take((size_t)6 * 64 * 4);
  if ((size_t)(w - (char*)d_ws) > ws_size) { fprintf(stderr, "workspace too small: need %zu have %zu\n", (size_t)(w - (char*)d_ws), ws_size); return; }
  void* args[] = {&p};
  hipError_t e = hipLaunchCooperativeKernel((void*)mega, dim3(grid_blocks), dim3(512), args, 0, stream);
  if (e != hipSuccess) fprintf(stderr, "coop launch failed: %s (grid %d)\n", hipGetErrorString(e), grid_blocks);
}
```
